# Optimizing an MI355X kernel written in HIP

```python
import math
import jax, jax.numpy as jnp
from jax import lax
import numpy as np


D_MODEL = 1024
BATCH = 8
SEQ = 4096
DEPTH = 4

CHUNK = 64
N_META = 16
Q_BLOCK = 128
D_MIX = D_MODEL
NORM_EPS = 1e-6
SUBLN_EPS = 1e-5
NEG = -1e30

FOX_HEADS = 4
FOX_HD = D_MODEL // 16
FOX_W = FOX_HEADS * FOX_HD
FORGET_BIAS_CENTER = 3.0

DIFF_HEADS = 4
DIFF_HD = D_MODEL // 16
DIFF_VD = 2 * DIFF_HD
DIFF_W = DIFF_HEADS * DIFF_VD
ALIBI_SLOPES = tuple(2.0 ** (-8.0 * (h + 1) / DIFF_HEADS) for h in range(DIFF_HEADS))

POOL_WINDOWS = (2, 4, 8, 16)
POOL_GROUPS = len(POOL_WINDOWS)
POOL_W = D_MIX - FOX_W - DIFF_W
POOL_GD = POOL_W // POOL_GROUPS

IN_SIZES = (FOX_W, FOX_W, FOX_W, FOX_W, FOX_HEADS,
            2 * DIFF_HEADS * DIFF_HD, 2 * DIFF_HEADS * DIFF_HD, DIFF_W, DIFF_W,
            POOL_W, POOL_W)
IN_DIM = sum(IN_SIZES)
IN_OFFSETS = tuple(int(o) for o in np.cumsum(IN_SIZES)[:-1])

kernel_name = 'hymba_fox_diff_pool_chunk_causal'


def rmsnorm(x, g, eps=NORM_EPS):
    xf = x.astype(jnp.float32)
    y = xf * lax.rsqrt(jnp.mean(xf * xf, axis=-1, keepdims=True) + eps) * g.astype(jnp.float32)
    return y.astype(x.dtype)


def chunk_ids(pos):
    return jnp.where(pos < N_META, 0, 1 + (pos - N_META) // CHUNK)


def chunk_end(p):
    return N_META + CHUNK * ((p - N_META) // CHUNK + 1)


def forgetting_attention(q, k, v, c):
    Lp = q.shape[1]
    pos = jnp.arange(Lp)
    scale = FOX_HD ** -0.5
    outs = []
    for q0 in range(0, Lp, Q_BLOCK):
        q1 = q0 + Q_BLOCK
        kend = q1
        s = jnp.einsum('bqhd,bkhd->bhqk', q[:, q0:q1], k[:, :kend]).astype(jnp.float32) * scale
        s = s + c[:, :, q0:q1, None] - c[:, :, None, :kend]
        mask = pos[None, :kend] <= pos[q0:q1, None]
        p = jax.nn.softmax(jnp.where(mask, s, NEG), axis=-1).astype(v.dtype)
        outs.append(jnp.einsum('bhqk,bkhd->bqhd', p, v[:, :kend]))
    return jnp.concatenate(outs, axis=1)


def differential_attention(q, k, v, lam):
    Lp = q.shape[1]
    pos = jnp.arange(Lp)
    chunk = chunk_ids(pos)
    slopes = jnp.asarray(ALIBI_SLOPES, jnp.float32)
    scale = DIFF_HD ** -0.5
    outs = []
    for q0 in range(0, Lp, Q_BLOCK):
        q1 = q0 + Q_BLOCK
        kend = min(Lp, chunk_end(q1 - 1))
        s = jnp.einsum('bqhcd,bkhcd->bchqk', q[:, q0:q1], k[:, :kend]).astype(jnp.float32) * scale
        dist = jnp.abs(pos[q0:q1, None] - pos[None, :kend]).astype(jnp.float32)
        s = s - slopes[:, None, None] * dist
        mask = chunk[None, :kend] <= chunk[q0:q1, None]
        p = jax.nn.softmax(jnp.where(mask, s, NEG), axis=-1)
        w = (p[:, 0] - lam * p[:, 1]).astype(v.dtype)
        outs.append(jnp.einsum('bhqk,bkhe->bqhe', w, v[:, :kend]))
    return jnp.concatenate(outs, axis=1)


def pooling_mixer(u, w_pool, pool_scale):
    B, Lp, _ = u.shape
    uf = u.astype(jnp.float32).reshape(B, Lp, POOL_GROUPS, POOL_GD)
    cs = jnp.cumsum(uf, axis=1)
    cs0 = jnp.pad(cs, ((0, 0), (1, 0), (0, 0), (0, 0)))
    t = jnp.arange(Lp)
    win = jnp.asarray(POOL_WINDOWS)
    lo = jnp.maximum(t[:, None] + 1 - win[None, :], 0)
    lower = cs0[:, lo, jnp.arange(POOL_GROUPS)[None, :]]
    cnt = (t[:, None] + 1 - lo).astype(jnp.float32)
    pooled = (cs - lower) / cnt[None, :, :, None] - uf
    y = jnp.einsum('blgc,gcd->blgd', pooled.astype(u.dtype), w_pool)
    return y.reshape(B, Lp, POOL_W) * pool_scale


def setup_inputs(seed: int = 0) -> dict:
    key = jax.random.key(seed)
    ks = jax.random.split(key, 14)
    f32 = jnp.float32
    x = jax.random.normal(ks[0], (BATCH, SEQ, D_MODEL), f32)
    meta_tokens = jax.random.normal(ks[1], (N_META, D_MODEL), f32)
    norm_g = 1.0 + 0.02 * jax.random.normal(ks[2], (DEPTH, D_MODEL), f32)
    w_in = jax.random.normal(ks[3], (DEPTH, D_MODEL, IN_DIM), f32) * D_MODEL ** -0.5
    b_f = FORGET_BIAS_CENTER + 0.5 * jax.random.normal(ks[4], (DEPTH, FOX_HEADS), f32)
    lam_q1 = 0.1 * jax.random.normal(ks[5], (DEPTH, DIFF_HD), f32)
    lam_k1 = 0.1 * jax.random.normal(ks[6], (DEPTH, DIFF_HD), f32)
    lam_q2 = 0.1 * jax.random.normal(ks[7], (DEPTH, DIFF_HD), f32)
    lam_k2 = 0.1 * jax.random.normal(ks[8], (DEPTH, DIFF_HD), f32)
    subln_g = 1.0 + 0.02 * jax.random.normal(ks[9], (DEPTH, DIFF_VD), f32)
    w_pool = jax.random.normal(ks[10], (DEPTH, POOL_GROUPS, POOL_GD, POOL_GD), f32) * POOL_GD ** -0.5
    pool_scale = 1.0 + 0.1 * jax.random.normal(ks[11], (DEPTH, POOL_W), f32)
    w_out = jax.random.normal(ks[12], (DEPTH, D_MIX, D_MODEL), f32) * D_MIX ** -0.5
    final_g = 1.0 + 0.02 * jax.random.normal(ks[13], (D_MODEL,), f32)
    return {'x': x, 'meta_tokens': meta_tokens, 'norm_g': norm_g, 'w_in': w_in, 'b_f': b_f,
            'lam_q1': lam_q1, 'lam_k1': lam_k1, 'lam_q2': lam_q2, 'lam_k2': lam_k2,
            'subln_g': subln_g, 'w_pool': w_pool, 'pool_scale': pool_scale,
            'w_out': w_out, 'final_g': final_g}


def reference(x, meta_tokens, norm_g, w_in, b_f, lam_q1, lam_k1, lam_q2, lam_k2,
              subln_g, w_pool, pool_scale, w_out, final_g):
    B, S, D = x.shape
    L = N_META + S
    Lp = -(-L // Q_BLOCK) * Q_BLOCK
    meta = jnp.broadcast_to(meta_tokens.astype(x.dtype)[None], (B, N_META, D))
    h = jnp.concatenate([meta, x], axis=1)
    h = jnp.pad(h, ((0, 0), (0, Lp - L), (0, 0)))
    for l in range(DEPTH):
        hn = rmsnorm(h, norm_g[l])
        proj = jnp.einsum('bld,de->ble', hn, w_in[l])
        fq, fk, fv, fz, fg, dq, dk, dv, dz, pu, pz = jnp.split(proj, IN_OFFSETS, axis=-1)

        log_f = jax.nn.log_sigmoid(fg.astype(jnp.float32) + b_f[l].astype(jnp.float32))
        c = jnp.transpose(jnp.cumsum(log_f, axis=1), (0, 2, 1))
        a_out = forgetting_attention(fq.reshape(B, Lp, FOX_HEADS, FOX_HD),
                                     fk.reshape(B, Lp, FOX_HEADS, FOX_HD),
                                     fv.reshape(B, Lp, FOX_HEADS, FOX_HD), c)
        a_out = a_out.reshape(B, Lp, FOX_W) * jax.nn.silu(fz)

        lambda_init = 0.8 - 0.6 * math.exp(-0.3 * l)
        lam = (jnp.exp(jnp.sum(lam_q1[l].astype(jnp.float32) * lam_k1[l].astype(jnp.float32)))
               - jnp.exp(jnp.sum(lam_q2[l].astype(jnp.float32) * lam_k2[l].astype(jnp.float32)))
               + lambda_init)
        b_out = differential_attention(dq.reshape(B, Lp, DIFF_HEADS, 2, DIFF_HD),
                                       dk.reshape(B, Lp, DIFF_HEADS, 2, DIFF_HD),
                                       dv.reshape(B, Lp, DIFF_HEADS, DIFF_VD), lam)
        b_out = rmsnorm(b_out, subln_g[l], SUBLN_EPS) * (1.0 - lambda_init)
        b_out = b_out.reshape(B, Lp, DIFF_W) * jax.nn.silu(dz)

        c_out = pooling_mixer(pu, w_pool[l], pool_scale[l]) * jax.nn.silu(pz)

        mix = jnp.concatenate([a_out, b_out, c_out], axis=-1)
        h = h + jnp.einsum('ble,ed->bld', mix, w_out[l])
    y = rmsnorm(h[:, N_META:N_META + S], final_g)
    return y
```

```cpp
#include <hip/hip_runtime.h>
#include <stdint.h>

typedef unsigned short bf16_t;
__device__ __forceinline__ float bf2f(bf16_t v) { return __uint_as_float(((unsigned)v) << 16); }
__device__ __forceinline__ bf16_t f2bf(float f) { unsigned u = __float_as_uint(f); return (bf16_t)((u + 0x7fffu + ((u >> 16) & 1u)) >> 16); }

constexpr int BATCH = 8, SEQ = 4096, DM = 1024, DEPTH = 4, NMETA = 16;
constexpr int MR = BATCH * SEQ;
constexpr int MT = MR + NMETA;
constexpr int IN_DIM = 3588, NP = 3584;
constexpr int C_FQ = 0, C_FK = 256, C_FV = 512, C_FZ = 768, C_DQ = 1024, C_DK = 1536, C_DV = 2048, C_DZ = 2560, C_PU = 3072, C_PZ = 3328;
constexpr int M_A = 0, M_B = 256, M_C = 768;

constexpr size_t MiB = 1u << 20;
constexpr size_t WS_CTL = 0;
constexpr size_t WS_W1T = 2 * MiB;
constexpr size_t WS_W2T = 30 * MiB;
constexpr size_t WS_WFG = 38 * MiB;
constexpr size_t WS_LAM = 38 * MiB + 65536;
constexpr size_t WS_HM  = 38 * MiB + 131072;
constexpr size_t WS_LOGF = 39 * MiB;
constexpr size_t WS_CUM = 40 * MiB;
constexpr size_t WS_HB = 42 * MiB;
constexpr size_t WS_MIX = 108 * MiB;
constexpr size_t WS_PROJ = 174 * MiB;
constexpr size_t WS_END = 400 * MiB;

__global__ void k_prep(const float* __restrict__ w_in, const float* __restrict__ w_out, const float* __restrict__ norm_g,
                       const float* lq1, const float* lk1, const float* lq2, const float* lk2,
                       bf16_t* W1T, bf16_t* W2T, float* WFG, float* LAM) {
    size_t tid = (size_t)blockIdx.x * blockDim.x + threadIdx.x, nth = (size_t)gridDim.x * blockDim.x;
    const size_t n1 = (size_t)DEPTH * 1024 * NP;
    for (size_t i = tid; i < n1; i += nth) {
        int n = (int)(i % NP); size_t r = i / NP; int k = (int)(r % 1024); int l = (int)(r / 1024);
        int rc = n < 1024 ? n : n + 4;
        float v = w_in[((size_t)l * 1024 + k) * IN_DIM + rc] * norm_g[l * 1024 + k];
        W1T[((size_t)l * NP + n) * 1024 + k] = f2bf(v);
    }
    const size_t n2 = (size_t)DEPTH * 1024 * 1024;
    for (size_t i = tid; i < n2; i += nth) {
        int n = (int)(i % 1024); size_t r = i / 1024; int k = (int)(r % 1024); int l = (int)(r / 1024);
        W2T[((size_t)l * 1024 + n) * 1024 + k] = f2bf(w_out[i]);
    }
    const size_t n3 = (size_t)DEPTH * 1024 * 4;
    for (size_t i = tid; i < n3; i += nth) {
        int c = (int)(i % 4); size_t r = i / 4; int k = (int)(r % 1024); int l = (int)(r / 1024);
        WFG[((size_t)l * 4 + c) * 1024 + k] = w_in[((size_t)l * 1024 + k) * IN_DIM + 1024 + c] * norm_g[l * 1024 + k];
    }
    if (tid < DEPTH) {
        int l = (int)tid; float s1 = 0.f, s2 = 0.f;
        for (int i = 0; i < 64; ++i) { s1 += lq1[l * 64 + i] * lk1[l * 64 + i]; s2 += lq2[l * 64 + i] * lk2[l * 64 + i]; }
        float li = 0.8f - 0.6f * expf(-0.3f * (float)l);
        LAM[l] = expf(s1) - expf(s2) + li;
    }
}

__device__ __forceinline__ float wave_sum(float v) {
#pragma unroll
    for (int o = 1; o < 64; o <<= 1) v += __shfl_xor(v, o);
    return v;
}
__device__ __forceinline__ float log_sigmoid(float x) { return fminf(x, 0.f) - log1pf(expf(-fabsf(x))); }
__device__ __forceinline__ float silu(float x) { return x / (1.f + expf(-x)); }

__global__ __launch_bounds__(256) void k_norm(const float* __restrict__ hreal, const float* __restrict__ hmeta, const float* __restrict__ WFG_l,
                                              const float* __restrict__ bf_l, bf16_t* HB, float* LOGF) {
    int row = (blockIdx.x * 256 + threadIdx.x) >> 6, lane = threadIdx.x & 63;
    if (row >= MT) return;
    const float* hp = row < MR ? hreal + (size_t)row * DM : hmeta + (size_t)(row - MR) * DM;
    float4 v[4]; float ss = 0.f;
#pragma unroll
    for (int j = 0; j < 4; ++j) { v[j] = *(const float4*)(hp + j * 256 + lane * 4); ss += v[j].x * v[j].x + v[j].y * v[j].y + v[j].z * v[j].z + v[j].w * v[j].w; }
    ss = wave_sum(ss);
    float rstd = rsqrtf(ss * (1.f / DM) + 1e-6f);
    float fg[4];
#pragma unroll
    for (int c = 0; c < 4; ++c) {
        float a = 0.f;
#pragma unroll
        for (int j = 0; j < 4; ++j) { float4 w = *(const float4*)(WFG_l + c * 1024 + j * 256 + lane * 4); a += v[j].x * w.x + v[j].y * w.y + v[j].z * w.z + v[j].w * w.w; }
        fg[c] = wave_sum(a) * rstd;
    }
#pragma unroll
    for (int j = 0; j < 4; ++j) {
        ushort4 o; o.x = f2bf(v[j].x * rstd); o.y = f2bf(v[j].y * rstd); o.z = f2bf(v[j].z * rstd); o.w = f2bf(v[j].w * rstd);
        *(ushort4*)(HB + (size_t)row * DM + j * 256 + lane * 4) = o;
    }
    if (lane < 4) LOGF[row * 4 + lane] = log_sigmoid(fg[lane] + bf_l[lane]);
}

__global__ void k_scan(const float* __restrict__ LOGF, float* CUM) {
    int t = blockIdx.x * blockDim.x + threadIdx.x;
    if (t < 32) {
        int b = t >> 2, h = t & 3; float c = 0.f;
        for (int s = 0; s < SEQ; ++s) { c += LOGF[(size_t)(b * SEQ + s) * 4 + h]; CUM[(size_t)(b * SEQ + s) * 4 + h] = c; }
    } else if (t < 36) {
        int h = t - 32; float c = 0.f;
        for (int j = 15; j >= 0; --j) { CUM[(size_t)(MR + j) * 4 + h] = -c; c += LOGF[(size_t)(MR + j) * 4 + h]; }
    }
}

template <int MODE>
__global__ __launch_bounds__(256) void k_gemm(const bf16_t* __restrict__ A, const bf16_t* __restrict__ Bt, int M, int N, int K, bf16_t* Cb, int ldc,
                                              const float* base_real, const float* base_meta, float* out_real, float* out_meta) {
    __shared__ float As[16][132];
    __shared__ float Bs[16][132];
    const int bm = blockIdx.y * 128, bn = blockIdx.x * 128, tid = threadIdx.x, tx = tid & 15, ty = tid >> 4;
    float acc[8][8];
#pragma unroll
    for (int i = 0; i < 8; ++i)
#pragma unroll
        for (int j = 0; j < 8; ++j) acc[i][j] = 0.f;
    const int lr = tid >> 1, lk = (tid & 1) * 8;
    for (int k0 = 0; k0 < K; k0 += 16) {
        const int ar = bm + lr;
        uint4 av = make_uint4(0, 0, 0, 0);
        if (ar < M) av = *(const uint4*)(A + (size_t)ar * K + k0 + lk);
        uint4 bv = *(const uint4*)(Bt + (size_t)(bn + lr) * K + k0 + lk);
        const unsigned aw[4] = {av.x, av.y, av.z, av.w}, bw[4] = {bv.x, bv.y, bv.z, bv.w};
#pragma unroll
        for (int j = 0; j < 4; ++j) {
            As[lk + 2 * j][lr] = __uint_as_float(aw[j] << 16); As[lk + 2 * j + 1][lr] = __uint_as_float(aw[j] & 0xffff0000u);
            Bs[lk + 2 * j][lr] = __uint_as_float(bw[j] << 16); Bs[lk + 2 * j + 1][lr] = __uint_as_float(bw[j] & 0xffff0000u);
        }
        __syncthreads();
#pragma unroll
        for (int kk = 0; kk < 16; ++kk) {
            float a[8], b[8];
#pragma unroll
            for (int i = 0; i < 8; ++i) { a[i] = As[kk][ty * 8 + i]; b[i] = Bs[kk][tx * 8 + i]; }
#pragma unroll
            for (int i = 0; i < 8; ++i)
#pragma unroll
                for (int j = 0; j < 8; ++j) acc[i][j] += a[i] * b[j];
        }
        __syncthreads();
    }
#pragma unroll
    for (int i = 0; i < 8; ++i) {
        const int r = bm + ty * 8 + i;
        if (r >= M) continue;
        const int c0 = bn + tx * 8;
        if (MODE == 0) {
#pragma unroll
            for (int j = 0; j < 8; ++j) Cb[(size_t)r * ldc + c0 + j] = f2bf(acc[i][j]);
        } else {
            const float* bp = r < MR ? base_real + (size_t)r * 1024 : base_meta + (size_t)(r - MR) * 1024;
            float* op = r < MR ? out_real + (size_t)r * 1024 : out_meta + (size_t)(r - MR) * 1024;
#pragma unroll
            for (int j = 0; j < 8; ++j) op[c0 + j] = bp[c0 + j] + acc[i][j];
        }
    }
}

__global__ __launch_bounds__(256) void k_fox(const bf16_t* __restrict__ PROJ, const float* __restrict__ CUM, bf16_t* MIX) {
    const int gw = (blockIdx.x * 256 + threadIdx.x) >> 6, lane = threadIdx.x & 63;
    const int h = gw & 3, grp = gw >> 2;
    if (grp >= 513) return;
    const bool meta = grp == 512;
    const bool valid = !meta || lane < 16;
    const int row = meta ? MR + (lane & 15) : grp * 64 + lane;
    const int b = meta ? 0 : (grp * 64) / SEQ;
    const int t0 = meta ? 0 : (grp * 64) % SEQ;
    const int t = meta ? (lane & 15) : t0 + lane;
    float q[64], o[64];
    const bf16_t* qp = PROJ + (size_t)row * NP + C_FQ + h * 64;
#pragma unroll
    for (int d = 0; d < 64; ++d) { q[d] = bf2f(qp[d]) * 0.125f; o[d] = 0.f; }
    const float cq = CUM[(size_t)row * 4 + h];
    float m = -1e30f, lsum = 0.f;
    const int nkeys = meta ? 16 : 16 + t0 + 64;
    for (int kk = 0; kk < nkeys; ++kk) {
        int krow; bool vis;
        if (kk < 16) { krow = MR + kk; vis = meta ? (kk <= t) : true; }
        else { const int s = kk - 16; krow = b * SEQ + s; vis = s <= t; }
        const bf16_t* kp = PROJ + (size_t)krow * NP + C_FK + h * 64;
        const bf16_t* vp = PROJ + (size_t)krow * NP + C_FV + h * 64;
        float sc = 0.f;
#pragma unroll
        for (int d = 0; d < 64; ++d) sc += q[d] * bf2f(kp[d]);
        sc += cq - CUM[(size_t)krow * 4 + h];
        if (vis) {
            if (sc > m) { const float a = __expf(m - sc); lsum *= a;
#pragma unroll
                for (int d = 0; d < 64; ++d) o[d] *= a;
                m = sc; }
            const float p = __expf(sc - m); lsum += p;
#pragma unroll
            for (int d = 0; d < 64; ++d) o[d] += p * bf2f(vp[d]);
        }
    }
    if (!valid) return;
    const float inv = 1.f / lsum;
    const bf16_t* zp = PROJ + (size_t)row * NP + C_FZ + h * 64;
    bf16_t* mp = MIX + (size_t)row * DM + M_A + h * 64;
#pragma unroll
    for (int d = 0; d < 64; ++d) mp[d] = f2bf(o[d] * inv * silu(bf2f(zp[d])));
}

__global__ __launch_bounds__(256) void k_diff(const bf16_t* __restrict__ PROJ, const float* __restrict__ subln_g_l, const float* __restrict__ LAM, int layer, bf16_t* MIX) {
    const int gw = (blockIdx.x * 256 + threadIdx.x) >> 6, lane = threadIdx.x & 63;
    const int h = gw & 3, grp = gw >> 2;
    if (grp >= 1025) return;
    const bool meta = grp == 1024;
    const int ri = lane >> 1, eh = lane & 1;
    const bool valid = !meta || ri < 16;
    const int row = meta ? MR + (ri & 15) : grp * 32 + ri;
    const int b = meta ? 0 : (grp * 32) / SEQ;
    const int t0 = meta ? 0 : (grp * 32) % SEQ;
    const int t = meta ? (ri & 15) : t0 + ri;
    const float posq = meta ? (float)t : (float)(16 + t);
    const float slope = exp2f(-8.f * (float)(h + 1) / 4.f);
    const int nkeys = meta ? 16 : 16 + 64 * (t0 / 64 + 1);
    const float lam = LAM[layer];
    float res[64];
    for (int c = 0; c < 2; ++c) {
        float q[64], o[64];
        const bf16_t* qp = PROJ + (size_t)row * NP + C_DQ + h * 128 + c * 64;
#pragma unroll
        for (int d = 0; d < 64; ++d) { q[d] = bf2f(qp[d]) * 0.125f; o[d] = 0.f; }
        float m = -1e30f, lsum = 0.f;
        for (int kk = 0; kk < nkeys; ++kk) {
            int krow; float posk;
            if (kk < 16) { krow = MR + kk; posk = (float)kk; }
            else { const int s = kk - 16; krow = b * SEQ + s; posk = (float)(16 + s); }
            const bf16_t* kp = PROJ + (size_t)krow * NP + C_DK + h * 128 + c * 64;
            const bf16_t* vp = PROJ + (size_t)krow * NP + C_DV + h * 128 + eh * 64;
            float sc = 0.f;
#pragma unroll
            for (int d = 0; d < 64; ++d) sc += q[d] * bf2f(kp[d]);
            sc -= slope * fabsf(posq - posk);
            if (sc > m) { const float a = __expf(m - sc); lsum *= a;
#pragma unroll
                for (int d = 0; d < 64; ++d) o[d] *= a;
                m = sc; }
            const float p = __expf(sc - m); lsum += p;
#pragma unroll
            for (int d = 0; d < 64; ++d) o[d] += p * bf2f(vp[d]);
        }
        const float inv = 1.f / lsum;
        if (c == 0) {
#pragma unroll
            for (int d = 0; d < 64; ++d) res[d] = o[d] * inv;
        } else {
#pragma unroll
            for (int d = 0; d < 64; ++d) res[d] -= lam * o[d] * inv;
        }
    }
    float ss = 0.f;
#pragma unroll
    for (int d = 0; d < 64; ++d) ss += res[d] * res[d];
    ss += __shfl_xor(ss, 1);
    const float rstd = rsqrtf(ss * (1.f / 128.f) + 1e-5f);
    const float li = 0.8f - 0.6f * expf(-0.3f * (float)layer);
    if (!valid) return;
    const bf16_t* zp = PROJ + (size_t)row * NP + C_DZ + h * 128 + eh * 64;
    bf16_t* mp = MIX + (size_t)row * DM + M_B + h * 128 + eh * 64;
#pragma unroll
    for (int d = 0; d < 64; ++d) mp[d] = f2bf(res[d] * rstd * subln_g_l[eh * 64 + d] * (1.f - li) * silu(bf2f(zp[d])));
}

__global__ __launch_bounds__(256) void k_pool(const bf16_t* __restrict__ PROJ, const float* __restrict__ wpool_l, const float* __restrict__ pscale_l, bf16_t* MIX) {
    __shared__ float pooled[4][64];
    const int row = blockIdx.x, g = threadIdx.x >> 6, c = threadIdx.x & 63;
    const bool meta = row >= MR;
    const int b = meta ? 0 : row / SEQ, t = meta ? row - MR : row % SEQ;
    const int pos = meta ? t : 16 + t;
    const int w = 2 << g;
    const int cnt = (pos + 1) < w ? (pos + 1) : w;
    float s = 0.f;
    for (int i = 0; i < cnt; ++i) {
        const int p = pos - i;
        const int r = p < 16 ? MR + p : b * SEQ + (p - 16);
        s += bf2f(PROJ[(size_t)r * NP + C_PU + g * 64 + c]);
    }
    pooled[g][c] = s / (float)cnt - bf2f(PROJ[(size_t)row * NP + C_PU + g * 64 + c]);
    __syncthreads();
    float y = 0.f;
    for (int i = 0; i < 64; ++i) y += pooled[g][i] * wpool_l[(g * 64 + i) * 64 + c];
    const float z = bf2f(PROJ[(size_t)row * NP + C_PZ + g * 64 + c]);
    MIX[(size_t)row * DM + M_C + g * 64 + c] = f2bf(y * pscale_l[g * 64 + c] * silu(z));
}

__global__ __launch_bounds__(256) void k_final(float* H, const float* __restrict__ final_g) {
    int row = (blockIdx.x * 256 + threadIdx.x) >> 6, lane = threadIdx.x & 63;
    if (row >= MR) return;
    float* hp = H + (size_t)row * DM;
    float4 v[4]; float ss = 0.f;
#pragma unroll
    for (int j = 0; j < 4; ++j) { v[j] = *(const float4*)(hp + j * 256 + lane * 4); ss += v[j].x * v[j].x + v[j].y * v[j].y + v[j].z * v[j].z + v[j].w * v[j].w; }
    ss = wave_sum(ss);
    const float rstd = rsqrtf(ss * (1.f / DM) + 1e-6f);
#pragma unroll
    for (int j = 0; j < 4; ++j) {
        const float4 g = *(const float4*)(final_g + j * 256 + lane * 4);
        float4 o; o.x = v[j].x * rstd * g.x; o.y = v[j].y * rstd * g.y; o.z = v[j].z * rstd * g.z; o.w = v[j].w * rstd * g.w;
        *(float4*)(hp + j * 256 + lane * 4) = o;
    }
}

extern "C" void kernel_launch(void* const* d_in, const int* in_sizes, int n_in, void* d_out, int out_size, void* d_ws, size_t ws_size, hipStream_t stream) {
    const float* x = (const float*)d_in[0];
    const float* meta_tokens = (const float*)d_in[1];
    const float* norm_g = (const float*)d_in[2];
    const float* w_in = (const float*)d_in[3];
    const float* b_f = (const float*)d_in[4];
    const float* lq1 = (const float*)d_in[5];
    const float* lk1 = (const float*)d_in[6];
    const float* lq2 = (const float*)d_in[7];
    const float* lk2 = (const float*)d_in[8];
    const float* subln_g = (const float*)d_in[9];
    const float* w_pool = (const float*)d_in[10];
    const float* pool_scale = (const float*)d_in[11];
    const float* w_out = (const float*)d_in[12];
    const float* final_g = (const float*)d_in[13];
    unsigned char* ws = (unsigned char*)d_ws;
    bf16_t* W1T = (bf16_t*)(ws + WS_W1T); bf16_t* W2T = (bf16_t*)(ws + WS_W2T);
    float* WFG = (float*)(ws + WS_WFG); float* LAM = (float*)(ws + WS_LAM); float* HM = (float*)(ws + WS_HM);
    float* LOGF = (float*)(ws + WS_LOGF); float* CUM = (float*)(ws + WS_CUM);
    bf16_t* HB = (bf16_t*)(ws + WS_HB); bf16_t* MIX = (bf16_t*)(ws + WS_MIX); bf16_t* PROJ = (bf16_t*)(ws + WS_PROJ);
    float* H = (float*)d_out;

    hipLaunchKernelGGL(k_prep, dim3(2048), dim3(256), 0, stream, w_in, w_out, norm_g, lq1, lk1, lq2, lk2, W1T, W2T, WFG, LAM);
    for (int l = 0; l < DEPTH; ++l) {
        const float* hreal = l == 0 ? x : H;
        const float* hmeta = l == 0 ? meta_tokens : HM;
        hipLaunchKernelGGL(k_norm, dim3((MT * 64 + 255) / 256), dim3(256), 0, stream, hreal, hmeta, WFG + (size_t)l * 4096, b_f + l * 4, HB, LOGF);
        hipLaunchKernelGGL(k_scan, dim3(1), dim3(64), 0, stream, LOGF, CUM);
        hipLaunchKernelGGL(k_gemm<0>, dim3(NP / 128, (MT + 127) / 128), dim3(256), 0, stream, HB, W1T + (size_t)l * NP * 1024, MT, NP, 1024, PROJ, NP,
                           (const float*)nullptr, (const float*)nullptr, (float*)nullptr, (float*)nullptr);
        hipLaunchKernelGGL(k_fox, dim3((513 * 4 * 64 + 255) / 256), dim3(256), 0, stream, PROJ, CUM, MIX);
        hipLaunchKernelGGL(k_diff, dim3((1025 * 4 * 64 + 255) / 256), dim3(256), 0, stream, PROJ, subln_g + l * 128, LAM, l, MIX);
        hipLaunchKernelGGL(k_pool, dim3(MT), dim3(256), 0, stream, PROJ, w_pool + (size_t)l * 4 * 64 * 64, pool_scale + l * 256, MIX);
        hipLaunchKernelGGL(k_gemm<1>, dim3(1024 / 128, (MT + 127) / 128), dim3(256), 0, stream, MIX, W2T + (size_t)l * 1024 * 1024, MT, 1024, 1024, (bf16_t*)nullptr, 0,
                           hreal, hmeta, H, HM);
    }
    hipLaunchKernelGGL(k_final, dim3((MR * 64 + 255) / 256), dim3(256), 0, stream, H, final_g);
}
```

```cpp
#include <hip/hip_runtime.h>
#include <stdint.h>

typedef unsigned short bf16_t;
__device__ __forceinline__ float bf2f(bf16_t v) { return __uint_as_float(((unsigned)v) << 16); }
__device__ __forceinline__ bf16_t f2bf(float f) { unsigned u = __float_as_uint(f); return (bf16_t)((u + 0x7fffu + ((u >> 16) & 1u)) >> 16); }

constexpr int BATCH = 8, SEQ = 4096, DM = 1024, DEPTH = 4, NMETA = 16;
constexpr int MR = BATCH * SEQ;
constexpr int MT = MR + NMETA;
constexpr int IN_DIM = 3588, NP = 3584;
constexpr int C_FQ = 0, C_FK = 256, C_FV = 512, C_FZ = 768, C_DQ = 1024, C_DK = 1536, C_DV = 2048, C_DZ = 2560, C_PU = 3072, C_PZ = 3328;
constexpr int M_A = 0, M_B = 256, M_C = 768;

constexpr size_t MiB = 1u << 20;
constexpr size_t WS_CTL = 0;
constexpr size_t WS_W1T = 2 * MiB;
constexpr size_t WS_W2T = 30 * MiB;
constexpr size_t WS_WFG = 38 * MiB;
constexpr size_t WS_LAM = 38 * MiB + 65536;
constexpr size_t WS_HM  = 38 * MiB + 131072;
constexpr size_t WS_LOGF = 39 * MiB;
constexpr size_t WS_CUM = 40 * MiB;
constexpr size_t WS_HB = 42 * MiB;
constexpr size_t WS_MIX = 108 * MiB;
constexpr size_t WS_PROJ = 174 * MiB;
constexpr size_t WS_RES = 400 * MiB;
constexpr size_t WS_END = 464 * MiB;

__global__ void k_prep(const float* __restrict__ w_in, const float* __restrict__ w_out, const float* __restrict__ norm_g,
                       const float* lq1, const float* lk1, const float* lq2, const float* lk2,
                       bf16_t* W1T, bf16_t* W2T, float* WFG, float* LAM) {
    size_t tid = (size_t)blockIdx.x * blockDim.x + threadIdx.x, nth = (size_t)gridDim.x * blockDim.x;
    const size_t n1 = (size_t)DEPTH * 1024 * NP;
    for (size_t i = tid; i < n1; i += nth) {
        int n = (int)(i % NP); size_t r = i / NP; int k = (int)(r % 1024); int l = (int)(r / 1024);
        int rc = n < 1024 ? n : n + 4;
        float v = w_in[((size_t)l * 1024 + k) * IN_DIM + rc] * norm_g[l * 1024 + k];
        W1T[((size_t)l * NP + n) * 1024 + k] = f2bf(v);
    }
    const size_t n2 = (size_t)DEPTH * 1024 * 1024;
    for (size_t i = tid; i < n2; i += nth) {
        int n = (int)(i % 1024); size_t r = i / 1024; int k = (int)(r % 1024); int l = (int)(r / 1024);
        W2T[((size_t)l * 1024 + n) * 1024 + k] = f2bf(w_out[i]);
    }
    const size_t n3 = (size_t)DEPTH * 1024 * 4;
    for (size_t i = tid; i < n3; i += nth) {
        int c = (int)(i % 4); size_t r = i / 4; int k = (int)(r % 1024); int l = (int)(r / 1024);
        WFG[((size_t)l * 4 + c) * 1024 + k] = w_in[((size_t)l * 1024 + k) * IN_DIM + 1024 + c] * norm_g[l * 1024 + k];
    }
    if (tid < DEPTH) {
        int l = (int)tid; float s1 = 0.f, s2 = 0.f;
        for (int i = 0; i < 64; ++i) { s1 += lq1[l * 64 + i] * lk1[l * 64 + i]; s2 += lq2[l * 64 + i] * lk2[l * 64 + i]; }
        float li = 0.8f - 0.6f * expf(-0.3f * (float)l);
        LAM[l] = expf(s1) - expf(s2) + li;
    }
}

__device__ __forceinline__ float wave_sum(float v) {
#pragma unroll
    for (int o = 1; o < 64; o <<= 1) v += __shfl_xor(v, o);
    return v;
}
__device__ __forceinline__ float log_sigmoid(float x) { return fminf(x, 0.f) - log1pf(expf(-fabsf(x))); }
__device__ __forceinline__ float silu(float x) { return x / (1.f + expf(-x)); }

__global__ __launch_bounds__(256) void k_norm(const float* __restrict__ hreal, const float* __restrict__ hmeta, const float* __restrict__ WFG_l,
                                              const float* __restrict__ bf_l, bf16_t* HB, float* LOGF) {
    int row = (blockIdx.x * 256 + threadIdx.x) >> 6, lane = threadIdx.x & 63;
    if (row >= MT) return;
    const float* hp = row < MR ? hreal + (size_t)row * DM : hmeta + (size_t)(row - MR) * DM;
    float4 v[4]; float ss = 0.f;
#pragma unroll
    for (int j = 0; j < 4; ++j) { v[j] = *(const float4*)(hp + j * 256 + lane * 4); ss += v[j].x * v[j].x + v[j].y * v[j].y + v[j].z * v[j].z + v[j].w * v[j].w; }
    ss = wave_sum(ss);
    float rstd = rsqrtf(ss * (1.f / DM) + 1e-6f);
    float fg[4];
#pragma unroll
    for (int c = 0; c < 4; ++c) {
        float a = 0.f;
#pragma unroll
        for (int j = 0; j < 4; ++j) { float4 w = *(const float4*)(WFG_l + c * 1024 + j * 256 + lane * 4); a += v[j].x * w.x + v[j].y * w.y + v[j].z * w.z + v[j].w * w.w; }
        fg[c] = wave_sum(a) * rstd;
    }
#pragma unroll
    for (int j = 0; j < 4; ++j) {
        ushort4 o; o.x = f2bf(v[j].x * rstd); o.y = f2bf(v[j].y * rstd); o.z = f2bf(v[j].z * rstd); o.w = f2bf(v[j].w * rstd);
        *(ushort4*)(HB + (size_t)row * DM + j * 256 + lane * 4) = o;
    }
    if (lane < 4) LOGF[row * 4 + lane] = log_sigmoid(fg[lane] + bf_l[lane]);
}

__global__ void k_scan(const float* __restrict__ LOGF, float* CUM) {
    int t = blockIdx.x * blockDim.x + threadIdx.x;
    if (t < 32) {
        int b = t >> 2, h = t & 3; float c = 0.f;
        for (int s = 0; s < SEQ; ++s) { c += LOGF[(size_t)(b * SEQ + s) * 4 + h]; CUM[(size_t)(b * SEQ + s) * 4 + h] = c; }
    } else if (t < 36) {
        int h = t - 32; float c = 0.f;
        for (int j = 15; j >= 0; --j) { CUM[(size_t)(MR + j) * 4 + h] = -c; c += LOGF[(size_t)(MR + j) * 4 + h]; }
    }
}

template <int MODE>
__global__ __launch_bounds__(256) void k_gemm(const bf16_t* __restrict__ A, const bf16_t* __restrict__ Bt, int M, int N, int K, bf16_t* Cb, int ldc,
                                              const float* base_real, const float* base_meta, float* out_real, float* out_meta) {
    __shared__ float As[16][132];
    __shared__ float Bs[16][132];
    const int bm = blockIdx.y * 128, bn = blockIdx.x * 128, tid = threadIdx.x, tx = tid & 15, ty = tid >> 4;
    float acc[8][8];
#pragma unroll
    for (int i = 0; i < 8; ++i)
#pragma unroll
        for (int j = 0; j < 8; ++j) acc[i][j] = 0.f;
    const int lr = tid >> 1, lk = (tid & 1) * 8;
    for (int k0 = 0; k0 < K; k0 += 16) {
        const int ar = bm + lr;
        uint4 av = make_uint4(0, 0, 0, 0);
        if (ar < M) av = *(const uint4*)(A + (size_t)ar * K + k0 + lk);
        uint4 bv = *(const uint4*)(Bt + (size_t)(bn + lr) * K + k0 + lk);
        const unsigned aw[4] = {av.x, av.y, av.z, av.w}, bw[4] = {bv.x, bv.y, bv.z, bv.w};
#pragma unroll
        for (int j = 0; j < 4; ++j) {
            As[lk + 2 * j][lr] = __uint_as_float(aw[j] << 16); As[lk + 2 * j + 1][lr] = __uint_as_float(aw[j] & 0xffff0000u);
            Bs[lk + 2 * j][lr] = __uint_as_float(bw[j] << 16); Bs[lk + 2 * j + 1][lr] = __uint_as_float(bw[j] & 0xffff0000u);
        }
        __syncthreads();
#pragma unroll
        for (int kk = 0; kk < 16; ++kk) {
            float a[8], b[8];
#pragma unroll
            for (int i = 0; i < 8; ++i) { a[i] = As[kk][ty * 8 + i]; b[i] = Bs[kk][tx * 8 + i]; }
#pragma unroll
            for (int i = 0; i < 8; ++i)
#pragma unroll
                for (int j = 0; j < 8; ++j) acc[i][j] += a[i] * b[j];
        }
        __syncthreads();
    }
#pragma unroll
    for (int i = 0; i < 8; ++i) {
        const int r = bm + ty * 8 + i;
        if (r >= M) continue;
        const int c0 = bn + tx * 8;
        if (MODE == 0) {
#pragma unroll
            for (int j = 0; j < 8; ++j) Cb[(size_t)r * ldc + c0 + j] = f2bf(acc[i][j]);
        } else {
            const float* bp = r < MR ? base_real + (size_t)r * 1024 : base_meta + (size_t)(r - MR) * 1024;
            float* op = r < MR ? out_real + (size_t)r * 1024 : out_meta + (size_t)(r - MR) * 1024;
#pragma unroll
            for (int j = 0; j < 8; ++j) op[c0 + j] = bp[c0 + j] + acc[i][j];
        }
    }
}

__global__ __launch_bounds__(256) void k_fox(const bf16_t* __restrict__ PROJ, const float* __restrict__ CUM, bf16_t* MIX, int grp_lo) {
    const int gw = (blockIdx.x * 256 + threadIdx.x) >> 6, lane = threadIdx.x & 63;
    const int h = gw & 3, grp = (gw >> 2) + grp_lo;
    if (grp >= 513) return;
    const bool meta = grp == 512;
    const bool valid = !meta || lane < 16;
    const int row = meta ? MR + (lane & 15) : grp * 64 + lane;
    const int b = meta ? 0 : (grp * 64) / SEQ;
    const int t0 = meta ? 0 : (grp * 64) % SEQ;
    const int t = meta ? (lane & 15) : t0 + lane;
    float q[64], o[64];
    const bf16_t* qp = PROJ + (size_t)row * NP + C_FQ + h * 64;
#pragma unroll
    for (int d = 0; d < 64; ++d) { q[d] = bf2f(qp[d]) * (meta ? 0.125f : 0.6931471805599453f); o[d] = 0.f; }
    const float cq = CUM[(size_t)row * 4 + h];
    float m = -1e30f, lsum = 0.f;
    const int nkeys = meta ? 16 : 16 + t0 + 64;
    for (int kk = 0; kk < nkeys; ++kk) {
        int krow; bool vis;
        if (kk < 16) { krow = MR + kk; vis = meta ? (kk <= t) : true; }
        else { const int s = kk - 16; krow = b * SEQ + s; vis = s <= t; }
        const bf16_t* kp = PROJ + (size_t)krow * NP + C_FK + h * 64;
        const bf16_t* vp = PROJ + (size_t)krow * NP + C_FV + h * 64;
        float sc = 0.f;
#pragma unroll
        for (int d = 0; d < 64; ++d) sc += q[d] * bf2f(kp[d]);
        sc += cq - CUM[(size_t)krow * 4 + h];
        if (vis) {
            if (sc > m) { const float a = __expf(m - sc); lsum *= a;
#pragma unroll
                for (int d = 0; d < 64; ++d) o[d] *= a;
                m = sc; }
            const float p = __expf(sc - m); lsum += p;
#pragma unroll
            for (int d = 0; d < 64; ++d) o[d] += p * bf2f(vp[d]);
        }
    }
    if (!valid) return;
    const float inv = 1.f / lsum;
    const bf16_t* zp = PROJ + (size_t)row * NP + C_FZ + h * 64;
    bf16_t* mp = MIX + (size_t)row * DM + M_A + h * 64;
#pragma unroll
    for (int d = 0; d < 64; ++d) mp[d] = f2bf(o[d] * inv * silu(bf2f(zp[d])));
}

__global__ __launch_bounds__(256) void k_diff(const bf16_t* __restrict__ PROJ, const float* __restrict__ subln_g_l, const float* __restrict__ LAM, int layer, bf16_t* MIX, int grp_lo) {
    const int gw = (blockIdx.x * 256 + threadIdx.x) >> 6, lane = threadIdx.x & 63;
    const int h = gw & 3, grp = (gw >> 2) + grp_lo;
    if (grp >= 1025) return;
    const bool meta = grp == 1024;
    const int ri = lane >> 1, eh = lane & 1;
    const bool valid = !meta || ri < 16;
    const int row = meta ? MR + (ri & 15) : grp * 32 + ri;
    const int b = meta ? 0 : (grp * 32) / SEQ;
    const int t0 = meta ? 0 : (grp * 32) % SEQ;
    const int t = meta ? (ri & 15) : t0 + ri;
    const float posq = meta ? (float)t : (float)(16 + t);
    const float slope = exp2f(-8.f * (float)(h + 1) / 4.f);
    const int nkeys = meta ? 16 : 16 + 64 * (t0 / 64 + 1);
    const float lam = LAM[layer];
    float res[64];
    for (int c = 0; c < 2; ++c) {
        float q[64], o[64];
        const bf16_t* qp = PROJ + (size_t)row * NP + C_DQ + h * 128 + c * 64;
#pragma unroll
        for (int d = 0; d < 64; ++d) { q[d] = bf2f(qp[d]) * (meta ? 0.125f : 0.6931471805599453f); o[d] = 0.f; }
        float m = -1e30f, lsum = 0.f;
        for (int kk = 0; kk < nkeys; ++kk) {
            int krow; float posk;
            if (kk < 16) { krow = MR + kk; posk = (float)kk; }
            else { const int s = kk - 16; krow = b * SEQ + s; posk = (float)(16 + s); }
            const bf16_t* kp = PROJ + (size_t)krow * NP + C_DK + h * 128 + c * 64;
            const bf16_t* vp = PROJ + (size_t)krow * NP + C_DV + h * 128 + eh * 64;
            float sc = 0.f;
#pragma unroll
            for (int d = 0; d < 64; ++d) sc += q[d] * bf2f(kp[d]);
            sc -= slope * fabsf(posq - posk);
            if (sc > m) { const float a = __expf(m - sc); lsum *= a;
#pragma unroll
                for (int d = 0; d < 64; ++d) o[d] *= a;
                m = sc; }
            const float p = __expf(sc - m); lsum += p;
#pragma unroll
            for (int d = 0; d < 64; ++d) o[d] += p * bf2f(vp[d]);
        }
        const float inv = 1.f / lsum;
        if (c == 0) {
#pragma unroll
            for (int d = 0; d < 64; ++d) res[d] = o[d] * inv;
        } else {
#pragma unroll
            for (int d = 0; d < 64; ++d) res[d] -= lam * o[d] * inv;
        }
    }
    float ss = 0.f;
#pragma unroll
    for (int d = 0; d < 64; ++d) ss += res[d] * res[d];
    ss += __shfl_xor(ss, 1);
    const float rstd = rsqrtf(ss * (1.f / 128.f) + 1e-5f);
    const float li = 0.8f - 0.6f * expf(-0.3f * (float)layer);
    if (!valid) return;
    const bf16_t* zp = PROJ + (size_t)row * NP + C_DZ + h * 128 + eh * 64;
    bf16_t* mp = MIX + (size_t)row * DM + M_B + h * 128 + eh * 64;
#pragma unroll
    for (int d = 0; d < 64; ++d) mp[d] = f2bf(res[d] * rstd * subln_g_l[eh * 64 + d] * (1.f - li) * silu(bf2f(zp[d])));
}

__global__ __launch_bounds__(256) void k_pool(const bf16_t* __restrict__ PROJ, const float* __restrict__ wpool_l, const float* __restrict__ pscale_l, bf16_t* MIX) {
    __shared__ float pooled[4][64];
    const int row = blockIdx.x, g = threadIdx.x >> 6, c = threadIdx.x & 63;
    const bool meta = row >= MR;
    const int b = meta ? 0 : row / SEQ, t = meta ? row - MR : row % SEQ;
    const int pos = meta ? t : 16 + t;
    const int w = 2 << g;
    const int cnt = (pos + 1) < w ? (pos + 1) : w;
    float s = 0.f;
    for (int i = 0; i < cnt; ++i) {
        const int p = pos - i;
        const int r = p < 16 ? MR + p : b * SEQ + (p - 16);
        s += bf2f(PROJ[(size_t)r * NP + C_PU + g * 64 + c]);
    }
    pooled[g][c] = s / (float)cnt - bf2f(PROJ[(size_t)row * NP + C_PU + g * 64 + c]);
    __syncthreads();
    float y = 0.f;
    for (int i = 0; i < 64; ++i) y += pooled[g][i] * wpool_l[(g * 64 + i) * 64 + c];
    const float z = bf2f(PROJ[(size_t)row * NP + C_PZ + g * 64 + c]);
    MIX[(size_t)row * DM + M_C + g * 64 + c] = f2bf(y * pscale_l[g * 64 + c] * silu(z));
}

__global__ __launch_bounds__(256) void k_final(float* H, const float* __restrict__ final_g) {
    int row = (blockIdx.x * 256 + threadIdx.x) >> 6, lane = threadIdx.x & 63;
    if (row >= MR) return;
    float* hp = H + (size_t)row * DM;
    float4 v[4]; float ss = 0.f;
#pragma unroll
    for (int j = 0; j < 4; ++j) { v[j] = *(const float4*)(hp + j * 256 + lane * 4); ss += v[j].x * v[j].x + v[j].y * v[j].y + v[j].z * v[j].z + v[j].w * v[j].w; }
    ss = wave_sum(ss);
    const float rstd = rsqrtf(ss * (1.f / DM) + 1e-6f);
#pragma unroll
    for (int j = 0; j < 4; ++j) {
        const float4 g = *(const float4*)(final_g + j * 256 + lane * 4);
        float4 o; o.x = v[j].x * rstd * g.x; o.y = v[j].y * rstd * g.y; o.z = v[j].z * rstd * g.z; o.w = v[j].w * rstd * g.w;
        *(float4*)(hp + j * 256 + lane * 4) = o;
    }
}


namespace pg8 {
#define PG8_LAS __attribute__((address_space(3)))
typedef unsigned short bf16_t;
typedef short bf16x8 __attribute__((ext_vector_type(8)));
typedef float f32x4 __attribute__((ext_vector_type(4)));
typedef unsigned u32x4 __attribute__((ext_vector_type(4)));
constexpr int BM = 256, BK = 64, HALF = 128, HTB = HALF * BK * 2  , STAGE_BYTES = 8 * HTB, NXCD = 8, WGM = 8;

__host__ __device__ __forceinline__ int lds_byte(int r, int c) { const int st = (r >> 4) * 2 + (c >> 5), rr = r & 15, cc = c & 31, ob = rr * 64 + cc * 2; return st * 1024 + (ob ^ (((ob >> 9) & 1) << 5)); }
__host__ __device__ __forceinline__ void stage_rc(int b, int& R, int& C) { const int st = b / 1024, sb = b % 1024, swz = sb ^ (((sb >> 9) & 1) << 5); R = (st >> 1) * 16 + swz / 64; C = (st & 1) * 32 + (swz % 64) / 2; }
__host__ __device__ __forceinline__ int perm32(int rho) { const int n = rho >> 4, i = rho & 15; return 8 * (i >> 2) + 4 * n + (i & 3); }

struct Unit { int pm, pn; };
struct Gemm { const bf16_t* A; const bf16_t* Bt; int M, N, K; };

struct StaticOrder {
    int nM, nN, nwg, G, c;
    __host__ __device__ void init(int M, int N, int G_, int c_) { nM = M / BM; nN = N / BM; nwg = nM * nN; G = G_; c = c_; }
    __host__ __device__ bool next(int i, Unit& u) const {
        const long L = (long)i * G + c; if (L >= nwg) return false;
        int wgid = (int)L; { const int q = nwg / NXCD, r = nwg % NXCD, xcd = wgid % NXCD, off = wgid / NXCD; wgid = (xcd < r ? xcd * (q + 1) : r * (q + 1) + (xcd - r) * q) + off; }
        const int nig = WGM * nN, gid = wgid / nig, fm = gid * WGM, gsz = (nM - fm) < WGM ? (nM - fm) : WGM;
        u.pm = fm + ((wgid % nig) % gsz); u.pn = (wgid % nig) / gsz; return true;
    }
    __device__ __forceinline__ void a_ready(const Unit&) const {}
    __device__ __forceinline__ void done(const Unit&) const {}
};

__device__ __forceinline__ unsigned cvt_pk_bf16(float lo, float hi) { unsigned r; asm volatile("v_cvt_pk_bf16_f32 %0, %1, %2" : "=v"(r) : "v"(lo), "v"(hi)); return r; }

struct EpiProj {
    static constexpr bool PERM = true, AFTER_DRAIN = false;
    bf16_t* O; int ldc; float qscale;
    __device__ __forceinline__ void operator()(const f32x4 (&acc)[2][2][4][2], const Unit& u, int wr, int wc, int fr, int fq) const {
        const int row0 = u.pm * BM + wr * 64 + fr, col0 = u.pn * BM + wc * 32 + 8 * fq;
        const float sc = (u.pn == 0 || u.pn == 4 || u.pn == 5) ? qscale : 1.f;
#pragma unroll
        for (int ai = 0; ai < 2; ++ai)
#pragma unroll
            for (int m = 0; m < 4; ++m) { bf16_t* rowp = O + (size_t)(row0 + ai * HALF + m * 16) * ldc + col0;
#pragma unroll
                for (int bj = 0; bj < 2; ++bj) { const f32x4 v0 = acc[ai][bj][m][0] * sc, v1 = acc[ai][bj][m][1] * sc;
                    u32x4 w; w.x = cvt_pk_bf16(v0[0], v0[1]); w.y = cvt_pk_bf16(v0[2], v0[3]); w.z = cvt_pk_bf16(v1[0], v1[1]); w.w = cvt_pk_bf16(v1[2], v1[3]);
                    *(u32x4*)(rowp + bj * HALF) = w; } }
    }
};
struct EpiResid {
    static constexpr bool PERM = false, AFTER_DRAIN = false;
    const float* base; float* out; int ldc;
    __device__ __forceinline__ void operator()(const f32x4 (&acc)[2][2][4][2], const Unit& u, int wr, int wc, int fr, int fq) const {
        const int col0 = u.pn * BM + wc * 32 + 4 * fq;
#pragma unroll
        for (int ai = 0; ai < 2; ++ai)
#pragma unroll
            for (int m = 0; m < 4; ++m) { const size_t off = (size_t)(u.pm * BM + ai * HALF + wr * 64 + m * 16 + fr) * ldc + col0;
#pragma unroll
                for (int bj = 0; bj < 2; ++bj)
#pragma unroll
                    for (int n = 0; n < 2; ++n) { const f32x4 bs = *(const f32x4*)(base + off + bj * HALF + n * 16); *(f32x4*)(out + off + bj * HALF + n * 16) = bs + acc[ai][bj][m][n]; } }
    }
};
template <class Epi, class Sched, bool ALIGN_EPI = false, bool SP2 = false>
__device__ __forceinline__ void gemm_phase(PG8_LAS unsigned char* lds, const Gemm g, const Sched& S, const Epi& E) {
    const int tid = threadIdx.x, wid = __builtin_amdgcn_readfirstlane(tid >> 6), lane = tid & 63, wr = wid >> 2, wc = wid & 3, fr = lane & 15, fq = lane >> 4;
    const int K = g.K, nt = K / BK;
    unsigned voffA[2], voffB[2];
#pragma unroll
    for (int i = 0; i < 2; ++i) { int R, C; stage_rc(tid * 16 + i * 8192, R, C); const int Rb = Epi::PERM ? ((R & ~31) + perm32(R & 31)) : R;
        voffA[i] = (unsigned)(R * K + C) * 2u; voffB[i] = (unsigned)(Rb * K + C) * 2u; }
    const size_t kstep = (size_t)(BK * 2);
    const size_t hstep = (size_t)HALF * K * 2;
    const size_t tstep = 2 * hstep;
    const unsigned ldsw = (unsigned)wid * 1024u;
    const int aoff = lds_byte(wr * 64 + fr, fq * 8), boff = lds_byte(wc * 32 + fr, fq * 8);
#define PG8_SA(b, h) (((b) * 2 + (h)) * HTB)
#define PG8_SB(b, h) ((4 + (b) * 2 + (h)) * HTB)
#define PG8_STAGE(bufoff, gbase, voff) do { _Pragma("unroll") for (int _i = 0; _i < 2; ++_i) \
        __builtin_amdgcn_global_load_lds((const unsigned*)((const char*)(gbase) + (voff)[_i]), (PG8_LAS unsigned*)(lds + (bufoff) + ldsw + _i * 8192), 16, 0, 0); } while (0)
#define PG8_LDA(dst, b, h) do { _Pragma("unroll") for (int m = 0; m < 4; ++m) _Pragma("unroll") for (int k = 0; k < 2; ++k) dst[m][k] = *(const PG8_LAS bf16x8*)(lds + PG8_SA(b, h) + aoff + m * 2048 + k * 1024); } while (0)
#define PG8_LDB(dst, b, h) do { _Pragma("unroll") for (int n = 0; n < 2; ++n) _Pragma("unroll") for (int k = 0; k < 2; ++k) dst[n][k] = *(const PG8_LAS bf16x8*)(lds + PG8_SB(b, h) + boff + n * 2048 + k * 1024); } while (0)
#define PG8_MMA(ai, bj, At, Bt) do { __builtin_amdgcn_s_setprio(1); _Pragma("unroll") for (int m = 0; m < 4; ++m) _Pragma("unroll") for (int n = 0; n < 2; ++n) _Pragma("unroll") for (int k = 0; k < 2; ++k) \
        acc[ai][bj][m][n] = __builtin_amdgcn_mfma_f32_16x16x32_bf16(Bt[n][k], At[m][k], acc[ai][bj][m][n], 0, 0, 0); __builtin_amdgcn_s_setprio(0); } while (0)
#define PG8_WAIT_V(n) asm volatile("s_waitcnt vmcnt(" #n ")" ::: "memory")
#define PG8_WAIT_L(n) asm volatile("s_waitcnt lgkmcnt(" #n ")" ::: "memory")
#define PG8_BAR __builtin_amdgcn_s_barrier()
#define PG8_SCHED __builtin_amdgcn_sched_barrier(0)
    Unit cur, nxt; int ui = 0;
    if (!S.next(0, cur)) return;
    f32x4 acc[2][2][4][2];
#pragma unroll
    for (int a = 0; a < 2; ++a)
#pragma unroll
        for (int b = 0; b < 2; ++b)
#pragma unroll
            for (int m = 0; m < 4; ++m)
#pragma unroll
                for (int n = 0; n < 2; ++n) acc[a][b][m][n] = (f32x4){0.f, 0.f, 0.f, 0.f};
    bf16x8 At[4][2], B0[2][2], B1[2][2];
    const char* cA = (const char*)g.A + (size_t)cur.pm * tstep; const char* cB = (const char*)g.Bt + (size_t)cur.pn * tstep;
    S.a_ready(cur);
    if constexpr (SP2) {
        PG8_STAGE(PG8_SB(0, 0), cB, voffB); PG8_STAGE(PG8_SB(0, 1), cB + hstep, voffB); PG8_STAGE(PG8_SA(0, 0), cA, voffA); PG8_STAGE(PG8_SA(0, 1), cA + hstep, voffA);
        if (wr == 1) PG8_BAR;
        PG8_WAIT_V(2); PG8_BAR;
        PG8_STAGE(PG8_SB(1, 0), cB + kstep, voffB); PG8_STAGE(PG8_SA(1, 0), cA + kstep, voffA); PG8_STAGE(PG8_SB(1, 1), cB + hstep + kstep, voffB);
        PG8_WAIT_V(6); PG8_BAR;
    } else {
        PG8_STAGE(PG8_SB(0, 0), cB, voffB); PG8_STAGE(PG8_SA(0, 0), cA, voffA); PG8_STAGE(PG8_SB(0, 1), cB + hstep, voffB); PG8_STAGE(PG8_SA(0, 1), cA + hstep, voffA);
        if (wr == 1) PG8_BAR;
        PG8_WAIT_V(4); PG8_BAR;
        PG8_STAGE(PG8_SB(1, 0), cB + kstep, voffB); PG8_STAGE(PG8_SA(1, 0), cA + kstep, voffA); PG8_STAGE(PG8_SB(1, 1), cB + hstep + kstep, voffB);
        PG8_WAIT_V(6); PG8_BAR;
    }
    for (;;) {
        const bool has_next = S.next(ui + 1, nxt);
        const char* nA = has_next ? (const char*)g.A + (size_t)nxt.pm * tstep : cA; const char* nB = has_next ? (const char*)g.Bt + (size_t)nxt.pn * tstep : cB;
        for (int t = 0; t < nt; t += 2) {
            const bool last = (t == nt - 2);
            const char* a1 = cA + (size_t)(t + 1) * kstep;
            const char* a2 = last ? nA : cA + (size_t)(t + 2) * kstep; const char* b2 = last ? nB : cB + (size_t)(t + 2) * kstep;
            const char* a3 = a2 + kstep; const char* b3 = b2 + kstep;
            if (last && has_next) S.a_ready(nxt);
            if constexpr (SP2) {
            PG8_LDB(B0, 0, 0); PG8_LDB(B1, 0, 1); PG8_SCHED; PG8_LDA(At, 0, 0); PG8_STAGE(PG8_SA(1, 1), a1 + hstep, voffA);
            PG8_WAIT_V(8); PG8_WAIT_L(0); PG8_BAR; PG8_MMA(0, 0, At, B0); PG8_MMA(0, 1, At, B1); PG8_BAR; PG8_SCHED;
            PG8_LDA(At, 0, 1); PG8_STAGE(PG8_SB(0, 0), b2, voffB); PG8_STAGE(PG8_SB(0, 1), b2 + hstep, voffB); PG8_STAGE(PG8_SA(0, 0), a2, voffA);
            PG8_WAIT_V(8); PG8_WAIT_L(0); PG8_BAR; PG8_MMA(1, 0, At, B0); PG8_MMA(1, 1, At, B1); PG8_BAR; PG8_SCHED;
            PG8_LDB(B0, 1, 0); PG8_LDB(B1, 1, 1); PG8_SCHED; PG8_LDA(At, 1, 0); PG8_STAGE(PG8_SA(0, 1), a2 + hstep, voffA);
            PG8_WAIT_V(8); PG8_WAIT_L(0); PG8_BAR; PG8_MMA(0, 0, At, B0); PG8_MMA(0, 1, At, B1); PG8_BAR; PG8_SCHED;
            PG8_LDA(At, 1, 1); PG8_STAGE(PG8_SB(1, 0), b3, voffB); PG8_STAGE(PG8_SB(1, 1), b3 + hstep, voffB); PG8_STAGE(PG8_SA(1, 0), a3, voffA);
            PG8_WAIT_V(8); PG8_WAIT_L(0); PG8_BAR; PG8_MMA(1, 0, At, B0); PG8_MMA(1, 1, At, B1); PG8_BAR; PG8_SCHED;
            } else {
            PG8_LDB(B0, 0, 0); PG8_SCHED; PG8_LDA(At, 0, 0); PG8_STAGE(PG8_SA(1, 1), a1 + hstep, voffA);
            PG8_WAIT_L(8); PG8_BAR; PG8_WAIT_L(0); PG8_MMA(0, 0, At, B0); PG8_BAR; PG8_SCHED;
            PG8_LDB(B1, 0, 1); PG8_STAGE(PG8_SB(0, 0), b2, voffB);
            PG8_BAR; PG8_WAIT_L(0); PG8_MMA(0, 1, At, B1); PG8_BAR;
            PG8_LDA(At, 0, 1); PG8_STAGE(PG8_SA(0, 0), a2, voffA);
            PG8_BAR; PG8_WAIT_L(0); PG8_MMA(1, 0, At, B0); PG8_BAR; PG8_SCHED;
            PG8_STAGE(PG8_SB(0, 1), b2 + hstep, voffB);
            PG8_WAIT_V(6); PG8_BAR; PG8_MMA(1, 1, At, B1); PG8_BAR;
            PG8_LDB(B0, 1, 0); PG8_SCHED; PG8_LDA(At, 1, 0); PG8_STAGE(PG8_SA(0, 1), a2 + hstep, voffA);
            PG8_WAIT_L(8); PG8_BAR; PG8_WAIT_L(0); PG8_MMA(0, 0, At, B0); PG8_BAR; PG8_SCHED;
            PG8_LDB(B1, 1, 1); PG8_STAGE(PG8_SB(1, 0), b3, voffB);
            PG8_BAR; PG8_WAIT_L(0); PG8_MMA(0, 1, At, B1); PG8_BAR;
            PG8_LDA(At, 1, 1); PG8_STAGE(PG8_SA(1, 0), a3, voffA);
            PG8_BAR; PG8_WAIT_L(0); PG8_MMA(1, 0, At, B0); PG8_BAR; PG8_SCHED;
            PG8_STAGE(PG8_SB(1, 1), b3 + hstep, voffB);
            PG8_WAIT_V(6); PG8_BAR; PG8_MMA(1, 1, At, B1); PG8_BAR;
            }
        }
        if constexpr (ALIGN_EPI) { if (wr == 0) PG8_BAR; }
        if constexpr (!Epi::AFTER_DRAIN) { E(acc, cur, wr, wc, fr, fq); S.done(cur); }
        if (!has_next) break;
#pragma unroll
        for (int a = 0; a < 2; ++a)
#pragma unroll
            for (int b = 0; b < 2; ++b)
#pragma unroll
                for (int m = 0; m < 4; ++m)
#pragma unroll
                    for (int n = 0; n < 2; ++n) acc[a][b][m][n] = (f32x4){0.f, 0.f, 0.f, 0.f};
        cur = nxt; cA = nA; cB = nB; ++ui;
        if constexpr (ALIGN_EPI) { if (wr == 1) PG8_BAR; }
    }
    PG8_WAIT_V(0);
    if constexpr (!ALIGN_EPI) { if (wr == 0) PG8_BAR; }
    PG8_BAR;
    if constexpr (Epi::AFTER_DRAIN) { E.fused(acc, cur, wr, wc, fr, fq, lds, wid, lane); S.done(cur); }
#undef PG8_SA
#undef PG8_SB
#undef PG8_STAGE
#undef PG8_LDA
#undef PG8_LDB
#undef PG8_MMA
#undef PG8_WAIT_V
#undef PG8_WAIT_L
#undef PG8_BAR
#undef PG8_SCHED
}
}

#ifndef PG8_SP2
#define PG8_SP2 true
#endif
#ifndef PG8_ALIGN
#define PG8_ALIGN true
#endif
constexpr int NWAVES = 8;
constexpr int RING_OFF = 0, RING_BYTES = 131072;
constexpr int LDSCTL_OFF = RING_BYTES, MISC_OFF = LDSCTL_OFF + 320;
constexpr int LDS_BYTES = 147456;
constexpr int CW_TMO = 0, CW_CODE = 1, CW_BAR = 4096;
constexpr size_t CTL_ZERO_BYTES = 1 * MiB;
#define GAS __attribute__((address_space(1)))
#define LAS __attribute__((address_space(3)))
typedef unsigned short bf16;
typedef unsigned v4u __attribute__((ext_vector_type(4)));
typedef float f32x4 __attribute__((ext_vector_type(4)));
typedef short bf16x8 __attribute__((ext_vector_type(8)));
typedef GAS unsigned gu32;
typedef GAS unsigned long long gu64;
#define RLX_AGENT __ATOMIC_RELAXED, __HIP_MEMORY_SCOPE_AGENT
#define LDS_WAIT() asm volatile("s_waitcnt lgkmcnt(0)" ::: "memory")
#define VM_WAIT() asm volatile("s_waitcnt vmcnt(0)" ::: "memory")
__device__ __forceinline__ unsigned long long rt() { return __builtin_amdgcn_s_memrealtime(); }
__device__ __forceinline__ unsigned pk2(float lo, float hi) { return (unsigned)f2bf(lo) | ((unsigned)f2bf(hi) << 16); }

#define XB_TMO      128
#define XB_XCNT(j)  (256  + 64 * (j))
#define XB_XSUB(j)  (1280 + 64 * (j))
#define XB_XGEN(j)  (2304 + 64 * (j))
#define XB_TOP      3328
#define XB_TOPGEN   3392
#define XCD_BAR_WORDS 3456
#define XB_SPIN_CAP (1u << 18)

__device__ __forceinline__ unsigned xb_ld(unsigned* p)              { return __hip_atomic_load(p, __ATOMIC_RELAXED, __HIP_MEMORY_SCOPE_AGENT); }
__device__ __forceinline__ unsigned xb_add(unsigned* p, unsigned v) { return __hip_atomic_fetch_add(p, v, __ATOMIC_RELAXED, __HIP_MEMORY_SCOPE_AGENT); }
__device__ __forceinline__ unsigned xb_xcc_id() { return (unsigned)__builtin_amdgcn_s_getreg((3 << 11) | 20) & 0xFu; }
#define XB_SPIN(cond, bar) do { unsigned _sp = 0; while (cond) { __builtin_amdgcn_s_sleep(1); \
    if ((++_sp & 255u) == 0u) { if (xb_ld(&(bar)[XB_TMO])) break; if (_sp > XB_SPIN_CAP) { atomicAdd(&(bar)[XB_TMO], 1u); break; } } } } while (0)

struct XcdBarrier {
    unsigned* bar; unsigned x;
    volatile LAS unsigned* st;
};

__device__ __forceinline__ XcdBarrier xcd_barrier_post(unsigned* bar, volatile LAS unsigned* st) {
    XcdBarrier b; b.bar = bar; b.x = xb_xcc_id(); b.st = st;
    if (threadIdx.x == 0) (void)xb_add(&bar[XB_XCNT(b.x)], 1u);
    return b;
}
__device__ __forceinline__ void xcd_barrier_complete(unsigned* bar, unsigned x, unsigned& nloc, unsigned& nx) {
    const unsigned G = gridDim.x * gridDim.y * gridDim.z;
    unsigned sum, cnt, mine, sp = 0u;
    for (;;) {
        sum = 0u; cnt = 0u; mine = 0u;
#pragma unroll
        for (unsigned j = 0; j < 16; ++j) { const unsigned c = xb_ld(&bar[XB_XCNT(j)]); sum += c; cnt += (c > 0u) ? 1u : 0u; mine = (j == x) ? c : mine; }
        if (sum == G) break;
        __builtin_amdgcn_s_sleep(1);
        if ((++sp & 255u) == 0u) { if (xb_ld(&bar[XB_TMO])) break; if (sp > XB_SPIN_CAP) { atomicAdd(&bar[XB_TMO], 1u); break; } }
    }
    nloc = mine > 0u ? mine : 1u; nx = cnt > 0u ? cnt : 1u;
}

__device__ __forceinline__ void xcd_barrier(const XcdBarrier& b) {
    asm volatile("s_waitcnt vmcnt(0)" ::: "memory");
    __syncthreads();
    if (threadIdx.x == 0) {
        unsigned* bar = b.bar;
        __builtin_amdgcn_s_waitcnt(0);
        unsigned nloc = b.st[0], nx = b.st[1];
        if (nloc == 0u) { xcd_barrier_complete(bar, b.x, nloc, nx); b.st[0] = nloc; b.st[1] = nx; }
        const unsigned old = xb_add(&bar[XB_XSUB(b.x)], 1u);
        const unsigned gen = old / nloc;
        if (old + 1u == (gen + 1u) * nloc) {
            __builtin_amdgcn_fence(__ATOMIC_RELEASE, "agent");
            asm volatile("s_waitcnt vmcnt(0)" ::: "memory");
            const unsigned og = xb_add(&bar[XB_TOP], 1u);
            const unsigned tg = og / nx;
            if (og + 1u == (tg + 1u) * nx) xb_add(&bar[XB_TOPGEN], 1u);
            else XB_SPIN(xb_ld(&bar[XB_TOPGEN]) == tg, bar);
            __builtin_amdgcn_fence(__ATOMIC_ACQUIRE, "agent");
            xb_add(&bar[XB_XGEN(b.x)], 1u);
            asm volatile("s_waitcnt vmcnt(0)" ::: "memory");
        } else {
            XB_SPIN(xb_ld(&bar[XB_XGEN(b.x)]) == gen, bar);
            __builtin_amdgcn_fence(__ATOMIC_ACQUIRE, "agent");
            asm volatile("s_waitcnt vmcnt(0)" ::: "memory");
        }
    }
    __syncthreads();
}

namespace att {
typedef float f32x16 __attribute__((ext_vector_type(16)));
typedef float f32x4 __attribute__((ext_vector_type(4)));
typedef short bf16x8 __attribute__((ext_vector_type(8)));
typedef short s16x4 __attribute__((ext_vector_type(4)));
typedef unsigned u32x4 __attribute__((ext_vector_type(4)));
#define ALAS __attribute__((address_space(3)))
constexpr int KCS = 1040, VDS = 4160, KBUF = 8 * KCS, VBUF = 4 * VDS, KBOFF = KBUF + VBUF, STG = KBOFF + 256;
constexpr int L_WSF = 2 * STG, L_OST = L_WSF + 8 * 256, L_END = L_OST + 8 * 8192;
constexpr float LOG2E = 1.4426950408889634f, C2 = 0.125f * LOG2E, THR = 8.f, NEGBIG = -1e30f;
__device__ __forceinline__ int crow(int r, int hi) { return (r & 3) + 8 * (r >> 2) + 4 * hi; }
__device__ __forceinline__ unsigned cvtpk(float lo, float hi) { typedef float f2 __attribute__((ext_vector_type(2))); typedef __bf16 b2 __attribute__((ext_vector_type(2))); f2 v = {lo, hi}; b2 b = __builtin_convertvector(v, b2); return __builtin_bit_cast(unsigned, b); }
__device__ __forceinline__ s16x4 vtr(const ALAS unsigned char* p) { typedef short v4i16_t __attribute__((ext_vector_type(4))); return __builtin_bit_cast(s16x4, __builtin_amdgcn_ds_read_tr16_b64_v4i16((ALAS v4i16_t*)p)); }
__device__ __forceinline__ float bfl(unsigned w) { return __uint_as_float(w << 16); }
__device__ __forceinline__ float bfh(unsigned w) { return __uint_as_float(w & 0xffff0000u); }
__device__ __forceinline__ float silu_f(float x) { return x / (1.f + __expf(-x)); }

struct TileRegs { u32x4 k, v0, v1; float kb; };

template <int MODE> __device__ __forceinline__ void load_tile(TileRegs& R, const bf16_t* __restrict__ PROJ, const float* __restrict__ CUM, size_t krow0, bool meta, int kcol, int vcol, int h, int tid) {
    const u32x4 z = {0u, 0u, 0u, 0u};
    { const int key = tid >> 3, ch = tid & 7;
      R.k = z; if (!(meta && key >= 16)) R.k = *(const u32x4*)(PROJ + (krow0 + key) * NP + kcol + ch * 8);
      if (MODE == 0) { R.v0 = z; if (!(meta && key >= 16)) R.v0 = *(const u32x4*)(PROJ + (krow0 + key) * NP + vcol + ch * 8); } }
    if (MODE == 1) { const int key = tid >> 4, ch = tid & 15;
      R.v0 = z; R.v1 = z;
      if (!(meta && key >= 16)) R.v0 = *(const u32x4*)(PROJ + (krow0 + key) * NP + vcol + ch * 8);
      if (!meta) R.v1 = *(const u32x4*)(PROJ + (krow0 + key + 32) * NP + vcol + ch * 8); }
    if (MODE == 0) { R.kb = NEGBIG; if (tid < 64 && !(meta && tid >= 16)) R.kb = -CUM[(krow0 + tid) * 4 + h] * LOG2E; }
}
template <int MODE> __device__ __forceinline__ void store_tile(const TileRegs& R, ALAS unsigned char* buf, int tid) {
    { const int key = tid >> 3, ch = tid & 7;
      *(ALAS u32x4*)(buf + ch * KCS + key * 16) = R.k;
      if (MODE == 0) *(ALAS u32x4*)(buf + KBUF + (ch >> 2) * VDS + (key >> 4) * 1024 + (key & 15) * 64 + (ch & 3) * 16) = R.v0; }
    if (MODE == 1) { const int key = tid >> 4, ch = tid & 15;
      ALAS unsigned char* p = buf + KBUF + (ch >> 2) * VDS + (key >> 4) * 1024 + (key & 15) * 64 + (ch & 3) * 16;
      *(ALAS u32x4*)p = R.v0; *(ALAS u32x4*)(p + 2048) = R.v1; }
    if (MODE == 0) { if (tid < 64) *(ALAS float*)(buf + KBOFF + tid * 4) = R.kb; }
}

template <int MODE, int NDB> __device__ __forceinline__ void compute_tile(const ALAS unsigned char* buf, const bf16x8 (&qr)[4], f32x16 (&o)[NDB], float& mhat, float& l,
        int kidx0, bool meta, bool diag, int qw0, float slope2, ALAS float* wsf, int lane) {
    const int r32 = lane & 31, hi = lane >> 5;
    f32x16 p0, p1;
    asm volatile("" : "+v"(slope2), "+s"(kidx0));
    if (MODE == 0) {
        const ALAS f32x4* kbp = (const ALAS f32x4*)(buf + KBOFF);
#pragma unroll
        for (int g = 0; g < 4; ++g) { const f32x4 a = kbp[2 * g + hi], b = kbp[8 + 2 * g + hi];
#pragma unroll
            for (int j = 0; j < 4; ++j) { p0[4 * g + j] = a[j] - mhat; p1[4 * g + j] = b[j] - mhat; } }
    } else {
        if (!diag) {
            const float base = slope2 * (float)(kidx0 + 4 * hi - qw0) - mhat;
#pragma unroll
            for (int r = 0; r < 16; ++r) { const int c = (r & 3) + 8 * (r >> 2); p0[r] = fmaf((float)c, slope2, base); p1[r] = fmaf((float)(c + 32), slope2, base); }
            if (meta) {
#pragma unroll
                for (int r = 0; r < 16; ++r) { if ((r >> 2) >= 2) p0[r] = NEGBIG; p1[r] = NEGBIG; }
            }
        } else {
            const float dq = (float)(qw0 + r32 - kidx0 - 4 * hi), fr = (float)r32;
#pragma unroll
            for (int r = 0; r < 16; ++r) { const int c = (r & 3) + 8 * (r >> 2);
                p0[r] = slope2 * (fr - fabsf(dq - (float)c)) - mhat; p1[r] = slope2 * (fr - fabsf(dq - (float)(c + 32))) - mhat; }
        }
    }
    { const ALAS unsigned char* kb = buf + hi * KCS + r32 * 16;
#pragma unroll
      for (int d0 = 0; d0 < 4; ++d0) {
          const bf16x8 k0 = *(const ALAS bf16x8*)(kb + d0 * 2 * KCS), k1 = *(const ALAS bf16x8*)(kb + d0 * 2 * KCS + 512);
          p0 = __builtin_amdgcn_mfma_f32_32x32x16_bf16(k0, qr[d0], p0, 0, 0, 0);
          p1 = __builtin_amdgcn_mfma_f32_32x32x16_bf16(k1, qr[d0], p1, 0, 0, 0); } }
    if (MODE == 0 && diag) {
        const int lim = qw0 + r32 - kidx0 - 4 * hi;
#pragma unroll
        for (int r = 0; r < 16; ++r) { const int c = (r & 3) + 8 * (r >> 2); if (c > lim) p0[r] = NEGBIG; if (c + 32 > lim) p1[r] = NEGBIG; }
    }
    float rm;
    { float a = fmaxf(p0[0], p1[0]);
#pragma unroll
      for (int r = 1; r < 16; ++r) a = fmaxf(a, fmaxf(p0[r], p1[r]));
      auto rr = __builtin_amdgcn_permlane32_swap(__float_as_uint(a), __float_as_uint(a), false, false);
      rm = fmaxf(__uint_as_float(rr[0]), __uint_as_float(rr[1])); }
    bool resc = false;
    if (__any(rm > THR)) {
        const float dl = fmaxf(rm, 0.f); mhat += dl;
#pragma unroll
        for (int r = 0; r < 16; ++r) { p0[r] -= dl; p1[r] -= dl; }
        const float f = __builtin_amdgcn_exp2f(-dl); l *= f; if (hi == 0) wsf[r32] = f; resc = true;
    }
    float sacc = 0.f;
#pragma unroll
    for (int r = 0; r < 16; ++r) { p0[r] = __builtin_amdgcn_exp2f(p0[r]); p1[r] = __builtin_amdgcn_exp2f(p1[r]); sacc += p0[r] + p1[r]; }
    l += sacc;
    u32x4 pw[4];
#pragma unroll
    for (int j = 0; j < 4; ++j) { pw[0][j] = cvtpk(p0[2 * j], p0[2 * j + 1]); pw[1][j] = cvtpk(p0[8 + 2 * j], p0[9 + 2 * j]); pw[2][j] = cvtpk(p1[2 * j], p1[2 * j + 1]); pw[3][j] = cvtpk(p1[8 + 2 * j], p1[9 + 2 * j]); }
    if (resc) {
#pragma unroll
        for (int r = 0; r < 16; ++r) { const float f = wsf[crow(r, hi)];
#pragma unroll
            for (int d = 0; d < NDB; ++d) o[d][r] *= f; }
    }
    { const ALAS unsigned char* vb = buf + KBUF + ((lane >> 4) & 1) * 32 + (lane & 3) * 8 + (4 * hi + ((lane & 15) >> 2)) * 64;
#pragma unroll
      for (int d = 0; d < NDB; ++d)
#pragma unroll
          for (int ks = 0; ks < 4; ++ks) {
              const s16x4 lo = vtr(vb + d * VDS + ks * 1024), hh = vtr(vb + d * VDS + ks * 1024 + 512);
              const bf16x8 vf = {lo[0], lo[1], lo[2], lo[3], hh[0], hh[1], hh[2], hh[3]};
              o[d] = __builtin_amdgcn_mfma_f32_32x32x16_bf16(__builtin_bit_cast(bf16x8, pw[ks]), vf, o[d], 0, 0, 0); } }
}

__device__ __forceinline__ u32x4 gate8(u32x4 v, u32x4 z) {
    u32x4 o;
#pragma unroll
    for (int j = 0; j < 4; ++j) { const float a = bfl(v[j]) * silu_f(bfl(z[j])), b = bfh(v[j]) * silu_f(bfh(z[j])); o[j] = cvtpk(a, b); }
    return o;
}

template <int MODE> __device__ __forceinline__ void attn_unit(ALAS unsigned char* lds, const bf16_t* __restrict__ PROJ, const float* __restrict__ CUM, bf16_t* __restrict__ MIX,
        int b, int h, int qb, float lam, float li, const float* __restrict__ subg, float* park) {
    constexpr int NDB = MODE == 1 ? 4 : 2, NBR = MODE == 1 ? 2 : 1, HS = MODE == 1 ? 128 : 64;
    int tid_ = threadIdx.x; asm volatile("" : "+v"(tid_));
    const int tid = tid_, lane = tid & 63, r32 = lane & 31, hi = lane >> 5, wid = __builtin_amdgcn_readfirstlane(tid >> 6);
    const int q0 = qb * 256, qw0 = q0 + wid * 32;
    const size_t rowb = (size_t)b * SEQ;
    const int NT = 4 * qb + 4, my_last = 4 * qb + (wid >> 1);
    ALAS float* wsf = (ALAS float*)(lds + L_WSF) + wid * 64;
    const float slope2 = MODE == 1 ? exp2f(-2.f * (float)(h + 1)) * LOG2E : 0.f;
    f32x16 res[NDB];
#pragma clang loop unroll(disable)
    for (int c = 0; c < NBR; ++c) {
        const int qcol = MODE == 0 ? C_FQ + h * 64 : C_DQ + h * 128 + c * 64;
        const int kcol = MODE == 0 ? C_FK + h * 64 : C_DK + h * 128 + c * 64;
        const int vcol = MODE == 0 ? C_FV + h * 64 : C_DV + h * 128;
        bf16x8 qr[4];
        { const bf16_t* Qw = PROJ + (rowb + qw0 + r32) * NP + qcol + hi * 8;
#pragma unroll
          for (int d0 = 0; d0 < 4; ++d0) qr[d0] = *(const bf16x8*)(Qw + d0 * 16); }
        float mhat = MODE == 0 ? -CUM[(rowb + qw0) * 4 + h] * LOG2E : 0.f, l = 0.f;
        f32x16 o[NDB];
#pragma unroll
        for (int d = 0; d < NDB; ++d)
#pragma unroll
            for (int r = 0; r < 16; ++r) o[d][r] = 0.f;
        TileRegs R;
        load_tile<MODE>(R, PROJ, CUM, rowb + (size_t)(NT - 1) * 64, false, kcol, vcol, h, tid);
        store_tile<MODE>(R, lds, tid);
        __syncthreads();
        for (int i = 0; i <= NT; ++i) {
            const bool metat = (i == NT); const int t = NT - 1 - i;
            if (i < NT) { const bool nm = (i + 1 == NT); load_tile<MODE>(R, PROJ, CUM, nm ? (size_t)MR : rowb + (size_t)(t - 1) * 64, nm, kcol, vcol, h, tid); }
            if (metat || t <= my_last)
                compute_tile<MODE, NDB>(lds + (i & 1) * STG, qr, o, mhat, l, metat ? -16 : 64 * t, metat, (!metat) && t == my_last, qw0, slope2, wsf, lane);
            if (i < NT) store_tile<MODE>(R, lds + ((i + 1) & 1) * STG, tid);
            __syncthreads();
        }
        { auto rr = __builtin_amdgcn_permlane32_swap(__float_as_uint(l), __float_as_uint(l), false, false); l = __uint_as_float(rr[0]) + __uint_as_float(rr[1]); }
        if (hi == 0) wsf[32 + r32] = l;
        float rli[16];
#pragma unroll
        for (int r = 0; r < 16; ++r) rli[r] = 1.f / wsf[32 + crow(r, hi)];
        if (MODE == 0) {
#pragma unroll
            for (int d = 0; d < NDB; ++d)
#pragma unroll
                for (int r = 0; r < 16; ++r) res[d][r] = o[d][r] * rli[r];
        } else {
            float* pk = park + c * 4096 + lane;
#pragma unroll
            for (int d = 0; d < NDB; ++d) {
                float* pkd = pk + d * 1024; asm volatile("" : "+v"(pkd));
#pragma unroll
                for (int r = 0; r < 16; ++r) pkd[r * 64] = o[d][r] * rli[r];
            }
        }
    }
    if (MODE == 1) {
#pragma unroll
        for (int d = 0; d < NDB; ++d) {
            const float* pa = park + lane + d * 1024; const float* pb = pa + 4096; asm volatile("" : "+v"(pa), "+v"(pb));
#pragma unroll
            for (int r = 0; r < 16; ++r) res[d][r] = pa[r * 64] - lam * pb[r * 64];
        }
    }
    ALAS bf16_t* stg = (ALAS bf16_t*)(lds + L_OST + wid * 8192);
    if (MODE == 1) {
        float ss[16];
#pragma unroll
        for (int r = 0; r < 16; ++r) { float s = 0.f;
#pragma unroll
            for (int d = 0; d < NDB; ++d) s += res[d][r] * res[d][r];
            ss[r] = s; }
#pragma unroll
        for (int m = 1; m < 32; m <<= 1)
#pragma unroll
            for (int r = 0; r < 16; ++r) ss[r] += __shfl_xor(ss[r], m);
        float gc[NDB];
#pragma unroll
        for (int d = 0; d < NDB; ++d) gc[d] = subg[32 * d + r32] * (1.f - li);
#pragma unroll
        for (int r = 0; r < 16; ++r) { const float rs = rsqrtf(ss[r] * (1.f / 128.f) + 1e-5f);
#pragma unroll
            for (int d = 0; d < NDB; ++d) res[d][r] *= rs * gc[d]; }
    }
#pragma unroll
    for (int r = 0; r < 16; ++r) { const int orow = crow(r, hi);
#pragma unroll
        for (int d = 0; d < NDB; ++d) stg[orow * (NDB * 32) + d * 32 + r32] = f2bf(res[d][r]); }
    constexpr int CPR = NDB * 4;
    constexpr int RPP = 64 / CPR;
    const int zcol = MODE == 0 ? C_FZ + h * 64 : C_DZ + h * 128, mcol = MODE == 0 ? M_A + h * 64 : M_B + h * 128;
#pragma unroll
    for (int i = 0; i < 32 / RPP; ++i) {
        const int row = i * RPP + lane / CPR, ch = lane % CPR;
        const u32x4 v = *(const ALAS u32x4*)(stg + row * (NDB * 32) + ch * 8);
        const u32x4 z = *(const u32x4*)(PROJ + (rowb + qw0 + row) * NP + zcol + ch * 8);
        *(u32x4*)(MIX + (rowb + qw0 + row) * DM + mcol + ch * 8) = gate8(v, z);
    }
}
#undef ALAS
}

constexpr int PH_PRO = 0, PH_FIN = 17, NPH = 18;
struct Args { const float* in[14]; float* out; unsigned char* ws; int ph_lo, ph_hi, at_mask, pad; };
__global__ void __launch_bounds__(NWAVES * 64, 2) mk_fwd(Args args) {
    extern __shared__ __attribute__((aligned(16))) unsigned char lds[];
    LAS unsigned char* ldsp = (LAS unsigned char*)lds;
    volatile LAS unsigned* MISC = (volatile LAS unsigned*)(ldsp + MISC_OFF);
    const int tid = threadIdx.x;
    unsigned char* ws = args.ws;
    gu32* ctl = (gu32*)(ws + WS_CTL);
    for (int u = tid; u < (LDS_BYTES - LDSCTL_OFF) / 4; u += NWAVES * 64) ((LAS unsigned*)(ldsp + LDSCTL_OFF))[u] = 0u;
    __syncthreads();
    XcdBarrier bar = xcd_barrier_post((unsigned*)(ctl + CW_BAR), MISC + 8);
    const float* x = args.in[0]; const float* meta_tokens = args.in[1];
    bf16_t* W1T = (bf16_t*)(ws + WS_W1T); bf16_t* W2T = (bf16_t*)(ws + WS_W2T);
    bf16_t* HB = (bf16_t*)(ws + WS_HB); bf16_t* MIX = (bf16_t*)(ws + WS_MIX); bf16_t* PROJ = (bf16_t*)(ws + WS_PROJ);
    float* H = args.out;
    const int lo = args.ph_lo, hi = args.ph_hi;
    for (int ph_ = lo; ph_ < hi; ++ph_) {
        int ph = ph_, bid = (int)blockIdx.x, G = (int)gridDim.x;
        asm volatile("" : "+s"(ph), "+s"(bid), "+s"(G));
        if (ph >= 1 && ph <= 16) {
            const int l = (ph - 1) >> 2, sub = (ph - 1) & 3;
#ifndef NO_GEMM
            if (sub == 1) {
                pg8::Gemm g{HB, W1T + (size_t)l * NP * 1024, MR, NP, 1024}; pg8::StaticOrder S; S.init(MR, NP, G, bid);
                pg8::EpiProj E{PROJ, NP, att::C2};
                pg8::gemm_phase<pg8::EpiProj, pg8::StaticOrder, PG8_ALIGN, PG8_SP2>(ldsp + RING_OFF, g, S, E);
            } else
#endif
            if (sub == 2) {
                const float* CUMp = (const float*)(ws + WS_CUM);
                const float li = 0.8f - 0.6f * expf(-0.3f * (float)l);
                const float lam = ((const float*)(ws + WS_LAM))[l];
                const float* subg = args.in[9] + l * 128;
                const int vcu = (G % 8 == 0) ? (bid % 8) * (G / 8) + bid / 8 : bid;
                float* park = (float*)(ws + WS_RES) + ((size_t)bid * 8 + (size_t)__builtin_amdgcn_readfirstlane(tid >> 6)) * 8192;
                for (int pi = vcu; pi < 256; pi += G) {
                    const int bh = pi >> 3, s_ = pi & 7, b_ = bh >> 2, h_ = bh & 3;
                    if (args.at_mask & 1) for (int u = 0; u < 2; ++u) att::attn_unit<0>(ldsp + RING_OFF, PROJ, CUMp, MIX, b_, h_, u ? s_ : 15 - s_, lam, li, subg, park);
#ifndef NO_DIFF
                    if (args.at_mask & 2) for (int u = 0; u < 2; ++u) att::attn_unit<1>(ldsp + RING_OFF, PROJ, CUMp, MIX, b_, h_, u ? s_ : 15 - s_, lam, li, subg, park);
#endif
                }
            }
#ifndef NO_GEMM
            else if (sub == 3) {
                pg8::Gemm g{MIX, W2T + (size_t)l * 1024 * 1024, MR, 1024, 1024}; pg8::StaticOrder S; S.init(MR, 1024, G, bid);
                pg8::EpiResid E{l == 0 ? x : H, H, 1024};
                pg8::gemm_phase<pg8::EpiResid, pg8::StaticOrder, PG8_ALIGN, PG8_SP2>(ldsp + RING_OFF, g, S, E);
            }
#endif
        }
        if (ph_ + 1 < hi) xcd_barrier(bar);
    }
}

#ifndef AT_MASK
#define AT_MASK 3
#endif
static int g_grid = 0;
static void launch_phases(Args a, int lo, int hi, hipStream_t stream) {
    a.ph_lo = lo; a.ph_hi = hi;
    hipLaunchKernelGGL(mk_fwd, dim3(g_grid), dim3(NWAVES * 64), LDS_BYTES, stream, a);
}

extern "C" void kernel_launch(void* const* d_in, const int* in_sizes, int n_in, void* d_out, int out_size, void* d_ws, size_t ws_size, hipStream_t stream) {
    if (g_grid == 0) {
        int dev = 0, cus = 0, per_cu = 0;
        hipGetDevice(&dev); hipDeviceGetAttribute(&cus, hipDeviceAttributeMultiprocessorCount, dev);
        hipFuncSetAttribute((const void*)mk_fwd, hipFuncAttributeMaxDynamicSharedMemorySize, LDS_BYTES);
        hipOccupancyMaxActiveBlocksPerMultiprocessor(&per_cu, (const void*)mk_fwd, NWAVES * 64, LDS_BYTES);
        (void)hipGetLastError();
        g_grid = cus > 0 ? cus : 256;
    }
    const float* x = (const float*)d_in[0];
    const float* meta_tokens = (const float*)d_in[1];
    const float* norm_g = (const float*)d_in[2];
    const float* w_in = (const float*)d_in[3];
    const float* b_f = (const float*)d_in[4];
    const float* lq1 = (const float*)d_in[5];
    const float* lk1 = (const float*)d_in[6];
    const float* lq2 = (const float*)d_in[7];
    const float* lk2 = (const float*)d_in[8];
    const float* subln_g = (const float*)d_in[9];
    const float* w_pool = (const float*)d_in[10];
    const float* pool_scale = (const float*)d_in[11];
    const float* w_out = (const float*)d_in[12];
    const float* final_g = (const float*)d_in[13];
    unsigned char* ws = (unsigned char*)d_ws;
    bf16_t* W1T = (bf16_t*)(ws + WS_W1T); bf16_t* W2T = (bf16_t*)(ws + WS_W2T);
    float* WFG = (float*)(ws + WS_WFG); float* LAM = (float*)(ws + WS_LAM); float* HM = (float*)(ws + WS_HM);
    float* LOGF = (float*)(ws + WS_LOGF); float* CUM = (float*)(ws + WS_CUM);
    bf16_t* HB = (bf16_t*)(ws + WS_HB); bf16_t* MIX = (bf16_t*)(ws + WS_MIX); bf16_t* PROJ = (bf16_t*)(ws + WS_PROJ);
    float* H = (float*)d_out;
    hipMemsetAsync(ws + WS_CTL, 0, CTL_ZERO_BYTES, stream);
    Args a{};
    for (int i = 0; i < 14; ++i) a.in[i] = (const float*)d_in[i];
    a.out = (float*)d_out; a.ws = ws;

    hipLaunchKernelGGL(k_prep, dim3(2048), dim3(256), 0, stream, w_in, w_out, norm_g, lq1, lk1, lq2, lk2, W1T, W2T, WFG, LAM);
    for (int l = 0; l < DEPTH; ++l) {
        const float* hreal = l == 0 ? x : H;
        const float* hmeta = l == 0 ? meta_tokens : HM;
        hipLaunchKernelGGL(k_norm, dim3((MT * 64 + 255) / 256), dim3(256), 0, stream, hreal, hmeta, WFG + (size_t)l * 4096, b_f + l * 4, HB, LOGF);
        hipLaunchKernelGGL(k_scan, dim3(1), dim3(64), 0, stream, LOGF, CUM);
        launch_phases(a, 2 + 4 * l, 3 + 4 * l, stream);
        hipLaunchKernelGGL(k_gemm<0>, dim3(NP / 128, 1), dim3(256), 0, stream, HB + (size_t)MR * DM, W1T + (size_t)l * NP * 1024, 16, NP, 1024, PROJ + (size_t)MR * NP, NP,
                           (const float*)nullptr, (const float*)nullptr, (float*)nullptr, (float*)nullptr);
        a.at_mask = AT_MASK; launch_phases(a, 3 + 4 * l, 4 + 4 * l, stream);
        hipLaunchKernelGGL(k_fox, dim3(1), dim3(256), 0, stream, PROJ, CUM, MIX, 512);
        if (AT_MASK & 2) hipLaunchKernelGGL(k_diff, dim3(1), dim3(256), 0, stream, PROJ, subln_g + l * 128, LAM, l, MIX, 1024);
        else hipLaunchKernelGGL(k_diff, dim3((1025 * 4 * 64 + 255) / 256), dim3(256), 0, stream, PROJ, subln_g + l * 128, LAM, l, MIX, 0);
        hipLaunchKernelGGL(k_pool, dim3(MT), dim3(256), 0, stream, PROJ, w_pool + (size_t)l * 4 * 64 * 64, pool_scale + l * 256, MIX);
        launch_phases(a, 4 + 4 * l, 5 + 4 * l, stream);
        hipLaunchKernelGGL(k_gemm<1>, dim3(1024 / 128, 1), dim3(256), 0, stream, MIX + (size_t)MR * DM, W2T + (size_t)l * 1024 * 1024, 16, 1024, 1024, (bf16_t*)nullptr, 0,
                           hmeta, hmeta, HM, HM);
    }
    hipLaunchKernelGGL(k_final, dim3((MR * 64 + 255) / 256), dim3(256), 0, stream, H, final_g);
}
```

```cpp
#include <hip/hip_runtime.h>
#include <stdint.h>

typedef unsigned short bf16_t;
__device__ __forceinline__ float bf2f(bf16_t v) { return __uint_as_float(((unsigned)v) << 16); }
__device__ __forceinline__ bf16_t f2bf(float f) { unsigned u = __float_as_uint(f); return (bf16_t)((u + 0x7fffu + ((u >> 16) & 1u)) >> 16); }

constexpr int BATCH = 8, SEQ = 4096, DM = 1024, DEPTH = 4, NMETA = 16;
constexpr int MR = BATCH * SEQ;
constexpr int MT = MR + NMETA;
constexpr int IN_DIM = 3588, NP = 3584;
constexpr int C_FQ = 0, C_FK = 256, C_FV = 512, C_FZ = 768, C_DQ = 1024, C_DK = 1536, C_DV = 2048, C_DZ = 2560, C_PU = 3072, C_PZ = 3328;
constexpr int M_A = 0, M_B = 256, M_C = 768;
constexpr float LN2F = 0.6931471805599453f;

constexpr size_t MiB = 1u << 20;
constexpr size_t WS_CTL = 0;
constexpr size_t WS_W1T = 2 * MiB;
constexpr size_t WS_W2T = 30 * MiB;
constexpr size_t WS_WFG = 38 * MiB;
constexpr size_t WS_LAM = 38 * MiB + 65536;
constexpr size_t WS_HM  = 38 * MiB + 131072;
constexpr size_t WS_WPT = 38 * MiB + 262144;
constexpr size_t WS_LOGF = 39 * MiB;
constexpr size_t WS_CUM = 40 * MiB;
constexpr size_t WS_HB = 42 * MiB;
constexpr size_t WS_MIX = 108 * MiB;
constexpr size_t WS_PROJ = 174 * MiB;
constexpr size_t WS_RES = 400 * MiB;
constexpr size_t WS_END = 464 * MiB;

__device__ __forceinline__ float wave_sum(float v) {
#pragma unroll
    for (int o = 1; o < 64; o <<= 1) v += __shfl_xor(v, o);
    return v;
}
__device__ __forceinline__ float log_sigmoid(float x) { return fminf(x, 0.f) - log1pf(expf(-fabsf(x))); }
__device__ __forceinline__ float silu(float x) { return x / (1.f + expf(-x)); }

__device__ __forceinline__ void norm_row(int row, int lane, const float* __restrict__ hreal, const float* __restrict__ hmeta, const float* __restrict__ WFG_l,
                                         const float* __restrict__ bf_l, bf16_t* HB, float* LOGF) {
    const float* hp = row < MR ? hreal + (size_t)row * DM : hmeta + (size_t)(row - MR) * DM;
    float4 v[4]; float ss = 0.f;
#pragma unroll
    for (int j = 0; j < 4; ++j) { v[j] = *(const float4*)(hp + j * 256 + lane * 4); ss += v[j].x * v[j].x + v[j].y * v[j].y + v[j].z * v[j].z + v[j].w * v[j].w; }
    ss = wave_sum(ss);
    const float rstd = rsqrtf(ss * (1.f / DM) + 1e-6f);
    float fg[4];
#pragma unroll
    for (int c = 0; c < 4; ++c) {
        float a = 0.f;
#pragma unroll
        for (int j = 0; j < 4; ++j) { const float4 w = *(const float4*)(WFG_l + c * 1024 + j * 256 + lane * 4); a += v[j].x * w.x + v[j].y * w.y + v[j].z * w.z + v[j].w * w.w; }
        fg[c] = wave_sum(a) * rstd;
    }
#pragma unroll
    for (int j = 0; j < 4; ++j) {
        ushort4 o; o.x = f2bf(v[j].x * rstd); o.y = f2bf(v[j].y * rstd); o.z = f2bf(v[j].z * rstd); o.w = f2bf(v[j].w * rstd);
        *(ushort4*)(HB + (size_t)row * DM + j * 256 + lane * 4) = o;
    }
    if (lane < 4) LOGF[row * 4 + lane] = log_sigmoid((lane == 0 ? fg[0] : lane == 1 ? fg[1] : lane == 2 ? fg[2] : fg[3]) + bf_l[lane]);
}
__device__ __forceinline__ void final_row(int row, int lane, float* H, const float* __restrict__ final_g) {
    float* hp = H + (size_t)row * DM;
    float4 v[4]; float ss = 0.f;
#pragma unroll
    for (int j = 0; j < 4; ++j) { v[j] = *(const float4*)(hp + j * 256 + lane * 4); ss += v[j].x * v[j].x + v[j].y * v[j].y + v[j].z * v[j].z + v[j].w * v[j].w; }
    ss = wave_sum(ss);
    const float rstd = rsqrtf(ss * (1.f / DM) + 1e-6f);
#pragma unroll
    for (int j = 0; j < 4; ++j) {
        const float4 g = *(const float4*)(final_g + j * 256 + lane * 4);
        float4 o; o.x = v[j].x * rstd * g.x; o.y = v[j].y * rstd * g.y; o.z = v[j].z * rstd * g.z; o.w = v[j].w * rstd * g.w;
        *(float4*)(hp + j * 256 + lane * 4) = o;
    }
}
__device__ __forceinline__ void scan_bh(int b, int h, int lane, const float* __restrict__ LOGF, float* CUM) {
    const float* p = LOGF + ((size_t)b * SEQ + (size_t)lane * 64) * 4 + h;
    float s = 0.f;
#pragma unroll 16
    for (int j = 0; j < 64; ++j) s += p[j * 4];
    float inc = s;
#pragma unroll
    for (int o = 1; o < 64; o <<= 1) { const float t = __shfl_up(inc, o); if (lane >= o) inc += t; }
    float c = inc - s;
    float* q = CUM + ((size_t)b * SEQ + (size_t)lane * 64) * 4 + h;
#pragma unroll 16
    for (int j = 0; j < 64; ++j) { c += p[j * 4]; q[j * 4] = c; }
}
__device__ __forceinline__ void scan_meta(int lane, const float* __restrict__ LOGF, float* CUM) {
    if (lane < 4) { const int h = lane; float c = 0.f;
        for (int j = 15; j >= 0; --j) { CUM[(size_t)(MR + j) * 4 + h] = -c; c += LOGF[(size_t)(MR + j) * 4 + h]; } }
}
typedef short mbf16x8 __attribute__((ext_vector_type(8)));
typedef float mf32x4 __attribute__((ext_vector_type(4)));
__device__ __forceinline__ mf32x4 meta_gemm16(const bf16_t* __restrict__ A16, const bf16_t* __restrict__ Bt, int nb, int lane) {
    const int fr = lane & 15, fq = lane >> 4; mf32x4 acc = {0.f, 0.f, 0.f, 0.f};
    const bf16_t* ap = A16 + fr * 1024 + fq * 8; const bf16_t* bp = Bt + (size_t)(16 * nb + fr) * 1024 + fq * 8;
#pragma unroll 8
    for (int kk = 0; kk < 32; ++kk) { const mbf16x8 a = *(const mbf16x8*)(ap + kk * 32), b = *(const mbf16x8*)(bp + kk * 32); acc = __builtin_amdgcn_mfma_f32_16x16x32_bf16(a, b, acc, 0, 0, 0); }
    return acc;
}
__device__ __forceinline__ void fox_meta(int h, int lane, const bf16_t* __restrict__ PROJ, const float* __restrict__ CUM, bf16_t* MIX) {
    const int t = lane & 15, row = MR + t;
    float q[64], o[64];
    const bf16_t* qp = PROJ + (size_t)row * NP + C_FQ + h * 64;
#pragma unroll
    for (int d = 0; d < 64; ++d) { q[d] = bf2f(qp[d]) * LN2F; o[d] = 0.f; }
    const float cq = CUM[(size_t)row * 4 + h];
    float m = -1e30f, lsum = 0.f;
    for (int kk = 0; kk < 16; ++kk) {
        const int krow = MR + kk;
        const bf16_t* kp = PROJ + (size_t)krow * NP + C_FK + h * 64;
        const bf16_t* vp = PROJ + (size_t)krow * NP + C_FV + h * 64;
        float sc = 0.f;
#pragma unroll
        for (int d = 0; d < 64; ++d) sc += q[d] * bf2f(kp[d]);
        sc += cq - CUM[(size_t)krow * 4 + h];
        if (kk <= t) {
            if (sc > m) { const float a = __expf(m - sc); lsum *= a;
#pragma unroll
                for (int d = 0; d < 64; ++d) o[d] *= a;
                m = sc; }
            const float p = __expf(sc - m); lsum += p;
#pragma unroll
            for (int d = 0; d < 64; ++d) o[d] += p * bf2f(vp[d]);
        }
    }
    if (lane >= 16) return;
    const float inv = 1.f / lsum;
    const bf16_t* zp = PROJ + (size_t)row * NP + C_FZ + h * 64;
    bf16_t* mp = MIX + (size_t)row * DM + M_A + h * 64;
#pragma unroll
    for (int d = 0; d < 64; ++d) mp[d] = f2bf(o[d] * inv * silu(bf2f(zp[d])));
}
__device__ __forceinline__ void diff_meta(int h, int lane, const bf16_t* __restrict__ PROJ, const float* __restrict__ subln_g_l, float lam, float li, bf16_t* MIX) {
    const int ri = (lane >> 1) & 15, eh = lane & 1, row = MR + ri;
    const float posq = (float)ri, slope = exp2f(-2.f * (float)(h + 1));
    float res[64];
    for (int c = 0; c < 2; ++c) {
        float q[64], o[64];
        const bf16_t* qp = PROJ + (size_t)row * NP + C_DQ + h * 128 + c * 64;
#pragma unroll
        for (int d = 0; d < 64; ++d) { q[d] = bf2f(qp[d]) * LN2F; o[d] = 0.f; }
        float m = -1e30f, lsum = 0.f;
        for (int kk = 0; kk < 16; ++kk) {
            const int krow = MR + kk;
            const bf16_t* kp = PROJ + (size_t)krow * NP + C_DK + h * 128 + c * 64;
            const bf16_t* vp = PROJ + (size_t)krow * NP + C_DV + h * 128 + eh * 64;
            float sc = 0.f;
#pragma unroll
            for (int d = 0; d < 64; ++d) sc += q[d] * bf2f(kp[d]);
            sc -= slope * fabsf(posq - (float)kk);
            if (sc > m) { const float a = __expf(m - sc); lsum *= a;
#pragma unroll
                for (int d = 0; d < 64; ++d) o[d] *= a;
                m = sc; }
            const float p = __expf(sc - m); lsum += p;
#pragma unroll
            for (int d = 0; d < 64; ++d) o[d] += p * bf2f(vp[d]);
        }
        const float inv = 1.f / lsum;
        if (c == 0) {
#pragma unroll
            for (int d = 0; d < 64; ++d) res[d] = o[d] * inv;
        } else {
#pragma unroll
            for (int d = 0; d < 64; ++d) res[d] -= lam * o[d] * inv;
        }
    }
    float ss = 0.f;
#pragma unroll
    for (int d = 0; d < 64; ++d) ss += res[d] * res[d];
    ss += __shfl_xor(ss, 1);
    const float rstd = rsqrtf(ss * (1.f / 128.f) + 1e-5f);
    if (lane >= 32) return;
    const bf16_t* zp = PROJ + (size_t)row * NP + C_DZ + h * 128 + eh * 64;
    bf16_t* mp = MIX + (size_t)row * DM + M_B + h * 128 + eh * 64;
#pragma unroll
    for (int d = 0; d < 64; ++d) mp[d] = f2bf(res[d] * rstd * subln_g_l[eh * 64 + d] * (1.f - li) * silu(bf2f(zp[d])));
}
__device__ __forceinline__ void pool_meta(int j, int g, int lane, const bf16_t* __restrict__ PROJ, const float* __restrict__ wpool_l, const float* __restrict__ pscale_l, bf16_t* MIX) {
    const int w = 2 << g, cnt = (j + 1) < w ? (j + 1) : w, row = MR + j;
    float s = 0.f;
    for (int i = 0; i < cnt; ++i) s += bf2f(PROJ[(size_t)(MR + j - i) * NP + C_PU + g * 64 + lane]);
    const float pooled = s / (float)cnt - bf2f(PROJ[(size_t)row * NP + C_PU + g * 64 + lane]);
    float y = 0.f;
    for (int i = 0; i < 64; ++i) y += __shfl(pooled, i) * wpool_l[(g * 64 + i) * 64 + lane];
    const float z = bf2f(PROJ[(size_t)row * NP + C_PZ + g * 64 + lane]);
    MIX[(size_t)row * DM + M_C + g * 64 + lane] = f2bf(y * pscale_l[g * 64 + lane] * silu(z));
}

namespace pg8 {
#define PG8_LAS __attribute__((address_space(3)))
typedef unsigned short bf16_t;
typedef short bf16x8 __attribute__((ext_vector_type(8)));
typedef float f32x4 __attribute__((ext_vector_type(4)));
typedef unsigned u32x4 __attribute__((ext_vector_type(4)));
constexpr int BM = 256, BK = 64, HALF = 128, HTB = HALF * BK * 2  , STAGE_BYTES = 8 * HTB, NXCD = 8, WGM = 8;

__host__ __device__ __forceinline__ int lds_byte(int r, int c) { const int st = (r >> 4) * 2 + (c >> 5), rr = r & 15, cc = c & 31, ob = rr * 64 + cc * 2; return st * 1024 + (ob ^ (((ob >> 9) & 1) << 5)); }
__host__ __device__ __forceinline__ void stage_rc(int b, int& R, int& C) { const int st = b / 1024, sb = b % 1024, swz = sb ^ (((sb >> 9) & 1) << 5); R = (st >> 1) * 16 + swz / 64; C = (st & 1) * 32 + (swz % 64) / 2; }
__host__ __device__ __forceinline__ int perm32(int rho) { const int n = rho >> 4, i = rho & 15; return 8 * (i >> 2) + 4 * n + (i & 3); }

struct Unit { int pm, pn; };
struct Gemm { const bf16_t* A; const bf16_t* Bt; int M, N, K; };

struct StaticOrder {
    int nM, nN, nwg, G, c;
    __host__ __device__ void init(int M, int N, int G_, int c_) { nM = M / BM; nN = N / BM; nwg = nM * nN; G = G_; c = c_; }
    __host__ __device__ bool next(int i, Unit& u) const {
        const long L = (long)i * G + c; if (L >= nwg) return false;
        int wgid = (int)L; { const int q = nwg / NXCD, r = nwg % NXCD, xcd = wgid % NXCD, off = wgid / NXCD; wgid = (xcd < r ? xcd * (q + 1) : r * (q + 1) + (xcd - r) * q) + off; }
        const int nig = WGM * nN, gid = wgid / nig, fm = gid * WGM, gsz = (nM - fm) < WGM ? (nM - fm) : WGM;
        u.pm = fm + ((wgid % nig) % gsz); u.pn = (wgid % nig) / gsz; return true;
    }
    __device__ __forceinline__ void a_ready(const Unit&) const {}
    __device__ __forceinline__ void done(const Unit&) const {}
};

__device__ __forceinline__ unsigned cvt_pk_bf16(float lo, float hi) { unsigned r; asm volatile("v_cvt_pk_bf16_f32 %0, %1, %2" : "=v"(r) : "v"(lo), "v"(hi)); return r; }
struct EpiProj {
    static constexpr bool PERM = true, AFTER_DRAIN = false;
    bf16_t* O; int ldc; float qscale;
    __device__ __forceinline__ void operator()(const f32x4 (&acc)[2][2][4][2], const Unit& u, int wr, int wc, int fr, int fq) const {
        const int row0 = u.pm * BM + wr * 64 + fr, col0 = u.pn * BM + wc * 32 + 8 * fq;
        const float sc = (u.pn == 0 || u.pn == 4 || u.pn == 5) ? qscale : 1.f;
#pragma unroll
        for (int ai = 0; ai < 2; ++ai)
#pragma unroll
            for (int m = 0; m < 4; ++m) { bf16_t* rowp = O + (size_t)(row0 + ai * HALF + m * 16) * ldc + col0;
#pragma unroll
                for (int bj = 0; bj < 2; ++bj) { const f32x4 v0 = acc[ai][bj][m][0] * sc, v1 = acc[ai][bj][m][1] * sc;
                    u32x4 w; w.x = cvt_pk_bf16(v0[0], v0[1]); w.y = cvt_pk_bf16(v0[2], v0[3]); w.z = cvt_pk_bf16(v1[0], v1[1]); w.w = cvt_pk_bf16(v1[2], v1[3]);
                    *(u32x4*)(rowp + bj * HALF) = w; } }
    }
};
struct EpiResid {
    static constexpr bool PERM = false, AFTER_DRAIN = false;
    const float* base; float* out; int ldc;
    __device__ __forceinline__ void operator()(const f32x4 (&acc)[2][2][4][2], const Unit& u, int wr, int wc, int fr, int fq) const {
        const int col0 = u.pn * BM + wc * 32 + 4 * fq;
#pragma unroll
        for (int ai = 0; ai < 2; ++ai)
#pragma unroll
            for (int m = 0; m < 4; ++m) { const size_t off = (size_t)(u.pm * BM + ai * HALF + wr * 64 + m * 16 + fr) * ldc + col0;
#pragma unroll
                for (int bj = 0; bj < 2; ++bj)
#pragma unroll
                    for (int n = 0; n < 2; ++n) { const f32x4 bs = *(const f32x4*)(base + off + bj * HALF + n * 16); *(f32x4*)(out + off + bj * HALF + n * 16) = bs + acc[ai][bj][m][n]; } }
    }
};
template <class Epi, class Sched, bool ALIGN_EPI = false, bool SP2 = false>
__device__ __forceinline__ void gemm_phase(PG8_LAS unsigned char* lds, const Gemm g, const Sched& S, const Epi& E) {
    int tid_ = threadIdx.x; asm volatile("" : "+v"(tid_));
    const int tid = tid_, wid = __builtin_amdgcn_readfirstlane(tid >> 6), lane = tid & 63, wr = wid >> 2, wc = wid & 3, fr = lane & 15, fq = lane >> 4;
    const int K = g.K, nt = K / BK;
    unsigned voffA[2], voffB[2];
#pragma unroll
    for (int i = 0; i < 2; ++i) { int R, C; stage_rc(tid * 16 + i * 8192, R, C); const int Rb = Epi::PERM ? ((R & ~31) + perm32(R & 31)) : R;
        voffA[i] = (unsigned)(R * K + C) * 2u; voffB[i] = (unsigned)(Rb * K + C) * 2u; }
    const size_t kstep = (size_t)(BK * 2);
    const size_t hstep = (size_t)HALF * K * 2;
    const size_t tstep = 2 * hstep;
    const unsigned ldsw = (unsigned)wid * 1024u;
    const int aoff = lds_byte(wr * 64 + fr, fq * 8), boff = lds_byte(wc * 32 + fr, fq * 8);
#define PG8_SA(b, h) (((b) * 2 + (h)) * HTB)
#define PG8_SB(b, h) ((4 + (b) * 2 + (h)) * HTB)
#define PG8_STAGE(bufoff, gbase, voff) do { _Pragma("unroll") for (int _i = 0; _i < 2; ++_i) \
        __builtin_amdgcn_global_load_lds((const unsigned*)((const char*)(gbase) + (voff)[_i]), (PG8_LAS unsigned*)(lds + (bufoff) + ldsw + _i * 8192), 16, 0, 0); } while (0)
#define PG8_LDA(dst, b, h) do { _Pragma("unroll") for (int m = 0; m < 4; ++m) _Pragma("unroll") for (int k = 0; k < 2; ++k) dst[m][k] = *(const PG8_LAS bf16x8*)(lds + PG8_SA(b, h) + aoff + m * 2048 + k * 1024); } while (0)
#define PG8_LDB(dst, b, h) do { _Pragma("unroll") for (int n = 0; n < 2; ++n) _Pragma("unroll") for (int k = 0; k < 2; ++k) dst[n][k] = *(const PG8_LAS bf16x8*)(lds + PG8_SB(b, h) + boff + n * 2048 + k * 1024); } while (0)
#define PG8_MMA(ai, bj, At, Bt) do { __builtin_amdgcn_s_setprio(1); _Pragma("unroll") for (int m = 0; m < 4; ++m) _Pragma("unroll") for (int n = 0; n < 2; ++n) _Pragma("unroll") for (int k = 0; k < 2; ++k) \
        acc[ai][bj][m][n] = __builtin_amdgcn_mfma_f32_16x16x32_bf16(Bt[n][k], At[m][k], acc[ai][bj][m][n], 0, 0, 0); __builtin_amdgcn_s_setprio(0); } while (0)
#define PG8_WAIT_V(n) asm volatile("s_waitcnt vmcnt(" #n ")" ::: "memory")
#define PG8_WAIT_L(n) asm volatile("s_waitcnt lgkmcnt(" #n ")" ::: "memory")
#define PG8_BAR __builtin_amdgcn_s_barrier()
#define PG8_SCHED __builtin_amdgcn_sched_barrier(0)
    Unit cur, nxt; int ui = 0;
    if (!S.next(0, cur)) return;
    f32x4 acc[2][2][4][2];
#pragma unroll
    for (int a = 0; a < 2; ++a)
#pragma unroll
        for (int b = 0; b < 2; ++b)
#pragma unroll
            for (int m = 0; m < 4; ++m)
#pragma unroll
                for (int n = 0; n < 2; ++n) acc[a][b][m][n] = (f32x4){0.f, 0.f, 0.f, 0.f};
    bf16x8 At[4][2], B0[2][2], B1[2][2];
    const char* cA = (const char*)g.A + (size_t)cur.pm * tstep; const char* cB = (const char*)g.Bt + (size_t)cur.pn * tstep;
    S.a_ready(cur);
    if constexpr (SP2) {
        PG8_STAGE(PG8_SB(0, 0), cB, voffB); PG8_STAGE(PG8_SB(0, 1), cB + hstep, voffB); PG8_STAGE(PG8_SA(0, 0), cA, voffA); PG8_STAGE(PG8_SA(0, 1), cA + hstep, voffA);
        if (wr == 1) PG8_BAR;
        PG8_WAIT_V(2); PG8_BAR;
        PG8_STAGE(PG8_SB(1, 0), cB + kstep, voffB); PG8_STAGE(PG8_SA(1, 0), cA + kstep, voffA); PG8_STAGE(PG8_SB(1, 1), cB + hstep + kstep, voffB);
        PG8_WAIT_V(6); PG8_BAR;
    } else {
        PG8_STAGE(PG8_SB(0, 0), cB, voffB); PG8_STAGE(PG8_SA(0, 0), cA, voffA); PG8_STAGE(PG8_SB(0, 1), cB + hstep, voffB); PG8_STAGE(PG8_SA(0, 1), cA + hstep, voffA);
        if (wr == 1) PG8_BAR;
        PG8_WAIT_V(4); PG8_BAR;
        PG8_STAGE(PG8_SB(1, 0), cB + kstep, voffB); PG8_STAGE(PG8_SA(1, 0), cA + kstep, voffA); PG8_STAGE(PG8_SB(1, 1), cB + hstep + kstep, voffB);
        PG8_WAIT_V(6); PG8_BAR;
    }
    for (;;) {
        const bool has_next = S.next(ui + 1, nxt);
        const char* nA = has_next ? (const char*)g.A + (size_t)nxt.pm * tstep : cA; const char* nB = has_next ? (const char*)g.Bt + (size_t)nxt.pn * tstep : cB;
        for (int t = 0; t < nt; t += 2) {
            const bool last = (t == nt - 2);
            const char* a1 = cA + (size_t)(t + 1) * kstep;
            const char* a2 = last ? nA : cA + (size_t)(t + 2) * kstep; const char* b2 = last ? nB : cB + (size_t)(t + 2) * kstep;
            const char* a3 = a2 + kstep; const char* b3 = b2 + kstep;
            if (last && has_next) S.a_ready(nxt);
            if constexpr (SP2) {
            PG8_LDB(B0, 0, 0); PG8_LDB(B1, 0, 1); PG8_SCHED; PG8_LDA(At, 0, 0); PG8_STAGE(PG8_SA(1, 1), a1 + hstep, voffA);
            PG8_WAIT_V(8); PG8_WAIT_L(0); PG8_BAR; PG8_MMA(0, 0, At, B0); PG8_MMA(0, 1, At, B1); PG8_BAR; PG8_SCHED;
            PG8_LDA(At, 0, 1); PG8_STAGE(PG8_SB(0, 0), b2, voffB); PG8_STAGE(PG8_SB(0, 1), b2 + hstep, voffB); PG8_STAGE(PG8_SA(0, 0), a2, voffA);
            PG8_WAIT_V(8); PG8_WAIT_L(0); PG8_BAR; PG8_MMA(1, 0, At, B0); PG8_MMA(1, 1, At, B1); PG8_BAR; PG8_SCHED;
            PG8_LDB(B0, 1, 0); PG8_LDB(B1, 1, 1); PG8_SCHED; PG8_LDA(At, 1, 0); PG8_STAGE(PG8_SA(0, 1), a2 + hstep, voffA);
            PG8_WAIT_V(8); PG8_WAIT_L(0); PG8_BAR; PG8_MMA(0, 0, At, B0); PG8_MMA(0, 1, At, B1); PG8_BAR; PG8_SCHED;
            PG8_LDA(At, 1, 1); PG8_STAGE(PG8_SB(1, 0), b3, voffB); PG8_STAGE(PG8_SB(1, 1), b3 + hstep, voffB); PG8_STAGE(PG8_SA(1, 0), a3, voffA);
            PG8_WAIT_V(8); PG8_WAIT_L(0); PG8_BAR; PG8_MMA(1, 0, At, B0); PG8_MMA(1, 1, At, B1); PG8_BAR; PG8_SCHED;
            } else {
            PG8_LDB(B0, 0, 0); PG8_SCHED; PG8_LDA(At, 0, 0); PG8_STAGE(PG8_SA(1, 1), a1 + hstep, voffA);
            PG8_WAIT_L(8); PG8_BAR; PG8_WAIT_L(0); PG8_MMA(0, 0, At, B0); PG8_BAR; PG8_SCHED;
            PG8_LDB(B1, 0, 1); PG8_STAGE(PG8_SB(0, 0), b2, voffB);
            PG8_BAR; PG8_WAIT_L(0); PG8_MMA(0, 1, At, B1); PG8_BAR;
            PG8_LDA(At, 0, 1); PG8_STAGE(PG8_SA(0, 0), a2, voffA);
            PG8_BAR; PG8_WAIT_L(0); PG8_MMA(1, 0, At, B0); PG8_BAR; PG8_SCHED;
            PG8_STAGE(PG8_SB(0, 1), b2 + hstep, voffB);
            PG8_WAIT_V(6); PG8_BAR; PG8_MMA(1, 1, At, B1); PG8_BAR;
            PG8_LDB(B0, 1, 0); PG8_SCHED; PG8_LDA(At, 1, 0); PG8_STAGE(PG8_SA(0, 1), a2 + hstep, voffA);
            PG8_WAIT_L(8); PG8_BAR; PG8_WAIT_L(0); PG8_MMA(0, 0, At, B0); PG8_BAR; PG8_SCHED;
            PG8_LDB(B1, 1, 1); PG8_STAGE(PG8_SB(1, 0), b3, voffB);
            PG8_BAR; PG8_WAIT_L(0); PG8_MMA(0, 1, At, B1); PG8_BAR;
            PG8_LDA(At, 1, 1); PG8_STAGE(PG8_SA(1, 0), a3, voffA);
            PG8_BAR; PG8_WAIT_L(0); PG8_MMA(1, 0, At, B0); PG8_BAR; PG8_SCHED;
            PG8_STAGE(PG8_SB(1, 1), b3 + hstep, voffB);
            PG8_WAIT_V(6); PG8_BAR; PG8_MMA(1, 1, At, B1); PG8_BAR;
            }
        }
        if constexpr (ALIGN_EPI) { if (wr == 0) PG8_BAR; }
        if constexpr (!Epi::AFTER_DRAIN) { E(acc, cur, wr, wc, fr, fq); S.done(cur); }
        if (!has_next) break;
#pragma unroll
        for (int a = 0; a < 2; ++a)
#pragma unroll
            for (int b = 0; b < 2; ++b)
#pragma unroll
                for (int m = 0; m < 4; ++m)
#pragma unroll
                    for (int n = 0; n < 2; ++n) acc[a][b][m][n] = (f32x4){0.f, 0.f, 0.f, 0.f};
        cur = nxt; cA = nA; cB = nB; ++ui;
        if constexpr (ALIGN_EPI) { if (wr == 1) PG8_BAR; }
    }
    PG8_WAIT_V(0);
    if constexpr (!ALIGN_EPI) { if (wr == 0) PG8_BAR; }
    PG8_BAR;
    if constexpr (Epi::AFTER_DRAIN) { E.fused(acc, cur, wr, wc, fr, fq, lds, wid, lane); S.done(cur); }
#undef PG8_SA
#undef PG8_SB
#undef PG8_STAGE
#undef PG8_LDA
#undef PG8_LDB
#undef PG8_MMA
#undef PG8_WAIT_V
#undef PG8_WAIT_L
#undef PG8_BAR
#undef PG8_SCHED
}
}
namespace att {
typedef float f32x16 __attribute__((ext_vector_type(16)));
typedef float f32x4 __attribute__((ext_vector_type(4)));
typedef short bf16x8 __attribute__((ext_vector_type(8)));
typedef short s16x4 __attribute__((ext_vector_type(4)));
typedef unsigned u32x4 __attribute__((ext_vector_type(4)));
#define ALAS __attribute__((address_space(3)))
constexpr int KCS = 1040, VDS = 4160, KBUF = 8 * KCS, VBUF = 4 * VDS, KBOFF = KBUF + VBUF, STG = KBOFF + 256;
constexpr int L_WSF = 2 * STG, L_OST = L_WSF + 8 * 256, L_END = L_OST + 8 * 8192;
constexpr float LOG2E = 1.4426950408889634f, C2 = 0.125f * LOG2E, THR = 8.f, NEGBIG = -1e30f;
__device__ __forceinline__ int crow(int r, int hi) { return (r & 3) + 8 * (r >> 2) + 4 * hi; }
__device__ __forceinline__ unsigned cvtpk(float lo, float hi) { typedef float f2 __attribute__((ext_vector_type(2))); typedef __bf16 b2 __attribute__((ext_vector_type(2))); f2 v = {lo, hi}; b2 b = __builtin_convertvector(v, b2); return __builtin_bit_cast(unsigned, b); }
__device__ __forceinline__ s16x4 vtr(const ALAS unsigned char* p) { typedef short v4i16_t __attribute__((ext_vector_type(4))); return __builtin_bit_cast(s16x4, __builtin_amdgcn_ds_read_tr16_b64_v4i16((ALAS v4i16_t*)p)); }
__device__ __forceinline__ float bfl(unsigned w) { return __uint_as_float(w << 16); }
__device__ __forceinline__ float bfh(unsigned w) { return __uint_as_float(w & 0xffff0000u); }
__device__ __forceinline__ float silu_f(float x) { return x / (1.f + __expf(-x)); }

struct TileRegs { u32x4 k, v0, v1; float kb; };

template <int MODE> __device__ __forceinline__ void load_tile(TileRegs& R, const bf16_t* __restrict__ PROJ, const float* __restrict__ CUM, size_t krow0, bool meta, int kcol, int vcol, int h, int tid) {
    const u32x4 z = {0u, 0u, 0u, 0u};
    { const int key = tid >> 3, ch = tid & 7;
      R.k = z; if (!(meta && key >= 16)) R.k = *(const u32x4*)(PROJ + (krow0 + key) * NP + kcol + ch * 8);
      if (MODE == 0) { R.v0 = z; if (!(meta && key >= 16)) R.v0 = *(const u32x4*)(PROJ + (krow0 + key) * NP + vcol + ch * 8); } }
    if (MODE == 1) { const int key = tid >> 4, ch = tid & 15;
      R.v0 = z; R.v1 = z;
      if (!(meta && key >= 16)) R.v0 = *(const u32x4*)(PROJ + (krow0 + key) * NP + vcol + ch * 8);
      if (!meta) R.v1 = *(const u32x4*)(PROJ + (krow0 + key + 32) * NP + vcol + ch * 8); }
    if (MODE == 0) { R.kb = NEGBIG; if (tid < 64 && !(meta && tid >= 16)) R.kb = -CUM[(krow0 + tid) * 4 + h] * LOG2E; }
}
template <int MODE> __device__ __forceinline__ void store_tile(const TileRegs& R, ALAS unsigned char* buf, int tid) {
    { const int key = tid >> 3, ch = tid & 7;
      *(ALAS u32x4*)(buf + ch * KCS + key * 16) = R.k;
      if (MODE == 0) *(ALAS u32x4*)(buf + KBUF + (ch >> 2) * VDS + (key >> 4) * 1024 + (key & 15) * 64 + (ch & 3) * 16) = R.v0; }
    if (MODE == 1) { const int key = tid >> 4, ch = tid & 15;
      ALAS unsigned char* p = buf + KBUF + (ch >> 2) * VDS + (key >> 4) * 1024 + (key & 15) * 64 + (ch & 3) * 16;
      *(ALAS u32x4*)p = R.v0; *(ALAS u32x4*)(p + 2048) = R.v1; }
    if (MODE == 0) { if (tid < 64) *(ALAS float*)(buf + KBOFF + tid * 4) = R.kb; }
}

template <int MODE, int NDB> __device__ __forceinline__ void compute_tile(const ALAS unsigned char* buf, const bf16x8 (&qr)[4], f32x16 (&o)[NDB], float& mhat, float& l,
        int kidx0, bool meta, bool diag, int qw0, float slope2, ALAS float* wsf, int lane) {
    const int r32 = lane & 31, hi = lane >> 5;
    f32x16 p0, p1;
    asm volatile("" : "+v"(slope2), "+s"(kidx0));
    if (MODE == 0) {
        const ALAS f32x4* kbp = (const ALAS f32x4*)(buf + KBOFF);
#pragma unroll
        for (int g = 0; g < 4; ++g) { const f32x4 a = kbp[2 * g + hi], b = kbp[8 + 2 * g + hi];
#pragma unroll
            for (int j = 0; j < 4; ++j) { p0[4 * g + j] = a[j] - mhat; p1[4 * g + j] = b[j] - mhat; } }
    } else {
        if (!diag) {
            const float base = slope2 * (float)(kidx0 + 4 * hi - qw0) - mhat;
#pragma unroll
            for (int r = 0; r < 16; ++r) { const int c = (r & 3) + 8 * (r >> 2); p0[r] = fmaf((float)c, slope2, base); p1[r] = fmaf((float)(c + 32), slope2, base); }
            if (meta) {
#pragma unroll
                for (int r = 0; r < 16; ++r) { if ((r >> 2) >= 2) p0[r] = NEGBIG; p1[r] = NEGBIG; }
            }
        } else {
            const float dq = (float)(qw0 + r32 - kidx0 - 4 * hi), fr = (float)r32;
#pragma unroll
            for (int r = 0; r < 16; ++r) { const int c = (r & 3) + 8 * (r >> 2);
                p0[r] = slope2 * (fr - fabsf(dq - (float)c)) - mhat; p1[r] = slope2 * (fr - fabsf(dq - (float)(c + 32))) - mhat; }
        }
    }
    { const ALAS unsigned char* kb = buf + hi * KCS + r32 * 16;
#pragma unroll
      for (int d0 = 0; d0 < 4; ++d0) {
          const bf16x8 k0 = *(const ALAS bf16x8*)(kb + d0 * 2 * KCS), k1 = *(const ALAS bf16x8*)(kb + d0 * 2 * KCS + 512);
          p0 = __builtin_amdgcn_mfma_f32_32x32x16_bf16(k0, qr[d0], p0, 0, 0, 0);
          p1 = __builtin_amdgcn_mfma_f32_32x32x16_bf16(k1, qr[d0], p1, 0, 0, 0); } }
    if (MODE == 0 && diag) {
        const int lim = qw0 + r32 - kidx0 - 4 * hi;
#pragma unroll
        for (int r = 0; r < 16; ++r) { const int c = (r & 3) + 8 * (r >> 2); if (c > lim) p0[r] = NEGBIG; if (c + 32 > lim) p1[r] = NEGBIG; }
    }
    float rm;
    { float a = fmaxf(p0[0], p1[0]);
#pragma unroll
      for (int r = 1; r < 16; ++r) a = fmaxf(a, fmaxf(p0[r], p1[r]));
      auto rr = __builtin_amdgcn_permlane32_swap(__float_as_uint(a), __float_as_uint(a), false, false);
      rm = fmaxf(__uint_as_float(rr[0]), __uint_as_float(rr[1])); }
    bool resc = false;
    if (__any(rm > THR)) {
        const float dl = fmaxf(rm, 0.f); mhat += dl;
#pragma unroll
        for (int r = 0; r < 16; ++r) { p0[r] -= dl; p1[r] -= dl; }
        const float f = __builtin_amdgcn_exp2f(-dl); l *= f; if (hi == 0) wsf[r32] = f; resc = true;
    }
    float sacc = 0.f;
#pragma unroll
    for (int r = 0; r < 16; ++r) { p0[r] = __builtin_amdgcn_exp2f(p0[r]); p1[r] = __builtin_amdgcn_exp2f(p1[r]); sacc += p0[r] + p1[r]; }
    l += sacc;
    u32x4 pw[4];
#pragma unroll
    for (int j = 0; j < 4; ++j) { pw[0][j] = cvtpk(p0[2 * j], p0[2 * j + 1]); pw[1][j] = cvtpk(p0[8 + 2 * j], p0[9 + 2 * j]); pw[2][j] = cvtpk(p1[2 * j], p1[2 * j + 1]); pw[3][j] = cvtpk(p1[8 + 2 * j], p1[9 + 2 * j]); }
    if (resc) {
#pragma unroll
        for (int r = 0; r < 16; ++r) { const float f = wsf[crow(r, hi)];
#pragma unroll
            for (int d = 0; d < NDB; ++d) o[d][r] *= f; }
    }
    { const ALAS unsigned char* vb = buf + KBUF + ((lane >> 4) & 1) * 32 + (lane & 3) * 8 + (4 * hi + ((lane & 15) >> 2)) * 64;
#pragma unroll
      for (int d = 0; d < NDB; ++d)
#pragma unroll
          for (int ks = 0; ks < 4; ++ks) {
              const s16x4 lo = vtr(vb + d * VDS + ks * 1024), hh = vtr(vb + d * VDS + ks * 1024 + 512);
              const bf16x8 vf = {lo[0], lo[1], lo[2], lo[3], hh[0], hh[1], hh[2], hh[3]};
              o[d] = __builtin_amdgcn_mfma_f32_32x32x16_bf16(__builtin_bit_cast(bf16x8, pw[ks]), vf, o[d], 0, 0, 0); } }
}

__device__ __forceinline__ u32x4 gate8(u32x4 v, u32x4 z) {
    u32x4 o;
#pragma unroll
    for (int j = 0; j < 4; ++j) { const float a = bfl(v[j]) * silu_f(bfl(z[j])), b = bfh(v[j]) * silu_f(bfh(z[j])); o[j] = cvtpk(a, b); }
    return o;
}


template <int NDB> __device__ __forceinline__ void stage_gate_store(const f32x16 (&res)[NDB], ALAS bf16_t* stg, const bf16_t* __restrict__ zbase, bf16_t* __restrict__ mbase, int lane) {
    const int r32 = lane & 31, hi = lane >> 5;
#pragma unroll
    for (int r = 0; r < 16; ++r) { const int orow = crow(r, hi);
#pragma unroll
        for (int d = 0; d < NDB; ++d) stg[orow * (NDB * 32) + d * 32 + r32] = f2bf(res[d][r]); }
    constexpr int CPR = NDB * 4;
    constexpr int RPP = 64 / CPR;
#pragma unroll
    for (int i = 0; i < 32 / RPP; ++i) {
        const int row = i * RPP + lane / CPR, ch = lane % CPR;
        const u32x4 v = *(const ALAS u32x4*)(stg + row * (NDB * 32) + ch * 8);
        const u32x4 z = *(const u32x4*)(zbase + (size_t)row * NP + ch * 8);
        *(u32x4*)(mbase + (size_t)row * DM + ch * 8) = gate8(v, z);
    }
}

template <int MODE> __device__ __forceinline__ void attn_unit(ALAS unsigned char* lds, const bf16_t* __restrict__ PROJ, const float* __restrict__ CUM, bf16_t* __restrict__ MIX,
        int b, int h, int qb, float lam, float li, const float* __restrict__ subg, float* park) {
    constexpr int NDB = MODE == 1 ? 4 : 2, NBR = MODE == 1 ? 2 : 1, HS = MODE == 1 ? 128 : 64;
    int tid_ = threadIdx.x; asm volatile("" : "+v"(tid_));
    const int tid = tid_, lane = tid & 63, r32 = lane & 31, hi = lane >> 5, wid = __builtin_amdgcn_readfirstlane(tid >> 6);
    const int q0 = qb * 256, qw0 = q0 + wid * 32;
    const size_t rowb = (size_t)b * SEQ;
    const int NT = 4 * qb + 4, my_last = 4 * qb + (wid >> 1);
    ALAS float* wsf = (ALAS float*)(lds + L_WSF) + wid * 64;
    const float slope2 = MODE == 1 ? exp2f(-2.f * (float)(h + 1)) * LOG2E : 0.f;
    f32x16 res[NDB];
#pragma clang loop unroll(disable)
    for (int c = 0; c < NBR; ++c) {
        const int qcol = MODE == 0 ? C_FQ + h * 64 : C_DQ + h * 128 + c * 64;
        const int kcol = MODE == 0 ? C_FK + h * 64 : C_DK + h * 128 + c * 64;
        const int vcol = MODE == 0 ? C_FV + h * 64 : C_DV + h * 128;
        bf16x8 qr[4];
        { const bf16_t* Qw = PROJ + (rowb + qw0 + r32) * NP + qcol + hi * 8;
#pragma unroll
          for (int d0 = 0; d0 < 4; ++d0) qr[d0] = *(const bf16x8*)(Qw + d0 * 16); }
        float mhat = MODE == 0 ? -CUM[(rowb + qw0) * 4 + h] * LOG2E : 0.f, l = 0.f;
        f32x16 o[NDB];
#pragma unroll
        for (int d = 0; d < NDB; ++d)
#pragma unroll
            for (int r = 0; r < 16; ++r) o[d][r] = 0.f;
        TileRegs R;
        load_tile<MODE>(R, PROJ, CUM, rowb + (size_t)(NT - 1) * 64, false, kcol, vcol, h, tid);
        store_tile<MODE>(R, lds, tid);
        __syncthreads();
        for (int i = 0; i <= NT; ++i) {
            const bool metat = (i == NT); const int t = NT - 1 - i;
            if (i < NT) { const bool nm = (i + 1 == NT); load_tile<MODE>(R, PROJ, CUM, nm ? (size_t)MR : rowb + (size_t)(t - 1) * 64, nm, kcol, vcol, h, tid); }
            if (metat || t <= my_last)
                compute_tile<MODE, NDB>(lds + (i & 1) * STG, qr, o, mhat, l, metat ? -16 : 64 * t, metat, (!metat) && t == my_last, qw0, slope2, wsf, lane);
            if (i < NT) store_tile<MODE>(R, lds + ((i + 1) & 1) * STG, tid);
            __syncthreads();
        }
        { auto rr = __builtin_amdgcn_permlane32_swap(__float_as_uint(l), __float_as_uint(l), false, false); l = __uint_as_float(rr[0]) + __uint_as_float(rr[1]); }
        if (hi == 0) wsf[32 + r32] = l;
        float rli[16];
#pragma unroll
        for (int r = 0; r < 16; ++r) rli[r] = 1.f / wsf[32 + crow(r, hi)];
        if (MODE == 0) {
#pragma unroll
            for (int d = 0; d < NDB; ++d)
#pragma unroll
                for (int r = 0; r < 16; ++r) res[d][r] = o[d][r] * rli[r];
        } else {
            float* pk = park + c * 4096 + lane;
#pragma unroll
            for (int d = 0; d < NDB; ++d) {
                float* pkd = pk + d * 1024; asm volatile("" : "+v"(pkd));
#pragma unroll
                for (int r = 0; r < 16; ++r) pkd[r * 64] = o[d][r] * rli[r];
            }
        }
    }
    if (MODE == 1) {
#pragma unroll
        for (int d = 0; d < NDB; ++d) {
            const float* pa = park + lane + d * 1024; const float* pb = pa + 4096; asm volatile("" : "+v"(pa), "+v"(pb));
#pragma unroll
            for (int r = 0; r < 16; ++r) res[d][r] = pa[r * 64] - lam * pb[r * 64];
        }
    }
    ALAS bf16_t* stg = (ALAS bf16_t*)(lds + L_OST + wid * 8192);
    if (MODE == 1) {
        float ss[16];
#pragma unroll
        for (int r = 0; r < 16; ++r) { float s = 0.f;
#pragma unroll
            for (int d = 0; d < NDB; ++d) s += res[d][r] * res[d][r];
            ss[r] = s; }
#pragma unroll
        for (int m = 1; m < 32; m <<= 1)
#pragma unroll
            for (int r = 0; r < 16; ++r) ss[r] += __shfl_xor(ss[r], m);
        float gc[NDB];
#pragma unroll
        for (int d = 0; d < NDB; ++d) gc[d] = subg[32 * d + r32] * (1.f - li);
#pragma unroll
        for (int r = 0; r < 16; ++r) { const float rs = rsqrtf(ss[r] * (1.f / 128.f) + 1e-5f);
#pragma unroll
            for (int d = 0; d < NDB; ++d) res[d][r] *= rs * gc[d]; }
    }
    const int zcol = MODE == 0 ? C_FZ + h * 64 : C_DZ + h * 128, mcol = MODE == 0 ? M_A + h * 64 : M_B + h * 128;
    stage_gate_store<NDB>(res, stg, PROJ + (rowb + qw0) * NP + zcol, MIX + (rowb + qw0) * DM + mcol, lane);
}

__device__ __forceinline__ void pool_unit(ALAS unsigned char* lds, const bf16_t* __restrict__ PROJ, const bf16_t* __restrict__ WPT_l, const float* __restrict__ pscale_l, bf16_t* __restrict__ MIX, int unit) {
    int tid_ = threadIdx.x; asm volatile("" : "+v"(tid_));
    const int tid = tid_, lane = tid & 63, r32 = lane & 31, hi = lane >> 5, wid = __builtin_amdgcn_readfirstlane(tid >> 6);
    const int g = wid & 3, win = 2 << g; const float invw = 1.f / (float)win;
    const int Rw = unit * 128 + (wid >> 2) * 64, b = Rw >> 12, tw = Rw & 4095;
    ALAS bf16_t* stg = (ALAS bf16_t*)(lds + L_OST + wid * 8192);
    bf16x8 wb[2][4];
#pragma unroll
    for (int nb = 0; nb < 2; ++nb)
#pragma unroll
        for (int ks = 0; ks < 4; ++ks) wb[nb][ks] = *(const bf16x8*)(WPT_l + ((g * 64 + 32 * nb + r32) * 64 + 16 * ks + 8 * hi));
    const float ps0 = pscale_l[g * 64 + r32], ps1 = pscale_l[g * 64 + 32 + r32];
    for (int blk = 0; blk < 2; ++blk) {
        const int t = tw + 32 * blk + r32;
        f32x16 acc[2];
#pragma unroll
        for (int r = 0; r < 16; ++r) { acc[0][r] = 0.f; acc[1][r] = 0.f; }
#pragma unroll
        for (int ks = 0; ks < 4; ++ks) {
            const int c0 = C_PU + g * 64 + 16 * ks + 8 * hi;
            float s[8], own[8];
#pragma unroll
            for (int j = 0; j < 8; ++j) { s[j] = 0.f; own[j] = 0.f; }
            for (int i = 0; i < win; ++i) {
                const int ti = t - i; const size_t row = ti >= 0 ? (size_t)b * SEQ + ti : (size_t)(MR + 16 + ti);
                const u32x4 v = *(const u32x4*)(PROJ + row * NP + c0);
#pragma unroll
                for (int j = 0; j < 4; ++j) { const float lo = bfl(v[j]), hh = bfh(v[j]); s[2 * j] += lo; s[2 * j + 1] += hh; if (i == 0) { own[2 * j] = lo; own[2 * j + 1] = hh; } }
            }
            u32x4 pa;
#pragma unroll
            for (int j = 0; j < 4; ++j) pa[j] = cvtpk(s[2 * j] * invw - own[2 * j], s[2 * j + 1] * invw - own[2 * j + 1]);
            const bf16x8 af = __builtin_bit_cast(bf16x8, pa);
            acc[0] = __builtin_amdgcn_mfma_f32_32x32x16_bf16(af, wb[0][ks], acc[0], 0, 0, 0);
            acc[1] = __builtin_amdgcn_mfma_f32_32x32x16_bf16(af, wb[1][ks], acc[1], 0, 0, 0);
        }
#pragma unroll
        for (int r = 0; r < 16; ++r) { acc[0][r] *= ps0; acc[1][r] *= ps1; }
        const size_t row0 = (size_t)Rw + 32 * blk;
        stage_gate_store<2>(acc, stg, PROJ + row0 * NP + C_PZ + g * 64, MIX + row0 * DM + M_C + g * 64, lane);
    }
}
#undef ALAS
}


#ifndef PG8_SP2
#define PG8_SP2 true
#endif
#ifndef PG8_ALIGN
#define PG8_ALIGN true
#endif
constexpr int NWAVES = 8;
constexpr int RING_OFF = 0, RING_BYTES = 131072;
constexpr int LDSCTL_OFF = RING_BYTES, MISC_OFF = LDSCTL_OFF + 320;
constexpr int LDS_BYTES = 147456;
constexpr int CW_TMO = 0, CW_CODE = 1, CW_BAR = 4096;
constexpr size_t CTL_ZERO_BYTES = 1 * MiB;
static_assert(att::L_END <= RING_BYTES, "attention LDS map");
#define GAS __attribute__((address_space(1)))
#define LAS __attribute__((address_space(3)))
typedef unsigned short bf16;
typedef unsigned v4u __attribute__((ext_vector_type(4)));
typedef float f32x4 __attribute__((ext_vector_type(4)));
typedef short bf16x8 __attribute__((ext_vector_type(8)));
typedef GAS unsigned gu32;
typedef GAS unsigned long long gu64;
#define RLX_AGENT __ATOMIC_RELAXED, __HIP_MEMORY_SCOPE_AGENT
#define LDS_WAIT() asm volatile("s_waitcnt lgkmcnt(0)" ::: "memory")
#define VM_WAIT() asm volatile("s_waitcnt vmcnt(0)" ::: "memory")
__device__ __forceinline__ unsigned long long rt() { return __builtin_amdgcn_s_memrealtime(); }
__device__ __forceinline__ unsigned pk2(float lo, float hi) { return (unsigned)f2bf(lo) | ((unsigned)f2bf(hi) << 16); }

#define XB_TMO      128
#define XB_XCNT(j)  (256  + 64 * (j))
#define XB_XSUB(j)  (1280 + 64 * (j))
#define XB_XGEN(j)  (2304 + 64 * (j))
#define XB_TOP      3328
#define XB_TOPGEN   3392
#define XCD_BAR_WORDS 3456
#define XB_SPIN_CAP (1u << 18)

__device__ __forceinline__ unsigned xb_ld(unsigned* p)              { return __hip_atomic_load(p, __ATOMIC_RELAXED, __HIP_MEMORY_SCOPE_AGENT); }
__device__ __forceinline__ unsigned xb_add(unsigned* p, unsigned v) { return __hip_atomic_fetch_add(p, v, __ATOMIC_RELAXED, __HIP_MEMORY_SCOPE_AGENT); }
__device__ __forceinline__ unsigned xb_xcc_id() { return (unsigned)__builtin_amdgcn_s_getreg((3 << 11) | 20) & 0xFu; }
#define XB_SPIN(cond, bar) do { unsigned _sp = 0; while (cond) { __builtin_amdgcn_s_sleep(1); \
    if ((++_sp & 255u) == 0u) { if (xb_ld(&(bar)[XB_TMO])) break; if (_sp > XB_SPIN_CAP) { atomicAdd(&(bar)[XB_TMO], 1u); break; } } } } while (0)

struct XcdBarrier {
    unsigned* bar; unsigned x;
    volatile LAS unsigned* st;
};

__device__ __forceinline__ XcdBarrier xcd_barrier_post(unsigned* bar, volatile LAS unsigned* st) {
    XcdBarrier b; b.bar = bar; b.x = xb_xcc_id(); b.st = st;
    if (threadIdx.x == 0) (void)xb_add(&bar[XB_XCNT(b.x)], 1u);
    return b;
}
__device__ __forceinline__ void xcd_barrier_complete(unsigned* bar, unsigned x, unsigned& nloc, unsigned& nx) {
    const unsigned G = gridDim.x * gridDim.y * gridDim.z;
    unsigned sum, cnt, mine, sp = 0u;
    for (;;) {
        sum = 0u; cnt = 0u; mine = 0u;
#pragma unroll
        for (unsigned j = 0; j < 16; ++j) { const unsigned c = xb_ld(&bar[XB_XCNT(j)]); sum += c; cnt += (c > 0u) ? 1u : 0u; mine = (j == x) ? c : mine; }
        if (sum == G) break;
        __builtin_amdgcn_s_sleep(1);
        if ((++sp & 255u) == 0u) { if (xb_ld(&bar[XB_TMO])) break; if (sp > XB_SPIN_CAP) { atomicAdd(&bar[XB_TMO], 1u); break; } }
    }
    nloc = mine > 0u ? mine : 1u; nx = cnt > 0u ? cnt : 1u;
}

__device__ __forceinline__ void xcd_barrier(const XcdBarrier& b) {
    asm volatile("s_waitcnt vmcnt(0)" ::: "memory");
    __syncthreads();
    if (threadIdx.x == 0) {
        unsigned* bar = b.bar;
        __builtin_amdgcn_s_waitcnt(0);
        unsigned nloc = b.st[0], nx = b.st[1];
        if (nloc == 0u) { xcd_barrier_complete(bar, b.x, nloc, nx); b.st[0] = nloc; b.st[1] = nx; }
        const unsigned old = xb_add(&bar[XB_XSUB(b.x)], 1u);
        const unsigned gen = old / nloc;
        if (old + 1u == (gen + 1u) * nloc) {
            __builtin_amdgcn_fence(__ATOMIC_RELEASE, "agent");
            asm volatile("s_waitcnt vmcnt(0)" ::: "memory");
            const unsigned og = xb_add(&bar[XB_TOP], 1u);
            const unsigned tg = og / nx;
            if (og + 1u == (tg + 1u) * nx) xb_add(&bar[XB_TOPGEN], 1u);
            else XB_SPIN(xb_ld(&bar[XB_TOPGEN]) == tg, bar);
            __builtin_amdgcn_fence(__ATOMIC_ACQUIRE, "agent");
            xb_add(&bar[XB_XGEN(b.x)], 1u);
            asm volatile("s_waitcnt vmcnt(0)" ::: "memory");
        } else {
            XB_SPIN(xb_ld(&bar[XB_XGEN(b.x)]) == gen, bar);
            __builtin_amdgcn_fence(__ATOMIC_ACQUIRE, "agent");
            asm volatile("s_waitcnt vmcnt(0)" ::: "memory");
        }
    }
    __syncthreads();
}

__device__ __forceinline__ void transpose_item(const float* __restrict__ W, int ldw, int col0, const float* __restrict__ gk, bf16_t* WT, int K, LAS float* scr, int k0, int n0dst, int lane) {
#pragma unroll 8
    for (int i = 0; i < 32; ++i) { const int kk = 2 * i + (lane >> 5); float v = W[(size_t)(k0 + kk) * ldw + col0 + (lane & 31)]; if (gk) v *= gk[k0 + kk]; scr[kk * 33 + (lane & 31)] = v; }
    LDS_WAIT(); asm volatile("" ::: "memory");
    const int c = lane & 7;
#pragma unroll
    for (int j = 0; j < 4; ++j) { const int n = (lane >> 3) + 8 * j; const LAS float* s = scr + (8 * c) * 33 + n;
        v4u o; o.x = pk2(s[0 * 33], s[1 * 33]); o.y = pk2(s[2 * 33], s[3 * 33]); o.z = pk2(s[4 * 33], s[5 * 33]); o.w = pk2(s[6 * 33], s[7 * 33]);
        *(GAS v4u*)(WT + (size_t)(n0dst + n) * K + k0 + 8 * c) = o; }
    LDS_WAIT(); asm volatile("" ::: "memory");
}

constexpr int NPH = 18;
struct Args { const float* in[14]; float* out; unsigned char* ws; int ph_lo, ph_hi; };
__global__ void __launch_bounds__(NWAVES * 64, 2) mk_fwd(Args args) {
    extern __shared__ __attribute__((aligned(16))) unsigned char lds[];
    LAS unsigned char* ldsp = (LAS unsigned char*)lds;
    volatile LAS unsigned* MISC = (volatile LAS unsigned*)(ldsp + MISC_OFF);
    gu32* ctl = (gu32*)(args.ws + WS_CTL);
    for (int u = threadIdx.x; u < (LDS_BYTES - LDSCTL_OFF) / 4; u += NWAVES * 64) ((LAS unsigned*)(ldsp + LDSCTL_OFF))[u] = 0u;
    __syncthreads();
    XcdBarrier bar = xcd_barrier_post((unsigned*)(ctl + CW_BAR), MISC + 8);
    const int lo = args.ph_lo, hi = args.ph_hi;
    for (int ph_ = lo; ph_ < hi; ++ph_) {
        int ph = ph_, bid = (int)blockIdx.x, G = (int)gridDim.x;
        unsigned char* ws = args.ws; unsigned* barw = bar.bar;
        asm volatile("" : "+s"(ph), "+s"(bid), "+s"(G), "+s"(ws), "+s"(barw));
        int tid_ = threadIdx.x; asm volatile("" : "+v"(tid_));
        const int tid = tid_, lane = tid & 63, wave = __builtin_amdgcn_readfirstlane(tid >> 6);
        const int vcu = (G % 8 == 0) ? (bid % 8) * (G / 8) + bid / 8 : bid;
        const int gw = bid * NWAVES + wave, NGW = G * NWAVES;
        bf16_t* W1T = (bf16_t*)(ws + WS_W1T); bf16_t* W2T = (bf16_t*)(ws + WS_W2T);
        float* WFG = (float*)(ws + WS_WFG); float* LAM = (float*)(ws + WS_LAM); float* HM = (float*)(ws + WS_HM);
        bf16_t* WPT = (bf16_t*)(ws + WS_WPT);
        float* LOGF = (float*)(ws + WS_LOGF); float* CUM = (float*)(ws + WS_CUM);
        bf16_t* HB = (bf16_t*)(ws + WS_HB); bf16_t* MIX = (bf16_t*)(ws + WS_MIX); bf16_t* PROJ = (bf16_t*)(ws + WS_PROJ);
        float* H = args.out;
        if (ph == 0) {
            const float* norm_g = args.in[2]; const float* w_in = args.in[3]; const float* w_pool = args.in[10]; const float* w_out = args.in[12];
            LAS float* scr = (LAS float*)(ldsp + RING_OFF + wave * 16384);
            constexpr int NIT1 = DEPTH * 16 * 112, NIT2 = DEPTH * 16 * 32;
            for (int it = gw; it < NIT1 + NIT2; it += NGW) {
                if (it < NIT1) { const int l = it / 1792, r = it % 1792, kb = r / 112, nb = r % 112, n0 = 32 * nb, col0 = n0 < 1024 ? n0 : n0 + 4;
                    transpose_item(w_in + (size_t)l * 1024 * IN_DIM, IN_DIM, col0, norm_g + l * 1024, W1T + (size_t)l * NP * 1024, 1024, scr, 64 * kb, n0, lane); }
                else { const int r0 = it - NIT1, l = r0 / 512, r = r0 % 512, kb = r / 32, nb = r % 32;
                    transpose_item(w_out + (size_t)l * 1024 * 1024, 1024, 32 * nb, nullptr, W2T + (size_t)l * 1024 * 1024, 1024, scr, 64 * kb, 32 * nb, lane); }
            }
            const int gt = bid * (NWAVES * 64) + tid, NT = G * NWAVES * 64;
            for (int i = gt; i < DEPTH * 4 * 1024; i += NT) { const int k = i & 1023, c = (i >> 10) & 3, l = i >> 12; WFG[i] = w_in[((size_t)l * 1024 + k) * IN_DIM + 1024 + c] * norm_g[l * 1024 + k]; }
            for (int i = gt; i < DEPTH * 4 * 64 * 64; i += NT) { const int c = i & 63, d = (i >> 6) & 63, lg = i >> 12; WPT[i] = f2bf(w_pool[((size_t)lg * 64 + c) * 64 + d]); }
            if (gt < DEPTH) { const int l = gt; float s1 = 0.f, s2 = 0.f;
                for (int i = 0; i < 64; ++i) { s1 += args.in[5][l * 64 + i] * args.in[6][l * 64 + i]; s2 += args.in[7][l * 64 + i] * args.in[8][l * 64 + i]; }
                LAM[l] = expf(s1) - expf(s2) + (0.8f - 0.6f * expf(-0.3f * (float)l)); }
        } else if (ph <= 16) {
            const int l = (ph - 1) >> 2, sub = (ph - 1) & 3;
            const float* hreal = l == 0 ? args.in[0] : H; const float* hmeta = l == 0 ? args.in[1] : HM;
            if (sub == 0) {
                for (int row = gw; row < MT; row += NGW) norm_row(row, lane, hreal, hmeta, WFG + (size_t)l * 4096, args.in[4] + l * 4, HB, LOGF);
            } else if (sub == 1) {
                if (wave == 0) { for (int i = bid; i < 33; i += G) { if (i < 32) scan_bh(i >> 2, i & 3, lane, LOGF, CUM); else scan_meta(lane, LOGF, CUM); } }
                if (wave == 1) { for (int nb = bid; nb < NP / 16; nb += G) {
                    const mf32x4 acc = meta_gemm16(HB + (size_t)MR * DM, W1T + (size_t)l * NP * 1024, nb, lane);
                    const int col = 16 * nb + (lane & 15), fq = lane >> 4; const float sc = (col < 256 || (col >= 1024 && col < 1536)) ? att::C2 : 1.f;
#pragma unroll
                    for (int j = 0; j < 4; ++j) PROJ[(size_t)(MR + 4 * fq + j) * NP + col] = f2bf(acc[j] * sc); } }
                pg8::Gemm g{HB, W1T + (size_t)l * NP * 1024, MR, NP, 1024}; pg8::StaticOrder S; S.init(MR, NP, G, bid);
                pg8::EpiProj E{PROJ, NP, att::C2};
                pg8::gemm_phase<pg8::EpiProj, pg8::StaticOrder, PG8_ALIGN, PG8_SP2>(ldsp + RING_OFF, g, S, E);
            } else if (sub == 2) {
                const float li = 0.8f - 0.6f * expf(-0.3f * (float)l);
                const float lam = LAM[l];
                const float* subg = args.in[9] + l * 128;
                float* park = (float*)(ws + WS_RES) + ((size_t)bid * 8 + (size_t)wave) * 8192;
                for (int pi = vcu; pi < 256; pi += G) {
                    const int bh = pi >> 3, s_ = pi & 7, b_ = bh >> 2, h_ = bh & 3;
                    for (int u = 0; u < 2; ++u) att::attn_unit<0>(ldsp + RING_OFF, PROJ, CUM, MIX, b_, h_, u ? s_ : 15 - s_, lam, li, subg, park);
                    for (int u = 0; u < 2; ++u) att::attn_unit<1>(ldsp + RING_OFF, PROJ, CUM, MIX, b_, h_, u ? s_ : 15 - s_, lam, li, subg, park);
                }
                for (int pu = vcu; pu < 256; pu += G) att::pool_unit(ldsp + RING_OFF, PROJ, WPT + (size_t)l * 4 * 64 * 64, args.in[11] + l * 256, MIX, pu);
                if (bid == G - 1) {
                    if (wave < 4) fox_meta(wave, lane, PROJ, CUM, MIX); else diff_meta(wave - 4, lane, PROJ, subg, lam, li, MIX);
                    for (int tk = wave; tk < 64; tk += NWAVES) pool_meta(tk >> 2, tk & 3, lane, PROJ, args.in[10] + (size_t)l * 4 * 64 * 64, args.in[11] + l * 256, MIX);
                }
            } else {
                if (wave == 0) { for (int nb = bid; nb < 64; nb += G) {
                    const mf32x4 acc = meta_gemm16(MIX + (size_t)MR * DM, W2T + (size_t)l * 1024 * 1024, nb, lane);
                    const int col = 16 * nb + (lane & 15), fq = lane >> 4;
#pragma unroll
                    for (int j = 0; j < 4; ++j) HM[(4 * fq + j) * 1024 + col] = hmeta[(4 * fq + j) * 1024 + col] + acc[j]; } }
                pg8::Gemm g{MIX, W2T + (size_t)l * 1024 * 1024, MR, 1024, 1024}; pg8::StaticOrder S; S.init(MR, 1024, G, bid);
                pg8::EpiResid E{hreal, H, 1024};
                pg8::gemm_phase<pg8::EpiResid, pg8::StaticOrder, PG8_ALIGN, PG8_SP2>(ldsp + RING_OFF, g, S, E);
            }
        } else {
            for (int row = gw; row < MR; row += NGW) final_row(row, lane, H, args.in[13]);
        }
        if (ph_ + 1 < hi) { XcdBarrier b2 = bar; b2.bar = barw; xcd_barrier(b2); }
    }
}

#ifndef MK_PER_PHASE
#define MK_PER_PHASE 0
#endif
extern "C" void kernel_launch(void* const* d_in, const int* in_sizes, int n_in, void* d_out, int out_size, void* d_ws, size_t ws_size, hipStream_t stream) {
    static int g_grid = 0;
    if (g_grid == 0) {
        int dev = 0, cus = 0, per_cu = 0;
        hipGetDevice(&dev); hipDeviceGetAttribute(&cus, hipDeviceAttributeMultiprocessorCount, dev);
        hipFuncSetAttribute((const void*)mk_fwd, hipFuncAttributeMaxDynamicSharedMemorySize, LDS_BYTES);
        hipOccupancyMaxActiveBlocksPerMultiprocessor(&per_cu, (const void*)mk_fwd, NWAVES * 64, LDS_BYTES);
        (void)hipGetLastError();
        g_grid = cus > 0 ? cus : 256;
    }
    hipMemsetAsync((unsigned char*)d_ws + WS_CTL, 0, CTL_ZERO_BYTES, stream);
    Args a{};
    for (int i = 0; i < 14; ++i) a.in[i] = (const float*)d_in[i];
    a.out = (float*)d_out; a.ws = (unsigned char*)d_ws;
#if MK_PER_PHASE
    for (int p = 0; p < NPH; ++p) { a.ph_lo = p; a.ph_hi = p + 1; hipLaunchKernelGGL(mk_fwd, dim3(g_grid), dim3(NWAVES * 64), LDS_BYTES, stream, a); }
#else
    a.ph_lo = 0; a.ph_hi = NPH;
    hipLaunchKernelGGL(mk_fwd, dim3(g_grid), dim3(NWAVES * 64), LDS_BYTES, stream, a);
#endif
}
```

```cpp
#include <hip/hip_runtime.h>
#include <stdint.h>

typedef unsigned short bf16_t;
__device__ __forceinline__ float bf2f(bf16_t v) { return __uint_as_float(((unsigned)v) << 16); }
__device__ __forceinline__ bf16_t f2bf(float f) { unsigned u = __float_as_uint(f); return (bf16_t)((u + 0x7fffu + ((u >> 16) & 1u)) >> 16); }

constexpr int BATCH = 8, SEQ = 4096, DM = 1024, DEPTH = 4, NMETA = 16;
constexpr int MR = BATCH * SEQ;
constexpr int MT = MR + NMETA;
constexpr int IN_DIM = 3588, NP = 3584;
constexpr int C_FQ = 0, C_FK = 256, C_FV = 512, C_FZ = 768, C_DQ = 1024, C_DK = 1536, C_DV = 2048, C_DZ = 2560, C_PU = 3072, C_PZ = 3328;
constexpr int M_A = 0, M_B = 256, M_C = 768;
constexpr float LN2F = 0.6931471805599453f;

constexpr size_t MiB = 1u << 20;
constexpr size_t WS_CTL = 0;
constexpr size_t WS_W1T = 2 * MiB;
constexpr size_t WS_W2T = 30 * MiB;
constexpr size_t WS_WFG = 38 * MiB;
constexpr size_t WS_LAM = 38 * MiB + 65536;
constexpr size_t WS_HM  = 38 * MiB + 131072;
constexpr size_t WS_WPT = 38 * MiB + 262144;
constexpr size_t WS_LOGF = 39 * MiB;
constexpr size_t WS_CUM = 40 * MiB;
constexpr size_t WS_HB = 42 * MiB;
constexpr size_t WS_MIX = 108 * MiB;
constexpr size_t WS_PROJ = 174 * MiB;
constexpr size_t WS_RES = 400 * MiB;
constexpr size_t WS_END = 464 * MiB;

__device__ __forceinline__ float shx(float v, int m, int lane) { return __int_as_float(__builtin_amdgcn_ds_bpermute((lane ^ m) << 2, __float_as_int(v))); }
__device__ __forceinline__ float shl(float v, int src) { return __int_as_float(__builtin_amdgcn_ds_bpermute(src << 2, __float_as_int(v))); }
__device__ __forceinline__ float wave_sum(float v, int lane) {
#pragma unroll
    for (int o = 1; o < 64; o <<= 1) v += shx(v, o, lane);
    return v;
}
__device__ __forceinline__ float fexp(float x) { return __builtin_amdgcn_exp2f(x * 1.4426950408889634f); }
__device__ __forceinline__ float log_sigmoid(float x) { return fminf(x, 0.f) - __builtin_amdgcn_logf(1.f + fexp(-fabsf(x))) * 0.6931471805599453f; }
__device__ __forceinline__ float silu(float x) { return x / (1.f + fexp(-x)); }

__device__ __forceinline__ void norm_row(int row, int lane, const float* __restrict__ hreal, const float* __restrict__ hmeta, const float* __restrict__ WFG_l,
                                         const float* __restrict__ bf_l, bf16_t* HB, float* LOGF) {
    const float* hp = row < MR ? hreal + (size_t)row * DM : hmeta + (size_t)(row - MR) * DM;
    float4 v[4]; float ss = 0.f;
#pragma unroll
    for (int j = 0; j < 4; ++j) { v[j] = *(const float4*)(hp + j * 256 + lane * 4); ss += v[j].x * v[j].x + v[j].y * v[j].y + v[j].z * v[j].z + v[j].w * v[j].w; }
    ss = wave_sum(ss, lane);
    const float rstd = rsqrtf(ss * (1.f / DM) + 1e-6f);
    float fg[4];
#pragma unroll
    for (int c = 0; c < 4; ++c) {
        float a = 0.f;
#pragma unroll
        for (int j = 0; j < 4; ++j) { const float4 w = *(const float4*)(WFG_l + c * 1024 + j * 256 + lane * 4); a += v[j].x * w.x + v[j].y * w.y + v[j].z * w.z + v[j].w * w.w; }
        fg[c] = wave_sum(a, lane) * rstd;
    }
#pragma unroll
    for (int j = 0; j < 4; ++j) {
        ushort4 o; o.x = f2bf(v[j].x * rstd); o.y = f2bf(v[j].y * rstd); o.z = f2bf(v[j].z * rstd); o.w = f2bf(v[j].w * rstd);
        *(ushort4*)(HB + (size_t)row * DM + j * 256 + lane * 4) = o;
    }
    if (lane < 4) LOGF[row * 4 + lane] = log_sigmoid((lane == 0 ? fg[0] : lane == 1 ? fg[1] : lane == 2 ? fg[2] : fg[3]) + bf_l[lane]);
}
__device__ __forceinline__ void final_row(int row, int lane, float* H, const float* __restrict__ final_g) {
    float* hp = H + (size_t)row * DM;
    float4 v[4]; float ss = 0.f;
#pragma unroll
    for (int j = 0; j < 4; ++j) { v[j] = *(const float4*)(hp + j * 256 + lane * 4); ss += v[j].x * v[j].x + v[j].y * v[j].y + v[j].z * v[j].z + v[j].w * v[j].w; }
    ss = wave_sum(ss, lane);
    const float rstd = rsqrtf(ss * (1.f / DM) + 1e-6f);
#pragma unroll
    for (int j = 0; j < 4; ++j) {
        const float4 g = *(const float4*)(final_g + j * 256 + lane * 4);
        float4 o; o.x = v[j].x * rstd * g.x; o.y = v[j].y * rstd * g.y; o.z = v[j].z * rstd * g.z; o.w = v[j].w * rstd * g.w;
        *(float4*)(hp + j * 256 + lane * 4) = o;
    }
}
__device__ __forceinline__ void scan_bh(int b, int h, int lane, const float* __restrict__ LOGF, float* CUM) {
    const float* p = LOGF + ((size_t)b * SEQ + (size_t)lane * 64) * 4 + h;
    float s = 0.f;
#pragma unroll 16
    for (int j = 0; j < 64; ++j) s += p[j * 4];
    float inc = s;
#pragma unroll
    for (int o = 1; o < 64; o <<= 1) { const float t = shl(inc, lane >= o ? lane - o : lane); if (lane >= o) inc += t; }
    float c = inc - s;
    float* q = CUM + ((size_t)b * SEQ + (size_t)lane * 64) * 4 + h;
#pragma unroll 16
    for (int j = 0; j < 64; ++j) { c += p[j * 4]; q[j * 4] = c; }
}
__device__ __forceinline__ void scan_meta(int lane, const float* __restrict__ LOGF, float* CUM) {
    if (lane < 4) { const int h = lane; float c = 0.f;
        for (int j = 15; j >= 0; --j) { CUM[(size_t)(MR + j) * 4 + h] = -c; c += LOGF[(size_t)(MR + j) * 4 + h]; } }
}
typedef short mbf16x8 __attribute__((ext_vector_type(8)));
typedef float mf32x4 __attribute__((ext_vector_type(4)));
__device__ __forceinline__ mf32x4 meta_gemm16(const bf16_t* __restrict__ A16, const bf16_t* __restrict__ Bt, int nb, int lane) {
    const int fr = lane & 15, fq = lane >> 4; mf32x4 acc = {0.f, 0.f, 0.f, 0.f};
    const bf16_t* ap = A16 + fr * 1024 + fq * 8; const bf16_t* bp = Bt + (size_t)(16 * nb + fr) * 1024 + fq * 8;
#pragma unroll 8
    for (int kk = 0; kk < 32; ++kk) { const mbf16x8 a = *(const mbf16x8*)(ap + kk * 32), b = *(const mbf16x8*)(bp + kk * 32); acc = __builtin_amdgcn_mfma_f32_16x16x32_bf16(a, b, acc, 0, 0, 0); }
    return acc;
}
__device__ __forceinline__ void fox_meta(int h, int lane, const bf16_t* __restrict__ PROJ, const float* __restrict__ CUM, bf16_t* MIX) {
    const int t = lane & 15, row = MR + t;
    float q[64], o[64];
    float ln2 = LN2F, m = -1e30f; asm volatile("" : "+v"(ln2), "+v"(m));
    const bf16_t* qp = PROJ + (size_t)row * NP + C_FQ + h * 64;
#pragma unroll
    for (int d = 0; d < 64; ++d) { q[d] = bf2f(qp[d]) * ln2; o[d] = 0.f; }
    const float cq = CUM[(size_t)row * 4 + h];
    float lsum = 0.f;
    for (int kk = 0; kk < 16; ++kk) {
        const int krow = MR + kk;
        const bf16_t* kp = PROJ + (size_t)krow * NP + C_FK + h * 64;
        const bf16_t* vp = PROJ + (size_t)krow * NP + C_FV + h * 64;
        float sc = 0.f;
#pragma unroll
        for (int d = 0; d < 64; ++d) sc += q[d] * bf2f(kp[d]);
        sc += cq - CUM[(size_t)krow * 4 + h];
        if (kk <= t) {
            if (sc > m) { const float a = fexp(m - sc); lsum *= a;
#pragma unroll
                for (int d = 0; d < 64; ++d) o[d] *= a;
                m = sc; }
            const float p = fexp(sc - m); lsum += p;
#pragma unroll
            for (int d = 0; d < 64; ++d) o[d] += p * bf2f(vp[d]);
        }
    }
    if (lane >= 16) return;
    const float inv = 1.f / lsum;
    const bf16_t* zp = PROJ + (size_t)row * NP + C_FZ + h * 64;
    bf16_t* mp = MIX + (size_t)row * DM + M_A + h * 64;
#pragma unroll
    for (int d = 0; d < 64; ++d) mp[d] = f2bf(o[d] * inv * silu(bf2f(zp[d])));
}
__device__ __forceinline__ void diff_meta(int h, int lane, const bf16_t* __restrict__ PROJ, const float* __restrict__ subln_g_l, float lam, float li, bf16_t* MIX) {
    const int ri = (lane >> 1) & 15, eh = lane & 1, row = MR + ri;
    const float posq = (float)ri, slope = 1.f / (float)(1 << (2 * h + 2));
    float res[64];
    for (int c = 0; c < 2; ++c) {
        float q[64], o[64];
        float ln2 = LN2F, m = -1e30f; asm volatile("" : "+v"(ln2), "+v"(m));
        const bf16_t* qp = PROJ + (size_t)row * NP + C_DQ + h * 128 + c * 64;
#pragma unroll
        for (int d = 0; d < 64; ++d) { q[d] = bf2f(qp[d]) * ln2; o[d] = 0.f; }
        float lsum = 0.f;
        for (int kk = 0; kk < 16; ++kk) {
            const int krow = MR + kk;
            const bf16_t* kp = PROJ + (size_t)krow * NP + C_DK + h * 128 + c * 64;
            const bf16_t* vp = PROJ + (size_t)krow * NP + C_DV + h * 128 + eh * 64;
            float sc = 0.f;
#pragma unroll
            for (int d = 0; d < 64; ++d) sc += q[d] * bf2f(kp[d]);
            sc -= slope * fabsf(posq - (float)kk);
            if (sc > m) { const float a = fexp(m - sc); lsum *= a;
#pragma unroll
                for (int d = 0; d < 64; ++d) o[d] *= a;
                m = sc; }
            const float p = fexp(sc - m); lsum += p;
#pragma unroll
            for (int d = 0; d < 64; ++d) o[d] += p * bf2f(vp[d]);
        }
        const float inv = 1.f / lsum;
        if (c == 0) {
#pragma unroll
            for (int d = 0; d < 64; ++d) res[d] = o[d] * inv;
        } else {
#pragma unroll
            for (int d = 0; d < 64; ++d) res[d] -= lam * o[d] * inv;
        }
    }
    float ss = 0.f;
#pragma unroll
    for (int d = 0; d < 64; ++d) ss += res[d] * res[d];
    ss += shx(ss, 1, lane);
    const float rstd = rsqrtf(ss * (1.f / 128.f) + 1e-5f);
    if (lane >= 32) return;
    const bf16_t* zp = PROJ + (size_t)row * NP + C_DZ + h * 128 + eh * 64;
    bf16_t* mp = MIX + (size_t)row * DM + M_B + h * 128 + eh * 64;
#pragma unroll
    for (int d = 0; d < 64; ++d) mp[d] = f2bf(res[d] * rstd * subln_g_l[eh * 64 + d] * (1.f - li) * silu(bf2f(zp[d])));
}
__device__ __forceinline__ void pool_meta(int j, int g, int lane, const bf16_t* __restrict__ PROJ, const float* __restrict__ wpool_l, const float* __restrict__ pscale_l, bf16_t* MIX) {
    const int w = 2 << g, cnt = (j + 1) < w ? (j + 1) : w, row = MR + j;
    float s = 0.f;
    for (int i = 0; i < cnt; ++i) s += bf2f(PROJ[(size_t)(MR + j - i) * NP + C_PU + g * 64 + lane]);
    const float pooled = s / (float)cnt - bf2f(PROJ[(size_t)row * NP + C_PU + g * 64 + lane]);
    float y = 0.f;
    for (int i = 0; i < 64; ++i) y += shl(pooled, i) * wpool_l[(g * 64 + i) * 64 + lane];
    const float z = bf2f(PROJ[(size_t)row * NP + C_PZ + g * 64 + lane]);
    MIX[(size_t)row * DM + M_C + g * 64 + lane] = f2bf(y * pscale_l[g * 64 + lane] * silu(z));
}

namespace pg8 {
#define PG8_LAS __attribute__((address_space(3)))
typedef unsigned short bf16_t;
typedef short bf16x8 __attribute__((ext_vector_type(8)));
typedef float f32x4 __attribute__((ext_vector_type(4)));
typedef unsigned u32x4 __attribute__((ext_vector_type(4)));
constexpr int BM = 256, BK = 64, HALF = 128, HTB = HALF * BK * 2  , STAGE_BYTES = 8 * HTB, NXCD = 8, WGM = 8;

__host__ __device__ __forceinline__ int lds_byte(int r, int c) { const int st = (r >> 4) * 2 + (c >> 5), rr = r & 15, cc = c & 31, ob = rr * 64 + cc * 2; return st * 1024 + (ob ^ (((ob >> 9) & 1) << 5)); }
__host__ __device__ __forceinline__ void stage_rc(int b, int& R, int& C) { const int st = b / 1024, sb = b % 1024, swz = sb ^ (((sb >> 9) & 1) << 5); R = (st >> 1) * 16 + swz / 64; C = (st & 1) * 32 + (swz % 64) / 2; }
__host__ __device__ __forceinline__ int perm32(int rho) { const int n = rho >> 4, i = rho & 15; return 8 * (i >> 2) + 4 * n + (i & 3); }

struct Unit { int pm, pn; };
struct Gemm { const bf16_t* A; const bf16_t* Bt; int M, N, K; };

struct StaticOrder {
    int nM, nN, nwg, G, c;
    __host__ __device__ void init(int M, int N, int G_, int c_) { nM = M / BM; nN = N / BM; nwg = nM * nN; G = G_; c = c_; }
    __host__ __device__ bool next(int i, Unit& u) const {
        const long L = (long)i * G + c; if (L >= nwg) return false;
        int wgid = (int)L; { const int q = nwg / NXCD, r = nwg % NXCD, xcd = wgid % NXCD, off = wgid / NXCD; wgid = (xcd < r ? xcd * (q + 1) : r * (q + 1) + (xcd - r) * q) + off; }
        const int nig = WGM * nN, gid = wgid / nig, fm = gid * WGM, gsz = (nM - fm) < WGM ? (nM - fm) : WGM;
        u.pm = fm + ((wgid % nig) % gsz); u.pn = (wgid % nig) / gsz; return true;
    }
    __device__ __forceinline__ void a_ready(const Unit&) const {}
    __device__ __forceinline__ void done(const Unit&) const {}
};

__device__ __forceinline__ unsigned cvt_pk_bf16(float lo, float hi) { unsigned r; asm volatile("v_cvt_pk_bf16_f32 %0, %1, %2" : "=v"(r) : "v"(lo), "v"(hi)); return r; }
struct EpiProj {
    static constexpr bool PERM = true, AFTER_DRAIN = false;
    bf16_t* O; int ldc; float qscale;
    __device__ __forceinline__ void operator()(const f32x4 (&acc)[2][2][4][2], const Unit& u, int wr, int wc, int fr, int fq) const {
        const int row0 = u.pm * BM + wr * 64 + fr, col0 = u.pn * BM + wc * 32 + 8 * fq;
        const float sc = (u.pn == 0 || u.pn == 4 || u.pn == 5) ? qscale : 1.f;
#pragma unroll
        for (int ai = 0; ai < 2; ++ai)
#pragma unroll
            for (int m = 0; m < 4; ++m) { bf16_t* rowp = O + (size_t)(row0 + ai * HALF + m * 16) * ldc + col0;
#pragma unroll
                for (int bj = 0; bj < 2; ++bj) { const f32x4 v0 = acc[ai][bj][m][0] * sc, v1 = acc[ai][bj][m][1] * sc;
                    u32x4 w; w.x = cvt_pk_bf16(v0[0], v0[1]); w.y = cvt_pk_bf16(v0[2], v0[3]); w.z = cvt_pk_bf16(v1[0], v1[1]); w.w = cvt_pk_bf16(v1[2], v1[3]);
                    *(u32x4*)(rowp + bj * HALF) = w; } }
    }
};
struct EpiResid {
    static constexpr bool PERM = false, AFTER_DRAIN = false;
    const float* base; float* out; int ldc;
    __device__ __forceinline__ void operator()(const f32x4 (&acc)[2][2][4][2], const Unit& u, int wr, int wc, int fr, int fq) const {
        const int col0 = u.pn * BM + wc * 32 + 4 * fq;
#pragma unroll
        for (int ai = 0; ai < 2; ++ai)
#pragma unroll
            for (int m = 0; m < 4; ++m) { const size_t off = (size_t)(u.pm * BM + ai * HALF + wr * 64 + m * 16 + fr) * ldc + col0;
#pragma unroll
                for (int bj = 0; bj < 2; ++bj)
#pragma unroll
                    for (int n = 0; n < 2; ++n) { const f32x4 bs = *(const f32x4*)(base + off + bj * HALF + n * 16); *(f32x4*)(out + off + bj * HALF + n * 16) = bs + acc[ai][bj][m][n]; } }
    }
};
template <class Epi, class Sched, bool ALIGN_EPI = false, bool SP2 = false>
__device__ __forceinline__ void gemm_phase(PG8_LAS unsigned char* lds, const Gemm g, const Sched& S, const Epi& E) {
    int tid_ = threadIdx.x; asm volatile("" : "+v"(tid_));
    const int tid = tid_, wid = __builtin_amdgcn_readfirstlane(tid >> 6), lane = tid & 63, wr = wid >> 2, wc = wid & 3, fr = lane & 15, fq = lane >> 4;
    const int K = g.K, nt = K / BK;
    unsigned voffA[2], voffB[2];
#pragma unroll
    for (int i = 0; i < 2; ++i) { int R, C; stage_rc(tid * 16 + i * 8192, R, C); const int Rb = Epi::PERM ? ((R & ~31) + perm32(R & 31)) : R;
        voffA[i] = (unsigned)(R * K + C) * 2u; voffB[i] = (unsigned)(Rb * K + C) * 2u; }
    const size_t kstep = (size_t)(BK * 2);
    const size_t hstep = (size_t)HALF * K * 2;
    const size_t tstep = 2 * hstep;
    const unsigned ldsw = (unsigned)wid * 1024u;
    const int aoff = lds_byte(wr * 64 + fr, fq * 8), boff = lds_byte(wc * 32 + fr, fq * 8);
#define PG8_SA(b, h) (((b) * 2 + (h)) * HTB)
#define PG8_SB(b, h) ((4 + (b) * 2 + (h)) * HTB)
#define PG8_STAGE(bufoff, gbase, voff) do { _Pragma("unroll") for (int _i = 0; _i < 2; ++_i) \
        __builtin_amdgcn_global_load_lds((const unsigned*)((const char*)(gbase) + (voff)[_i]), (PG8_LAS unsigned*)(lds + (bufoff) + ldsw + _i * 8192), 16, 0, 0); } while (0)
#define PG8_LDA(dst, b, h) do { _Pragma("unroll") for (int m = 0; m < 4; ++m) _Pragma("unroll") for (int k = 0; k < 2; ++k) dst[m][k] = *(const PG8_LAS bf16x8*)(lds + PG8_SA(b, h) + aoff + m * 2048 + k * 1024); } while (0)
#define PG8_LDB(dst, b, h) do { _Pragma("unroll") for (int n = 0; n < 2; ++n) _Pragma("unroll") for (int k = 0; k < 2; ++k) dst[n][k] = *(const PG8_LAS bf16x8*)(lds + PG8_SB(b, h) + boff + n * 2048 + k * 1024); } while (0)
#define PG8_MMA(ai, bj, At, Bt) do { __builtin_amdgcn_s_setprio(1); _Pragma("unroll") for (int m = 0; m < 4; ++m) _Pragma("unroll") for (int n = 0; n < 2; ++n) _Pragma("unroll") for (int k = 0; k < 2; ++k) \
        acc[ai][bj][m][n] = __builtin_amdgcn_mfma_f32_16x16x32_bf16(Bt[n][k], At[m][k], acc[ai][bj][m][n], 0, 0, 0); __builtin_amdgcn_s_setprio(0); } while (0)
#define PG8_WAIT_V(n) asm volatile("s_waitcnt vmcnt(" #n ")" ::: "memory")
#define PG8_WAIT_L(n) asm volatile("s_waitcnt lgkmcnt(" #n ")" ::: "memory")
#define PG8_BAR __builtin_amdgcn_s_barrier()
#define PG8_SCHED __builtin_amdgcn_sched_barrier(0)
    Unit cur, nxt; int ui = 0;
    if (!S.next(0, cur)) return;
    f32x4 acc[2][2][4][2];
#pragma unroll
    for (int a = 0; a < 2; ++a)
#pragma unroll
        for (int b = 0; b < 2; ++b)
#pragma unroll
            for (int m = 0; m < 4; ++m)
#pragma unroll
                for (int n = 0; n < 2; ++n) acc[a][b][m][n] = (f32x4){0.f, 0.f, 0.f, 0.f};
    bf16x8 At[4][2], B0[2][2], B1[2][2];
    const char* cA = (const char*)g.A + (size_t)cur.pm * tstep; const char* cB = (const char*)g.Bt + (size_t)cur.pn * tstep;
    S.a_ready(cur);
    if constexpr (SP2) {
        PG8_STAGE(PG8_SB(0, 0), cB, voffB); PG8_STAGE(PG8_SB(0, 1), cB + hstep, voffB); PG8_STAGE(PG8_SA(0, 0), cA, voffA); PG8_STAGE(PG8_SA(0, 1), cA + hstep, voffA);
        if (wr == 1) PG8_BAR;
        PG8_WAIT_V(2); PG8_BAR;
        PG8_STAGE(PG8_SB(1, 0), cB + kstep, voffB); PG8_STAGE(PG8_SA(1, 0), cA + kstep, voffA); PG8_STAGE(PG8_SB(1, 1), cB + hstep + kstep, voffB);
        PG8_WAIT_V(6); PG8_BAR;
    } else {
        PG8_STAGE(PG8_SB(0, 0), cB, voffB); PG8_STAGE(PG8_SA(0, 0), cA, voffA); PG8_STAGE(PG8_SB(0, 1), cB + hstep, voffB); PG8_STAGE(PG8_SA(0, 1), cA + hstep, voffA);
        if (wr == 1) PG8_BAR;
        PG8_WAIT_V(4); PG8_BAR;
        PG8_STAGE(PG8_SB(1, 0), cB + kstep, voffB); PG8_STAGE(PG8_SA(1, 0), cA + kstep, voffA); PG8_STAGE(PG8_SB(1, 1), cB + hstep + kstep, voffB);
        PG8_WAIT_V(6); PG8_BAR;
    }
    for (;;) {
        const bool has_next = S.next(ui + 1, nxt);
        const char* nA = has_next ? (const char*)g.A + (size_t)nxt.pm * tstep : cA; const char* nB = has_next ? (const char*)g.Bt + (size_t)nxt.pn * tstep : cB;
        for (int t = 0; t < nt; t += 2) {
            const bool last = (t == nt - 2);
            const char* a1 = cA + (size_t)(t + 1) * kstep;
            const char* a2 = last ? nA : cA + (size_t)(t + 2) * kstep; const char* b2 = last ? nB : cB + (size_t)(t + 2) * kstep;
            const char* a3 = a2 + kstep; const char* b3 = b2 + kstep;
            if (last && has_next) S.a_ready(nxt);
            if constexpr (SP2) {
            PG8_LDB(B0, 0, 0); PG8_LDB(B1, 0, 1); PG8_SCHED; PG8_LDA(At, 0, 0); PG8_STAGE(PG8_SA(1, 1), a1 + hstep, voffA);
            PG8_WAIT_V(8); PG8_WAIT_L(0); PG8_BAR; PG8_MMA(0, 0, At, B0); PG8_MMA(0, 1, At, B1); PG8_BAR; PG8_SCHED;
            PG8_LDA(At, 0, 1); PG8_STAGE(PG8_SB(0, 0), b2, voffB); PG8_STAGE(PG8_SB(0, 1), b2 + hstep, voffB); PG8_STAGE(PG8_SA(0, 0), a2, voffA);
            PG8_WAIT_V(8); PG8_WAIT_L(0); PG8_BAR; PG8_MMA(1, 0, At, B0); PG8_MMA(1, 1, At, B1); PG8_BAR; PG8_SCHED;
            PG8_LDB(B0, 1, 0); PG8_LDB(B1, 1, 1); PG8_SCHED; PG8_LDA(At, 1, 0); PG8_STAGE(PG8_SA(0, 1), a2 + hstep, voffA);
            PG8_WAIT_V(8); PG8_WAIT_L(0); PG8_BAR; PG8_MMA(0, 0, At, B0); PG8_MMA(0, 1, At, B1); PG8_BAR; PG8_SCHED;
            PG8_LDA(At, 1, 1); PG8_STAGE(PG8_SB(1, 0), b3, voffB); PG8_STAGE(PG8_SB(1, 1), b3 + hstep, voffB); PG8_STAGE(PG8_SA(1, 0), a3, voffA);
            PG8_WAIT_V(8); PG8_WAIT_L(0); PG8_BAR; PG8_MMA(1, 0, At, B0); PG8_MMA(1, 1, At, B1); PG8_BAR; PG8_SCHED;
            } else {
            PG8_LDB(B0, 0, 0); PG8_SCHED; PG8_LDA(At, 0, 0); PG8_STAGE(PG8_SA(1, 1), a1 + hstep, voffA);
            PG8_WAIT_L(8); PG8_BAR; PG8_WAIT_L(0); PG8_MMA(0, 0, At, B0); PG8_BAR; PG8_SCHED;
            PG8_LDB(B1, 0, 1); PG8_STAGE(PG8_SB(0, 0), b2, voffB);
            PG8_BAR; PG8_WAIT_L(0); PG8_MMA(0, 1, At, B1); PG8_BAR;
            PG8_LDA(At, 0, 1); PG8_STAGE(PG8_SA(0, 0), a2, voffA);
            PG8_BAR; PG8_WAIT_L(0); PG8_MMA(1, 0, At, B0); PG8_BAR; PG8_SCHED;
            PG8_STAGE(PG8_SB(0, 1), b2 + hstep, voffB);
            PG8_WAIT_V(6); PG8_BAR; PG8_MMA(1, 1, At, B1); PG8_BAR;
            PG8_LDB(B0, 1, 0); PG8_SCHED; PG8_LDA(At, 1, 0); PG8_STAGE(PG8_SA(0, 1), a2 + hstep, voffA);
            PG8_WAIT_L(8); PG8_BAR; PG8_WAIT_L(0); PG8_MMA(0, 0, At, B0); PG8_BAR; PG8_SCHED;
            PG8_LDB(B1, 1, 1); PG8_STAGE(PG8_SB(1, 0), b3, voffB);
            PG8_BAR; PG8_WAIT_L(0); PG8_MMA(0, 1, At, B1); PG8_BAR;
            PG8_LDA(At, 1, 1); PG8_STAGE(PG8_SA(1, 0), a3, voffA);
            PG8_BAR; PG8_WAIT_L(0); PG8_MMA(1, 0, At, B0); PG8_BAR; PG8_SCHED;
            PG8_STAGE(PG8_SB(1, 1), b3 + hstep, voffB);
            PG8_WAIT_V(6); PG8_BAR; PG8_MMA(1, 1, At, B1); PG8_BAR;
            }
        }
        if constexpr (ALIGN_EPI) { if (wr == 0) PG8_BAR; }
        if constexpr (!Epi::AFTER_DRAIN) { E(acc, cur, wr, wc, fr, fq); S.done(cur); }
        if (!has_next) break;
#pragma unroll
        for (int a = 0; a < 2; ++a)
#pragma unroll
            for (int b = 0; b < 2; ++b)
#pragma unroll
                for (int m = 0; m < 4; ++m)
#pragma unroll
                    for (int n = 0; n < 2; ++n) acc[a][b][m][n] = (f32x4){0.f, 0.f, 0.f, 0.f};
        cur = nxt; cA = nA; cB = nB; ++ui;
        if constexpr (ALIGN_EPI) { if (wr == 1) PG8_BAR; }
    }
    PG8_WAIT_V(0);
    if constexpr (!ALIGN_EPI) { if (wr == 0) PG8_BAR; }
    PG8_BAR;
    if constexpr (Epi::AFTER_DRAIN) { E.fused(acc, cur, wr, wc, fr, fq, lds, wid, lane); S.done(cur); }
#undef PG8_SA
#undef PG8_SB
#undef PG8_STAGE
#undef PG8_LDA
#undef PG8_LDB
#undef PG8_MMA
#undef PG8_WAIT_V
#undef PG8_WAIT_L
#undef PG8_BAR
#undef PG8_SCHED
}
}
namespace att {
typedef float f32x16 __attribute__((ext_vector_type(16)));
typedef float f32x4 __attribute__((ext_vector_type(4)));
typedef short bf16x8 __attribute__((ext_vector_type(8)));
typedef short s16x4 __attribute__((ext_vector_type(4)));
typedef unsigned u32x4 __attribute__((ext_vector_type(4)));
#define ALAS __attribute__((address_space(3)))
constexpr int KCS = 1040, VDS = 4160, KBUF = 8 * KCS, VBUF = 4 * VDS, KBOFF = KBUF + VBUF, STG = KBOFF + 256, NSLOT = 3;
constexpr int L_WSF = NSLOT * STG, L_OST = L_WSF + 8 * 256, L_END = L_OST + 8 * 8192;
constexpr float LOG2E = 1.4426950408889634f, C2 = 0.125f * LOG2E, THR = 8.f, NEGBIG = -1e30f;
__device__ __forceinline__ int crow(int r, int hi) { return (r & 3) + 8 * (r >> 2) + 4 * hi; }
__device__ __forceinline__ unsigned cvtpk(float lo, float hi) { typedef float f2 __attribute__((ext_vector_type(2))); typedef __bf16 b2 __attribute__((ext_vector_type(2))); f2 v = {lo, hi}; b2 b = __builtin_convertvector(v, b2); return __builtin_bit_cast(unsigned, b); }
__device__ __forceinline__ s16x4 vtr(const ALAS unsigned char* p) { typedef short v4i16_t __attribute__((ext_vector_type(4))); return __builtin_bit_cast(s16x4, __builtin_amdgcn_ds_read_tr16_b64_v4i16((ALAS v4i16_t*)p)); }
__device__ __forceinline__ float bfl(unsigned w) { return __uint_as_float(w << 16); }
__device__ __forceinline__ float bfh(unsigned w) { return __uint_as_float(w & 0xffff0000u); }
__device__ __forceinline__ float silu_f(float x) { return x / (1.f + fexp(-x)); }
__device__ __forceinline__ void glds16(const void* gsrc, unsigned lds_dst) { unsigned keep;
    asm volatile("s_mov_b32 %0, m0\n\ts_mov_b32 m0, %2\n\ts_nop 0\n\tglobal_load_lds_dwordx4 %1, off\n\ts_mov_b32 m0, %0" : "=&s"(keep) : "v"(gsrc), "s"(lds_dst) : "memory"); }
__device__ __forceinline__ void glds4(const void* gsrc, unsigned lds_dst) { unsigned keep;
    asm volatile("s_mov_b32 %0, m0\n\ts_mov_b32 m0, %2\n\ts_nop 0\n\tglobal_load_lds_dword %1, off\n\ts_mov_b32 m0, %0" : "=&s"(keep) : "v"(gsrc), "s"(lds_dst) : "memory"); }
#define ATT_WAIT_BAR(N) asm volatile("s_waitcnt vmcnt(" #N ") lgkmcnt(0)\n\ts_barrier" ::: "memory")

template <int MODE> __device__ __forceinline__ void dma_tile(unsigned slot, const bf16_t* __restrict__ PROJ, const float* __restrict__ CUM, size_t krow0, int kcol, int vcol, int h, int wid, int lane) {
    if (MODE == 0 && wid == 0) glds4(CUM + (krow0 + lane) * 4 + h, (unsigned)__builtin_amdgcn_readfirstlane(slot + KBOFF));
    glds16(PROJ + (krow0 + lane) * NP + kcol + wid * 8, (unsigned)__builtin_amdgcn_readfirstlane(slot + wid * KCS));
    const bf16_t* vs = PROJ + (krow0 + (wid & 3) * 16 + (lane >> 2)) * NP + vcol + (wid >> 2) * 32 + (lane & 3) * 8;
    glds16(vs, (unsigned)__builtin_amdgcn_readfirstlane(slot + KBUF + (wid >> 2) * VDS + (wid & 3) * 1024));
    if (MODE == 1) glds16(vs + 64, (unsigned)__builtin_amdgcn_readfirstlane(slot + KBUF + (2 + (wid >> 2)) * VDS + (wid & 3) * 1024));
}

template <int MODE, bool DIAG> __device__ __forceinline__ bool qs_front(const ALAS unsigned char* buf, const ALAS unsigned char* vprev, s16x4 (&vl)[8], s16x4 (&vh)[8], const bf16x8 (&qr)[4], f32x16& p0, f32x16& p1, float& mhat, float& l,
        int kidx0, bool meta, int qw0, float slope2, ALAS float* wsf, int lane) {
    constexpr bool diag = DIAG;
    const int r32 = lane & 31, hi = lane >> 5;
    {
      const ALAS unsigned char* vb = vprev + KBUF + ((lane >> 4) & 1) * 32 + (lane & 3) * 8 + (4 * hi + ((lane & 15) >> 2)) * 64; asm volatile("" : "+v"(vb));
#pragma unroll
      for (int i = 0; i < (MODE == 0 ? 8 : 4); ++i) { vl[i] = vtr(vb + (i & 1) * VDS + (i >> 1) * 1024); vh[i] = vtr(vb + (i & 1) * VDS + (i >> 1) * 1024 + 512); } }
    asm volatile("" : "+v"(slope2), "+s"(kidx0));
    if (MODE == 0) {
        const ALAS f32x4* kbp = (const ALAS f32x4*)(buf + KBOFF + hi * 16); asm volatile("" : "+v"(kbp));
#pragma unroll
        for (int g = 0; g < 4; ++g) { const f32x4 a = kbp[2 * g], b = kbp[8 + 2 * g];
#pragma unroll
            for (int j = 0; j < 4; ++j) { p0[4 * g + j] = fmaf(a[j], -LOG2E, -mhat); p1[4 * g + j] = fmaf(b[j], -LOG2E, -mhat); } }
    } else {
        if (!diag) {
            const float base = slope2 * (float)(kidx0 + 4 * hi - qw0) - mhat;
#pragma unroll
            for (int r = 0; r < 16; ++r) { const int c = (r & 3) + 8 * (r >> 2); p0[r] = fmaf((float)c, slope2, base); p1[r] = fmaf((float)(c + 32), slope2, base); }
            if (meta) {
#pragma unroll
                for (int r = 0; r < 16; ++r) { if ((r >> 2) >= 2) p0[r] = NEGBIG; p1[r] = NEGBIG; }
            }
        } else {
            const float dq = (float)(qw0 + r32 - kidx0 - 4 * hi), fr = (float)r32;
#pragma unroll
            for (int r = 0; r < 16; ++r) { const int c = (r & 3) + 8 * (r >> 2);
                p0[r] = slope2 * (fr - fabsf(dq - (float)c)) - mhat; p1[r] = slope2 * (fr - fabsf(dq - (float)(c + 32))) - mhat; }
        }
    }
    { const ALAS unsigned char* kb = buf + hi * KCS + r32 * 16; asm volatile("" : "+v"(kb));
#pragma unroll
      for (int d0 = 0; d0 < 4; ++d0) {
          const bf16x8 k0 = *(const ALAS bf16x8*)(kb + d0 * 2 * KCS), k1 = *(const ALAS bf16x8*)(kb + d0 * 2 * KCS + 512);
          p0 = __builtin_amdgcn_mfma_f32_32x32x16_bf16(k0, qr[d0], p0, 0, 0, 0);
          p1 = __builtin_amdgcn_mfma_f32_32x32x16_bf16(k1, qr[d0], p1, 0, 0, 0); } }
    if (MODE == 0 && diag) {
        const int lim = qw0 + r32 - kidx0 - 4 * hi;
#pragma unroll
        for (int r = 0; r < 16; ++r) { const int c = (r & 3) + 8 * (r >> 2); if (c > lim) p0[r] = NEGBIG; if (c + 32 > lim) p1[r] = NEGBIG; }
    }
    float rm;
    {
#define ATT_MX3(a, b, c) __builtin_fmaxf(__builtin_fmaxf((a), (b)), (c))
      float a = ATT_MX3(p0[0], p0[1], p1[0]), b = ATT_MX3(p0[2], p0[3], p1[1]); a = ATT_MX3(a, p1[2], p1[3]);
#pragma unroll
      for (int r = 4; r < 16; r += 4) { a = ATT_MX3(a, p0[r], p0[r + 1]); b = ATT_MX3(b, p0[r + 2], p0[r + 3]); a = ATT_MX3(a, p1[r], p1[r + 1]); b = ATT_MX3(b, p1[r + 2], p1[r + 3]); }
#undef ATT_MX3
      a = __builtin_fmaxf(a, b);
      auto rr = __builtin_amdgcn_permlane32_swap(__float_as_uint(a), __float_as_uint(a), false, false);
      rm = __builtin_fmaxf(__uint_as_float(rr[0]), __uint_as_float(rr[1])); }
    bool resc = false;
    if (__any(rm > THR)) {
        const float dl = fmaxf(rm, 0.f); mhat += dl;
#pragma unroll
        for (int r = 0; r < 16; ++r) { p0[r] -= dl; p1[r] -= dl; }
        const float f = __builtin_amdgcn_exp2f(-dl); l *= f; if (hi == 0) wsf[r32] = f; resc = true;
    }
    return resc;
}
#define ATT_SBAR() __builtin_amdgcn_sched_barrier(0)
#define ATT_PIN(x) asm volatile("" : "+v"(x))
#define ATT_VF(L, H, i) (bf16x8){L[i][0], L[i][1], L[i][2], L[i][3], H[i][0], H[i][1], H[i][2], H[i][3]}
template <int NDB> __device__ __forceinline__ void pv_exp(const ALAS unsigned char* vbuf, s16x4 (&vl)[8], s16x4 (&vh)[8], const u32x4 (&pwo)[4], f32x16 (&o)[NDB], f32x16& p0, f32x16& p1, u32x4 (&pwn)[4], float& l, int lane) {
    const int hi = lane >> 5;
    float s0 = 0.f, s1 = 0.f, s2 = 0.f, s3 = 0.f;
    ATT_SBAR();
    if (NDB == 2) {
#pragma unroll
        for (int k = 0; k < 8; ++k) {
            o[k & 1] = __builtin_amdgcn_mfma_f32_32x32x16_bf16(__builtin_bit_cast(bf16x8, pwo[k >> 1]), ATT_VF(vl, vh, k), o[k & 1], 0, 0, 0);
            p0[2 * k] = __builtin_amdgcn_exp2f(p0[2 * k]); p0[2 * k + 1] = __builtin_amdgcn_exp2f(p0[2 * k + 1]); p1[2 * k] = __builtin_amdgcn_exp2f(p1[2 * k]); p1[2 * k + 1] = __builtin_amdgcn_exp2f(p1[2 * k + 1]);
            s0 += p0[2 * k]; s1 += p0[2 * k + 1]; s2 += p1[2 * k]; s3 += p1[2 * k + 1];
            pwn[k >> 2][k & 3] = cvtpk(p0[2 * k], p0[2 * k + 1]); pwn[2 + (k >> 2)][k & 3] = cvtpk(p1[2 * k], p1[2 * k + 1]);
            ATT_PIN(p0); ATT_PIN(p1); ATT_PIN(s0); ATT_PIN(s1); ATT_PIN(s2); ATT_PIN(s3); ATT_PIN(pwn[k >> 2]); ATT_PIN(pwn[2 + (k >> 2)]);
            ATT_SBAR();
        }
    } else {
        const ALAS unsigned char* vb = vbuf + KBUF + ((lane >> 4) & 1) * 32 + (lane & 3) * 8 + (4 * hi + ((lane & 15) >> 2)) * 64; asm volatile("" : "+v"(vb));
        s16x4 (&wl)[8] = vl; s16x4 (&wh)[8] = vh;
#pragma unroll
        for (int k = 0; k < 16; ++k) {
            const int blk = 2 * (k >> 3) + (k & 1), ks = (k >> 1) & 3;
            o[blk] = __builtin_amdgcn_mfma_f32_32x32x16_bf16(__builtin_bit_cast(bf16x8, pwo[ks]), ATT_VF(wl, wh, k & 3), o[blk], 0, 0, 0);
            if (k + 4 < 16) { const int j = k + 4, jb = 2 * (j >> 3) + (j & 1), jk = (j >> 1) & 3; wl[k & 3] = vtr(vb + jb * VDS + jk * 1024); wh[k & 3] = vtr(vb + jb * VDS + jk * 1024 + 512); }
            if (k < 8) { p0[2 * k] = __builtin_amdgcn_exp2f(p0[2 * k]); p0[2 * k + 1] = __builtin_amdgcn_exp2f(p0[2 * k + 1]); s0 += p0[2 * k]; s1 += p0[2 * k + 1];
                pwn[k >> 2][k & 3] = cvtpk(p0[2 * k], p0[2 * k + 1]); ATT_PIN(p0); ATT_PIN(s0); ATT_PIN(s1); ATT_PIN(pwn[k >> 2]); }
            else { const int q = k - 8; p1[2 * q] = __builtin_amdgcn_exp2f(p1[2 * q]); p1[2 * q + 1] = __builtin_amdgcn_exp2f(p1[2 * q + 1]); s2 += p1[2 * q]; s3 += p1[2 * q + 1];
                pwn[2 + (q >> 2)][q & 3] = cvtpk(p1[2 * q], p1[2 * q + 1]); ATT_PIN(p1); ATT_PIN(s2); ATT_PIN(s3); ATT_PIN(pwn[2 + (q >> 2)]); }
            ATT_SBAR();
        }
    }
    l += (s0 + s1) + (s2 + s3);
}
template <int NDB> __device__ __forceinline__ void pv_only(const ALAS unsigned char* vbuf, const u32x4 (&pwo)[4], f32x16 (&o)[NDB], int lane) {
    const int hi = lane >> 5;
    const ALAS unsigned char* vb = vbuf + KBUF + ((lane >> 4) & 1) * 32 + (lane & 3) * 8 + (4 * hi + ((lane & 15) >> 2)) * 64; asm volatile("" : "+v"(vb));
#pragma unroll
    for (int d = 0; d < NDB; ++d) {
        s16x4 lo[4], hh[4];
#pragma unroll
        for (int ks = 0; ks < 4; ++ks) { lo[ks] = vtr(vb + d * VDS + ks * 1024); hh[ks] = vtr(vb + d * VDS + ks * 1024 + 512); }
#pragma unroll
        for (int ks = 0; ks < 4; ++ks) o[d] = __builtin_amdgcn_mfma_f32_32x32x16_bf16(__builtin_bit_cast(bf16x8, pwo[ks]), ATT_VF(lo, hh, ks), o[d], 0, 0, 0);
        ATT_SBAR();
    }
}
template <int NDB> __device__ __forceinline__ void rescale_o(f32x16 (&o)[NDB], const ALAS float* wsf, int lane) {
    const int hi = lane >> 5;
#pragma unroll
    for (int r = 0; r < 16; ++r) { const float f = wsf[crow(r, hi)];
#pragma unroll
        for (int d = 0; d < NDB; ++d) o[d][r] *= f; }
}
__device__ __forceinline__ u32x4 gate8(u32x4 v, u32x4 z) {
    u32x4 o;
#pragma unroll
    for (int j = 0; j < 4; ++j) { const float a = bfl(v[j]) * silu_f(bfl(z[j])), b = bfh(v[j]) * silu_f(bfh(z[j])); o[j] = cvtpk(a, b); }
    return o;
}


template <int NDB> __device__ __forceinline__ void stage_gate_store(const f32x16 (&res)[NDB], ALAS bf16_t* stg, const bf16_t* __restrict__ zbase, bf16_t* __restrict__ mbase, int lane) {
    const int r32 = lane & 31, hi = lane >> 5;
#pragma unroll
    for (int r = 0; r < 16; ++r) { const int orow = crow(r, hi);
#pragma unroll
        for (int d = 0; d < NDB; ++d) stg[orow * (NDB * 32) + d * 32 + r32] = f2bf(res[d][r]); }
    constexpr int CPR = NDB * 4;
    constexpr int RPP = 64 / CPR;
#pragma unroll
    for (int i = 0; i < 32 / RPP; ++i) {
        const int row = i * RPP + lane / CPR, ch = lane % CPR;
        const u32x4 v = *(const ALAS u32x4*)(stg + row * (NDB * 32) + ch * 8);
        const u32x4 z = *(const u32x4*)(zbase + (size_t)row * NP + ch * 8);
        *(u32x4*)(mbase + (size_t)row * DM + ch * 8) = gate8(v, z);
    }
}

template <int MODE> __device__ __forceinline__ void attn_unit(ALAS unsigned char* lds, const bf16_t* __restrict__ PROJ, const float* __restrict__ CUM, bf16_t* __restrict__ MIX,
        int b, int h, int qb, float lam, float li, const float* __restrict__ subg, float* park) {
    constexpr int NDB = MODE == 1 ? 4 : 2, NBR = MODE == 1 ? 2 : 1, HS = MODE == 1 ? 128 : 64;
    int tid_ = threadIdx.x; asm volatile("" : "+v"(tid_));
    const int tid = tid_, lane = tid & 63, r32 = lane & 31, hi = lane >> 5, wid = __builtin_amdgcn_readfirstlane(tid >> 6);
    const int q0 = qb * 256, qw0 = q0 + wid * 32;
    const size_t rowb = (size_t)b * SEQ;
    const int NT = 4 * qb + 4, my_last = 4 * qb + (wid >> 1);
    ALAS float* wsf = (ALAS float*)(lds + L_WSF) + wid * 64;
    const unsigned ldsb = (unsigned)(size_t)lds;
    const float slope2 = MODE == 1 ? LOG2E / (float)(1 << (2 * h + 2)) : 0.f;
    f32x16 res[NDB];
#pragma clang loop unroll(disable)
    for (int c = 0; c < NBR; ++c) {
        const int qcol = MODE == 0 ? C_FQ + h * 64 : C_DQ + h * 128 + c * 64;
        const int kcol = MODE == 0 ? C_FK + h * 64 : C_DK + h * 128 + c * 64;
        const int vcol = MODE == 0 ? C_FV + h * 64 : C_DV + h * 128;
        bf16x8 qr[4];
        { const bf16_t* Qw = PROJ + (rowb + qw0 + r32) * NP + qcol + hi * 8;
#pragma unroll
          for (int d0 = 0; d0 < 4; ++d0) qr[d0] = *(const bf16x8*)(Qw + d0 * 16); }
        float mhat = MODE == 0 ? -CUM[(rowb + qw0) * 4 + h] * LOG2E : 0.f, l = 0.f;
        f32x16 o[NDB];
#pragma unroll
        for (int d = 0; d < NDB; ++d)
#pragma unroll
            for (int r = 0; r < 16; ++r) o[d][r] = 0.f;
        u32x4 pwa[4], pwb[4]; f32x16 p0, p1; s16x4 vl[8], vh[8];
#pragma unroll
        for (int k = 0; k < 4; ++k) { pwa[k] = (u32x4){0u, 0u, 0u, 0u}; pwb[k] = (u32x4){0u, 0u, 0u, 0u}; }
#define ATT_TROW(i) ((i) < NT ? rowb + (size_t)(NT - 1 - (i)) * 64 : (size_t)MR)
#define ATT_STEP(i, PIN_, POUT_) do { \
            if ((i) + 1 <= NT) dma_tile<MODE>(ldsb + (unsigned)s_next, PROJ, CUM, ATT_TROW((i) + 1), kcol, vcol, h, wid, lane);     \
            const bool mt_ = ((i) == NT); const int t_ = NT - 1 - (i); \
            if (mt_ || t_ <= my_last) { \
                bool resc_; \
                if ((!mt_) && t_ == my_last) resc_ = qs_front<MODE, true>(lds + s_cur, lds + s_prev, vl, vh, qr, p0, p1, mhat, l, 64 * t_, false, qw0, slope2, wsf, lane); \
                else resc_ = qs_front<MODE, false>(lds + s_cur, lds + s_prev, vl, vh, qr, p0, p1, mhat, l, mt_ ? -16 : 64 * t_, mt_, qw0, slope2, wsf, lane); \
                pv_exp<NDB>(lds + s_prev, vl, vh, PIN_, o, p0, p1, POUT_, l, lane); \
                if (resc_) rescale_o<NDB>(o, wsf, lane); \
            } \
            ATT_WAIT_BAR(0);        \
            { const int tt = s_prev; s_prev = s_cur; s_cur = s_next; s_next = tt; } } while (0)
        dma_tile<MODE>(ldsb, PROJ, CUM, ATT_TROW(0), kcol, vcol, h, wid, lane);
        dma_tile<MODE>(ldsb + 2 * STG, PROJ, CUM, ATT_TROW(0), kcol, vcol, h, wid, lane);
        ATT_WAIT_BAR(0);
        int s_prev = 2 * STG, s_cur = 0, s_next = STG;
#pragma clang loop unroll(disable)
        for (int i = 0; i < NT; i += 2) { ATT_STEP(i, pwa, pwb); ATT_STEP(i + 1, pwb, pwa); }
        ATT_STEP(NT, pwa, pwb);
        pv_only<NDB>(lds + s_prev, pwb, o, lane);
#undef ATT_STEP
#undef ATT_TROW
        ATT_WAIT_BAR(0);
        { auto rr = __builtin_amdgcn_permlane32_swap(__float_as_uint(l), __float_as_uint(l), false, false); l = __uint_as_float(rr[0]) + __uint_as_float(rr[1]); }
        if (hi == 0) wsf[32 + r32] = l;
        float rli[16];
#pragma unroll
        for (int r = 0; r < 16; ++r) rli[r] = 1.f / wsf[32 + crow(r, hi)];
        if (MODE == 0) {
#pragma unroll
            for (int d = 0; d < NDB; ++d)
#pragma unroll
                for (int r = 0; r < 16; ++r) res[d][r] = o[d][r] * rli[r];
        } else {
            float* pk = park + c * 4096 + lane;
#pragma unroll
            for (int d = 0; d < NDB; ++d) {
                float* pkd = pk + d * 1024; asm volatile("" : "+v"(pkd));
#pragma unroll
                for (int r = 0; r < 16; ++r) pkd[r * 64] = o[d][r] * rli[r];
            }
        }
    }
    if (MODE == 1) {
#pragma unroll
        for (int d = 0; d < NDB; ++d) {
            const float* pa = park + lane + d * 1024; const float* pb = pa + 4096; asm volatile("" : "+v"(pa), "+v"(pb));
#pragma unroll
            for (int r = 0; r < 16; ++r) res[d][r] = pa[r * 64] - lam * pb[r * 64];
            __builtin_amdgcn_sched_barrier(0);
        }
    }
    ALAS bf16_t* stg = (ALAS bf16_t*)(lds + L_OST + wid * 8192);
    if (MODE == 1) {
        float ss[16];
#pragma unroll
        for (int r = 0; r < 16; ++r) { float s = 0.f;
#pragma unroll
            for (int d = 0; d < NDB; ++d) s += res[d][r] * res[d][r];
            ss[r] = s; }
#pragma unroll
        for (int m = 1; m < 32; m <<= 1)
#pragma unroll
            for (int r = 0; r < 16; ++r) ss[r] += shx(ss[r], m, lane);
        float gc[NDB];
#pragma unroll
        for (int d = 0; d < NDB; ++d) gc[d] = subg[32 * d + r32] * (1.f - li);
#pragma unroll
        for (int r = 0; r < 16; ++r) { const float rs = rsqrtf(ss[r] * (1.f / 128.f) + 1e-5f);
#pragma unroll
            for (int d = 0; d < NDB; ++d) res[d][r] *= rs * gc[d]; }
    }
    const int zcol = MODE == 0 ? C_FZ + h * 64 : C_DZ + h * 128, mcol = MODE == 0 ? M_A + h * 64 : M_B + h * 128;
    stage_gate_store<NDB>(res, stg, PROJ + (rowb + qw0) * NP + zcol, MIX + (rowb + qw0) * DM + mcol, lane);
}

__device__ __forceinline__ void pool_unit(ALAS unsigned char* lds, const bf16_t* __restrict__ PROJ, const bf16_t* __restrict__ WPT_l, const float* __restrict__ pscale_l, bf16_t* __restrict__ MIX, int unit) {
    int tid_ = threadIdx.x; asm volatile("" : "+v"(tid_));
    const int tid = tid_, lane = tid & 63, r32 = lane & 31, hi = lane >> 5, wid = __builtin_amdgcn_readfirstlane(tid >> 6);
    const int g = wid & 3, win = 2 << g; const float invw = 1.f / (float)win;
    const int Rw = unit * 128 + (wid >> 2) * 64, b = Rw >> 12, tw = Rw & 4095;
    ALAS bf16_t* stg = (ALAS bf16_t*)(lds + L_OST + wid * 8192);
    bf16x8 wb[2][4];
#pragma unroll
    for (int nb = 0; nb < 2; ++nb)
#pragma unroll
        for (int ks = 0; ks < 4; ++ks) wb[nb][ks] = *(const bf16x8*)(WPT_l + ((g * 64 + 32 * nb + r32) * 64 + 16 * ks + 8 * hi));
    const float ps0 = pscale_l[g * 64 + r32], ps1 = pscale_l[g * 64 + 32 + r32];
    for (int blk = 0; blk < 2; ++blk) {
        const int t = tw + 32 * blk + r32;
        f32x16 acc[2];
#pragma unroll
        for (int r = 0; r < 16; ++r) { acc[0][r] = 0.f; acc[1][r] = 0.f; }
#pragma unroll
        for (int ks = 0; ks < 4; ++ks) {
            const int c0 = C_PU + g * 64 + 16 * ks + 8 * hi;
            float s[8], own[8];
#pragma unroll
            for (int j = 0; j < 8; ++j) { s[j] = 0.f; own[j] = 0.f; }
            for (int i = 0; i < win; ++i) {
                const int ti = t - i; const size_t row = ti >= 0 ? (size_t)b * SEQ + ti : (size_t)(MR + 16 + ti);
                const u32x4 v = *(const u32x4*)(PROJ + row * NP + c0);
#pragma unroll
                for (int j = 0; j < 4; ++j) { const float lo = bfl(v[j]), hh = bfh(v[j]); s[2 * j] += lo; s[2 * j + 1] += hh; if (i == 0) { own[2 * j] = lo; own[2 * j + 1] = hh; } }
            }
            u32x4 pa;
#pragma unroll
            for (int j = 0; j < 4; ++j) pa[j] = cvtpk(s[2 * j] * invw - own[2 * j], s[2 * j + 1] * invw - own[2 * j + 1]);
            const bf16x8 af = __builtin_bit_cast(bf16x8, pa);
            acc[0] = __builtin_amdgcn_mfma_f32_32x32x16_bf16(af, wb[0][ks], acc[0], 0, 0, 0);
            acc[1] = __builtin_amdgcn_mfma_f32_32x32x16_bf16(af, wb[1][ks], acc[1], 0, 0, 0);
        }
#pragma unroll
        for (int r = 0; r < 16; ++r) { acc[0][r] *= ps0; acc[1][r] *= ps1; }
        const size_t row0 = (size_t)Rw + 32 * blk;
        stage_gate_store<2>(acc, stg, PROJ + row0 * NP + C_PZ + g * 64, MIX + row0 * DM + M_C + g * 64, lane);
    }
}
#undef ALAS
}


#ifndef PG8_SP2
#define PG8_SP2 true
#endif
#ifndef PG8_ALIGN
#define PG8_ALIGN true
#endif
constexpr int NWAVES = 8;
constexpr int RING_OFF = 0, RING_BYTES = 143360;
constexpr int LDSCTL_OFF = RING_BYTES, MISC_OFF = LDSCTL_OFF + 320;
constexpr int LDS_BYTES = RING_BYTES + 1024;
constexpr int CW_TMO = 0, CW_CODE = 1, CW_BAR = 4096;
constexpr size_t CTL_ZERO_BYTES = 1 * MiB;
static_assert(att::L_END <= RING_BYTES, "attention LDS map");
#define GAS __attribute__((address_space(1)))
#define LAS __attribute__((address_space(3)))
typedef unsigned short bf16;
typedef unsigned v4u __attribute__((ext_vector_type(4)));
typedef float f32x4 __attribute__((ext_vector_type(4)));
typedef short bf16x8 __attribute__((ext_vector_type(8)));
typedef GAS unsigned gu32;
typedef GAS unsigned long long gu64;
#define RLX_AGENT __ATOMIC_RELAXED, __HIP_MEMORY_SCOPE_AGENT
#define LDS_WAIT() asm volatile("s_waitcnt lgkmcnt(0)" ::: "memory")
#define VM_WAIT() asm volatile("s_waitcnt vmcnt(0)" ::: "memory")
__device__ __forceinline__ unsigned long long rt() { return __builtin_amdgcn_s_memrealtime(); }
__device__ __forceinline__ unsigned pk2(float lo, float hi) { return (unsigned)f2bf(lo) | ((unsigned)f2bf(hi) << 16); }

#define XB_TMO      128
#define XB_XCNT(j)  (256  + 64 * (j))
#define XB_XSUB(j)  (1280 + 64 * (j))
#define XB_XGEN(j)  (2304 + 64 * (j))
#define XB_TOP      3328
#define XB_TOPGEN   3392
#define XCD_BAR_WORDS 3456
#define XB_SPIN_CAP (1u << 18)

__device__ __forceinline__ unsigned xb_ld(unsigned* p)              { return __hip_atomic_load(p, __ATOMIC_RELAXED, __HIP_MEMORY_SCOPE_AGENT); }
__device__ __forceinline__ unsigned xb_add(unsigned* p, unsigned v) { return __hip_atomic_fetch_add(p, v, __ATOMIC_RELAXED, __HIP_MEMORY_SCOPE_AGENT); }
__device__ __forceinline__ unsigned xb_xcc_id() { return (unsigned)__builtin_amdgcn_s_getreg((3 << 11) | 20) & 0xFu; }
#define XB_SPIN(cond, bar) do { unsigned _sp = 0; while (cond) { __builtin_amdgcn_s_sleep(1); \
    if ((++_sp & 255u) == 0u) { if (xb_ld(&(bar)[XB_TMO])) break; if (_sp > XB_SPIN_CAP) { atomicAdd(&(bar)[XB_TMO], 1u); break; } } } } while (0)

struct XcdBarrier {
    unsigned* bar; unsigned x;
    volatile LAS unsigned* st;
};

__device__ __forceinline__ XcdBarrier xcd_barrier_post(unsigned* bar, volatile LAS unsigned* st) {
    XcdBarrier b; b.bar = bar; b.x = xb_xcc_id(); b.st = st;
    if (threadIdx.x == 0) (void)xb_add(&bar[XB_XCNT(b.x)], 1u);
    return b;
}
__device__ __forceinline__ void xcd_barrier_complete(unsigned* bar, unsigned x, unsigned& nloc, unsigned& nx) {
    const unsigned G = gridDim.x * gridDim.y * gridDim.z;
    unsigned sum, cnt, mine, sp = 0u;
    for (;;) {
        sum = 0u; cnt = 0u; mine = 0u;
#pragma unroll
        for (unsigned j = 0; j < 16; ++j) { const unsigned c = xb_ld(&bar[XB_XCNT(j)]); sum += c; cnt += (c > 0u) ? 1u : 0u; mine = (j == x) ? c : mine; }
        if (sum == G) break;
        __builtin_amdgcn_s_sleep(1);
        if ((++sp & 255u) == 0u) { if (xb_ld(&bar[XB_TMO])) break; if (sp > XB_SPIN_CAP) { atomicAdd(&bar[XB_TMO], 1u); break; } }
    }
    nloc = mine > 0u ? mine : 1u; nx = cnt > 0u ? cnt : 1u;
}

__device__ __forceinline__ void xcd_barrier(const XcdBarrier& b) {
    asm volatile("s_waitcnt vmcnt(0)" ::: "memory");
    __syncthreads();
    if (threadIdx.x == 0) {
        unsigned* bar = b.bar;
        __builtin_amdgcn_s_waitcnt(0);
        unsigned nloc = b.st[0], nx = b.st[1];
        if (nloc == 0u) { xcd_barrier_complete(bar, b.x, nloc, nx); b.st[0] = nloc; b.st[1] = nx; }
        const unsigned old = xb_add(&bar[XB_XSUB(b.x)], 1u);
        const unsigned gen = old / nloc;
        if (old + 1u == (gen + 1u) * nloc) {
            __builtin_amdgcn_fence(__ATOMIC_RELEASE, "agent");
            asm volatile("s_waitcnt vmcnt(0)" ::: "memory");
            const unsigned og = xb_add(&bar[XB_TOP], 1u);
            const unsigned tg = og / nx;
            if (og + 1u == (tg + 1u) * nx) xb_add(&bar[XB_TOPGEN], 1u);
            else XB_SPIN(xb_ld(&bar[XB_TOPGEN]) == tg, bar);
            __builtin_amdgcn_fence(__ATOMIC_ACQUIRE, "agent");
            xb_add(&bar[XB_XGEN(b.x)], 1u);
            asm volatile("s_waitcnt vmcnt(0)" ::: "memory");
        } else {
            XB_SPIN(xb_ld(&bar[XB_XGEN(b.x)]) == gen, bar);
            __builtin_amdgcn_fence(__ATOMIC_ACQUIRE, "agent");
            asm volatile("s_waitcnt vmcnt(0)" ::: "memory");
        }
    }
    __syncthreads();
}

__device__ __forceinline__ void transpose_item(const float* __restrict__ W, int ldw, int col0, const float* __restrict__ gk, bf16_t* WT, int K, LAS float* scr, int k0, int n0dst, int lane) {
#pragma unroll 8
    for (int i = 0; i < 32; ++i) { const int kk = 2 * i + (lane >> 5); float v = W[(size_t)(k0 + kk) * ldw + col0 + (lane & 31)]; if (gk) v *= gk[k0 + kk]; scr[kk * 33 + (lane & 31)] = v; }
    LDS_WAIT(); asm volatile("" ::: "memory");
    const int c = lane & 7;
#pragma unroll
    for (int j = 0; j < 4; ++j) { const int n = (lane >> 3) + 8 * j; const LAS float* s = scr + (8 * c) * 33 + n;
        v4u o; o.x = pk2(s[0 * 33], s[1 * 33]); o.y = pk2(s[2 * 33], s[3 * 33]); o.z = pk2(s[4 * 33], s[5 * 33]); o.w = pk2(s[6 * 33], s[7 * 33]);
        *(GAS v4u*)(WT + (size_t)(n0dst + n) * K + k0 + 8 * c) = o; }
    LDS_WAIT(); asm volatile("" ::: "memory");
}

constexpr int NPH = 18;
struct Args { const float* in[14]; float* out; unsigned char* ws; int ph_lo, ph_hi; };
__global__ void __launch_bounds__(NWAVES * 64, 2) mk_fwd(Args args) {
    extern __shared__ __attribute__((aligned(16))) unsigned char lds[];
    LAS unsigned char* ldsp = (LAS unsigned char*)lds;
    volatile LAS unsigned* MISC = (volatile LAS unsigned*)(ldsp + MISC_OFF);
    gu32* ctl = (gu32*)(args.ws + WS_CTL);
    for (int u = threadIdx.x; u < (LDS_BYTES - LDSCTL_OFF) / 4; u += NWAVES * 64) ((LAS unsigned*)(ldsp + LDSCTL_OFF))[u] = 0u;
    __syncthreads();
    XcdBarrier bar = xcd_barrier_post((unsigned*)(ctl + CW_BAR), MISC + 8);
    const int lo = args.ph_lo, hi = args.ph_hi;
    for (int ph_ = lo; ph_ < hi; ++ph_) {
        int ph = ph_, bid = (int)blockIdx.x, G = (int)gridDim.x;
        typedef const __attribute__((address_space(4))) Args* KArgs;
        KArgs ap = (KArgs)__builtin_amdgcn_kernarg_segment_ptr(); asm volatile("" : "+s"(ap));
        unsigned char* ws = ap->ws; unsigned* barw = bar.bar;
        asm volatile("" : "+s"(ph), "+s"(bid), "+s"(G), "+s"(ws), "+s"(barw));
        int tid_ = threadIdx.x; asm volatile("" : "+v"(tid_));
        const int tid = tid_, lane = tid & 63, wave = __builtin_amdgcn_readfirstlane(tid >> 6);
        const int vcu = (G % 8 == 0) ? (bid % 8) * (G / 8) + bid / 8 : bid;
        const int gw = bid * NWAVES + wave, NGW = G * NWAVES;
        bf16_t* W1T = (bf16_t*)(ws + WS_W1T); bf16_t* W2T = (bf16_t*)(ws + WS_W2T);
        float* WFG = (float*)(ws + WS_WFG); float* LAM = (float*)(ws + WS_LAM); float* HM = (float*)(ws + WS_HM);
        bf16_t* WPT = (bf16_t*)(ws + WS_WPT);
        float* LOGF = (float*)(ws + WS_LOGF); float* CUM = (float*)(ws + WS_CUM);
        bf16_t* HB = (bf16_t*)(ws + WS_HB); bf16_t* MIX = (bf16_t*)(ws + WS_MIX); bf16_t* PROJ = (bf16_t*)(ws + WS_PROJ);
        float* H = ap->out;
        if (ph == 0) {
            const float* norm_g = ap->in[2]; const float* w_in = ap->in[3]; const float* w_pool = ap->in[10]; const float* w_out = ap->in[12];
            LAS float* scr = (LAS float*)(ldsp + RING_OFF + wave * 16384);
            constexpr int NIT1 = DEPTH * 16 * 112, NIT2 = DEPTH * 16 * 32;
            for (int it = gw; it < NIT1 + NIT2; it += NGW) {
                if (it < NIT1) { const int l = it / 1792, r = it % 1792, kb = r / 112, nb = r % 112, n0 = 32 * nb, col0 = n0 < 1024 ? n0 : n0 + 4;
                    transpose_item(w_in + (size_t)l * 1024 * IN_DIM, IN_DIM, col0, norm_g + l * 1024, W1T + (size_t)l * NP * 1024, 1024, scr, 64 * kb, n0, lane); }
                else { const int r0 = it - NIT1, l = r0 / 512, r = r0 % 512, kb = r / 32, nb = r % 32;
                    transpose_item(w_out + (size_t)l * 1024 * 1024, 1024, 32 * nb, nullptr, W2T + (size_t)l * 1024 * 1024, 1024, scr, 64 * kb, 32 * nb, lane); }
            }
            const int gt = bid * (NWAVES * 64) + tid, NT = G * NWAVES * 64;
            for (int i = gt; i < DEPTH * 4 * 1024; i += NT) { const int k = i & 1023, c = (i >> 10) & 3, l = i >> 12; WFG[i] = w_in[((size_t)l * 1024 + k) * IN_DIM + 1024 + c] * norm_g[l * 1024 + k]; }
            for (int i = gt; i < DEPTH * 4 * 64 * 64; i += NT) { const int c = i & 63, d = (i >> 6) & 63, lg = i >> 12; WPT[i] = f2bf(w_pool[((size_t)lg * 64 + c) * 64 + d]); }
            unsigned zz = 0u; float big = 1e30f; asm volatile("" : "+v"(zz), "+v"(big));
            for (int i = gt; i < 48 * NP / 8; i += NT) ((uint4*)(PROJ + (size_t)(MR + 16) * NP))[i] = make_uint4(zz, zz, zz, zz);
            for (int i = gt; i < 48 * 4; i += NT) CUM[(size_t)(MR + 16) * 4 + i] = big;
            if (gt < DEPTH) { const int l = gt; float s1 = 0.f, s2 = 0.f;
                for (int i = 0; i < 64; ++i) { s1 += ap->in[5][l * 64 + i] * ap->in[6][l * 64 + i]; s2 += ap->in[7][l * 64 + i] * ap->in[8][l * 64 + i]; }
                LAM[l] = fexp(s1) - fexp(s2) + (0.8f - 0.6f * fexp(-0.3f * (float)l)); }
        } else if (ph <= 16) {
            const int l = (ph - 1) >> 2, sub = (ph - 1) & 3;
            if (sub == 0) {
                const float* hreal = l == 0 ? ap->in[0] : H; const float* hmeta = l == 0 ? ap->in[1] : HM;
                for (int row = gw; row < MT; row += NGW) norm_row(row, lane, hreal, hmeta, WFG + (size_t)l * 4096, ap->in[4] + l * 4, HB, LOGF);
            } else if (sub == 1) {
                if (wave == 0) { for (int i = bid; i < 33; i += G) { if (i < 32) scan_bh(i >> 2, i & 3, lane, LOGF, CUM); else scan_meta(lane, LOGF, CUM); } }
                if (wave == 1) { for (int nb = bid; nb < NP / 16; nb += G) {
                    const mf32x4 acc = meta_gemm16(HB + (size_t)MR * DM, W1T + (size_t)l * NP * 1024, nb, lane);
                    const int col = 16 * nb + (lane & 15), fq = lane >> 4; const float sc = (col < 256 || (col >= 1024 && col < 1536)) ? att::C2 : 1.f;
#pragma unroll
                    for (int j = 0; j < 4; ++j) PROJ[(size_t)(MR + 4 * fq + j) * NP + col] = f2bf(acc[j] * sc); } }
                pg8::Gemm g{HB, W1T + (size_t)l * NP * 1024, MR, NP, 1024}; pg8::StaticOrder S; S.init(MR, NP, G, bid);
                pg8::EpiProj E{PROJ, NP, att::C2};
#ifndef DIAG_NO_GEMM
                pg8::gemm_phase<pg8::EpiProj, pg8::StaticOrder, PG8_ALIGN, PG8_SP2>(ldsp + RING_OFF, g, S, E);
#endif
            } else if (sub == 2) {
                const float li = __int_as_float(__builtin_amdgcn_readfirstlane(__float_as_int(0.8f - 0.6f * fexp(-0.3f * (float)l))));
                const float lam = __int_as_float(__builtin_amdgcn_readfirstlane(__float_as_int(LAM[l])));
                const float* subg = ap->in[9] + l * 128;
                float* park = (float*)(ws + WS_RES) + ((size_t)bid * 8 + (size_t)wave) * 8192;
                for (int pi = vcu; pi < 256; pi += G) {
                    const int bh = pi >> 3, s_ = pi & 7, b_ = bh >> 2, h_ = bh & 3;
#ifndef DIAG_NO_FOX
                    for (int u = 0; u < 2; ++u) att::attn_unit<0>(ldsp + RING_OFF, PROJ, CUM, MIX, b_, h_, u ? s_ : 15 - s_, lam, li, subg, park);
#endif
#ifndef DIAG_NO_DIFF
                    for (int u = 0; u < 2; ++u) att::attn_unit<1>(ldsp + RING_OFF, PROJ, CUM, MIX, b_, h_, u ? s_ : 15 - s_, lam, li, subg, park);
#endif
                }
#ifndef DIAG_NO_POOL
                for (int pu = vcu; pu < 256; pu += G) att::pool_unit(ldsp + RING_OFF, PROJ, WPT + (size_t)l * 4 * 64 * 64, ap->in[11] + l * 256, MIX, pu);
#endif
#ifndef DIAG_NO_META
                if (bid == G - 1) {
                    if (wave < 4) fox_meta(wave, lane, PROJ, CUM, MIX); else diff_meta(wave - 4, lane, PROJ, subg, lam, li, MIX);
                    for (int tk = wave; tk < 64; tk += NWAVES) pool_meta(tk >> 2, tk & 3, lane, PROJ, ap->in[10] + (size_t)l * 4 * 64 * 64, ap->in[11] + l * 256, MIX);
                }
#endif
            } else {
                const float* hreal = l == 0 ? ap->in[0] : H; const float* hmeta = l == 0 ? ap->in[1] : HM;
                if (wave == 0) { for (int nb = bid; nb < 64; nb += G) {
                    const mf32x4 acc = meta_gemm16(MIX + (size_t)MR * DM, W2T + (size_t)l * 1024 * 1024, nb, lane);
                    const int col = 16 * nb + (lane & 15), fq = lane >> 4;
#pragma unroll
                    for (int j = 0; j < 4; ++j) HM[(4 * fq + j) * 1024 + col] = hmeta[(4 * fq + j) * 1024 + col] + acc[j]; } }
                pg8::Gemm g{MIX, W2T + (size_t)l * 1024 * 1024, MR, 1024, 1024}; pg8::StaticOrder S; S.init(MR, 1024, G, bid);
                pg8::EpiResid E{hreal, H, 1024};
#ifndef DIAG_NO_GEMM
                pg8::gemm_phase<pg8::EpiResid, pg8::StaticOrder, PG8_ALIGN, PG8_SP2>(ldsp + RING_OFF, g, S, E);
#endif
            }
        } else {
            for (int row = gw; row < MR; row += NGW) final_row(row, lane, H, ap->in[13]);
        }
        if (ph_ + 1 < hi) { XcdBarrier b2 = bar; b2.bar = barw; xcd_barrier(b2); }
    }
}

#ifndef MK_PER_PHASE
#define MK_PER_PHASE 0
#endif
extern "C" void kernel_launch(void* const* d_in, const int* in_sizes, int n_in, void* d_out, int out_size, void* d_ws, size_t ws_size, hipStream_t stream) {
    static int g_grid = 0;
    if (g_grid == 0) {
        int dev = 0, cus = 0, per_cu = 0;
        hipGetDevice(&dev); hipDeviceGetAttribute(&cus, hipDeviceAttributeMultiprocessorCount, dev);
        hipFuncSetAttribute((const void*)mk_fwd, hipFuncAttributeMaxDynamicSharedMemorySize, LDS_BYTES);
        hipOccupancyMaxActiveBlocksPerMultiprocessor(&per_cu, (const void*)mk_fwd, NWAVES * 64, LDS_BYTES);
        (void)hipGetLastError();
        g_grid = cus > 0 ? cus : 256;
    }
    hipMemsetAsync((unsigned char*)d_ws + WS_CTL, 0, CTL_ZERO_BYTES, stream);
    Args a{};
    for (int i = 0; i < 14; ++i) a.in[i] = (const float*)d_in[i];
    a.out = (float*)d_out; a.ws = (unsigned char*)d_ws;
#if MK_PER_PHASE
    for (int p = 0; p < NPH; ++p) { a.ph_lo = p; a.ph_hi = p + 1; hipLaunchKernelGGL(mk_fwd, dim3(g_grid), dim3(NWAVES * 64), LDS_BYTES, stream, a); }
#else
    a.ph_lo = 0; a.ph_hi = NPH;
    hipLaunchKernelGGL(mk_fwd, dim3(g_grid), dim3(NWAVES * 64), LDS_BYTES, stream, a);
#endif
}
```

```cpp
#include <hip/hip_runtime.h>
#include <stdint.h>

typedef unsigned short bf16_t;
__device__ __forceinline__ float bf2f(bf16_t v) { return __uint_as_float(((unsigned)v) << 16); }
__device__ __forceinline__ bf16_t f2bf(float f) { unsigned u = __float_as_uint(f); return (bf16_t)((u + 0x7fffu + ((u >> 16) & 1u)) >> 16); }

constexpr int BATCH = 8, SEQ = 4096, DM = 1024, DEPTH = 4, NMETA = 16;
constexpr int MR = BATCH * SEQ;
constexpr int MT = MR + NMETA;
constexpr int IN_DIM = 3588, NP = 3584;
constexpr int C_FQ = 0, C_FK = 256, C_FV = 512, C_FZ = 768, C_DQ = 1024, C_DK = 1536, C_DV = 2048, C_DZ = 2560, C_PU = 3072, C_PZ = 3328;
constexpr int M_A = 0, M_B = 256, M_C = 768;
constexpr float LN2F = 0.6931471805599453f;
__device__ __forceinline__ unsigned pk2(float lo, float hi) { return (unsigned)f2bf(lo) | ((unsigned)f2bf(hi) << 16); }

constexpr size_t MiB = 1u << 20;
constexpr size_t WS_CTL = 0;
constexpr size_t WS_W1T = 2 * MiB;
constexpr size_t WS_W2T = 30 * MiB;
constexpr size_t WS_WFG = 38 * MiB;
constexpr size_t WS_LAM = 38 * MiB + 65536;
constexpr size_t WS_HM  = 38 * MiB + 131072;
constexpr size_t WS_WPT = 38 * MiB + 262144;
constexpr int MTP = MR + 64;
constexpr size_t WS_LOGF = 39 * MiB;
constexpr size_t WS_CUM = 40 * MiB;
constexpr size_t WS_HB = 42 * MiB;
constexpr size_t WS_MIX = 108 * MiB;
constexpr size_t WS_PROJ = 174 * MiB;
constexpr size_t WS_RES = 400 * MiB;
constexpr size_t WS_END = 464 * MiB;

__device__ __forceinline__ float shx(float v, int m, int lane) { return __int_as_float(__builtin_amdgcn_ds_bpermute((lane ^ m) << 2, __float_as_int(v))); }
__device__ __forceinline__ float shl(float v, int src) { return __int_as_float(__builtin_amdgcn_ds_bpermute(src << 2, __float_as_int(v))); }
__device__ __forceinline__ float wave_sum(float v, int lane) {
#pragma unroll
    for (int o = 1; o < 64; o <<= 1) v += shx(v, o, lane);
    return v;
}
__device__ __forceinline__ float fexp(float x) { return __builtin_amdgcn_exp2f(x * 1.4426950408889634f); }
__device__ __forceinline__ float log_sigmoid(float x) { return fminf(x, 0.f) - __builtin_amdgcn_logf(1.f + fexp(-fabsf(x))) * 0.6931471805599453f; }
__device__ __forceinline__ float silu(float x) { return x / (1.f + fexp(-x)); }

__device__ __forceinline__ void norm_row(int row, int lane, const float* __restrict__ hreal, const float* __restrict__ hmeta, const float* __restrict__ WFG_l,
                                         const float* __restrict__ bf_l, bf16_t* HB, float* LOGF) {
    const float* hp = row < MR ? hreal + (size_t)row * DM : hmeta + (size_t)(row - MR) * DM;
    float4 v[4]; float ss = 0.f;
#pragma unroll
    for (int j = 0; j < 4; ++j) { v[j] = *(const float4*)(hp + j * 256 + lane * 4); ss += v[j].x * v[j].x + v[j].y * v[j].y + v[j].z * v[j].z + v[j].w * v[j].w; }
    ss = wave_sum(ss, lane);
    const float rstd = rsqrtf(ss * (1.f / DM) + 1e-6f);
    float fg[4];
#pragma unroll
    for (int c = 0; c < 4; ++c) {
        float a = 0.f;
#pragma unroll
        for (int j = 0; j < 4; ++j) { const float4 w = *(const float4*)(WFG_l + c * 1024 + j * 256 + lane * 4); a += v[j].x * w.x + v[j].y * w.y + v[j].z * w.z + v[j].w * w.w; }
        fg[c] = wave_sum(a, lane) * rstd;
    }
#pragma unroll
    for (int j = 0; j < 4; ++j) {
        ushort4 o; o.x = f2bf(v[j].x * rstd); o.y = f2bf(v[j].y * rstd); o.z = f2bf(v[j].z * rstd); o.w = f2bf(v[j].w * rstd);
        *(ushort4*)(HB + (size_t)row * DM + j * 256 + lane * 4) = o;
    }
    if (lane < 4) LOGF[(size_t)lane * MTP + row] = log_sigmoid((lane == 0 ? fg[0] : lane == 1 ? fg[1] : lane == 2 ? fg[2] : fg[3]) + bf_l[lane]);
}
__device__ __forceinline__ void final_row(int row, int lane, float* H, const float* __restrict__ final_g) {
    float* hp = H + (size_t)row * DM;
    float4 v[4]; float ss = 0.f;
#pragma unroll
    for (int j = 0; j < 4; ++j) { v[j] = *(const float4*)(hp + j * 256 + lane * 4); ss += v[j].x * v[j].x + v[j].y * v[j].y + v[j].z * v[j].z + v[j].w * v[j].w; }
    ss = wave_sum(ss, lane);
    const float rstd = rsqrtf(ss * (1.f / DM) + 1e-6f);
#pragma unroll
    for (int j = 0; j < 4; ++j) {
        const float4 g = *(const float4*)(final_g + j * 256 + lane * 4);
        float4 o; o.x = v[j].x * rstd * g.x; o.y = v[j].y * rstd * g.y; o.z = v[j].z * rstd * g.z; o.w = v[j].w * rstd * g.w;
        *(float4*)(hp + j * 256 + lane * 4) = o;
    }
}
__device__ __forceinline__ void scan_bh(int b, int h, int lane, const float* __restrict__ LOGF, float* CUM) {
    const float4* p = (const float4*)(LOGF + (size_t)h * MTP + (size_t)b * SEQ + (size_t)lane * 64);
    float4 v[16]; float s = 0.f;
#pragma unroll
    for (int j = 0; j < 16; ++j) { v[j] = p[j]; }
#pragma unroll
    for (int j = 0; j < 16; ++j) { s += (v[j].x + v[j].y) + (v[j].z + v[j].w); }
    float inc = s;
#pragma unroll
    for (int o = 1; o < 64; o <<= 1) { const float t = shl(inc, lane >= o ? lane - o : lane); if (lane >= o) inc += t; }
    float c = inc - s;
    float4* q = (float4*)(CUM + (size_t)h * MTP + (size_t)b * SEQ + (size_t)lane * 64);
#pragma unroll
    for (int j = 0; j < 16; ++j) { float4 o; c += v[j].x; o.x = c; c += v[j].y; o.y = c; c += v[j].z; o.z = c; c += v[j].w; o.w = c; q[j] = o; }
}
__device__ __forceinline__ void scan_meta(int lane, const float* __restrict__ LOGF, float* CUM) {
    if (lane < 4) { const int h = lane; float c = 0.f;
        for (int j = 15; j >= 0; --j) { CUM[(size_t)h * MTP + MR + j] = -c; c += LOGF[(size_t)h * MTP + MR + j]; } }
}
typedef short mbf16x8 __attribute__((ext_vector_type(8)));
typedef float mf32x4 __attribute__((ext_vector_type(4)));
__device__ __forceinline__ mf32x4 meta_gemm16(const bf16_t* __restrict__ A16, const bf16_t* __restrict__ Bt, int nb, int lane) {
    const int fr = lane & 15, fq = lane >> 4; mf32x4 acc = {0.f, 0.f, 0.f, 0.f};
    const bf16_t* ap = A16 + fr * 1024 + fq * 8; const bf16_t* bp = Bt + (size_t)(16 * nb + fr) * 1024 + fq * 8;
#pragma unroll 8
    for (int kk = 0; kk < 32; ++kk) { const mbf16x8 a = *(const mbf16x8*)(ap + kk * 32), b = *(const mbf16x8*)(bp + kk * 32); acc = __builtin_amdgcn_mfma_f32_16x16x32_bf16(a, b, acc, 0, 0, 0); }
    return acc;
}
__device__ __forceinline__ void ld16(const bf16_t* p, float (&x)[16]) {
    const uint4 a = *(const uint4*)p, b = *(const uint4*)(p + 8);
    const unsigned w[8] = {a.x, a.y, a.z, a.w, b.x, b.y, b.z, b.w};
#pragma unroll
    for (int j = 0; j < 8; ++j) { x[2 * j] = __uint_as_float(w[j] << 16); x[2 * j + 1] = __uint_as_float(w[j] & 0xffff0000u); }
}
__device__ __forceinline__ void fox_meta(int h, int lane, const bf16_t* __restrict__ PROJ, const float* __restrict__ CUM, bf16_t* MIX) {
    const int t = lane >> 2, dq = lane & 3, row = MR + t;
    float ln2 = LN2F, m = -1e30f; asm volatile("" : "+v"(ln2), "+v"(m));
    float q[16], o[16], x[16];
    ld16(PROJ + (size_t)row * NP + C_FQ + h * 64 + dq * 16, q);
#pragma unroll
    for (int d = 0; d < 16; ++d) { q[d] *= ln2; o[d] = 0.f; }
    const float cq = CUM[(size_t)h * MTP + row];
    float lsum = 0.f;
    for (int kk = 0; kk < 16; ++kk) {
        const int krow = MR + kk;
        ld16(PROJ + (size_t)krow * NP + C_FK + h * 64 + dq * 16, x);
        float sc = 0.f;
#pragma unroll
        for (int d = 0; d < 16; ++d) sc += q[d] * x[d];
        sc += shx(sc, 1, lane); sc += shx(sc, 2, lane);
        sc += cq - CUM[(size_t)h * MTP + krow];
        ld16(PROJ + (size_t)krow * NP + C_FV + h * 64 + dq * 16, x);
        if (kk <= t) {
            if (sc > m) { const float a = fexp(m - sc); lsum *= a;
#pragma unroll
                for (int d = 0; d < 16; ++d) o[d] *= a;
                m = sc; }
            const float p = fexp(sc - m); lsum += p;
#pragma unroll
            for (int d = 0; d < 16; ++d) o[d] += p * x[d];
        }
    }
    const float inv = 1.f / lsum;
    ld16(PROJ + (size_t)row * NP + C_FZ + h * 64 + dq * 16, x);
    bf16_t* mp = MIX + (size_t)row * DM + M_A + h * 64 + dq * 16;
#pragma unroll
    for (int d = 0; d < 16; d += 2) *(unsigned*)(mp + d) = pk2(o[d] * inv * silu(x[d]), o[d + 1] * inv * silu(x[d + 1]));
}
__device__ __forceinline__ void diff_meta(int h, int lane, const bf16_t* __restrict__ PROJ, const float* __restrict__ subln_g_l, float lam, float li, bf16_t* MIX) {
    const int ri = lane >> 2, qq = lane & 3, row = MR + ri;
    const float posq = (float)ri, slope = 1.f / (float)(1 << (2 * h + 2));
    float res[32], x[16], y[16];
    for (int c = 0; c < 2; ++c) {
        float ln2 = LN2F, m = -1e30f; asm volatile("" : "+v"(ln2), "+v"(m));
        float q[16], o[32];
        ld16(PROJ + (size_t)row * NP + C_DQ + h * 128 + c * 64 + qq * 16, q);
#pragma unroll
        for (int d = 0; d < 16; ++d) q[d] *= ln2;
#pragma unroll
        for (int d = 0; d < 32; ++d) o[d] = 0.f;
        float lsum = 0.f;
        for (int kk = 0; kk < 16; ++kk) {
            const int krow = MR + kk;
            ld16(PROJ + (size_t)krow * NP + C_DK + h * 128 + c * 64 + qq * 16, x);
            float sc = 0.f;
#pragma unroll
            for (int d = 0; d < 16; ++d) sc += q[d] * x[d];
            sc += shx(sc, 1, lane); sc += shx(sc, 2, lane);
            sc -= slope * fabsf(posq - (float)kk);
            ld16(PROJ + (size_t)krow * NP + C_DV + h * 128 + qq * 32, x);
            ld16(PROJ + (size_t)krow * NP + C_DV + h * 128 + qq * 32 + 16, y);
            if (sc > m) { const float a = fexp(m - sc); lsum *= a;
#pragma unroll
                for (int d = 0; d < 32; ++d) o[d] *= a;
                m = sc; }
            const float p = fexp(sc - m); lsum += p;
#pragma unroll
            for (int d = 0; d < 16; ++d) { o[d] += p * x[d]; o[16 + d] += p * y[d]; }
        }
        const float inv = 1.f / lsum;
        if (c == 0) {
#pragma unroll
            for (int d = 0; d < 32; ++d) res[d] = o[d] * inv;
        } else {
#pragma unroll
            for (int d = 0; d < 32; ++d) res[d] -= lam * o[d] * inv;
        }
    }
    float ss = 0.f;
#pragma unroll
    for (int d = 0; d < 32; ++d) ss += res[d] * res[d];
    ss += shx(ss, 1, lane); ss += shx(ss, 2, lane);
    const float rstd = rsqrtf(ss * (1.f / 128.f) + 1e-5f) * (1.f - li);
    ld16(PROJ + (size_t)row * NP + C_DZ + h * 128 + qq * 32, x);
    ld16(PROJ + (size_t)row * NP + C_DZ + h * 128 + qq * 32 + 16, y);
    bf16_t* mp = MIX + (size_t)row * DM + M_B + h * 128 + qq * 32;
    const float* gp = subln_g_l + qq * 32;
#pragma unroll
    for (int d = 0; d < 16; d += 2) {
        *(unsigned*)(mp + d) = pk2(res[d] * rstd * gp[d] * silu(x[d]), res[d + 1] * rstd * gp[d + 1] * silu(x[d + 1]));
        *(unsigned*)(mp + 16 + d) = pk2(res[16 + d] * rstd * gp[16 + d] * silu(y[d]), res[17 + d] * rstd * gp[17 + d] * silu(y[d + 1])); }
}
__device__ __forceinline__ void pool_meta(int j, int g, int lane, const bf16_t* __restrict__ PROJ, const float* __restrict__ wpool_l, const float* __restrict__ pscale_l, bf16_t* MIX) {
    const int w = 2 << g, cnt = (j + 1) < w ? (j + 1) : w, row = MR + j;
    float s = 0.f;
    for (int i = 0; i < cnt; ++i) s += bf2f(PROJ[(size_t)(MR + j - i) * NP + C_PU + g * 64 + lane]);
    const float pooled = s / (float)cnt - bf2f(PROJ[(size_t)row * NP + C_PU + g * 64 + lane]);
    float y = 0.f;
    for (int i = 0; i < 64; ++i) y += shl(pooled, i) * wpool_l[(g * 64 + i) * 64 + lane];
    const float z = bf2f(PROJ[(size_t)row * NP + C_PZ + g * 64 + lane]);
    MIX[(size_t)row * DM + M_C + g * 64 + lane] = f2bf(y * pscale_l[g * 64 + lane] * silu(z));
}

namespace pg8 {
#define PG8_LAS __attribute__((address_space(3)))
typedef unsigned short bf16_t;
typedef short bf16x8 __attribute__((ext_vector_type(8)));
typedef float f32x4 __attribute__((ext_vector_type(4)));
typedef unsigned u32x4 __attribute__((ext_vector_type(4)));
constexpr int BM = 256, BK = 64, HALF = 128, HTB = HALF * BK * 2  , STAGE_BYTES = 8 * HTB, NXCD = 8, WGM = 8;

__host__ __device__ __forceinline__ int lds_byte(int r, int c) { const int st = (r >> 4) * 2 + (c >> 5), rr = r & 15, cc = c & 31, ob = rr * 64 + cc * 2; return st * 1024 + (ob ^ (((ob >> 9) & 1) << 5)); }
__host__ __device__ __forceinline__ void stage_rc(int b, int& R, int& C) { const int st = b / 1024, sb = b % 1024, swz = sb ^ (((sb >> 9) & 1) << 5); R = (st >> 1) * 16 + swz / 64; C = (st & 1) * 32 + (swz % 64) / 2; }
__host__ __device__ __forceinline__ int perm32(int rho) { const int n = rho >> 4, i = rho & 15; return 8 * (i >> 2) + 4 * n + (i & 3); }

struct Unit { int pm, pn; };
struct Gemm { const bf16_t* A; const bf16_t* Bt; int M, N, K; };

struct StaticOrder {
    int nM, nN, nwg, G, c;
    __host__ __device__ void init(int M, int N, int G_, int c_) { nM = M / BM; nN = N / BM; nwg = nM * nN; G = G_; c = c_; }
    __host__ __device__ bool next(int i, Unit& u) const {
        const long L = (long)i * G + c; if (L >= nwg) return false;
        int wgid = (int)L; { const int q = nwg / NXCD, r = nwg % NXCD, xcd = wgid % NXCD, off = wgid / NXCD; wgid = (xcd < r ? xcd * (q + 1) : r * (q + 1) + (xcd - r) * q) + off; }
        const int nig = WGM * nN, gid = wgid / nig, fm = gid * WGM, gsz = (nM - fm) < WGM ? (nM - fm) : WGM;
        u.pm = fm + ((wgid % nig) % gsz); u.pn = (wgid % nig) / gsz; return true;
    }
    __device__ __forceinline__ void a_ready(const Unit&) const {}
    __device__ __forceinline__ void done(const Unit&) const {}
};

__device__ __forceinline__ unsigned cvt_pk_bf16(float lo, float hi) { unsigned r; asm volatile("v_cvt_pk_bf16_f32 %0, %1, %2" : "=v"(r) : "v"(lo), "v"(hi)); return r; }
struct EpiProj {
    static constexpr bool PERM = true, AFTER_DRAIN = false;
    bf16_t* O; int ldc; float qscale;
    __device__ __forceinline__ void operator()(const f32x4 (&acc)[2][2][4][2], const Unit& u, int wr, int wc, int fr, int fq) const {
        const int row0 = u.pm * BM + wr * 64 + fr, col0 = u.pn * BM + wc * 32 + 8 * fq;
        const float sc = (u.pn == 0 || u.pn == 4 || u.pn == 5) ? qscale : 1.f;
#pragma unroll
        for (int ai = 0; ai < 2; ++ai)
#pragma unroll
            for (int m = 0; m < 4; ++m) { bf16_t* rowp = O + (size_t)(row0 + ai * HALF + m * 16) * ldc + col0;
#pragma unroll
                for (int bj = 0; bj < 2; ++bj) { const f32x4 v0 = acc[ai][bj][m][0] * sc, v1 = acc[ai][bj][m][1] * sc;
                    u32x4 w; w.x = cvt_pk_bf16(v0[0], v0[1]); w.y = cvt_pk_bf16(v0[2], v0[3]); w.z = cvt_pk_bf16(v1[0], v1[1]); w.w = cvt_pk_bf16(v1[2], v1[3]);
                    *(u32x4*)(rowp + bj * HALF) = w; } }
    }
};
struct EpiResid {
    static constexpr bool PERM = false, AFTER_DRAIN = false;
    const float* base; float* out; int ldc;
    __device__ __forceinline__ void operator()(const f32x4 (&acc)[2][2][4][2], const Unit& u, int wr, int wc, int fr, int fq) const {
        const int col0 = u.pn * BM + wc * 32 + 4 * fq;
#pragma unroll
        for (int ai = 0; ai < 2; ++ai)
#pragma unroll
            for (int m = 0; m < 4; ++m) { const size_t off = (size_t)(u.pm * BM + ai * HALF + wr * 64 + m * 16 + fr) * ldc + col0;
#pragma unroll
                for (int bj = 0; bj < 2; ++bj)
#pragma unroll
                    for (int n = 0; n < 2; ++n) { const f32x4 bs = *(const f32x4*)(base + off + bj * HALF + n * 16); *(f32x4*)(out + off + bj * HALF + n * 16) = bs + acc[ai][bj][m][n]; } }
    }
};
template <class Epi, class Sched, bool ALIGN_EPI = false, bool SP2 = false>
__device__ __forceinline__ void gemm_phase(PG8_LAS unsigned char* lds, const Gemm g, const Sched& S, const Epi& E) {
    int tid_ = threadIdx.x; asm volatile("" : "+v"(tid_));
    const int tid = tid_, wid = __builtin_amdgcn_readfirstlane(tid >> 6), lane = tid & 63, wr = wid >> 2, wc = wid & 3, fr = lane & 15, fq = lane >> 4;
    const int K = g.K, nt = K / BK;
    unsigned voffA[2], voffB[2];
#pragma unroll
    for (int i = 0; i < 2; ++i) { int R, C; stage_rc(tid * 16 + i * 8192, R, C); const int Rb = Epi::PERM ? ((R & ~31) + perm32(R & 31)) : R;
        voffA[i] = (unsigned)(R * K + C) * 2u; voffB[i] = (unsigned)(Rb * K + C) * 2u; }
    const size_t kstep = (size_t)(BK * 2);
    const size_t hstep = (size_t)HALF * K * 2;
    const size_t tstep = 2 * hstep;
    const unsigned ldsw = (unsigned)wid * 1024u;
    const int aoff = lds_byte(wr * 64 + fr, fq * 8), boff = lds_byte(wc * 32 + fr, fq * 8);
#define PG8_SA(b, h) (((b) * 2 + (h)) * HTB)
#define PG8_SB(b, h) ((4 + (b) * 2 + (h)) * HTB)
#define PG8_STAGE(bufoff, gbase, voff) do { _Pragma("unroll") for (int _i = 0; _i < 2; ++_i) \
        __builtin_amdgcn_global_load_lds((const unsigned*)((const char*)(gbase) + (voff)[_i]), (PG8_LAS unsigned*)(lds + (bufoff) + ldsw + _i * 8192), 16, 0, 0); } while (0)
#define PG8_LDA(dst, b, h) do { _Pragma("unroll") for (int m = 0; m < 4; ++m) _Pragma("unroll") for (int k = 0; k < 2; ++k) dst[m][k] = *(const PG8_LAS bf16x8*)(lds + PG8_SA(b, h) + aoff + m * 2048 + k * 1024); } while (0)
#define PG8_LDB(dst, b, h) do { _Pragma("unroll") for (int n = 0; n < 2; ++n) _Pragma("unroll") for (int k = 0; k < 2; ++k) dst[n][k] = *(const PG8_LAS bf16x8*)(lds + PG8_SB(b, h) + boff + n * 2048 + k * 1024); } while (0)
#define PG8_MMA(ai, bj, At, Bt) do { __builtin_amdgcn_s_setprio(1); _Pragma("unroll") for (int m = 0; m < 4; ++m) _Pragma("unroll") for (int n = 0; n < 2; ++n) _Pragma("unroll") for (int k = 0; k < 2; ++k) \
        acc[ai][bj][m][n] = __builtin_amdgcn_mfma_f32_16x16x32_bf16(Bt[n][k], At[m][k], acc[ai][bj][m][n], 0, 0, 0); __builtin_amdgcn_s_setprio(0); } while (0)
#define PG8_WAIT_V(n) asm volatile("s_waitcnt vmcnt(" #n ")" ::: "memory")
#define PG8_WAIT_L(n) asm volatile("s_waitcnt lgkmcnt(" #n ")" ::: "memory")
#define PG8_BAR __builtin_amdgcn_s_barrier()
#define PG8_SCHED __builtin_amdgcn_sched_barrier(0)
    Unit cur, nxt; int ui = 0;
    if (!S.next(0, cur)) return;
    f32x4 acc[2][2][4][2];
#pragma unroll
    for (int a = 0; a < 2; ++a)
#pragma unroll
        for (int b = 0; b < 2; ++b)
#pragma unroll
            for (int m = 0; m < 4; ++m)
#pragma unroll
                for (int n = 0; n < 2; ++n) acc[a][b][m][n] = (f32x4){0.f, 0.f, 0.f, 0.f};
    bf16x8 At[4][2], B0[2][2], B1[2][2];
    const char* cA = (const char*)g.A + (size_t)cur.pm * tstep; const char* cB = (const char*)g.Bt + (size_t)cur.pn * tstep;
    S.a_ready(cur);
    if constexpr (SP2) {
        PG8_STAGE(PG8_SB(0, 0), cB, voffB); PG8_STAGE(PG8_SB(0, 1), cB + hstep, voffB); PG8_STAGE(PG8_SA(0, 0), cA, voffA); PG8_STAGE(PG8_SA(0, 1), cA + hstep, voffA);
        if (wr == 1) PG8_BAR;
        PG8_WAIT_V(2); PG8_BAR;
        PG8_STAGE(PG8_SB(1, 0), cB + kstep, voffB); PG8_STAGE(PG8_SA(1, 0), cA + kstep, voffA); PG8_STAGE(PG8_SB(1, 1), cB + hstep + kstep, voffB);
        PG8_WAIT_V(6); PG8_BAR;
    } else {
        PG8_STAGE(PG8_SB(0, 0), cB, voffB); PG8_STAGE(PG8_SA(0, 0), cA, voffA); PG8_STAGE(PG8_SB(0, 1), cB + hstep, voffB); PG8_STAGE(PG8_SA(0, 1), cA + hstep, voffA);
        if (wr == 1) PG8_BAR;
        PG8_WAIT_V(4); PG8_BAR;
        PG8_STAGE(PG8_SB(1, 0), cB + kstep, voffB); PG8_STAGE(PG8_SA(1, 0), cA + kstep, voffA); PG8_STAGE(PG8_SB(1, 1), cB + hstep + kstep, voffB);
        PG8_WAIT_V(6); PG8_BAR;
    }
    for (;;) {
        const bool has_next = S.next(ui + 1, nxt);
        const char* nA = has_next ? (const char*)g.A + (size_t)nxt.pm * tstep : cA; const char* nB = has_next ? (const char*)g.Bt + (size_t)nxt.pn * tstep : cB;
        for (int t = 0; t < nt; t += 2) {
            const bool last = (t == nt - 2);
            const char* a1 = cA + (size_t)(t + 1) * kstep;
            const char* a2 = last ? nA : cA + (size_t)(t + 2) * kstep; const char* b2 = last ? nB : cB + (size_t)(t + 2) * kstep;
            const char* a3 = a2 + kstep; const char* b3 = b2 + kstep;
            if (last && has_next) S.a_ready(nxt);
            if constexpr (SP2) {
            PG8_LDB(B0, 0, 0); PG8_LDB(B1, 0, 1); PG8_SCHED; PG8_LDA(At, 0, 0); PG8_STAGE(PG8_SA(1, 1), a1 + hstep, voffA);
            PG8_WAIT_V(8); PG8_WAIT_L(0); PG8_BAR; PG8_MMA(0, 0, At, B0); PG8_MMA(0, 1, At, B1); PG8_BAR; PG8_SCHED;
            PG8_LDA(At, 0, 1); PG8_STAGE(PG8_SB(0, 0), b2, voffB); PG8_STAGE(PG8_SB(0, 1), b2 + hstep, voffB); PG8_STAGE(PG8_SA(0, 0), a2, voffA);
            PG8_WAIT_V(8); PG8_WAIT_L(0); PG8_BAR; PG8_MMA(1, 0, At, B0); PG8_MMA(1, 1, At, B1); PG8_BAR; PG8_SCHED;
            PG8_LDB(B0, 1, 0); PG8_LDB(B1, 1, 1); PG8_SCHED; PG8_LDA(At, 1, 0); PG8_STAGE(PG8_SA(0, 1), a2 + hstep, voffA);
            PG8_WAIT_V(8); PG8_WAIT_L(0); PG8_BAR; PG8_MMA(0, 0, At, B0); PG8_MMA(0, 1, At, B1); PG8_BAR; PG8_SCHED;
            PG8_LDA(At, 1, 1); PG8_STAGE(PG8_SB(1, 0), b3, voffB); PG8_STAGE(PG8_SB(1, 1), b3 + hstep, voffB); PG8_STAGE(PG8_SA(1, 0), a3, voffA);
            PG8_WAIT_V(8); PG8_WAIT_L(0); PG8_BAR; PG8_MMA(1, 0, At, B0); PG8_MMA(1, 1, At, B1); PG8_BAR; PG8_SCHED;
            } else {
            PG8_LDB(B0, 0, 0); PG8_SCHED; PG8_LDA(At, 0, 0); PG8_STAGE(PG8_SA(1, 1), a1 + hstep, voffA);
            PG8_WAIT_L(8); PG8_BAR; PG8_WAIT_L(0); PG8_MMA(0, 0, At, B0); PG8_BAR; PG8_SCHED;
            PG8_LDB(B1, 0, 1); PG8_STAGE(PG8_SB(0, 0), b2, voffB);
            PG8_BAR; PG8_WAIT_L(0); PG8_MMA(0, 1, At, B1); PG8_BAR;
            PG8_LDA(At, 0, 1); PG8_STAGE(PG8_SA(0, 0), a2, voffA);
            PG8_BAR; PG8_WAIT_L(0); PG8_MMA(1, 0, At, B0); PG8_BAR; PG8_SCHED;
            PG8_STAGE(PG8_SB(0, 1), b2 + hstep, voffB);
            PG8_WAIT_V(6); PG8_BAR; PG8_MMA(1, 1, At, B1); PG8_BAR;
            PG8_LDB(B0, 1, 0); PG8_SCHED; PG8_LDA(At, 1, 0); PG8_STAGE(PG8_SA(0, 1), a2 + hstep, voffA);
            PG8_WAIT_L(8); PG8_BAR; PG8_WAIT_L(0); PG8_MMA(0, 0, At, B0); PG8_BAR; PG8_SCHED;
            PG8_LDB(B1, 1, 1); PG8_STAGE(PG8_SB(1, 0), b3, voffB);
            PG8_BAR; PG8_WAIT_L(0); PG8_MMA(0, 1, At, B1); PG8_BAR;
            PG8_LDA(At, 1, 1); PG8_STAGE(PG8_SA(1, 0), a3, voffA);
            PG8_BAR; PG8_WAIT_L(0); PG8_MMA(1, 0, At, B0); PG8_BAR; PG8_SCHED;
            PG8_STAGE(PG8_SB(1, 1), b3 + hstep, voffB);
            PG8_WAIT_V(6); PG8_BAR; PG8_MMA(1, 1, At, B1); PG8_BAR;
            }
        }
        if constexpr (ALIGN_EPI) { if (wr == 0) PG8_BAR; }
        if constexpr (!Epi::AFTER_DRAIN) { E(acc, cur, wr, wc, fr, fq); S.done(cur); }
        if (!has_next) break;
#pragma unroll
        for (int a = 0; a < 2; ++a)
#pragma unroll
            for (int b = 0; b < 2; ++b)
#pragma unroll
                for (int m = 0; m < 4; ++m)
#pragma unroll
                    for (int n = 0; n < 2; ++n) acc[a][b][m][n] = (f32x4){0.f, 0.f, 0.f, 0.f};
        cur = nxt; cA = nA; cB = nB; ++ui;
        if constexpr (ALIGN_EPI) { if (wr == 1) PG8_BAR; }
    }
    PG8_WAIT_V(0);
    if constexpr (!ALIGN_EPI) { if (wr == 0) PG8_BAR; }
    PG8_BAR;
    if constexpr (Epi::AFTER_DRAIN) { E.fused(acc, cur, wr, wc, fr, fq, lds, wid, lane); S.done(cur); }
#undef PG8_SA
#undef PG8_SB
#undef PG8_STAGE
#undef PG8_LDA
#undef PG8_LDB
#undef PG8_MMA
#undef PG8_WAIT_V
#undef PG8_WAIT_L
#undef PG8_BAR
#undef PG8_SCHED
}
}
namespace att {
typedef float f32x16 __attribute__((ext_vector_type(16)));
typedef float f32x4 __attribute__((ext_vector_type(4)));
typedef short bf16x8 __attribute__((ext_vector_type(8)));
typedef short s16x4 __attribute__((ext_vector_type(4)));
typedef unsigned u32x4 __attribute__((ext_vector_type(4)));
#define ALAS __attribute__((address_space(3)))
constexpr int KCS = 1040, VDS = 4160, KBUF = 8 * KCS, VBUF = 4 * VDS, KBOFF = KBUF + VBUF, STG = KBOFF + 256, NSLOT = 3;
constexpr int L_WSF = NSLOT * STG, L_OST = L_WSF + 8 * 256, L_END = L_OST + 8 * 8192;
constexpr float LOG2E = 1.4426950408889634f, C2 = 0.125f * LOG2E, THR = 8.f, NEGBIG = -1e30f;
__device__ __forceinline__ int crow(int r, int hi) { return (r & 3) + 8 * (r >> 2) + 4 * hi; }
__device__ __forceinline__ unsigned cvtpk(float lo, float hi) { typedef float f2 __attribute__((ext_vector_type(2))); typedef __bf16 b2 __attribute__((ext_vector_type(2))); f2 v = {lo, hi}; b2 b = __builtin_convertvector(v, b2); return __builtin_bit_cast(unsigned, b); }
__device__ __forceinline__ s16x4 vtr(const ALAS unsigned char* p) { typedef short v4i16_t __attribute__((ext_vector_type(4))); return __builtin_bit_cast(s16x4, __builtin_amdgcn_ds_read_tr16_b64_v4i16((ALAS v4i16_t*)p)); }
__device__ __forceinline__ float bfl(unsigned w) { return __uint_as_float(w << 16); }
__device__ __forceinline__ float bfh(unsigned w) { return __uint_as_float(w & 0xffff0000u); }
__device__ __forceinline__ float silu_f(float x) { return x / (1.f + fexp(-x)); }
__device__ __forceinline__ void glds16(const void* gsrc, unsigned lds_dst) { unsigned keep;
    asm volatile("s_mov_b32 %0, m0\n\ts_mov_b32 m0, %2\n\ts_nop 0\n\tglobal_load_lds_dwordx4 %1, off\n\ts_mov_b32 m0, %0" : "=&s"(keep) : "v"(gsrc), "s"(lds_dst) : "memory"); }
__device__ __forceinline__ void glds4(const void* gsrc, unsigned lds_dst) { unsigned keep;
    asm volatile("s_mov_b32 %0, m0\n\ts_mov_b32 m0, %2\n\ts_nop 0\n\tglobal_load_lds_dword %1, off\n\ts_mov_b32 m0, %0" : "=&s"(keep) : "v"(gsrc), "s"(lds_dst) : "memory"); }
#define ATT_WAIT_BAR(N) asm volatile("s_waitcnt vmcnt(" #N ") lgkmcnt(0)\n\ts_barrier" ::: "memory")

template <int MODE> __device__ __forceinline__ void dma_tile(unsigned slot, const bf16_t* __restrict__ PROJ, const float* __restrict__ CUM, size_t krow0, int kcol, int vcol, int h, int wid, int lane) {
    if (MODE == 0 && wid == 0) glds4(CUM + (size_t)h * MTP + krow0 + lane, (unsigned)__builtin_amdgcn_readfirstlane(slot + KBOFF));
    glds16(PROJ + (krow0 + lane) * NP + kcol + wid * 8, (unsigned)__builtin_amdgcn_readfirstlane(slot + wid * KCS));
    const bf16_t* vs = PROJ + (krow0 + (wid & 3) * 16 + (lane >> 2)) * NP + vcol + (wid >> 2) * 32 + (lane & 3) * 8;
    glds16(vs, (unsigned)__builtin_amdgcn_readfirstlane(slot + KBUF + (wid >> 2) * VDS + (wid & 3) * 1024));
    if (MODE == 1) glds16(vs + 64, (unsigned)__builtin_amdgcn_readfirstlane(slot + KBUF + (2 + (wid >> 2)) * VDS + (wid & 3) * 1024));
}

template <int MODE, bool DIAG> __device__ __forceinline__ bool qs_front(const ALAS unsigned char* buf, const ALAS unsigned char* vprev, s16x4 (&vl)[8], s16x4 (&vh)[8], const bf16x8 (&qr)[4], f32x16& p0, f32x16& p1, float& mhat, float& l,
        int kidx0, bool meta, int qw0, float slope2, ALAS float* wsf, int lane) {
    constexpr bool diag = DIAG;
    const int r32 = lane & 31, hi = lane >> 5;
    {
      const ALAS unsigned char* vb = vprev + KBUF + ((lane >> 4) & 1) * 32 + (lane & 3) * 8 + (4 * hi + ((lane & 15) >> 2)) * 64; asm volatile("" : "+v"(vb));
#pragma unroll
      for (int i = 0; i < (MODE == 0 ? 8 : 4); ++i) { vl[i] = vtr(vb + (i & 1) * VDS + (i >> 1) * 1024); vh[i] = vtr(vb + (i & 1) * VDS + (i >> 1) * 1024 + 512); } }
    asm volatile("" : "+v"(slope2), "+s"(kidx0));
    if (MODE == 0) {
        const ALAS f32x4* kbp = (const ALAS f32x4*)(buf + KBOFF + hi * 16); asm volatile("" : "+v"(kbp));
#pragma unroll
        for (int g = 0; g < 4; ++g) { const f32x4 a = kbp[2 * g], b = kbp[8 + 2 * g];
#pragma unroll
            for (int j = 0; j < 4; ++j) { p0[4 * g + j] = fmaf(a[j], -LOG2E, -mhat); p1[4 * g + j] = fmaf(b[j], -LOG2E, -mhat); } }
    } else {
        if (!diag) {
            const float base = slope2 * (float)(kidx0 + 4 * hi - qw0) - mhat;
#pragma unroll
            for (int r = 0; r < 16; ++r) { const int c = (r & 3) + 8 * (r >> 2); p0[r] = fmaf((float)c, slope2, base); p1[r] = fmaf((float)(c + 32), slope2, base); }
            if (meta) {
#pragma unroll
                for (int r = 0; r < 16; ++r) { if ((r >> 2) >= 2) p0[r] = NEGBIG; p1[r] = NEGBIG; }
            }
        } else {
            const float dq = (float)(qw0 + r32 - kidx0 - 4 * hi), fr = (float)r32;
#pragma unroll
            for (int r = 0; r < 16; ++r) { const int c = (r & 3) + 8 * (r >> 2);
                p0[r] = slope2 * (fr - fabsf(dq - (float)c)) - mhat; p1[r] = slope2 * (fr - fabsf(dq - (float)(c + 32))) - mhat; }
        }
    }
    { const ALAS unsigned char* kb = buf + hi * KCS + r32 * 16; asm volatile("" : "+v"(kb));
#pragma unroll
      for (int d0 = 0; d0 < 4; ++d0) {
          const bf16x8 k0 = *(const ALAS bf16x8*)(kb + d0 * 2 * KCS), k1 = *(const ALAS bf16x8*)(kb + d0 * 2 * KCS + 512);
          p0 = __builtin_amdgcn_mfma_f32_32x32x16_bf16(k0, qr[d0], p0, 0, 0, 0);
          p1 = __builtin_amdgcn_mfma_f32_32x32x16_bf16(k1, qr[d0], p1, 0, 0, 0); } }
    if (MODE == 0 && diag) {
        const int lim = qw0 + r32 - kidx0 - 4 * hi;
#pragma unroll
        for (int r = 0; r < 16; ++r) { const int c = (r & 3) + 8 * (r >> 2); if (c > lim) p0[r] = NEGBIG; if (c + 32 > lim) p1[r] = NEGBIG; }
    }
    float rm;
    {
#define ATT_MX3(a, b, c) __builtin_fmaxf(__builtin_fmaxf((a), (b)), (c))
      float a = ATT_MX3(p0[0], p0[1], p1[0]), b = ATT_MX3(p0[2], p0[3], p1[1]); a = ATT_MX3(a, p1[2], p1[3]);
#pragma unroll
      for (int r = 4; r < 16; r += 4) { a = ATT_MX3(a, p0[r], p0[r + 1]); b = ATT_MX3(b, p0[r + 2], p0[r + 3]); a = ATT_MX3(a, p1[r], p1[r + 1]); b = ATT_MX3(b, p1[r + 2], p1[r + 3]); }
#undef ATT_MX3
      a = __builtin_fmaxf(a, b);
      auto rr = __builtin_amdgcn_permlane32_swap(__float_as_uint(a), __float_as_uint(a), false, false);
      rm = __builtin_fmaxf(__uint_as_float(rr[0]), __uint_as_float(rr[1])); }
    bool resc = false;
    if (__any(rm > THR)) {
        const float dl = fmaxf(rm, 0.f); mhat += dl;
#pragma unroll
        for (int r = 0; r < 16; ++r) { p0[r] -= dl; p1[r] -= dl; }
        const float f = __builtin_amdgcn_exp2f(-dl); l *= f; if (hi == 0) wsf[r32] = f; resc = true;
    }
    return resc;
}
#define ATT_SBAR() __builtin_amdgcn_sched_barrier(0)
#define ATT_PIN(x) asm volatile("" : "+v"(x))
#define ATT_VF(L, H, i) (bf16x8){L[i][0], L[i][1], L[i][2], L[i][3], H[i][0], H[i][1], H[i][2], H[i][3]}
template <int NDB> __device__ __forceinline__ void pv_exp(const ALAS unsigned char* vbuf, s16x4 (&vl)[8], s16x4 (&vh)[8], const u32x4 (&pwo)[4], f32x16 (&o)[NDB], f32x16& p0, f32x16& p1, u32x4 (&pwn)[4], float& l, int lane) {
    const int hi = lane >> 5;
    float s0 = 0.f, s1 = 0.f, s2 = 0.f, s3 = 0.f;
    ATT_SBAR();
    if (NDB == 2) {
#pragma unroll
        for (int k = 0; k < 8; ++k) {
            o[k & 1] = __builtin_amdgcn_mfma_f32_32x32x16_bf16(__builtin_bit_cast(bf16x8, pwo[k >> 1]), ATT_VF(vl, vh, k), o[k & 1], 0, 0, 0);
            p0[2 * k] = __builtin_amdgcn_exp2f(p0[2 * k]); p0[2 * k + 1] = __builtin_amdgcn_exp2f(p0[2 * k + 1]); p1[2 * k] = __builtin_amdgcn_exp2f(p1[2 * k]); p1[2 * k + 1] = __builtin_amdgcn_exp2f(p1[2 * k + 1]);
            s0 += p0[2 * k]; s1 += p0[2 * k + 1]; s2 += p1[2 * k]; s3 += p1[2 * k + 1];
            pwn[k >> 2][k & 3] = cvtpk(p0[2 * k], p0[2 * k + 1]); pwn[2 + (k >> 2)][k & 3] = cvtpk(p1[2 * k], p1[2 * k + 1]);
            ATT_PIN(p0); ATT_PIN(p1); ATT_PIN(s0); ATT_PIN(s1); ATT_PIN(s2); ATT_PIN(s3); ATT_PIN(pwn[k >> 2]); ATT_PIN(pwn[2 + (k >> 2)]);
            ATT_SBAR();
        }
    } else {
        const ALAS unsigned char* vb = vbuf + KBUF + ((lane >> 4) & 1) * 32 + (lane & 3) * 8 + (4 * hi + ((lane & 15) >> 2)) * 64; asm volatile("" : "+v"(vb));
        s16x4 (&wl)[8] = vl; s16x4 (&wh)[8] = vh;
#pragma unroll
        for (int k = 0; k < 16; ++k) {
            const int blk = 2 * (k >> 3) + (k & 1), ks = (k >> 1) & 3;
            o[blk] = __builtin_amdgcn_mfma_f32_32x32x16_bf16(__builtin_bit_cast(bf16x8, pwo[ks]), ATT_VF(wl, wh, k & 3), o[blk], 0, 0, 0);
            if (k + 4 < 16) { const int j = k + 4, jb = 2 * (j >> 3) + (j & 1), jk = (j >> 1) & 3; wl[k & 3] = vtr(vb + jb * VDS + jk * 1024); wh[k & 3] = vtr(vb + jb * VDS + jk * 1024 + 512); }
            if (k < 8) { p0[2 * k] = __builtin_amdgcn_exp2f(p0[2 * k]); p0[2 * k + 1] = __builtin_amdgcn_exp2f(p0[2 * k + 1]); s0 += p0[2 * k]; s1 += p0[2 * k + 1];
                pwn[k >> 2][k & 3] = cvtpk(p0[2 * k], p0[2 * k + 1]); ATT_PIN(p0); ATT_PIN(s0); ATT_PIN(s1); ATT_PIN(pwn[k >> 2]); }
            else { const int q = k - 8; p1[2 * q] = __builtin_amdgcn_exp2f(p1[2 * q]); p1[2 * q + 1] = __builtin_amdgcn_exp2f(p1[2 * q + 1]); s2 += p1[2 * q]; s3 += p1[2 * q + 1];
                pwn[2 + (q >> 2)][q & 3] = cvtpk(p1[2 * q], p1[2 * q + 1]); ATT_PIN(p1); ATT_PIN(s2); ATT_PIN(s3); ATT_PIN(pwn[2 + (q >> 2)]); }
            ATT_SBAR();
        }
    }
    l += (s0 + s1) + (s2 + s3);
}
template <int NDB> __device__ __forceinline__ void pv_only(const ALAS unsigned char* vbuf, const u32x4 (&pwo)[4], f32x16 (&o)[NDB], int lane) {
    const int hi = lane >> 5;
    const ALAS unsigned char* vb = vbuf + KBUF + ((lane >> 4) & 1) * 32 + (lane & 3) * 8 + (4 * hi + ((lane & 15) >> 2)) * 64; asm volatile("" : "+v"(vb));
#pragma unroll
    for (int d = 0; d < NDB; ++d) {
        s16x4 lo[4], hh[4];
#pragma unroll
        for (int ks = 0; ks < 4; ++ks) { lo[ks] = vtr(vb + d * VDS + ks * 1024); hh[ks] = vtr(vb + d * VDS + ks * 1024 + 512); }
#pragma unroll
        for (int ks = 0; ks < 4; ++ks) o[d] = __builtin_amdgcn_mfma_f32_32x32x16_bf16(__builtin_bit_cast(bf16x8, pwo[ks]), ATT_VF(lo, hh, ks), o[d], 0, 0, 0);
        ATT_SBAR();
    }
}
template <int NDB> __device__ __forceinline__ void rescale_o(f32x16 (&o)[NDB], const ALAS float* wsf, int lane) {
    const int hi = lane >> 5;
#pragma unroll
    for (int r = 0; r < 16; ++r) { const float f = wsf[crow(r, hi)];
#pragma unroll
        for (int d = 0; d < NDB; ++d) o[d][r] *= f; }
}
__device__ __forceinline__ u32x4 gate8(u32x4 v, u32x4 z) {
    u32x4 o;
#pragma unroll
    for (int j = 0; j < 4; ++j) { const float a = bfl(v[j]) * silu_f(bfl(z[j])), b = bfh(v[j]) * silu_f(bfh(z[j])); o[j] = cvtpk(a, b); }
    return o;
}


template <int NDB> __device__ __forceinline__ void stage_gate_store(const f32x16 (&res)[NDB], ALAS bf16_t* stg, const bf16_t* __restrict__ zbase, bf16_t* __restrict__ mbase, int lane) {
    const int r32 = lane & 31, hi = lane >> 5;
#pragma unroll
    for (int r = 0; r < 16; ++r) { const int orow = crow(r, hi);
#pragma unroll
        for (int d = 0; d < NDB; ++d) stg[orow * (NDB * 32) + d * 32 + r32] = f2bf(res[d][r]); }
    constexpr int CPR = NDB * 4;
    constexpr int RPP = 64 / CPR;
#pragma unroll
    for (int i = 0; i < 32 / RPP; ++i) {
        const int row = i * RPP + lane / CPR, ch = lane % CPR;
        const u32x4 v = *(const ALAS u32x4*)(stg + row * (NDB * 32) + ch * 8);
        const u32x4 z = *(const u32x4*)(zbase + (size_t)row * NP + ch * 8);
        *(u32x4*)(mbase + (size_t)row * DM + ch * 8) = gate8(v, z);
    }
}

template <int MODE> __device__ __forceinline__ void attn_unit(ALAS unsigned char* lds, const bf16_t* __restrict__ PROJ, const float* __restrict__ CUM, bf16_t* __restrict__ MIX,
        int b, int h, int qb, float lam, float li, const float* __restrict__ subg, float* park) {
    constexpr int NDB = MODE == 1 ? 4 : 2, NBR = MODE == 1 ? 2 : 1, HS = MODE == 1 ? 128 : 64;
    int tid_ = threadIdx.x; asm volatile("" : "+v"(tid_));
    const int tid = tid_, lane = tid & 63, r32 = lane & 31, hi = lane >> 5, wid = __builtin_amdgcn_readfirstlane(tid >> 6);
    const int q0 = qb * 256, qw0 = q0 + wid * 32;
    const size_t rowb = (size_t)b * SEQ;
    const int NT = 4 * qb + 4, my_last = 4 * qb + (wid >> 1);
    ALAS float* wsf = (ALAS float*)(lds + L_WSF) + wid * 64;
    const unsigned ldsb = (unsigned)(size_t)lds;
    const float slope2 = MODE == 1 ? LOG2E / (float)(1 << (2 * h + 2)) : 0.f;
    f32x16 res[NDB];
#pragma clang loop unroll(disable)
    for (int c = 0; c < NBR; ++c) {
        const int qcol = MODE == 0 ? C_FQ + h * 64 : C_DQ + h * 128 + c * 64;
        const int kcol = MODE == 0 ? C_FK + h * 64 : C_DK + h * 128 + c * 64;
        const int vcol = MODE == 0 ? C_FV + h * 64 : C_DV + h * 128;
        bf16x8 qr[4];
        { const bf16_t* Qw = PROJ + (rowb + qw0 + r32) * NP + qcol + hi * 8;
#pragma unroll
          for (int d0 = 0; d0 < 4; ++d0) qr[d0] = *(const bf16x8*)(Qw + d0 * 16); }
        float mhat = MODE == 0 ? -CUM[(size_t)h * MTP + rowb + qw0] * LOG2E : 0.f, l = 0.f;
        f32x16 o[NDB];
#pragma unroll
        for (int d = 0; d < NDB; ++d)
#pragma unroll
            for (int r = 0; r < 16; ++r) o[d][r] = 0.f;
        u32x4 pwa[4], pwb[4]; f32x16 p0, p1; s16x4 vl[8], vh[8];
#pragma unroll
        for (int k = 0; k < 4; ++k) { pwa[k] = (u32x4){0u, 0u, 0u, 0u}; pwb[k] = (u32x4){0u, 0u, 0u, 0u}; }
#define ATT_TROW(i) ((i) < NT ? rowb + (size_t)(NT - 1 - (i)) * 64 : (size_t)MR)
#define ATT_STEP(i, PIN_, POUT_) do { \
            if ((i) + 1 <= NT) dma_tile<MODE>(ldsb + (unsigned)s_next, PROJ, CUM, ATT_TROW((i) + 1), kcol, vcol, h, wid, lane);     \
            const bool mt_ = ((i) == NT); const int t_ = NT - 1 - (i); \
            if (mt_ || t_ <= my_last) { \
                bool resc_; \
                if ((!mt_) && t_ == my_last) resc_ = qs_front<MODE, true>(lds + s_cur, lds + s_prev, vl, vh, qr, p0, p1, mhat, l, 64 * t_, false, qw0, slope2, wsf, lane); \
                else resc_ = qs_front<MODE, false>(lds + s_cur, lds + s_prev, vl, vh, qr, p0, p1, mhat, l, mt_ ? -16 : 64 * t_, mt_, qw0, slope2, wsf, lane); \
                pv_exp<NDB>(lds + s_prev, vl, vh, PIN_, o, p0, p1, POUT_, l, lane); \
                if (resc_) rescale_o<NDB>(o, wsf, lane); \
            } \
            ATT_WAIT_BAR(0);        \
            { const int tt = s_prev; s_prev = s_cur; s_cur = s_next; s_next = tt; } } while (0)
        dma_tile<MODE>(ldsb, PROJ, CUM, ATT_TROW(0), kcol, vcol, h, wid, lane);
        dma_tile<MODE>(ldsb + 2 * STG, PROJ, CUM, ATT_TROW(0), kcol, vcol, h, wid, lane);
        ATT_WAIT_BAR(0);
        int s_prev = 2 * STG, s_cur = 0, s_next = STG;
#pragma clang loop unroll(disable)
        for (int i = 0; i < NT; i += 2) { ATT_STEP(i, pwa, pwb); ATT_STEP(i + 1, pwb, pwa); }
        ATT_STEP(NT, pwa, pwb);
        pv_only<NDB>(lds + s_prev, pwb, o, lane);
#undef ATT_STEP
#undef ATT_TROW
        ATT_WAIT_BAR(0);
        { auto rr = __builtin_amdgcn_permlane32_swap(__float_as_uint(l), __float_as_uint(l), false, false); l = __uint_as_float(rr[0]) + __uint_as_float(rr[1]); }
        if (hi == 0) wsf[32 + r32] = l;
        float rli[16];
#pragma unroll
        for (int r = 0; r < 16; ++r) rli[r] = 1.f / wsf[32 + crow(r, hi)];
        if (MODE == 0) {
#pragma unroll
            for (int d = 0; d < NDB; ++d)
#pragma unroll
                for (int r = 0; r < 16; ++r) res[d][r] = o[d][r] * rli[r];
        } else {
            float* pk = park + c * 4096 + lane;
#pragma unroll
            for (int d = 0; d < NDB; ++d) {
                float* pkd = pk + d * 1024; asm volatile("" : "+v"(pkd));
#pragma unroll
                for (int r = 0; r < 16; ++r) pkd[r * 64] = o[d][r] * rli[r];
            }
        }
    }
    if (MODE == 1) {
#pragma unroll
        for (int d = 0; d < NDB; ++d) {
            const float* pa = park + lane + d * 1024; const float* pb = pa + 4096; asm volatile("" : "+v"(pa), "+v"(pb));
#pragma unroll
            for (int r = 0; r < 16; ++r) res[d][r] = pa[r * 64] - lam * pb[r * 64];
            __builtin_amdgcn_sched_barrier(0);
        }
    }
    ALAS bf16_t* stg = (ALAS bf16_t*)(lds + L_OST + wid * 8192);
    if (MODE == 1) {
        float ss[16];
#pragma unroll
        for (int r = 0; r < 16; ++r) { float s = 0.f;
#pragma unroll
            for (int d = 0; d < NDB; ++d) s += res[d][r] * res[d][r];
            ss[r] = s; }
#pragma unroll
        for (int m = 1; m < 32; m <<= 1)
#pragma unroll
            for (int r = 0; r < 16; ++r) ss[r] += shx(ss[r], m, lane);
        float gc[NDB];
#pragma unroll
        for (int d = 0; d < NDB; ++d) gc[d] = subg[32 * d + r32] * (1.f - li);
#pragma unroll
        for (int r = 0; r < 16; ++r) { const float rs = rsqrtf(ss[r] * (1.f / 128.f) + 1e-5f);
#pragma unroll
            for (int d = 0; d < NDB; ++d) res[d][r] *= rs * gc[d]; }
    }
    const int zcol = MODE == 0 ? C_FZ + h * 64 : C_DZ + h * 128, mcol = MODE == 0 ? M_A + h * 64 : M_B + h * 128;
    stage_gate_store<NDB>(res, stg, PROJ + (rowb + qw0) * NP + zcol, MIX + (rowb + qw0) * DM + mcol, lane);
}

__device__ __forceinline__ void pool_unit(ALAS unsigned char* lds, const bf16_t* __restrict__ PROJ, const bf16_t* __restrict__ WPT_l, const float* __restrict__ pscale_l, bf16_t* __restrict__ MIX, int unit) {
    int tid_ = threadIdx.x; asm volatile("" : "+v"(tid_));
    const int tid = tid_, lane = tid & 63, r32 = lane & 31, hi = lane >> 5, wid = __builtin_amdgcn_readfirstlane(tid >> 6);
    const int g = wid & 3, win = 2 << g; const float invw = 1.f / (float)win;
    const int Rw = unit * 128 + (wid >> 2) * 64, b = Rw >> 12, tw = Rw & 4095;
    ALAS bf16_t* stg = (ALAS bf16_t*)(lds + L_OST + wid * 8192);
    bf16x8 wb[2][4];
#pragma unroll
    for (int nb = 0; nb < 2; ++nb)
#pragma unroll
        for (int ks = 0; ks < 4; ++ks) wb[nb][ks] = *(const bf16x8*)(WPT_l + ((g * 64 + 32 * nb + r32) * 64 + 16 * ks + 8 * hi));
    const float ps0 = pscale_l[g * 64 + r32], ps1 = pscale_l[g * 64 + 32 + r32];
    for (int blk = 0; blk < 2; ++blk) {
        const int t = tw + 32 * blk + r32;
        f32x16 acc[2];
#pragma unroll
        for (int r = 0; r < 16; ++r) { acc[0][r] = 0.f; acc[1][r] = 0.f; }
#pragma unroll
        for (int ks = 0; ks < 4; ++ks) {
            const int c0 = C_PU + g * 64 + 16 * ks + 8 * hi;
            float s[8], own[8];
#pragma unroll
            for (int j = 0; j < 8; ++j) { s[j] = 0.f; own[j] = 0.f; }
            for (int i = 0; i < win; ++i) {
                const int ti = t - i; const size_t row = ti >= 0 ? (size_t)b * SEQ + ti : (size_t)(MR + 16 + ti);
                const u32x4 v = *(const u32x4*)(PROJ + row * NP + c0);
#pragma unroll
                for (int j = 0; j < 4; ++j) { const float lo = bfl(v[j]), hh = bfh(v[j]); s[2 * j] += lo; s[2 * j + 1] += hh; if (i == 0) { own[2 * j] = lo; own[2 * j + 1] = hh; } }
            }
            u32x4 pa;
#pragma unroll
            for (int j = 0; j < 4; ++j) pa[j] = cvtpk(s[2 * j] * invw - own[2 * j], s[2 * j + 1] * invw - own[2 * j + 1]);
            const bf16x8 af = __builtin_bit_cast(bf16x8, pa);
            acc[0] = __builtin_amdgcn_mfma_f32_32x32x16_bf16(af, wb[0][ks], acc[0], 0, 0, 0);
            acc[1] = __builtin_amdgcn_mfma_f32_32x32x16_bf16(af, wb[1][ks], acc[1], 0, 0, 0);
        }
#pragma unroll
        for (int r = 0; r < 16; ++r) { acc[0][r] *= ps0; acc[1][r] *= ps1; }
        const size_t row0 = (size_t)Rw + 32 * blk;
        stage_gate_store<2>(acc, stg, PROJ + row0 * NP + C_PZ + g * 64, MIX + row0 * DM + M_C + g * 64, lane);
    }
}
#undef ALAS
}


#ifndef PG8_SP2
#define PG8_SP2 true
#endif
#ifndef PG8_ALIGN
#define PG8_ALIGN true
#endif
constexpr int NWAVES = 8;
constexpr int RING_OFF = 0, RING_BYTES = 143360;
constexpr int LDSCTL_OFF = RING_BYTES, MISC_OFF = LDSCTL_OFF + 320;
constexpr int LDS_BYTES = RING_BYTES + 1024;
constexpr int CW_TMO = 0, CW_CODE = 1, CW_BAR = 4096;
constexpr size_t CTL_ZERO_BYTES = 1 * MiB;
static_assert(att::L_END <= RING_BYTES, "attention LDS map");
#define GAS __attribute__((address_space(1)))
#define LAS __attribute__((address_space(3)))
typedef unsigned short bf16;
typedef unsigned v4u __attribute__((ext_vector_type(4)));
typedef float f32x4 __attribute__((ext_vector_type(4)));
typedef short bf16x8 __attribute__((ext_vector_type(8)));
typedef GAS unsigned gu32;
typedef GAS unsigned long long gu64;
#define RLX_AGENT __ATOMIC_RELAXED, __HIP_MEMORY_SCOPE_AGENT
#define LDS_WAIT() asm volatile("s_waitcnt lgkmcnt(0)" ::: "memory")
#define VM_WAIT() asm volatile("s_waitcnt vmcnt(0)" ::: "memory")
__device__ __forceinline__ unsigned long long rt() { return __builtin_amdgcn_s_memrealtime(); }

#define XB_TMO      128
#define XB_XCNT(j)  (256  + 64 * (j))
#define XB_XSUB(j)  (1280 + 64 * (j))
#define XB_XGEN(j)  (2304 + 64 * (j))
#define XB_TOP      3328
#define XB_TOPGEN   3392
#define XCD_BAR_WORDS 3456
#define XB_SPIN_CAP (1u << 18)

__device__ __forceinline__ unsigned xb_ld(unsigned* p)              { return __hip_atomic_load(p, __ATOMIC_RELAXED, __HIP_MEMORY_SCOPE_AGENT); }
__device__ __forceinline__ unsigned xb_add(unsigned* p, unsigned v) { return __hip_atomic_fetch_add(p, v, __ATOMIC_RELAXED, __HIP_MEMORY_SCOPE_AGENT); }
__device__ __forceinline__ unsigned xb_xcc_id() { return (unsigned)__builtin_amdgcn_s_getreg((3 << 11) | 20) & 0xFu; }
#define XB_SPIN(cond, bar) do { unsigned _sp = 0; while (cond) { __builtin_amdgcn_s_sleep(1); \
    if ((++_sp & 255u) == 0u) { if (xb_ld(&(bar)[XB_TMO])) break; if (_sp > XB_SPIN_CAP) { atomicAdd(&(bar)[XB_TMO], 1u); break; } } } } while (0)

struct XcdBarrier {
    unsigned* bar; unsigned x;
    volatile LAS unsigned* st;
};

__device__ __forceinline__ XcdBarrier xcd_barrier_post(unsigned* bar, volatile LAS unsigned* st) {
    XcdBarrier b; b.bar = bar; b.x = xb_xcc_id(); b.st = st;
    if (threadIdx.x == 0) (void)xb_add(&bar[XB_XCNT(b.x)], 1u);
    return b;
}
__device__ __forceinline__ void xcd_barrier_complete(unsigned* bar, unsigned x, unsigned& nloc, unsigned& nx) {
    const unsigned G = gridDim.x * gridDim.y * gridDim.z;
    unsigned sum, cnt, mine, sp = 0u;
    for (;;) {
        sum = 0u; cnt = 0u; mine = 0u;
#pragma unroll
        for (unsigned j = 0; j < 16; ++j) { const unsigned c = xb_ld(&bar[XB_XCNT(j)]); sum += c; cnt += (c > 0u) ? 1u : 0u; mine = (j == x) ? c : mine; }
        if (sum == G) break;
        __builtin_amdgcn_s_sleep(1);
        if ((++sp & 255u) == 0u) { if (xb_ld(&bar[XB_TMO])) break; if (sp > XB_SPIN_CAP) { atomicAdd(&bar[XB_TMO], 1u); break; } }
    }
    nloc = mine > 0u ? mine : 1u; nx = cnt > 0u ? cnt : 1u;
}

__device__ __forceinline__ void xcd_barrier(const XcdBarrier& b) {
    asm volatile("s_waitcnt vmcnt(0)" ::: "memory");
    __syncthreads();
    if (threadIdx.x == 0) {
        unsigned* bar = b.bar;
        __builtin_amdgcn_s_waitcnt(0);
        unsigned nloc = b.st[0], nx = b.st[1];
        if (nloc == 0u) { xcd_barrier_complete(bar, b.x, nloc, nx); b.st[0] = nloc; b.st[1] = nx; }
        const unsigned old = xb_add(&bar[XB_XSUB(b.x)], 1u);
        const unsigned gen = old / nloc;
        if (old + 1u == (gen + 1u) * nloc) {
            __builtin_amdgcn_fence(__ATOMIC_RELEASE, "agent");
            asm volatile("s_waitcnt vmcnt(0)" ::: "memory");
            const unsigned og = xb_add(&bar[XB_TOP], 1u);
            const unsigned tg = og / nx;
            if (og + 1u == (tg + 1u) * nx) xb_add(&bar[XB_TOPGEN], 1u);
            else XB_SPIN(xb_ld(&bar[XB_TOPGEN]) == tg, bar);
            __builtin_amdgcn_fence(__ATOMIC_ACQUIRE, "agent");
            xb_add(&bar[XB_XGEN(b.x)], 1u);
            asm volatile("s_waitcnt vmcnt(0)" ::: "memory");
        } else {
            XB_SPIN(xb_ld(&bar[XB_XGEN(b.x)]) == gen, bar);
            __builtin_amdgcn_fence(__ATOMIC_ACQUIRE, "agent");
            asm volatile("s_waitcnt vmcnt(0)" ::: "memory");
        }
    }
    __syncthreads();
}

__device__ __forceinline__ void transpose_item(const float* __restrict__ W, int ldw, int col0, const float* __restrict__ gk, bf16_t* WT, int K, LAS float* scr, int k0, int n0dst, int lane) {
    float v[32];
    const float* src = W + (size_t)(k0 + (lane >> 5)) * ldw + col0 + (lane & 31);
#pragma unroll
    for (int i = 0; i < 32; ++i) v[i] = src[(size_t)(2 * i) * ldw];
    const int c = lane & 7;
    float g[8];
#pragma unroll
    for (int j = 0; j < 8; ++j) g[j] = gk ? gk[k0 + 8 * c + j] : 1.f;
#pragma unroll
    for (int i = 0; i < 32; ++i) scr[(2 * i + (lane >> 5)) * 33 + (lane & 31)] = v[i];
    LDS_WAIT(); asm volatile("" ::: "memory");
#pragma unroll
    for (int j = 0; j < 4; ++j) { const int n = (lane >> 3) + 8 * j; const LAS float* s = scr + (8 * c) * 33 + n;
        v4u o; o.x = pk2(s[0 * 33] * g[0], s[1 * 33] * g[1]); o.y = pk2(s[2 * 33] * g[2], s[3 * 33] * g[3]); o.z = pk2(s[4 * 33] * g[4], s[5 * 33] * g[5]); o.w = pk2(s[6 * 33] * g[6], s[7 * 33] * g[7]);
        *(GAS v4u*)(WT + (size_t)(n0dst + n) * K + k0 + 8 * c) = o; }
    LDS_WAIT(); asm volatile("" ::: "memory");
}

constexpr int NPH = 18;
struct Args { const float* in[14]; float* out; unsigned char* ws; int ph_lo, ph_hi; };
__global__ void __launch_bounds__(NWAVES * 64, 2) mk_fwd(Args args) {
    extern __shared__ __attribute__((aligned(16))) unsigned char lds[];
    LAS unsigned char* ldsp = (LAS unsigned char*)lds;
    volatile LAS unsigned* MISC = (volatile LAS unsigned*)(ldsp + MISC_OFF);
    gu32* ctl = (gu32*)(args.ws + WS_CTL);
    for (int u = threadIdx.x; u < (LDS_BYTES - LDSCTL_OFF) / 4; u += NWAVES * 64) ((LAS unsigned*)(ldsp + LDSCTL_OFF))[u] = 0u;
    __syncthreads();
    XcdBarrier bar = xcd_barrier_post((unsigned*)(ctl + CW_BAR), MISC + 8);
    const int lo = args.ph_lo, hi = args.ph_hi;
    for (int ph_ = lo; ph_ < hi; ++ph_) {
        int ph = ph_, bid = (int)blockIdx.x, G = (int)gridDim.x;
        typedef const __attribute__((address_space(4))) Args* KArgs;
        KArgs ap = (KArgs)__builtin_amdgcn_kernarg_segment_ptr(); asm volatile("" : "+s"(ap));
        unsigned char* ws = ap->ws; unsigned* barw = bar.bar;
        asm volatile("" : "+s"(ph), "+s"(bid), "+s"(G), "+s"(ws), "+s"(barw));
        int tid_ = threadIdx.x; asm volatile("" : "+v"(tid_));
        const int tid = tid_, lane = tid & 63, wave = __builtin_amdgcn_readfirstlane(tid >> 6);
        const int vcu = (G % 8 == 0) ? (bid % 8) * (G / 8) + bid / 8 : bid;
        const int gw = bid * NWAVES + wave, NGW = G * NWAVES;
        bf16_t* W1T = (bf16_t*)(ws + WS_W1T); bf16_t* W2T = (bf16_t*)(ws + WS_W2T);
        float* WFG = (float*)(ws + WS_WFG); float* LAM = (float*)(ws + WS_LAM); float* HM = (float*)(ws + WS_HM);
        bf16_t* WPT = (bf16_t*)(ws + WS_WPT);
        float* LOGF = (float*)(ws + WS_LOGF); float* CUM = (float*)(ws + WS_CUM);
        bf16_t* HB = (bf16_t*)(ws + WS_HB); bf16_t* MIX = (bf16_t*)(ws + WS_MIX); bf16_t* PROJ = (bf16_t*)(ws + WS_PROJ);
        float* H = ap->out;
        if (ph == 0) {
            const float* norm_g = ap->in[2]; const float* w_in = ap->in[3]; const float* w_pool = ap->in[10]; const float* w_out = ap->in[12];
            LAS float* scr = (LAS float*)(ldsp + RING_OFF + wave * 16384);
            constexpr int NIT1 = DEPTH * 16 * 112, NIT2 = DEPTH * 16 * 32;
            for (int it = gw; it < NIT1 + NIT2; it += NGW) {
                if (it < NIT1) { const int l = it / 1792, r = it % 1792, kb = r / 112, nb = r % 112, n0 = 32 * nb, col0 = n0 < 1024 ? n0 : n0 + 4;
                    transpose_item(w_in + (size_t)l * 1024 * IN_DIM, IN_DIM, col0, norm_g + l * 1024, W1T + (size_t)l * NP * 1024, 1024, scr, 64 * kb, n0, lane); }
                else { const int r0 = it - NIT1, l = r0 / 512, r = r0 % 512, kb = r / 32, nb = r % 32;
                    transpose_item(w_out + (size_t)l * 1024 * 1024, 1024, 32 * nb, nullptr, W2T + (size_t)l * 1024 * 1024, 1024, scr, 64 * kb, 32 * nb, lane); }
            }
            const int gt = bid * (NWAVES * 64) + tid, NT = G * NWAVES * 64;
            for (int i = gt; i < DEPTH * 4 * 1024; i += NT) { const int k = i & 1023, c = (i >> 10) & 3, l = i >> 12; WFG[i] = w_in[((size_t)l * 1024 + k) * IN_DIM + 1024 + c] * norm_g[l * 1024 + k]; }
            for (int i = gt; i < DEPTH * 4 * 64 * 64; i += NT) { const int c = i & 63, d = (i >> 6) & 63, lg = i >> 12; WPT[i] = f2bf(w_pool[((size_t)lg * 64 + c) * 64 + d]); }
            unsigned zz = 0u; float big = 1e30f; asm volatile("" : "+v"(zz), "+v"(big));
            for (int i = gt; i < 48 * NP / 8; i += NT) ((uint4*)(PROJ + (size_t)(MR + 16) * NP))[i] = make_uint4(zz, zz, zz, zz);
            for (int i = gt; i < 48 * 4; i += NT) CUM[(size_t)(i / 48) * MTP + MR + 16 + (i % 48)] = big;
            if (gt < DEPTH) { const int l = gt; float s1 = 0.f, s2 = 0.f;
                for (int i = 0; i < 64; ++i) { s1 += ap->in[5][l * 64 + i] * ap->in[6][l * 64 + i]; s2 += ap->in[7][l * 64 + i] * ap->in[8][l * 64 + i]; }
                LAM[l] = fexp(s1) - fexp(s2) + (0.8f - 0.6f * fexp(-0.3f * (float)l)); }
        } else if (ph <= 16) {
            const int l = (ph - 1) >> 2, sub = (ph - 1) & 3;
            if (sub == 0) {
                const float* hreal = l == 0 ? ap->in[0] : H; const float* hmeta = l == 0 ? ap->in[1] : HM;
                for (int row = gw; row < MT; row += NGW) norm_row(row, lane, hreal, hmeta, WFG + (size_t)l * 4096, ap->in[4] + l * 4, HB, LOGF);
            } else if (sub == 1) {
                if (wave == 0) { for (int i = bid; i < 33; i += G) { if (i < 32) scan_bh(i >> 2, i & 3, lane, LOGF, CUM); else scan_meta(lane, LOGF, CUM); } }
                if (wave == 1) { for (int nb = bid; nb < NP / 16; nb += G) {
                    const mf32x4 acc = meta_gemm16(HB + (size_t)MR * DM, W1T + (size_t)l * NP * 1024, nb, lane);
                    const int col = 16 * nb + (lane & 15), fq = lane >> 4; const float sc = (col < 256 || (col >= 1024 && col < 1536)) ? att::C2 : 1.f;
#pragma unroll
                    for (int j = 0; j < 4; ++j) PROJ[(size_t)(MR + 4 * fq + j) * NP + col] = f2bf(acc[j] * sc); } }
                pg8::Gemm g{HB, W1T + (size_t)l * NP * 1024, MR, NP, 1024}; pg8::StaticOrder S; S.init(MR, NP, G, bid);
                pg8::EpiProj E{PROJ, NP, att::C2};
#ifndef DIAG_NO_GEMM
                pg8::gemm_phase<pg8::EpiProj, pg8::StaticOrder, PG8_ALIGN, PG8_SP2>(ldsp + RING_OFF, g, S, E);
#endif
            } else if (sub == 2) {
                const float li = __int_as_float(__builtin_amdgcn_readfirstlane(__float_as_int(0.8f - 0.6f * fexp(-0.3f * (float)l))));
                const float lam = __int_as_float(__builtin_amdgcn_readfirstlane(__float_as_int(LAM[l])));
                const float* subg = ap->in[9] + l * 128;
                float* park = (float*)(ws + WS_RES) + ((size_t)bid * 8 + (size_t)wave) * 8192;
                for (int pi = vcu; pi < 256; pi += G) {
                    const int bh = pi >> 3, s_ = pi & 7, b_ = bh >> 2, h_ = bh & 3;
#ifndef DIAG_NO_FOX
                    for (int u = 0; u < 2; ++u) att::attn_unit<0>(ldsp + RING_OFF, PROJ, CUM, MIX, b_, h_, u ? s_ : 15 - s_, lam, li, subg, park);
#endif
#ifndef DIAG_NO_DIFF
                    for (int u = 0; u < 2; ++u) att::attn_unit<1>(ldsp + RING_OFF, PROJ, CUM, MIX, b_, h_, u ? s_ : 15 - s_, lam, li, subg, park);
#endif
                }
#ifndef DIAG_NO_POOL
                for (int pu = vcu; pu < 256; pu += G) att::pool_unit(ldsp + RING_OFF, PROJ, WPT + (size_t)l * 4 * 64 * 64, ap->in[11] + l * 256, MIX, pu);
#endif
#ifndef DIAG_NO_META
                if (bid == G - 1) {
                    if (wave < 4) fox_meta(wave, lane, PROJ, CUM, MIX); else diff_meta(wave - 4, lane, PROJ, subg, lam, li, MIX);
                    for (int tk = wave; tk < 64; tk += NWAVES) pool_meta(tk >> 2, tk & 3, lane, PROJ, ap->in[10] + (size_t)l * 4 * 64 * 64, ap->in[11] + l * 256, MIX);
                }
#endif
            } else {
                const float* hreal = l == 0 ? ap->in[0] : H; const float* hmeta = l == 0 ? ap->in[1] : HM;
                if (wave == 0) { for (int nb = bid; nb < 64; nb += G) {
                    const mf32x4 acc = meta_gemm16(MIX + (size_t)MR * DM, W2T + (size_t)l * 1024 * 1024, nb, lane);
                    const int col = 16 * nb + (lane & 15), fq = lane >> 4;
#pragma unroll
                    for (int j = 0; j < 4; ++j) HM[(4 * fq + j) * 1024 + col] = hmeta[(4 * fq + j) * 1024 + col] + acc[j]; } }
                pg8::Gemm g{MIX, W2T + (size_t)l * 1024 * 1024, MR, 1024, 1024}; pg8::StaticOrder S; S.init(MR, 1024, G, bid);
                pg8::EpiResid E{hreal, H, 1024};
#ifndef DIAG_NO_GEMM
                pg8::gemm_phase<pg8::EpiResid, pg8::StaticOrder, PG8_ALIGN, PG8_SP2>(ldsp + RING_OFF, g, S, E);
#endif
            }
        } else {
            for (int row = gw; row < MR; row += NGW) final_row(row, lane, H, ap->in[13]);
        }
        if (ph_ + 1 < hi) { XcdBarrier b2 = bar; b2.bar = barw; xcd_barrier(b2); }
    }
}

#ifndef MK_PER_PHASE
#define MK_PER_PHASE 0
#endif
extern "C" void kernel_launch(void* const* d_in, const int* in_sizes, int n_in, void* d_out, int out_size, void* d_ws, size_t ws_size, hipStream_t stream) {
    static int g_grid = 0;
    if (g_grid == 0) {
        int dev = 0, cus = 0, per_cu = 0;
        hipGetDevice(&dev); hipDeviceGetAttribute(&cus, hipDeviceAttributeMultiprocessorCount, dev);
        hipFuncSetAttribute((const void*)mk_fwd, hipFuncAttributeMaxDynamicSharedMemorySize, LDS_BYTES);
        hipOccupancyMaxActiveBlocksPerMultiprocessor(&per_cu, (const void*)mk_fwd, NWAVES * 64, LDS_BYTES);
        (void)hipGetLastError();
        g_grid = cus > 0 ? cus : 256;
    }
    hipMemsetAsync((unsigned char*)d_ws + WS_CTL, 0, CTL_ZERO_BYTES, stream);
    Args a{};
    for (int i = 0; i < 14; ++i) a.in[i] = (const float*)d_in[i];
    a.out = (float*)d_out; a.ws = (unsigned char*)d_ws;
#if MK_PER_PHASE
    for (int p = 0; p < NPH; ++p) { a.ph_lo = p; a.ph_hi = p + 1; hipLaunchKernelGGL(mk_fwd, dim3(g_grid), dim3(NWAVES * 64), LDS_BYTES, stream, a); }
#else
    a.ph_lo = 0; a.ph_hi = NPH;
    hipLaunchKernelGGL(mk_fwd, dim3(g_grid), dim3(NWAVES * 64), LDS_BYTES, stream, a);
#endif
}
```

```cpp
#include <hip/hip_runtime.h>
#include <stdint.h>

typedef unsigned short bf16_t;
__device__ __forceinline__ float bf2f(bf16_t v) { return __uint_as_float(((unsigned)v) << 16); }
__device__ __forceinline__ bf16_t f2bf(float f) { unsigned u = __float_as_uint(f); return (bf16_t)((u + 0x7fffu + ((u >> 16) & 1u)) >> 16); }

constexpr int BATCH = 8, SEQ = 4096, DM = 1024, DEPTH = 4, NMETA = 16;
constexpr int MR = BATCH * SEQ;
constexpr int MT = MR + NMETA;
constexpr int IN_DIM = 3588, NP = 3584;
constexpr int C_FQ = 0, C_FK = 256, C_FV = 512, C_FZ = 768, C_DQ = 1024, C_DK = 1536, C_DV = 2048, C_DZ = 2560, C_PU = 3072, C_PZ = 3328;
constexpr int M_A = 0, M_B = 256, M_C = 768;
constexpr float LN2F = 0.6931471805599453f;
__device__ __forceinline__ unsigned pk2(float lo, float hi) { return (unsigned)f2bf(lo) | ((unsigned)f2bf(hi) << 16); }

constexpr size_t MiB = 1u << 20;
constexpr size_t WS_CTL = 0;
constexpr size_t WS_W1T = 2 * MiB;
constexpr size_t WS_W2T = 30 * MiB;
constexpr size_t WS_WFG = 38 * MiB;
constexpr size_t WS_LAM = 38 * MiB + 65536;
constexpr size_t WS_HM  = 38 * MiB + 131072;
constexpr size_t WS_WPT = 38 * MiB + 262144;
constexpr size_t WS_KMX = 38 * MiB + 524288;
constexpr int KMX_WORDS = 24 * 2 * 8 * 64;
constexpr int MTP = MR + 64;
constexpr size_t WS_LOGF = 39 * MiB;
constexpr size_t WS_CUM = 40 * MiB;
constexpr size_t WS_HB = 42 * MiB;
constexpr size_t WS_MIX = 108 * MiB;
constexpr size_t WS_PROJ = 174 * MiB;
constexpr size_t WS_RES = 400 * MiB;
constexpr size_t WS_END = 464 * MiB;

__device__ __forceinline__ float shx(float v, int m, int lane) { return __int_as_float(__builtin_amdgcn_ds_bpermute((lane ^ m) << 2, __float_as_int(v))); }
__device__ __forceinline__ float shl(float v, int src) { return __int_as_float(__builtin_amdgcn_ds_bpermute(src << 2, __float_as_int(v))); }
__device__ __forceinline__ float wave_sum(float v, int lane) {
#pragma unroll
    for (int o = 1; o < 64; o <<= 1) v += shx(v, o, lane);
    return v;
}
__device__ __forceinline__ float fexp(float x) { return __builtin_amdgcn_exp2f(x * 1.4426950408889634f); }
__device__ __forceinline__ float log_sigmoid(float x) { return fminf(x, 0.f) - __builtin_amdgcn_logf(1.f + fexp(-fabsf(x))) * 0.6931471805599453f; }
__device__ __forceinline__ float silu(float x) { return x / (1.f + fexp(-x)); }

__device__ __forceinline__ void norm_row(int row, int lane, const float* __restrict__ hreal, const float* __restrict__ hmeta, const float* __restrict__ WFG_l,
                                         const float* __restrict__ bf_l, bf16_t* HB, float* LOGF) {
    const float* hp = row < MR ? hreal + (size_t)row * DM : hmeta + (size_t)(row - MR) * DM;
    float4 v[4]; float ss = 0.f;
#pragma unroll
    for (int j = 0; j < 4; ++j) { v[j] = *(const float4*)(hp + j * 256 + lane * 4); ss += v[j].x * v[j].x + v[j].y * v[j].y + v[j].z * v[j].z + v[j].w * v[j].w; }
    ss = wave_sum(ss, lane);
    const float rstd = rsqrtf(ss * (1.f / DM) + 1e-6f);
    float fg[4];
#pragma unroll
    for (int c = 0; c < 4; ++c) {
        float a = 0.f;
#pragma unroll
        for (int j = 0; j < 4; ++j) { const float4 w = *(const float4*)(WFG_l + c * 1024 + j * 256 + lane * 4); a += v[j].x * w.x + v[j].y * w.y + v[j].z * w.z + v[j].w * w.w; }
        fg[c] = wave_sum(a, lane) * rstd;
    }
#pragma unroll
    for (int j = 0; j < 4; ++j) {
        ushort4 o; o.x = f2bf(v[j].x * rstd); o.y = f2bf(v[j].y * rstd); o.z = f2bf(v[j].z * rstd); o.w = f2bf(v[j].w * rstd);
        *(ushort4*)(HB + (size_t)row * DM + j * 256 + lane * 4) = o;
    }
    if (lane < 4) LOGF[(size_t)lane * MTP + row] = log_sigmoid((lane == 0 ? fg[0] : lane == 1 ? fg[1] : lane == 2 ? fg[2] : fg[3]) + bf_l[lane]);
}
__device__ __forceinline__ void final_row(int row, int lane, float* H, const float* __restrict__ final_g) {
    float* hp = H + (size_t)row * DM;
    float4 v[4]; float ss = 0.f;
#pragma unroll
    for (int j = 0; j < 4; ++j) { v[j] = *(const float4*)(hp + j * 256 + lane * 4); ss += v[j].x * v[j].x + v[j].y * v[j].y + v[j].z * v[j].z + v[j].w * v[j].w; }
    ss = wave_sum(ss, lane);
    const float rstd = rsqrtf(ss * (1.f / DM) + 1e-6f);
#pragma unroll
    for (int j = 0; j < 4; ++j) {
        const float4 g = *(const float4*)(final_g + j * 256 + lane * 4);
        float4 o; o.x = v[j].x * rstd * g.x; o.y = v[j].y * rstd * g.y; o.z = v[j].z * rstd * g.z; o.w = v[j].w * rstd * g.w;
        *(float4*)(hp + j * 256 + lane * 4) = o;
    }
}
__device__ __forceinline__ void scan_bh(int b, int h, int lane, const float* __restrict__ LOGF, float* CUM) {
    const float4* p = (const float4*)(LOGF + (size_t)h * MTP + (size_t)b * SEQ + (size_t)lane * 64);
    float4 v[16]; float s = 0.f;
#pragma unroll
    for (int j = 0; j < 16; ++j) { v[j] = p[j]; }
#pragma unroll
    for (int j = 0; j < 16; ++j) { s += (v[j].x + v[j].y) + (v[j].z + v[j].w); }
    float inc = s;
#pragma unroll
    for (int o = 1; o < 64; o <<= 1) { const float t = shl(inc, lane >= o ? lane - o : lane); if (lane >= o) inc += t; }
    float c = inc - s;
    float4* q = (float4*)(CUM + (size_t)h * MTP + (size_t)b * SEQ + (size_t)lane * 64);
#pragma unroll
    for (int j = 0; j < 16; ++j) { float4 o; c += v[j].x; o.x = c; c += v[j].y; o.y = c; c += v[j].z; o.z = c; c += v[j].w; o.w = c; q[j] = o; }
}
__device__ __forceinline__ void scan_meta(int lane, const float* __restrict__ LOGF, float* CUM) {
    if (lane < 4) { const int h = lane; float c = 0.f;
        for (int j = 15; j >= 0; --j) { CUM[(size_t)h * MTP + MR + j] = -c; c += LOGF[(size_t)h * MTP + MR + j]; } }
}
typedef short mbf16x8 __attribute__((ext_vector_type(8)));
typedef float mf32x4 __attribute__((ext_vector_type(4)));
__device__ __forceinline__ mf32x4 meta_gemm16(const bf16_t* __restrict__ A16, const bf16_t* __restrict__ Bt, int nb, int lane) {
    const int fr = lane & 15, fq = lane >> 4; mf32x4 acc = {0.f, 0.f, 0.f, 0.f};
    const bf16_t* ap = A16 + fr * 1024 + fq * 8; const bf16_t* bp = Bt + (size_t)(16 * nb + fr) * 1024 + fq * 8;
#pragma unroll 8
    for (int kk = 0; kk < 32; ++kk) { const mbf16x8 a = *(const mbf16x8*)(ap + kk * 32), b = *(const mbf16x8*)(bp + kk * 32); acc = __builtin_amdgcn_mfma_f32_16x16x32_bf16(a, b, acc, 0, 0, 0); }
    return acc;
}
__device__ __forceinline__ void ld16(const bf16_t* p, float (&x)[16]) {
    const uint4 a = *(const uint4*)p, b = *(const uint4*)(p + 8);
    const unsigned w[8] = {a.x, a.y, a.z, a.w, b.x, b.y, b.z, b.w};
#pragma unroll
    for (int j = 0; j < 8; ++j) { x[2 * j] = __uint_as_float(w[j] << 16); x[2 * j + 1] = __uint_as_float(w[j] & 0xffff0000u); }
}
__device__ __forceinline__ void fox_meta(int h, int lane, const bf16_t* __restrict__ PROJ, const float* __restrict__ CUM, bf16_t* MIX) {
    const int t = lane >> 2, dq = lane & 3, row = MR + t;
    float ln2 = LN2F, m = -1e30f; asm volatile("" : "+v"(ln2), "+v"(m));
    float q[16], o[16], x[16];
    ld16(PROJ + (size_t)row * NP + C_FQ + h * 64 + dq * 16, q);
#pragma unroll
    for (int d = 0; d < 16; ++d) { q[d] *= ln2; o[d] = 0.f; }
    const float cq = CUM[(size_t)h * MTP + row];
    float lsum = 0.f;
    for (int kk = 0; kk < 16; ++kk) {
        const int krow = MR + kk;
        ld16(PROJ + (size_t)krow * NP + C_FK + h * 64 + dq * 16, x);
        float sc = 0.f;
#pragma unroll
        for (int d = 0; d < 16; ++d) sc += q[d] * x[d];
        sc += shx(sc, 1, lane); sc += shx(sc, 2, lane);
        sc += cq - CUM[(size_t)h * MTP + krow];
        ld16(PROJ + (size_t)krow * NP + C_FV + h * 64 + dq * 16, x);
        if (kk <= t) {
            if (sc > m) { const float a = fexp(m - sc); lsum *= a;
#pragma unroll
                for (int d = 0; d < 16; ++d) o[d] *= a;
                m = sc; }
            const float p = fexp(sc - m); lsum += p;
#pragma unroll
            for (int d = 0; d < 16; ++d) o[d] += p * x[d];
        }
    }
    const float inv = 1.f / lsum;
    ld16(PROJ + (size_t)row * NP + C_FZ + h * 64 + dq * 16, x);
    bf16_t* mp = MIX + (size_t)row * DM + M_A + h * 64 + dq * 16;
#pragma unroll
    for (int d = 0; d < 16; d += 2) *(unsigned*)(mp + d) = pk2(o[d] * inv * silu(x[d]), o[d + 1] * inv * silu(x[d + 1]));
}
__device__ __forceinline__ void diff_meta(int h, int lane, const bf16_t* __restrict__ PROJ, const float* __restrict__ subln_g_l, float lam, float li, bf16_t* MIX) {
    const int ri = lane >> 2, qq = lane & 3, row = MR + ri;
    const float posq = (float)ri, slope = 1.f / (float)(1 << (2 * h + 2));
    float res[32], x[16], y[16];
    for (int c = 0; c < 2; ++c) {
        float ln2 = LN2F, m = -1e30f; asm volatile("" : "+v"(ln2), "+v"(m));
        float q[16], o[32];
        ld16(PROJ + (size_t)row * NP + C_DQ + h * 128 + c * 64 + qq * 16, q);
#pragma unroll
        for (int d = 0; d < 16; ++d) q[d] *= ln2;
#pragma unroll
        for (int d = 0; d < 32; ++d) o[d] = 0.f;
        float lsum = 0.f;
        for (int kk = 0; kk < 16; ++kk) {
            const int krow = MR + kk;
            ld16(PROJ + (size_t)krow * NP + C_DK + h * 128 + c * 64 + qq * 16, x);
            float sc = 0.f;
#pragma unroll
            for (int d = 0; d < 16; ++d) sc += q[d] * x[d];
            sc += shx(sc, 1, lane); sc += shx(sc, 2, lane);
            sc -= slope * fabsf(posq - (float)kk);
            ld16(PROJ + (size_t)krow * NP + C_DV + h * 128 + qq * 32, x);
            ld16(PROJ + (size_t)krow * NP + C_DV + h * 128 + qq * 32 + 16, y);
            if (sc > m) { const float a = fexp(m - sc); lsum *= a;
#pragma unroll
                for (int d = 0; d < 32; ++d) o[d] *= a;
                m = sc; }
            const float p = fexp(sc - m); lsum += p;
#pragma unroll
            for (int d = 0; d < 16; ++d) { o[d] += p * x[d]; o[16 + d] += p * y[d]; }
        }
        const float inv = 1.f / lsum;
        if (c == 0) {
#pragma unroll
            for (int d = 0; d < 32; ++d) res[d] = o[d] * inv;
        } else {
#pragma unroll
            for (int d = 0; d < 32; ++d) res[d] -= lam * o[d] * inv;
        }
    }
    float ss = 0.f;
#pragma unroll
    for (int d = 0; d < 32; ++d) ss += res[d] * res[d];
    ss += shx(ss, 1, lane); ss += shx(ss, 2, lane);
    const float rstd = rsqrtf(ss * (1.f / 128.f) + 1e-5f) * (1.f - li);
    ld16(PROJ + (size_t)row * NP + C_DZ + h * 128 + qq * 32, x);
    ld16(PROJ + (size_t)row * NP + C_DZ + h * 128 + qq * 32 + 16, y);
    bf16_t* mp = MIX + (size_t)row * DM + M_B + h * 128 + qq * 32;
    const float* gp = subln_g_l + qq * 32;
#pragma unroll
    for (int d = 0; d < 16; d += 2) {
        *(unsigned*)(mp + d) = pk2(res[d] * rstd * gp[d] * silu(x[d]), res[d + 1] * rstd * gp[d + 1] * silu(x[d + 1]));
        *(unsigned*)(mp + 16 + d) = pk2(res[16 + d] * rstd * gp[16 + d] * silu(y[d]), res[17 + d] * rstd * gp[17 + d] * silu(y[d + 1])); }
}
__device__ __forceinline__ void pool_meta(int j, int g, int lane, const bf16_t* __restrict__ PROJ, const float* __restrict__ wpool_l, const float* __restrict__ pscale_l, bf16_t* MIX) {
    const int w = 2 << g, cnt = (j + 1) < w ? (j + 1) : w, row = MR + j;
    float s = 0.f;
    for (int i = 0; i < cnt; ++i) s += bf2f(PROJ[(size_t)(MR + j - i) * NP + C_PU + g * 64 + lane]);
    const float pooled = s / (float)cnt - bf2f(PROJ[(size_t)row * NP + C_PU + g * 64 + lane]);
    float y = 0.f;
    for (int i = 0; i < 64; ++i) y += shl(pooled, i) * wpool_l[(g * 64 + i) * 64 + lane];
    const float z = bf2f(PROJ[(size_t)row * NP + C_PZ + g * 64 + lane]);
    MIX[(size_t)row * DM + M_C + g * 64 + lane] = f2bf(y * pscale_l[g * 64 + lane] * silu(z));
}

namespace pg8 {
#define PG8_LAS __attribute__((address_space(3)))
typedef unsigned short bf16_t;
typedef short bf16x8 __attribute__((ext_vector_type(8)));
typedef float f32x4 __attribute__((ext_vector_type(4)));
typedef unsigned u32x4 __attribute__((ext_vector_type(4)));
constexpr int BM = 256, BK = 64, HALF = 128, HTB = HALF * BK * 2  , STAGE_BYTES = 8 * HTB, NXCD = 8, WGM = 8;

__host__ __device__ __forceinline__ int lds_byte(int r, int c) { const int st = (r >> 4) * 2 + (c >> 5), rr = r & 15, cc = c & 31, ob = rr * 64 + cc * 2; return st * 1024 + (ob ^ (((ob >> 9) & 1) << 5)); }
__host__ __device__ __forceinline__ void stage_rc(int b, int& R, int& C) { const int st = b / 1024, sb = b % 1024, swz = sb ^ (((sb >> 9) & 1) << 5); R = (st >> 1) * 16 + swz / 64; C = (st & 1) * 32 + (swz % 64) / 2; }
__host__ __device__ __forceinline__ int perm32(int rho) { const int n = rho >> 4, i = rho & 15; return 8 * (i >> 2) + 4 * n + (i & 3); }

struct Unit { int pm, pn; };
struct Gemm { const bf16_t* A; const bf16_t* Bt; int M, N, K; };

struct StaticOrder {
    int nM, nN, nwg, G, c;
    __host__ __device__ void init(int M, int N, int G_, int c_) { nM = M / BM; nN = N / BM; nwg = nM * nN; G = G_; c = c_; }
    __host__ __device__ bool next(int i, Unit& u) const {
        const long L = (long)i * G + c; if (L >= nwg) return false;
        int wgid = (int)L; { const int q = nwg / NXCD, r = nwg % NXCD, xcd = wgid % NXCD, off = wgid / NXCD; wgid = (xcd < r ? xcd * (q + 1) : r * (q + 1) + (xcd - r) * q) + off; }
        const int nig = WGM * nN, gid = wgid / nig, fm = gid * WGM, gsz = (nM - fm) < WGM ? (nM - fm) : WGM;
        u.pm = fm + ((wgid % nig) % gsz); u.pn = (wgid % nig) / gsz; return true;
    }
    __device__ __forceinline__ void a_ready(const Unit&) const {}
    __device__ __forceinline__ void done(const Unit&) const {}
};

__device__ __forceinline__ unsigned cvt_pk_bf16(float lo, float hi) { unsigned r; asm volatile("v_cvt_pk_bf16_f32 %0, %1, %2" : "=v"(r) : "v"(lo), "v"(hi)); return r; }
struct EpiProj {
    static constexpr bool PERM = true, AFTER_DRAIN = false;
    bf16_t* O; int ldc; float qscale; unsigned* kmx;
    __device__ __forceinline__ void operator()(const f32x4 (&acc)[2][2][4][2], const Unit& u, int wr, int wc, int fr, int fq) const {
        const int row0 = u.pm * BM + wr * 64 + fr, col0 = u.pn * BM + wc * 32 + 8 * fq;
        const float sc = (u.pn == 0 || u.pn == 4 || u.pn == 5) ? qscale : 1.f;
        const bool nrm = (u.pn <= 1) || (u.pn >= 4 && u.pn <= 7);
        float part[2][2][4];
#pragma unroll
        for (int ai = 0; ai < 2; ++ai)
#pragma unroll
            for (int m = 0; m < 4; ++m) { bf16_t* rowp = O + (size_t)(row0 + ai * HALF + m * 16) * ldc + col0;
#pragma unroll
                for (int bj = 0; bj < 2; ++bj) { const f32x4 v0 = acc[ai][bj][m][0] * sc, v1 = acc[ai][bj][m][1] * sc;
                    part[ai][bj][m] = (v0[0] * v0[0] + v0[1] * v0[1]) + (v0[2] * v0[2] + v0[3] * v0[3]) + (v1[0] * v1[0] + v1[1] * v1[1]) + (v1[2] * v1[2] + v1[3] * v1[3]);
                    u32x4 w; w.x = cvt_pk_bf16(v0[0], v0[1]); w.y = cvt_pk_bf16(v0[2], v0[3]); w.z = cvt_pk_bf16(v1[0], v1[1]); w.w = cvt_pk_bf16(v1[2], v1[3]);
                    *(u32x4*)(rowp + bj * HALF) = w; } }
        if (nrm) {
            const int lane = fr + 16 * fq;
#pragma unroll
            for (int ai = 0; ai < 2; ++ai)
#pragma unroll
                for (int bj = 0; bj < 2; ++bj) {
                    float mx = 0.f;
#pragma unroll
                    for (int m = 0; m < 4; ++m) { float p = part[ai][bj][m]; p += shx(p, 16, lane); p += shx(p, 32, lane); mx = fmaxf(mx, p); }
                    mx = fmaxf(mx, shx(mx, 1, lane)); mx = fmaxf(mx, shx(mx, 2, lane)); mx = fmaxf(mx, shx(mx, 4, lane)); mx = fmaxf(mx, shx(mx, 8, lane));
                    if (lane == 0) { const int R = u.pm * BM + ai * HALF + wr * 64, col = u.pn * BM + bj * HALF + wc * 32;
                        const int st = col < 512 ? (col >> 6) : 8 + ((col - 1024) >> 6), half = (col >> 5) & 1;
                        atomicMax(kmx + ((st * 2 + half) * 8 + (R >> 12)) * 64 + ((R & 4095) >> 6), __float_as_uint(mx)); }
                }
        }
    }
};
struct EpiResid {
    static constexpr bool PERM = false, AFTER_DRAIN = false;
    const float* base; float* out; int ldc;
    __device__ __forceinline__ void operator()(const f32x4 (&acc)[2][2][4][2], const Unit& u, int wr, int wc, int fr, int fq) const {
        const int col0 = u.pn * BM + wc * 32 + 4 * fq;
#pragma unroll
        for (int ai = 0; ai < 2; ++ai)
#pragma unroll
            for (int m = 0; m < 4; ++m) { const size_t off = (size_t)(u.pm * BM + ai * HALF + wr * 64 + m * 16 + fr) * ldc + col0;
#pragma unroll
                for (int bj = 0; bj < 2; ++bj)
#pragma unroll
                    for (int n = 0; n < 2; ++n) { const f32x4 bs = *(const f32x4*)(base + off + bj * HALF + n * 16); *(f32x4*)(out + off + bj * HALF + n * 16) = bs + acc[ai][bj][m][n]; } }
    }
};
template <class Epi, class Sched, bool ALIGN_EPI = false, bool SP2 = false>
__device__ __forceinline__ void gemm_phase(PG8_LAS unsigned char* lds, const Gemm g, const Sched& S, const Epi& E) {
    int tid_ = threadIdx.x; asm volatile("" : "+v"(tid_));
    const int tid = tid_, wid = __builtin_amdgcn_readfirstlane(tid >> 6), lane = tid & 63, wr = wid >> 2, wc = wid & 3, fr = lane & 15, fq = lane >> 4;
    const int K = g.K, nt = K / BK;
    unsigned voffA[2], voffB[2];
#pragma unroll
    for (int i = 0; i < 2; ++i) { int R, C; stage_rc(tid * 16 + i * 8192, R, C); const int Rb = Epi::PERM ? ((R & ~31) + perm32(R & 31)) : R;
        voffA[i] = (unsigned)(R * K + C) * 2u; voffB[i] = (unsigned)(Rb * K + C) * 2u; }
    const size_t kstep = (size_t)(BK * 2);
    const size_t hstep = (size_t)HALF * K * 2;
    const size_t tstep = 2 * hstep;
    const unsigned ldsw = (unsigned)wid * 1024u;
    const int aoff = lds_byte(wr * 64 + fr, fq * 8), boff = lds_byte(wc * 32 + fr, fq * 8);
#define PG8_SA(b, h) (((b) * 2 + (h)) * HTB)
#define PG8_SB(b, h) ((4 + (b) * 2 + (h)) * HTB)
#define PG8_STAGE(bufoff, gbase, voff) do { _Pragma("unroll") for (int _i = 0; _i < 2; ++_i) \
        __builtin_amdgcn_global_load_lds((const unsigned*)((const char*)(gbase) + (voff)[_i]), (PG8_LAS unsigned*)(lds + (bufoff) + ldsw + _i * 8192), 16, 0, 0); } while (0)
#define PG8_LDA(dst, b, h) do { _Pragma("unroll") for (int m = 0; m < 4; ++m) _Pragma("unroll") for (int k = 0; k < 2; ++k) dst[m][k] = *(const PG8_LAS bf16x8*)(lds + PG8_SA(b, h) + aoff + m * 2048 + k * 1024); } while (0)
#define PG8_LDB(dst, b, h) do { _Pragma("unroll") for (int n = 0; n < 2; ++n) _Pragma("unroll") for (int k = 0; k < 2; ++k) dst[n][k] = *(const PG8_LAS bf16x8*)(lds + PG8_SB(b, h) + boff + n * 2048 + k * 1024); } while (0)
#define PG8_MMA(ai, bj, At, Bt) do { __builtin_amdgcn_s_setprio(1); _Pragma("unroll") for (int m = 0; m < 4; ++m) _Pragma("unroll") for (int n = 0; n < 2; ++n) _Pragma("unroll") for (int k = 0; k < 2; ++k) \
        acc[ai][bj][m][n] = __builtin_amdgcn_mfma_f32_16x16x32_bf16(Bt[n][k], At[m][k], acc[ai][bj][m][n], 0, 0, 0); __builtin_amdgcn_s_setprio(0); } while (0)
#define PG8_WAIT_V(n) asm volatile("s_waitcnt vmcnt(" #n ")" ::: "memory")
#define PG8_WAIT_L(n) asm volatile("s_waitcnt lgkmcnt(" #n ")" ::: "memory")
#define PG8_BAR __builtin_amdgcn_s_barrier()
#define PG8_SCHED __builtin_amdgcn_sched_barrier(0)
    Unit cur, nxt; int ui = 0;
    if (!S.next(0, cur)) return;
    f32x4 acc[2][2][4][2];
#pragma unroll
    for (int a = 0; a < 2; ++a)
#pragma unroll
        for (int b = 0; b < 2; ++b)
#pragma unroll
            for (int m = 0; m < 4; ++m)
#pragma unroll
                for (int n = 0; n < 2; ++n) acc[a][b][m][n] = (f32x4){0.f, 0.f, 0.f, 0.f};
    bf16x8 At[4][2], B0[2][2], B1[2][2];
    const char* cA = (const char*)g.A + (size_t)cur.pm * tstep; const char* cB = (const char*)g.Bt + (size_t)cur.pn * tstep;
    S.a_ready(cur);
    if constexpr (SP2) {
        PG8_STAGE(PG8_SB(0, 0), cB, voffB); PG8_STAGE(PG8_SB(0, 1), cB + hstep, voffB); PG8_STAGE(PG8_SA(0, 0), cA, voffA); PG8_STAGE(PG8_SA(0, 1), cA + hstep, voffA);
        if (wr == 1) PG8_BAR;
        PG8_WAIT_V(2); PG8_BAR;
        PG8_STAGE(PG8_SB(1, 0), cB + kstep, voffB); PG8_STAGE(PG8_SA(1, 0), cA + kstep, voffA); PG8_STAGE(PG8_SB(1, 1), cB + hstep + kstep, voffB);
        PG8_WAIT_V(6); PG8_BAR;
    } else {
        PG8_STAGE(PG8_SB(0, 0), cB, voffB); PG8_STAGE(PG8_SA(0, 0), cA, voffA); PG8_STAGE(PG8_SB(0, 1), cB + hstep, voffB); PG8_STAGE(PG8_SA(0, 1), cA + hstep, voffA);
        if (wr == 1) PG8_BAR;
        PG8_WAIT_V(4); PG8_BAR;
        PG8_STAGE(PG8_SB(1, 0), cB + kstep, voffB); PG8_STAGE(PG8_SA(1, 0), cA + kstep, voffA); PG8_STAGE(PG8_SB(1, 1), cB + hstep + kstep, voffB);
        PG8_WAIT_V(6); PG8_BAR;
    }
    for (;;) {
        const bool has_next = S.next(ui + 1, nxt);
        const char* nA = has_next ? (const char*)g.A + (size_t)nxt.pm * tstep : cA; const char* nB = has_next ? (const char*)g.Bt + (size_t)nxt.pn * tstep : cB;
        for (int t = 0; t < nt; t += 2) {
            const bool last = (t == nt - 2);
            const char* a1 = cA + (size_t)(t + 1) * kstep;
            const char* a2 = last ? nA : cA + (size_t)(t + 2) * kstep; const char* b2 = last ? nB : cB + (size_t)(t + 2) * kstep;
            const char* a3 = a2 + kstep; const char* b3 = b2 + kstep;
            if (last && has_next) S.a_ready(nxt);
            if constexpr (SP2) {
            PG8_LDB(B0, 0, 0); PG8_LDB(B1, 0, 1); PG8_SCHED; PG8_LDA(At, 0, 0); PG8_STAGE(PG8_SA(1, 1), a1 + hstep, voffA);
            PG8_WAIT_V(8); PG8_WAIT_L(0); PG8_BAR; PG8_MMA(0, 0, At, B0); PG8_MMA(0, 1, At, B1); PG8_BAR; PG8_SCHED;
            PG8_LDA(At, 0, 1); PG8_STAGE(PG8_SB(0, 0), b2, voffB); PG8_STAGE(PG8_SB(0, 1), b2 + hstep, voffB); PG8_STAGE(PG8_SA(0, 0), a2, voffA);
            PG8_WAIT_V(8); PG8_WAIT_L(0); PG8_BAR; PG8_MMA(1, 0, At, B0); PG8_MMA(1, 1, At, B1); PG8_BAR; PG8_SCHED;
            PG8_LDB(B0, 1, 0); PG8_LDB(B1, 1, 1); PG8_SCHED; PG8_LDA(At, 1, 0); PG8_STAGE(PG8_SA(0, 1), a2 + hstep, voffA);
            PG8_WAIT_V(8); PG8_WAIT_L(0); PG8_BAR; PG8_MMA(0, 0, At, B0); PG8_MMA(0, 1, At, B1); PG8_BAR; PG8_SCHED;
            PG8_LDA(At, 1, 1); PG8_STAGE(PG8_SB(1, 0), b3, voffB); PG8_STAGE(PG8_SB(1, 1), b3 + hstep, voffB); PG8_STAGE(PG8_SA(1, 0), a3, voffA);
            PG8_WAIT_V(8); PG8_WAIT_L(0); PG8_BAR; PG8_MMA(1, 0, At, B0); PG8_MMA(1, 1, At, B1); PG8_BAR; PG8_SCHED;
            } else {
            PG8_LDB(B0, 0, 0); PG8_SCHED; PG8_LDA(At, 0, 0); PG8_STAGE(PG8_SA(1, 1), a1 + hstep, voffA);
            PG8_WAIT_L(8); PG8_BAR; PG8_WAIT_L(0); PG8_MMA(0, 0, At, B0); PG8_BAR; PG8_SCHED;
            PG8_LDB(B1, 0, 1); PG8_STAGE(PG8_SB(0, 0), b2, voffB);
            PG8_BAR; PG8_WAIT_L(0); PG8_MMA(0, 1, At, B1); PG8_BAR;
            PG8_LDA(At, 0, 1); PG8_STAGE(PG8_SA(0, 0), a2, voffA);
            PG8_BAR; PG8_WAIT_L(0); PG8_MMA(1, 0, At, B0); PG8_BAR; PG8_SCHED;
            PG8_STAGE(PG8_SB(0, 1), b2 + hstep, voffB);
            PG8_WAIT_V(6); PG8_BAR; PG8_MMA(1, 1, At, B1); PG8_BAR;
            PG8_LDB(B0, 1, 0); PG8_SCHED; PG8_LDA(At, 1, 0); PG8_STAGE(PG8_SA(0, 1), a2 + hstep, voffA);
            PG8_WAIT_L(8); PG8_BAR; PG8_WAIT_L(0); PG8_MMA(0, 0, At, B0); PG8_BAR; PG8_SCHED;
            PG8_LDB(B1, 1, 1); PG8_STAGE(PG8_SB(1, 0), b3, voffB);
            PG8_BAR; PG8_WAIT_L(0); PG8_MMA(0, 1, At, B1); PG8_BAR;
            PG8_LDA(At, 1, 1); PG8_STAGE(PG8_SA(1, 0), a3, voffA);
            PG8_BAR; PG8_WAIT_L(0); PG8_MMA(1, 0, At, B0); PG8_BAR; PG8_SCHED;
            PG8_STAGE(PG8_SB(1, 1), b3 + hstep, voffB);
            PG8_WAIT_V(6); PG8_BAR; PG8_MMA(1, 1, At, B1); PG8_BAR;
            }
        }
        if constexpr (ALIGN_EPI) { if (wr == 0) PG8_BAR; }
        if constexpr (!Epi::AFTER_DRAIN) { E(acc, cur, wr, wc, fr, fq); S.done(cur); }
        if (!has_next) break;
#pragma unroll
        for (int a = 0; a < 2; ++a)
#pragma unroll
            for (int b = 0; b < 2; ++b)
#pragma unroll
                for (int m = 0; m < 4; ++m)
#pragma unroll
                    for (int n = 0; n < 2; ++n) acc[a][b][m][n] = (f32x4){0.f, 0.f, 0.f, 0.f};
        cur = nxt; cA = nA; cB = nB; ++ui;
        if constexpr (ALIGN_EPI) { if (wr == 1) PG8_BAR; }
    }
    PG8_WAIT_V(0);
    if constexpr (!ALIGN_EPI) { if (wr == 0) PG8_BAR; }
    PG8_BAR;
    if constexpr (Epi::AFTER_DRAIN) { E.fused(acc, cur, wr, wc, fr, fq, lds, wid, lane); S.done(cur); }
#undef PG8_SA
#undef PG8_SB
#undef PG8_STAGE
#undef PG8_LDA
#undef PG8_LDB
#undef PG8_MMA
#undef PG8_WAIT_V
#undef PG8_WAIT_L
#undef PG8_BAR
#undef PG8_SCHED
}
}
namespace att {
typedef float f32x16 __attribute__((ext_vector_type(16)));
typedef float f32x4 __attribute__((ext_vector_type(4)));
typedef short bf16x8 __attribute__((ext_vector_type(8)));
typedef short s16x4 __attribute__((ext_vector_type(4)));
typedef unsigned u32x4 __attribute__((ext_vector_type(4)));
#define ALAS __attribute__((address_space(3)))
constexpr int KCS = 1040, VDS = 4160, KBUF = 8 * KCS, VBUF = 4 * VDS, KBOFF = KBUF + VBUF, STG = KBOFF + 256, NSLOT = 3;
constexpr int L_WSF = NSLOT * STG, L_OST = L_WSF + 8 * 256, L_END = L_OST + 8 * 8192;
constexpr float LOG2E = 1.4426950408889634f, C2 = 0.125f * LOG2E, THR = 8.f, NEGBIG = -1e30f;
__device__ __forceinline__ int crow(int r, int hi) { return (r & 3) + 8 * (r >> 2) + 4 * hi; }
__device__ __forceinline__ unsigned cvtpk(float lo, float hi) { typedef float f2 __attribute__((ext_vector_type(2))); typedef __bf16 b2 __attribute__((ext_vector_type(2))); f2 v = {lo, hi}; b2 b = __builtin_convertvector(v, b2); return __builtin_bit_cast(unsigned, b); }
__device__ __forceinline__ s16x4 vtr(const ALAS unsigned char* p) { typedef short v4i16_t __attribute__((ext_vector_type(4))); return __builtin_bit_cast(s16x4, __builtin_amdgcn_ds_read_tr16_b64_v4i16((ALAS v4i16_t*)p)); }
__device__ __forceinline__ float bfl(unsigned w) { return __uint_as_float(w << 16); }
__device__ __forceinline__ float bfh(unsigned w) { return __uint_as_float(w & 0xffff0000u); }
__device__ __forceinline__ float silu_f(float x) { return x / (1.f + fexp(-x)); }
__device__ __forceinline__ void glds16(const void* gsrc, unsigned lds_dst) { unsigned keep;
    asm volatile("s_mov_b32 %0, m0\n\ts_mov_b32 m0, %2\n\ts_nop 0\n\tglobal_load_lds_dwordx4 %1, off\n\ts_mov_b32 m0, %0" : "=&s"(keep) : "v"(gsrc), "s"(lds_dst) : "memory"); }
__device__ __forceinline__ void glds4(const void* gsrc, unsigned lds_dst) { unsigned keep;
    asm volatile("s_mov_b32 %0, m0\n\ts_mov_b32 m0, %2\n\ts_nop 0\n\tglobal_load_lds_dword %1, off\n\ts_mov_b32 m0, %0" : "=&s"(keep) : "v"(gsrc), "s"(lds_dst) : "memory"); }
#define ATT_WAIT_BAR(N) asm volatile("s_waitcnt vmcnt(" #N ") lgkmcnt(0)\n\ts_barrier" ::: "memory")

template <int MODE> __device__ __forceinline__ void dma_tile(unsigned slot, const bf16_t* __restrict__ PROJ, const float* __restrict__ CUM, size_t krow0, int kcol, int vcol, int h, int wid, int lane) {
    if (MODE == 0 && wid == 0) glds4(CUM + (size_t)h * MTP + krow0 + lane, (unsigned)__builtin_amdgcn_readfirstlane(slot + KBOFF));
    glds16(PROJ + (krow0 + lane) * NP + kcol + wid * 8, (unsigned)__builtin_amdgcn_readfirstlane(slot + wid * KCS));
    const bf16_t* vs = PROJ + (krow0 + (wid & 3) * 16 + (lane >> 2)) * NP + vcol + (wid >> 2) * 32 + (lane & 3) * 8;
    glds16(vs, (unsigned)__builtin_amdgcn_readfirstlane(slot + KBUF + (wid >> 2) * VDS + (wid & 3) * 1024));
    if (MODE == 1) glds16(vs + 64, (unsigned)__builtin_amdgcn_readfirstlane(slot + KBUF + (2 + (wid >> 2)) * VDS + (wid & 3) * 1024));
}

template <int MODE, bool DIAG> __device__ __forceinline__ bool qs_front(const ALAS unsigned char* buf, const ALAS unsigned char* vprev, s16x4 (&vl)[8], s16x4 (&vh)[8], const bf16x8 (&qr)[4], const ALAS bf16x8* qlds, f32x16& p0, f32x16& p1, float& mhat, float& l,
        int kidx0, bool meta, int qw0, float slope2, ALAS float* wsf, int lane) {
    constexpr bool diag = DIAG;
    const int r32 = lane & 31, hi = lane >> 5;
    {
      const ALAS unsigned char* vb = vprev + KBUF + ((lane >> 4) & 1) * 32 + (lane & 3) * 8 + (4 * hi + ((lane & 15) >> 2)) * 64; asm volatile("" : "+v"(vb));
#pragma unroll
      for (int i = 0; i < (MODE == 0 ? 8 : 4); ++i) { vl[i] = vtr(vb + (i & 1) * VDS + (i >> 1) * 1024); vh[i] = vtr(vb + (i & 1) * VDS + (i >> 1) * 1024 + 512); } }
    asm volatile("" : "+v"(slope2), "+s"(kidx0));
    if (MODE == 0) {
        const ALAS f32x4* kbp = (const ALAS f32x4*)(buf + KBOFF + hi * 16); asm volatile("" : "+v"(kbp));
#pragma unroll
        for (int g = 0; g < 4; ++g) { const f32x4 a = kbp[2 * g], b = kbp[8 + 2 * g];
#pragma unroll
            for (int j = 0; j < 4; ++j) { p0[4 * g + j] = fmaf(a[j], -LOG2E, -mhat); p1[4 * g + j] = fmaf(b[j], -LOG2E, -mhat); } }
    } else {
        if (!diag) {
            const float base = slope2 * (float)(kidx0 + 4 * hi - qw0) - mhat;
#pragma unroll
            for (int r = 0; r < 16; ++r) { const int c = (r & 3) + 8 * (r >> 2); p0[r] = fmaf((float)c, slope2, base); p1[r] = fmaf((float)(c + 32), slope2, base); }
            if (meta) {
#pragma unroll
                for (int r = 0; r < 16; ++r) { if ((r >> 2) >= 2) p0[r] = NEGBIG; p1[r] = NEGBIG; }
            }
        } else {
            const float dq = (float)(qw0 + r32 - kidx0 - 4 * hi), fr = (float)r32;
#pragma unroll
            for (int r = 0; r < 16; ++r) { const int c = (r & 3) + 8 * (r >> 2);
                p0[r] = slope2 * (fr - fabsf(dq - (float)c)) - mhat; p1[r] = slope2 * (fr - fabsf(dq - (float)(c + 32))) - mhat; }
        }
    }
    { const ALAS unsigned char* kb = buf + hi * KCS + r32 * 16; asm volatile("" : "+v"(kb));
#pragma unroll
      for (int d0 = 0; d0 < 4; ++d0) {
          const bf16x8 k0 = *(const ALAS bf16x8*)(kb + d0 * 2 * KCS), k1 = *(const ALAS bf16x8*)(kb + d0 * 2 * KCS + 512);
          const bf16x8 qf = MODE == 0 ? qr[d0] : qlds[d0 * 64];
          p0 = __builtin_amdgcn_mfma_f32_32x32x16_bf16(k0, qf, p0, 0, 0, 0);
          p1 = __builtin_amdgcn_mfma_f32_32x32x16_bf16(k1, qf, p1, 0, 0, 0); } }
    if (MODE == 0 && diag) {
        const int lim = qw0 + r32 - kidx0 - 4 * hi;
#pragma unroll
        for (int r = 0; r < 16; ++r) { const int c = (r & 3) + 8 * (r >> 2); if (c > lim) p0[r] = NEGBIG; if (c + 32 > lim) p1[r] = NEGBIG; }
    }
    float rm;
    {
#define ATT_MX3(a, b, c) __builtin_fmaxf(__builtin_fmaxf((a), (b)), (c))
      float a = ATT_MX3(p0[0], p0[1], p1[0]), b = ATT_MX3(p0[2], p0[3], p1[1]); a = ATT_MX3(a, p1[2], p1[3]);
#pragma unroll
      for (int r = 4; r < 16; r += 4) { a = ATT_MX3(a, p0[r], p0[r + 1]); b = ATT_MX3(b, p0[r + 2], p0[r + 3]); a = ATT_MX3(a, p1[r], p1[r + 1]); b = ATT_MX3(b, p1[r + 2], p1[r + 3]); }
#undef ATT_MX3
      a = __builtin_fmaxf(a, b);
      auto rr = __builtin_amdgcn_permlane32_swap(__float_as_uint(a), __float_as_uint(a), false, false);
      rm = __builtin_fmaxf(__uint_as_float(rr[0]), __uint_as_float(rr[1])); }
    bool resc = false;
    if (__any(rm > THR)) {
        const float dl = fmaxf(rm, 0.f); mhat += dl;
#pragma unroll
        for (int r = 0; r < 16; ++r) { p0[r] -= dl; p1[r] -= dl; }
        const float f = __builtin_amdgcn_exp2f(-dl); l *= f; if (hi == 0) wsf[r32] = f; resc = true;
    }
    return resc;
}
#define ATT_SBAR() __builtin_amdgcn_sched_barrier(0)
#define ATT_PIN(x) asm volatile("" : "+v"(x))
#define ATT_VF(L, H, i) (bf16x8){L[i][0], L[i][1], L[i][2], L[i][3], H[i][0], H[i][1], H[i][2], H[i][3]}
template <int NDB> __device__ __forceinline__ void pv_exp(const ALAS unsigned char* vbuf, s16x4 (&vl)[8], s16x4 (&vh)[8], const u32x4 (&pwo)[4], f32x16 (&o)[NDB], f32x16& p0, f32x16& p1, u32x4 (&pwn)[4], float& l, int lane) {
    const int hi = lane >> 5;
    float s0 = 0.f, s1 = 0.f, s2 = 0.f, s3 = 0.f;
    ATT_SBAR();
    if (NDB == 2) {
#pragma unroll
        for (int k = 0; k < 8; ++k) {
            o[k & 1] = __builtin_amdgcn_mfma_f32_32x32x16_bf16(__builtin_bit_cast(bf16x8, pwo[k >> 1]), ATT_VF(vl, vh, k), o[k & 1], 0, 0, 0);
            p0[2 * k] = __builtin_amdgcn_exp2f(p0[2 * k]); p0[2 * k + 1] = __builtin_amdgcn_exp2f(p0[2 * k + 1]); p1[2 * k] = __builtin_amdgcn_exp2f(p1[2 * k]); p1[2 * k + 1] = __builtin_amdgcn_exp2f(p1[2 * k + 1]);
            s0 += p0[2 * k]; s1 += p0[2 * k + 1]; s2 += p1[2 * k]; s3 += p1[2 * k + 1];
            pwn[k >> 2][k & 3] = cvtpk(p0[2 * k], p0[2 * k + 1]); pwn[2 + (k >> 2)][k & 3] = cvtpk(p1[2 * k], p1[2 * k + 1]);
            ATT_PIN(p0); ATT_PIN(p1); ATT_PIN(s0); ATT_PIN(s1); ATT_PIN(s2); ATT_PIN(s3); ATT_PIN(pwn[k >> 2]); ATT_PIN(pwn[2 + (k >> 2)]);
            ATT_SBAR();
        }
    } else {
        const ALAS unsigned char* vb = vbuf + KBUF + ((lane >> 4) & 1) * 32 + (lane & 3) * 8 + (4 * hi + ((lane & 15) >> 2)) * 64; asm volatile("" : "+v"(vb));
        s16x4 (&wl)[8] = vl; s16x4 (&wh)[8] = vh;
#pragma unroll
        for (int k = 0; k < 16; ++k) {
            const int blk = 2 * (k >> 3) + (k & 1), ks = (k >> 1) & 3;
            o[blk] = __builtin_amdgcn_mfma_f32_32x32x16_bf16(__builtin_bit_cast(bf16x8, pwo[ks]), ATT_VF(wl, wh, k & 3), o[blk], 0, 0, 0);
            if (k + 4 < 16) { const int j = k + 4, jb = 2 * (j >> 3) + (j & 1), jk = (j >> 1) & 3; wl[k & 3] = vtr(vb + jb * VDS + jk * 1024); wh[k & 3] = vtr(vb + jb * VDS + jk * 1024 + 512); }
            if (k < 8) { p0[2 * k] = __builtin_amdgcn_exp2f(p0[2 * k]); p0[2 * k + 1] = __builtin_amdgcn_exp2f(p0[2 * k + 1]); s0 += p0[2 * k]; s1 += p0[2 * k + 1];
                pwn[k >> 2][k & 3] = cvtpk(p0[2 * k], p0[2 * k + 1]); ATT_PIN(p0); ATT_PIN(s0); ATT_PIN(s1); ATT_PIN(pwn[k >> 2]); }
            else { const int q = k - 8; p1[2 * q] = __builtin_amdgcn_exp2f(p1[2 * q]); p1[2 * q + 1] = __builtin_amdgcn_exp2f(p1[2 * q + 1]); s2 += p1[2 * q]; s3 += p1[2 * q + 1];
                pwn[2 + (q >> 2)][q & 3] = cvtpk(p1[2 * q], p1[2 * q + 1]); ATT_PIN(p1); ATT_PIN(s2); ATT_PIN(s3); ATT_PIN(pwn[2 + (q >> 2)]); }
            ATT_SBAR();
        }
    }
    l += (s0 + s1) + (s2 + s3);
}
template <int NDB> __device__ __forceinline__ void pv_only(const ALAS unsigned char* vbuf, const u32x4 (&pwo)[4], f32x16 (&o)[NDB], int lane) {
    const int hi = lane >> 5;
    const ALAS unsigned char* vb = vbuf + KBUF + ((lane >> 4) & 1) * 32 + (lane & 3) * 8 + (4 * hi + ((lane & 15) >> 2)) * 64; asm volatile("" : "+v"(vb));
#pragma unroll
    for (int d = 0; d < NDB; ++d) {
        s16x4 lo[4], hh[4];
#pragma unroll
        for (int ks = 0; ks < 4; ++ks) { lo[ks] = vtr(vb + d * VDS + ks * 1024); hh[ks] = vtr(vb + d * VDS + ks * 1024 + 512); }
#pragma unroll
        for (int ks = 0; ks < 4; ++ks) o[d] = __builtin_amdgcn_mfma_f32_32x32x16_bf16(__builtin_bit_cast(bf16x8, pwo[ks]), ATT_VF(lo, hh, ks), o[d], 0, 0, 0);
        ATT_SBAR();
    }
}
template <int NDB> __device__ __forceinline__ void rescale_o(f32x16 (&o)[NDB], const ALAS float* wsf, int lane) {
    const int hi = lane >> 5;
#pragma unroll
    for (int r = 0; r < 16; ++r) { const float f = wsf[crow(r, hi)];
#pragma unroll
        for (int d = 0; d < NDB; ++d) o[d][r] *= f; }
}
__device__ __forceinline__ u32x4 gate8(u32x4 v, u32x4 z) {
    u32x4 o;
#pragma unroll
    for (int j = 0; j < 4; ++j) { const float a = bfl(v[j]) * silu_f(bfl(z[j])), b = bfh(v[j]) * silu_f(bfh(z[j])); o[j] = cvtpk(a, b); }
    return o;
}


template <int NDB> __device__ __forceinline__ void stage_gate_store(const f32x16 (&res)[NDB], ALAS bf16_t* stg, const bf16_t* __restrict__ zbase, bf16_t* __restrict__ mbase, int lane) {
    const int r32 = lane & 31, hi = lane >> 5;
#pragma unroll
    for (int r = 0; r < 16; ++r) { const int orow = crow(r, hi);
#pragma unroll
        for (int d = 0; d < NDB; ++d) stg[orow * (NDB * 32) + d * 32 + r32] = f2bf(res[d][r]); }
    constexpr int CPR = NDB * 4;
    constexpr int RPP = 64 / CPR;
#pragma unroll
    for (int i = 0; i < 32 / RPP; ++i) {
        const int row = i * RPP + lane / CPR, ch = lane % CPR;
        const u32x4 v = *(const ALAS u32x4*)(stg + row * (NDB * 32) + ch * 8);
        const u32x4 z = *(const u32x4*)(zbase + (size_t)row * NP + ch * 8);
        *(u32x4*)(mbase + (size_t)row * DM + ch * 8) = gate8(v, z);
    }
}

template <int MODE> __device__ __forceinline__ void attn_unit(ALAS unsigned char* lds, const bf16_t* __restrict__ PROJ, const float* __restrict__ CUM, bf16_t* __restrict__ MIX,
        int b, int h, int qb, float lam, float li, const float* __restrict__ subg, float* park, const unsigned* __restrict__ kmx) {
    constexpr int NDB = MODE == 1 ? 4 : 2, NBR = MODE == 1 ? 2 : 1, HS = MODE == 1 ? 128 : 64;
    int tid_ = threadIdx.x; asm volatile("" : "+v"(tid_));
    const int tid = tid_, lane = tid & 63, r32 = lane & 31, hi = lane >> 5, wid = __builtin_amdgcn_readfirstlane(tid >> 6);
    const int q0 = qb * 256, qw0 = q0 + wid * 32;
    const size_t rowb = (size_t)b * SEQ;
    const int NT = 4 * qb + 4, my_last = 4 * qb + (wid >> 1);
    ALAS float* wsf = (ALAS float*)(lds + L_WSF) + wid * 64;
    const unsigned ldsb = (unsigned)(size_t)lds;
    const float slope2 = MODE == 1 ? LOG2E / (float)(1 << (2 * h + 2)) : 0.f;
    f32x16 res[NDB];
#pragma clang loop unroll(disable)
    for (int c = 0; c < NBR; ++c) {
        const int qcol = MODE == 0 ? C_FQ + h * 64 : C_DQ + h * 128 + c * 64;
        const int kcol = MODE == 0 ? C_FK + h * 64 : C_DK + h * 128 + c * 64;
        const int vcol = MODE == 0 ? C_FV + h * 64 : C_DV + h * 128;
        bf16x8 qr[4];
        { const bf16_t* Qw = PROJ + (rowb + qw0 + r32) * NP + qcol + hi * 8;
#pragma unroll
          for (int d0 = 0; d0 < 4; ++d0) qr[d0] = *(const bf16x8*)(Qw + d0 * 16); }
        const ALAS bf16x8* qlds = (const ALAS bf16x8*)(lds + L_OST + wid * 8192) + lane;
        if (MODE == 1) {
#pragma unroll
            for (int d0 = 0; d0 < 4; ++d0) ((ALAS bf16x8*)qlds)[d0 * 64] = qr[d0];
        }
        float mhat = MODE == 0 ? -CUM[(size_t)h * MTP + rowb + qw0] * LOG2E : 0.f, l = 0.f;
        int T_min;
        { const int sq = MODE == 0 ? h : 8 + h * 2 + c, sk = MODE == 0 ? 4 + h : 16 + h * 2 + c, T = lane, band0 = 4 * qb;
          const float k2 = __uint_as_float(kmx[((sk * 2 + 0) * 8 + b) * 64 + T]) + __uint_as_float(kmx[((sk * 2 + 1) * 8 + b) * 64 + T]);
          const float q2 = __uint_as_float(kmx[((sq * 2 + 0) * 8 + b) * 64 + T]) + __uint_as_float(kmx[((sq * 2 + 1) * 8 + b) * 64 + T]);
          const bool inband = T >= band0 && T < NT;
          const float kn = sqrtf(k2) * 1.01f;
          float qv = inband ? q2 : 0.f, kv = inband ? kn : 0.f;
#pragma unroll
          for (int m = 1; m < 64; m <<= 1) { qv = fmaxf(qv, shx(qv, m, lane)); kv = fmaxf(kv, shx(kv, m, lane)); }
          const float Qn = sqrtf(qv) * 1.01f, Lown = Qn * kv;
          float D;
          if (MODE == 0) { const int kr = T < band0 ? 64 * T + 63 : q0; D = (CUM[(size_t)h * MTP + rowb + q0] - CUM[(size_t)h * MTP + rowb + kr]) * LOG2E; }
          else D = -slope2 * (float)(q0 - 64 * T - 63);
          const bool need = inband || (T < band0 && (Qn * kn + D + Lown > -40.f));
          const unsigned long long mask = __ballot(need);
          T_min = __builtin_amdgcn_readfirstlane((int)__builtin_ctzll(mask));
          if ((NT - T_min) & 1) T_min -= 1; }
        const int NTr = NT - T_min;
        f32x16 o[NDB];
#pragma unroll
        for (int d = 0; d < NDB; ++d)
#pragma unroll
            for (int r = 0; r < 16; ++r) o[d][r] = 0.f;
        u32x4 pwa[4], pwb[4]; f32x16 p0, p1; s16x4 vl[8], vh[8];
#pragma unroll
        for (int k = 0; k < 4; ++k) { pwa[k] = (u32x4){0u, 0u, 0u, 0u}; pwb[k] = (u32x4){0u, 0u, 0u, 0u}; }
#define ATT_TROW(i) ((i) < NTr ? rowb + (size_t)(NT - 1 - (i)) * 64 : (size_t)MR)
#define ATT_STEP(i, PIN_, POUT_) do { \
            if ((i) + 1 <= NTr) dma_tile<MODE>(ldsb + (unsigned)s_next, PROJ, CUM, ATT_TROW((i) + 1), kcol, vcol, h, wid, lane);     \
            const bool mt_ = ((i) == NTr); const int t_ = NT - 1 - (i); \
            if (mt_ || t_ <= my_last) { \
                bool resc_; \
                if ((!mt_) && t_ == my_last) resc_ = qs_front<MODE, true>(lds + s_cur, lds + s_prev, vl, vh, qr, qlds, p0, p1, mhat, l, 64 * t_, false, qw0, slope2, wsf, lane); \
                else resc_ = qs_front<MODE, false>(lds + s_cur, lds + s_prev, vl, vh, qr, qlds, p0, p1, mhat, l, mt_ ? -16 : 64 * t_, mt_, qw0, slope2, wsf, lane); \
                pv_exp<NDB>(lds + s_prev, vl, vh, PIN_, o, p0, p1, POUT_, l, lane); \
                if (resc_) rescale_o<NDB>(o, wsf, lane); \
            } \
            ATT_WAIT_BAR(0);        \
            { const int tt = s_prev; s_prev = s_cur; s_cur = s_next; s_next = tt; } } while (0)
        dma_tile<MODE>(ldsb, PROJ, CUM, ATT_TROW(0), kcol, vcol, h, wid, lane);
        dma_tile<MODE>(ldsb + 2 * STG, PROJ, CUM, ATT_TROW(0), kcol, vcol, h, wid, lane);
        ATT_WAIT_BAR(0);
        int s_prev = 2 * STG, s_cur = 0, s_next = STG;
#pragma clang loop unroll(disable)
        for (int i = 0; i < NTr; i += 2) { ATT_STEP(i, pwa, pwb); ATT_STEP(i + 1, pwb, pwa); }
        ATT_STEP(NTr, pwa, pwb);
        pv_only<NDB>(lds + s_prev, pwb, o, lane);
#undef ATT_STEP
#undef ATT_TROW
        ATT_WAIT_BAR(0);
        { auto rr = __builtin_amdgcn_permlane32_swap(__float_as_uint(l), __float_as_uint(l), false, false); l = __uint_as_float(rr[0]) + __uint_as_float(rr[1]); }
        if (hi == 0) wsf[32 + r32] = l;
        float rli[16];
#pragma unroll
        for (int r = 0; r < 16; ++r) rli[r] = 1.f / wsf[32 + crow(r, hi)];
        if (MODE == 0) {
#pragma unroll
            for (int d = 0; d < NDB; ++d)
#pragma unroll
                for (int r = 0; r < 16; ++r) res[d][r] = o[d][r] * rli[r];
        } else {
            float* pk = park + c * 4096 + lane;
#pragma unroll
            for (int d = 0; d < NDB; ++d) {
                float* pkd = pk + d * 1024; asm volatile("" : "+v"(pkd));
#pragma unroll
                for (int r = 0; r < 16; ++r) pkd[r * 64] = o[d][r] * rli[r];
            }
        }
    }
    if (MODE == 1) {
#pragma unroll
        for (int d = 0; d < NDB; ++d) {
            const float* pa = park + lane + d * 1024; const float* pb = pa + 4096; asm volatile("" : "+v"(pa), "+v"(pb));
#pragma unroll
            for (int r = 0; r < 16; ++r) res[d][r] = pa[r * 64] - lam * pb[r * 64];
            __builtin_amdgcn_sched_barrier(0);
        }
    }
    ALAS bf16_t* stg = (ALAS bf16_t*)(lds + L_OST + wid * 8192);
    if (MODE == 1) {
        float ss[16];
#pragma unroll
        for (int r = 0; r < 16; ++r) { float s = 0.f;
#pragma unroll
            for (int d = 0; d < NDB; ++d) s += res[d][r] * res[d][r];
            ss[r] = s; }
#pragma unroll
        for (int m = 1; m < 32; m <<= 1)
#pragma unroll
            for (int r = 0; r < 16; ++r) ss[r] += shx(ss[r], m, lane);
        float gc[NDB];
#pragma unroll
        for (int d = 0; d < NDB; ++d) gc[d] = subg[32 * d + r32] * (1.f - li);
#pragma unroll
        for (int r = 0; r < 16; ++r) { const float rs = rsqrtf(ss[r] * (1.f / 128.f) + 1e-5f);
#pragma unroll
            for (int d = 0; d < NDB; ++d) res[d][r] *= rs * gc[d]; }
    }
    const int zcol = MODE == 0 ? C_FZ + h * 64 : C_DZ + h * 128, mcol = MODE == 0 ? M_A + h * 64 : M_B + h * 128;
    stage_gate_store<NDB>(res, stg, PROJ + (rowb + qw0) * NP + zcol, MIX + (rowb + qw0) * DM + mcol, lane);
}

__device__ __forceinline__ void pool_unit(ALAS unsigned char* lds, const bf16_t* __restrict__ PROJ, const bf16_t* __restrict__ WPT_l, const float* __restrict__ pscale_l, bf16_t* __restrict__ MIX, int unit) {
    int tid_ = threadIdx.x; asm volatile("" : "+v"(tid_));
    const int tid = tid_, lane = tid & 63, r32 = lane & 31, hi = lane >> 5, wid = __builtin_amdgcn_readfirstlane(tid >> 6);
    const int g = wid & 3, win = 2 << g; const float invw = 1.f / (float)win;
    const int Rw = unit * 128 + (wid >> 2) * 64, b = Rw >> 12, tw = Rw & 4095;
    ALAS bf16_t* stg = (ALAS bf16_t*)(lds + L_OST + wid * 8192);
    bf16x8 wb[2][4];
#pragma unroll
    for (int nb = 0; nb < 2; ++nb)
#pragma unroll
        for (int ks = 0; ks < 4; ++ks) wb[nb][ks] = *(const bf16x8*)(WPT_l + ((g * 64 + 32 * nb + r32) * 64 + 16 * ks + 8 * hi));
    const float ps0 = pscale_l[g * 64 + r32], ps1 = pscale_l[g * 64 + 32 + r32];
    for (int blk = 0; blk < 2; ++blk) {
        const int t = tw + 32 * blk + r32;
        f32x16 acc[2];
#pragma unroll
        for (int r = 0; r < 16; ++r) { acc[0][r] = 0.f; acc[1][r] = 0.f; }
#pragma unroll
        for (int ks = 0; ks < 4; ++ks) {
            const int c0 = C_PU + g * 64 + 16 * ks + 8 * hi;
            float s[8], own[8];
#pragma unroll
            for (int j = 0; j < 8; ++j) { s[j] = 0.f; own[j] = 0.f; }
            for (int i = 0; i < win; ++i) {
                const int ti = t - i; const size_t row = ti >= 0 ? (size_t)b * SEQ + ti : (size_t)(MR + 16 + ti);
                const u32x4 v = *(const u32x4*)(PROJ + row * NP + c0);
#pragma unroll
                for (int j = 0; j < 4; ++j) { const float lo = bfl(v[j]), hh = bfh(v[j]); s[2 * j] += lo; s[2 * j + 1] += hh; if (i == 0) { own[2 * j] = lo; own[2 * j + 1] = hh; } }
            }
            u32x4 pa;
#pragma unroll
            for (int j = 0; j < 4; ++j) pa[j] = cvtpk(s[2 * j] * invw - own[2 * j], s[2 * j + 1] * invw - own[2 * j + 1]);
            const bf16x8 af = __builtin_bit_cast(bf16x8, pa);
            acc[0] = __builtin_amdgcn_mfma_f32_32x32x16_bf16(af, wb[0][ks], acc[0], 0, 0, 0);
            acc[1] = __builtin_amdgcn_mfma_f32_32x32x16_bf16(af, wb[1][ks], acc[1], 0, 0, 0);
        }
#pragma unroll
        for (int r = 0; r < 16; ++r) { acc[0][r] *= ps0; acc[1][r] *= ps1; }
        const size_t row0 = (size_t)Rw + 32 * blk;
        stage_gate_store<2>(acc, stg, PROJ + row0 * NP + C_PZ + g * 64, MIX + row0 * DM + M_C + g * 64, lane);
    }
}
#undef ALAS
}


#ifndef PG8_SP2
#define PG8_SP2 true
#endif
#ifndef PG8_ALIGN
#define PG8_ALIGN true
#endif
constexpr int NWAVES = 8;
constexpr int RING_OFF = 0, RING_BYTES = 143360;
constexpr int LDSCTL_OFF = RING_BYTES, MISC_OFF = LDSCTL_OFF + 320;
constexpr int LDS_BYTES = RING_BYTES + 1024;
constexpr int CW_TMO = 0, CW_CODE = 1, CW_BAR = 4096, CW_Q = 16384;
constexpr size_t CTL_ZERO_BYTES = 1 * MiB;
static_assert(att::L_END <= RING_BYTES, "attention LDS map");
#define GAS __attribute__((address_space(1)))
#define LAS __attribute__((address_space(3)))
typedef unsigned short bf16;
typedef unsigned v4u __attribute__((ext_vector_type(4)));
typedef float f32x4 __attribute__((ext_vector_type(4)));
typedef short bf16x8 __attribute__((ext_vector_type(8)));
typedef GAS unsigned gu32;
typedef GAS unsigned long long gu64;
#define RLX_AGENT __ATOMIC_RELAXED, __HIP_MEMORY_SCOPE_AGENT
#define LDS_WAIT() asm volatile("s_waitcnt lgkmcnt(0)" ::: "memory")
#define VM_WAIT() asm volatile("s_waitcnt vmcnt(0)" ::: "memory")
__device__ __forceinline__ unsigned long long rt() { return __builtin_amdgcn_s_memrealtime(); }

#define XB_TMO      128
#define XB_XCNT(j)  (256  + 64 * (j))
#define XB_XSUB(j)  (1280 + 64 * (j))
#define XB_XGEN(j)  (2304 + 64 * (j))
#define XB_TOP      3328
#define XB_TOPGEN   3392
#define XCD_BAR_WORDS 3456
#define XB_SPIN_CAP (1u << 18)

__device__ __forceinline__ unsigned xb_ld(unsigned* p)              { return __hip_atomic_load(p, __ATOMIC_RELAXED, __HIP_MEMORY_SCOPE_AGENT); }
__device__ __forceinline__ unsigned xb_add(unsigned* p, unsigned v) { return __hip_atomic_fetch_add(p, v, __ATOMIC_RELAXED, __HIP_MEMORY_SCOPE_AGENT); }
__device__ __forceinline__ unsigned xb_xcc_id() { return (unsigned)__builtin_amdgcn_s_getreg((3 << 11) | 20) & 0xFu; }
#define XB_SPIN(cond, bar) do { unsigned _sp = 0; while (cond) { __builtin_amdgcn_s_sleep(1); \
    if ((++_sp & 255u) == 0u) { if (xb_ld(&(bar)[XB_TMO])) break; if (_sp > XB_SPIN_CAP) { atomicAdd(&(bar)[XB_TMO], 1u); break; } } } } while (0)

struct XcdBarrier {
    unsigned* bar; unsigned x;
    volatile LAS unsigned* st;
};

__device__ __forceinline__ XcdBarrier xcd_barrier_post(unsigned* bar, volatile LAS unsigned* st) {
    XcdBarrier b; b.bar = bar; b.x = xb_xcc_id(); b.st = st;
    if (threadIdx.x == 0) (void)xb_add(&bar[XB_XCNT(b.x)], 1u);
    return b;
}
__device__ __forceinline__ void xcd_barrier_complete(unsigned* bar, unsigned x, unsigned& nloc, unsigned& nx) {
    const unsigned G = gridDim.x * gridDim.y * gridDim.z;
    unsigned sum, cnt, mine, sp = 0u;
    for (;;) {
        sum = 0u; cnt = 0u; mine = 0u;
#pragma unroll
        for (unsigned j = 0; j < 16; ++j) { const unsigned c = xb_ld(&bar[XB_XCNT(j)]); sum += c; cnt += (c > 0u) ? 1u : 0u; mine = (j == x) ? c : mine; }
        if (sum == G) break;
        __builtin_amdgcn_s_sleep(1);
        if ((++sp & 255u) == 0u) { if (xb_ld(&bar[XB_TMO])) break; if (sp > XB_SPIN_CAP) { atomicAdd(&bar[XB_TMO], 1u); break; } }
    }
    nloc = mine > 0u ? mine : 1u; nx = cnt > 0u ? cnt : 1u;
}

__device__ __forceinline__ void xcd_barrier(const XcdBarrier& b) {
    asm volatile("s_waitcnt vmcnt(0)" ::: "memory");
    __syncthreads();
    if (threadIdx.x == 0) {
        unsigned* bar = b.bar;
        __builtin_amdgcn_s_waitcnt(0);
        unsigned nloc = b.st[0], nx = b.st[1];
        if (nloc == 0u) { xcd_barrier_complete(bar, b.x, nloc, nx); b.st[0] = nloc; b.st[1] = nx; }
        const unsigned old = xb_add(&bar[XB_XSUB(b.x)], 1u);
        const unsigned gen = old / nloc;
        if (old + 1u == (gen + 1u) * nloc) {
            __builtin_amdgcn_fence(__ATOMIC_RELEASE, "agent");
            asm volatile("s_waitcnt vmcnt(0)" ::: "memory");
            const unsigned og = xb_add(&bar[XB_TOP], 1u);
            const unsigned tg = og / nx;
            if (og + 1u == (tg + 1u) * nx) xb_add(&bar[XB_TOPGEN], 1u);
            else XB_SPIN(xb_ld(&bar[XB_TOPGEN]) == tg, bar);
            __builtin_amdgcn_fence(__ATOMIC_ACQUIRE, "agent");
            xb_add(&bar[XB_XGEN(b.x)], 1u);
            asm volatile("s_waitcnt vmcnt(0)" ::: "memory");
        } else {
            XB_SPIN(xb_ld(&bar[XB_XGEN(b.x)]) == gen, bar);
            __builtin_amdgcn_fence(__ATOMIC_ACQUIRE, "agent");
            asm volatile("s_waitcnt vmcnt(0)" ::: "memory");
        }
    }
    __syncthreads();
}

__device__ __forceinline__ void transpose_item(const float* __restrict__ W, int ldw, int col0, const float* __restrict__ gk, bf16_t* WT, int K, LAS float* scr, int k0, int n0dst, int lane) {
    float v[32];
    const float* src = W + (size_t)(k0 + (lane >> 5)) * ldw + col0 + (lane & 31);
#pragma unroll
    for (int i = 0; i < 32; ++i) v[i] = src[(size_t)(2 * i) * ldw];
    const int c = lane & 7;
    float g[8];
#pragma unroll
    for (int j = 0; j < 8; ++j) g[j] = gk ? gk[k0 + 8 * c + j] : 1.f;
#pragma unroll
    for (int i = 0; i < 32; ++i) scr[(2 * i + (lane >> 5)) * 33 + (lane & 31)] = v[i];
    LDS_WAIT(); asm volatile("" ::: "memory");
#pragma unroll
    for (int j = 0; j < 4; ++j) { const int n = (lane >> 3) + 8 * j; const LAS float* s = scr + (8 * c) * 33 + n;
        v4u o; o.x = pk2(s[0 * 33] * g[0], s[1 * 33] * g[1]); o.y = pk2(s[2 * 33] * g[2], s[3 * 33] * g[3]); o.z = pk2(s[4 * 33] * g[4], s[5 * 33] * g[5]); o.w = pk2(s[6 * 33] * g[6], s[7 * 33] * g[7]);
        *(GAS v4u*)(WT + (size_t)(n0dst + n) * K + k0 + 8 * c) = o; }
    LDS_WAIT(); asm volatile("" ::: "memory");
}

constexpr int NPH = 18;
struct Args { const float* in[14]; float* out; unsigned char* ws; int ph_lo, ph_hi; };
__global__ void __launch_bounds__(NWAVES * 64, 2) mk_fwd(Args args) {
    extern __shared__ __attribute__((aligned(16))) unsigned char lds[];
    LAS unsigned char* ldsp = (LAS unsigned char*)lds;
    volatile LAS unsigned* MISC = (volatile LAS unsigned*)(ldsp + MISC_OFF);
    gu32* ctl = (gu32*)(args.ws + WS_CTL);
    for (int u = threadIdx.x; u < (LDS_BYTES - LDSCTL_OFF) / 4; u += NWAVES * 64) ((LAS unsigned*)(ldsp + LDSCTL_OFF))[u] = 0u;
    __syncthreads();
    XcdBarrier bar = xcd_barrier_post((unsigned*)(ctl + CW_BAR), MISC + 8);
    const int lo = args.ph_lo, hi = args.ph_hi;
    for (int ph_ = lo; ph_ < hi; ++ph_) {
        int ph = ph_, bid = (int)blockIdx.x, G = (int)gridDim.x;
        typedef const __attribute__((address_space(4))) Args* KArgs;
        KArgs ap = (KArgs)__builtin_amdgcn_kernarg_segment_ptr(); asm volatile("" : "+s"(ap));
        unsigned char* ws = ap->ws; unsigned* barw = bar.bar;
        asm volatile("" : "+s"(ph), "+s"(bid), "+s"(G), "+s"(ws), "+s"(barw));
        int tid_ = threadIdx.x; asm volatile("" : "+v"(tid_));
        const int tid = tid_, lane = tid & 63, wave = __builtin_amdgcn_readfirstlane(tid >> 6);
        const int vcu = (G % 8 == 0) ? (bid % 8) * (G / 8) + bid / 8 : bid;
        const int gw = bid * NWAVES + wave, NGW = G * NWAVES;
        bf16_t* W1T = (bf16_t*)(ws + WS_W1T); bf16_t* W2T = (bf16_t*)(ws + WS_W2T);
        float* WFG = (float*)(ws + WS_WFG); float* LAM = (float*)(ws + WS_LAM); float* HM = (float*)(ws + WS_HM);
        bf16_t* WPT = (bf16_t*)(ws + WS_WPT);
        float* LOGF = (float*)(ws + WS_LOGF); float* CUM = (float*)(ws + WS_CUM);
        bf16_t* HB = (bf16_t*)(ws + WS_HB); bf16_t* MIX = (bf16_t*)(ws + WS_MIX); bf16_t* PROJ = (bf16_t*)(ws + WS_PROJ);
        float* H = ap->out;
        if (ph == 0) {
            const float* norm_g = ap->in[2]; const float* w_in = ap->in[3]; const float* w_pool = ap->in[10]; const float* w_out = ap->in[12];
            LAS float* scr = (LAS float*)(ldsp + RING_OFF + wave * 16384);
            constexpr int NIT1 = DEPTH * 16 * 112, NIT2 = DEPTH * 16 * 32;
            for (int it = gw; it < NIT1 + NIT2; it += NGW) {
                if (it < NIT1) { const int l = it / 1792, r = it % 1792, kb = r / 112, nb = r % 112, n0 = 32 * nb, col0 = n0 < 1024 ? n0 : n0 + 4;
                    transpose_item(w_in + (size_t)l * 1024 * IN_DIM, IN_DIM, col0, norm_g + l * 1024, W1T + (size_t)l * NP * 1024, 1024, scr, 64 * kb, n0, lane); }
                else { const int r0 = it - NIT1, l = r0 / 512, r = r0 % 512, kb = r / 32, nb = r % 32;
                    transpose_item(w_out + (size_t)l * 1024 * 1024, 1024, 32 * nb, nullptr, W2T + (size_t)l * 1024 * 1024, 1024, scr, 64 * kb, 32 * nb, lane); }
            }
            const int gt = bid * (NWAVES * 64) + tid, NT = G * NWAVES * 64;
            for (int i = gt; i < DEPTH * 4 * 1024; i += NT) { const int k = i & 1023, c = (i >> 10) & 3, l = i >> 12; WFG[i] = w_in[((size_t)l * 1024 + k) * IN_DIM + 1024 + c] * norm_g[l * 1024 + k]; }
            for (int i = gt; i < DEPTH * 4 * 64 * 64; i += NT) { const int c = i & 63, d = (i >> 6) & 63, lg = i >> 12; WPT[i] = f2bf(w_pool[((size_t)lg * 64 + c) * 64 + d]); }
            unsigned zz = 0u; float big = 1e30f; asm volatile("" : "+v"(zz), "+v"(big));
            for (int i = gt; i < 48 * NP / 8; i += NT) ((uint4*)(PROJ + (size_t)(MR + 16) * NP))[i] = make_uint4(zz, zz, zz, zz);
            for (int i = gt; i < 48 * 4; i += NT) CUM[(size_t)(i / 48) * MTP + MR + 16 + (i % 48)] = big;
            if (gt < DEPTH) { const int l = gt; float s1 = 0.f, s2 = 0.f;
                for (int i = 0; i < 64; ++i) { s1 += ap->in[5][l * 64 + i] * ap->in[6][l * 64 + i]; s2 += ap->in[7][l * 64 + i] * ap->in[8][l * 64 + i]; }
                LAM[l] = fexp(s1) - fexp(s2) + (0.8f - 0.6f * fexp(-0.3f * (float)l)); }
        } else if (ph <= 16) {
            const int l = (ph - 1) >> 2, sub = (ph - 1) & 3;
            if (sub == 0) {
                const float* hreal = l == 0 ? ap->in[0] : H; const float* hmeta = l == 0 ? ap->in[1] : HM;
                { unsigned* kmx = (unsigned*)(ws + WS_KMX); for (int i = bid * (NWAVES * 64) + tid; i < KMX_WORDS; i += G * NWAVES * 64) kmx[i] = 0u; }
                for (int row = gw; row < MT; row += NGW) norm_row(row, lane, hreal, hmeta, WFG + (size_t)l * 4096, ap->in[4] + l * 4, HB, LOGF);
            } else if (sub == 1) {
                if (wave == 0) { for (int i = bid; i < 33; i += G) { if (i < 32) scan_bh(i >> 2, i & 3, lane, LOGF, CUM); else scan_meta(lane, LOGF, CUM); } }
                if (wave == 1) { for (int nb = bid; nb < NP / 16; nb += G) {
                    const mf32x4 acc = meta_gemm16(HB + (size_t)MR * DM, W1T + (size_t)l * NP * 1024, nb, lane);
                    const int col = 16 * nb + (lane & 15), fq = lane >> 4; const float sc = (col < 256 || (col >= 1024 && col < 1536)) ? att::C2 : 1.f;
#pragma unroll
                    for (int j = 0; j < 4; ++j) PROJ[(size_t)(MR + 4 * fq + j) * NP + col] = f2bf(acc[j] * sc); } }
                pg8::Gemm g{HB, W1T + (size_t)l * NP * 1024, MR, NP, 1024}; pg8::StaticOrder S; S.init(MR, NP, G, bid);
                pg8::EpiProj E{PROJ, NP, att::C2, (unsigned*)(ws + WS_KMX)};
#ifndef DIAG_NO_GEMM
                pg8::gemm_phase<pg8::EpiProj, pg8::StaticOrder, PG8_ALIGN, PG8_SP2>(ldsp + RING_OFF, g, S, E);
#endif
            } else if (sub == 2) {
                const float li = __int_as_float(__builtin_amdgcn_readfirstlane(__float_as_int(0.8f - 0.6f * fexp(-0.3f * (float)l))));
                const float lam = __int_as_float(__builtin_amdgcn_readfirstlane(__float_as_int(LAM[l])));
                const float* subg = ap->in[9] + l * 128;
                float* park = (float*)(ws + WS_RES) + ((size_t)bid * 8 + (size_t)wave) * 8192;
                const unsigned* kmx = (const unsigned*)(ws + WS_KMX);
#ifndef DIAG_NO_META
                if (bid == G - 1) {
                    if (wave < 4) fox_meta(wave, lane, PROJ, CUM, MIX); else diff_meta(wave - 4, lane, PROJ, subg, lam, li, MIX);
                    for (int tk = wave; tk < 64; tk += NWAVES) pool_meta(tk >> 2, tk & 3, lane, PROJ, ap->in[10] + (size_t)l * 4 * 64 * 64, ap->in[11] + l * 256, MIX);
                }
#endif
                gu32* qcnt = (gu32*)(ws + WS_CTL) + CW_Q + l * 8 * 64;
                const int xcc = (int)(bar.x & 7u);
                for (int qi = 0; qi < 8; ++qi) {
                    const int x = (xcc + qi) & 7;
                    for (;;) {
                        if (tid == 0) MISC[16] = __hip_atomic_fetch_add(qcnt + x * 64, 1u, __ATOMIC_RELAXED, __HIP_MEMORY_SCOPE_AGENT);
                        __syncthreads();
                        const int u = (int)MISC[16];
                        __syncthreads();
                        if (u >= 160) break;
                        if (u < 128) {
                            const int v = u & 63, qb_ = 15 - (v >> 2), h_ = 3 - (v & 3), b_ = (x - h_) & 7;
#ifndef DIAG_NO_DIFF
                            if (u < 64) att::attn_unit<1>(ldsp + RING_OFF, PROJ, CUM, MIX, b_, h_, qb_, lam, li, subg, park, kmx);
#endif
#ifndef DIAG_NO_FOX
                            if (u >= 64) att::attn_unit<0>(ldsp + RING_OFF, PROJ, CUM, MIX, b_, h_, qb_, lam, li, subg, park, kmx);
#endif
                        } else {
#ifndef DIAG_NO_POOL
                            att::pool_unit(ldsp + RING_OFF, PROJ, WPT + (size_t)l * 4 * 64 * 64, ap->in[11] + l * 256, MIX, x * 32 + (u - 128));
#endif
                        }
                    }
                }
            } else {
                const float* hreal = l == 0 ? ap->in[0] : H; const float* hmeta = l == 0 ? ap->in[1] : HM;
                if (wave == 0) { for (int nb = bid; nb < 64; nb += G) {
                    const mf32x4 acc = meta_gemm16(MIX + (size_t)MR * DM, W2T + (size_t)l * 1024 * 1024, nb, lane);
                    const int col = 16 * nb + (lane & 15), fq = lane >> 4;
#pragma unroll
                    for (int j = 0; j < 4; ++j) HM[(4 * fq + j) * 1024 + col] = hmeta[(4 * fq + j) * 1024 + col] + acc[j]; } }
                pg8::Gemm g{MIX, W2T + (size_t)l * 1024 * 1024, MR, 1024, 1024}; pg8::StaticOrder S; S.init(MR, 1024, G, bid);
                pg8::EpiResid E{hreal, H, 1024};
#ifndef DIAG_NO_GEMM
                pg8::gemm_phase<pg8::EpiResid, pg8::StaticOrder, PG8_ALIGN, PG8_SP2>(ldsp + RING_OFF, g, S, E);
#endif
            }
        } else {
            for (int row = gw; row < MR; row += NGW) final_row(row, lane, H, ap->in[13]);
        }
        if (ph_ + 1 < hi) { XcdBarrier b2 = bar; b2.bar = barw; xcd_barrier(b2); }
    }
}

#ifndef MK_PER_PHASE
#define MK_PER_PHASE 0
#endif
extern "C" void kernel_launch(void* const* d_in, const int* in_sizes, int n_in, void* d_out, int out_size, void* d_ws, size_t ws_size, hipStream_t stream) {
    static int g_grid = 0;
    if (g_grid == 0) {
        int dev = 0, cus = 0, per_cu = 0;
        hipGetDevice(&dev); hipDeviceGetAttribute(&cus, hipDeviceAttributeMultiprocessorCount, dev);
        hipFuncSetAttribute((const void*)mk_fwd, hipFuncAttributeMaxDynamicSharedMemorySize, LDS_BYTES);
        hipOccupancyMaxActiveBlocksPerMultiprocessor(&per_cu, (const void*)mk_fwd, NWAVES * 64, LDS_BYTES);
        (void)hipGetLastError();
        g_grid = cus > 0 ? cus : 256;
    }
    hipMemsetAsync((unsigned char*)d_ws + WS_CTL, 0, CTL_ZERO_BYTES, stream);
    Args a{};
    for (int i = 0; i < 14; ++i) a.in[i] = (const float*)d_in[i];
    a.out = (float*)d_out; a.ws = (unsigned char*)d_ws;
#if MK_PER_PHASE
    for (int p = 0; p < NPH; ++p) { a.ph_lo = p; a.ph_hi = p + 1; hipLaunchKernelGGL(mk_fwd, dim3(g_grid), dim3(NWAVES * 64), LDS_BYTES, stream, a); }
#else
    a.ph_lo = 0; a.ph_hi = NPH;
    hipLaunchKernelGGL(mk_fwd, dim3(g_grid), dim3(NWAVES * 64), LDS_BYTES, stream, a);
#endif
}
```

```cpp
#include <hip/hip_runtime.h>
#include <stdint.h>

typedef unsigned short bf16_t;
__device__ __forceinline__ float bf2f(bf16_t v) { return __uint_as_float(((unsigned)v) << 16); }
__device__ __forceinline__ bf16_t f2bf(float f) { unsigned u = __float_as_uint(f); return (bf16_t)((u + 0x7fffu + ((u >> 16) & 1u)) >> 16); }

constexpr int BATCH = 8, SEQ = 4096, DM = 1024, DEPTH = 4, NMETA = 16;
constexpr int MR = BATCH * SEQ;
constexpr int MT = MR + NMETA;
constexpr int IN_DIM = 3588, NP = 3584;
constexpr int C_FQ = 0, C_FK = 256, C_FV = 512, C_FZ = 768, C_DQ = 1024, C_DK = 1536, C_DV = 2048, C_DZ = 2560, C_PU = 3072, C_PZ = 3328;
constexpr int M_A = 0, M_B = 256, M_C = 768;
constexpr float LN2F = 0.6931471805599453f;
__device__ __forceinline__ unsigned pk2(float lo, float hi) { return (unsigned)f2bf(lo) | ((unsigned)f2bf(hi) << 16); }

constexpr size_t MiB = 1u << 20;
constexpr size_t WS_CTL = 0;
constexpr size_t WS_W1T = 2 * MiB;
constexpr size_t WS_W2T = 30 * MiB;
constexpr size_t WS_WFG = 38 * MiB;
constexpr size_t WS_LAM = 38 * MiB + 196608;
constexpr size_t WS_TOT = 38 * MiB + 131072;
constexpr size_t WS_WPT = 38 * MiB + 262144;
constexpr size_t WS_KMX = 38 * MiB + 524288;
constexpr int KMX_WORDS = 24 * 2 * 8 * 64;
constexpr int MTP = MR + 64;
constexpr size_t WS_SS = 39 * MiB;
typedef unsigned long long ssq_t;
__device__ __forceinline__ ssq_t ss_fix(float q) { return (ssq_t)(q * 16777216.f); }
__device__ __forceinline__ float ss_val(ssq_t v) { return (float)v * (1.f / 16777216.f); }
constexpr size_t WS_CUM = 40 * MiB;
constexpr size_t WS_HB = 42 * MiB;
constexpr size_t WS_MIX = 108 * MiB;
constexpr size_t WS_PROJ = 174 * MiB;
constexpr size_t WS_RES = 400 * MiB;
constexpr size_t WS_END = 464 * MiB;

__device__ __forceinline__ float shx(float v, int m, int lane) { return __int_as_float(__builtin_amdgcn_ds_bpermute((lane ^ m) << 2, __float_as_int(v))); }
__device__ __forceinline__ float shl(float v, int src) { return __int_as_float(__builtin_amdgcn_ds_bpermute(src << 2, __float_as_int(v))); }
__device__ __forceinline__ float wave_sum(float v, int lane) {
#pragma unroll
    for (int o = 1; o < 64; o <<= 1) v += shx(v, o, lane);
    return v;
}
__device__ __forceinline__ float fexp(float x) { return __builtin_amdgcn_exp2f(x * 1.4426950408889634f); }
__device__ __forceinline__ float log_sigmoid(float x) { return fminf(x, 0.f) - __builtin_amdgcn_logf(1.f + fexp(-fabsf(x))) * 0.6931471805599453f; }
__device__ __forceinline__ float silu(float x) { return x / (1.f + fexp(-x)); }

__device__ __forceinline__ void entry_row(int row, int lane, const float* __restrict__ xreal, const float* __restrict__ xmeta, bf16_t* HB, ssq_t* SS0) {
    const float* hp = row < MR ? xreal + (size_t)row * DM : xmeta + (size_t)(row - MR) * DM;
    float ss = 0.f;
#pragma unroll
    for (int j = 0; j < 4; ++j) { const float4 v = *(const float4*)(hp + j * 256 + lane * 4);
        const unsigned w0 = pk2(v.x, v.y), w1 = pk2(v.z, v.w);
        const float a0 = __uint_as_float(w0 << 16), a1 = __uint_as_float(w0 & 0xffff0000u), a2 = __uint_as_float(w1 << 16), a3 = __uint_as_float(w1 & 0xffff0000u);
        ss += (a0 * a0 + a1 * a1) + (a2 * a2 + a3 * a3);
        *(uint2*)(HB + (size_t)row * DM + j * 256 + lane * 4) = make_uint2(w0, w1); }
    ss = wave_sum(ss, lane);
    if (lane == 0) SS0[row] = ss_fix(ss);
}
__device__ __forceinline__ void final_row(int row, int lane, const bf16_t* __restrict__ HB, const ssq_t* __restrict__ SSf, float* OUT, const float* __restrict__ final_g) {
    const float rstd = rsqrtf(ss_val(SSf[row]) * (1.f / DM) + 1e-6f);
#pragma unroll
    for (int j = 0; j < 4; ++j) {
        const uint2 w = *(const uint2*)(HB + (size_t)row * DM + j * 256 + lane * 4);
        const float4 g = *(const float4*)(final_g + j * 256 + lane * 4);
        float4 o; o.x = __uint_as_float(w.x << 16) * rstd * g.x; o.y = __uint_as_float(w.x & 0xffff0000u) * rstd * g.y; o.z = __uint_as_float(w.y << 16) * rstd * g.z; o.w = __uint_as_float(w.y & 0xffff0000u) * rstd * g.w;
        *(float4*)(OUT + (size_t)row * DM + j * 256 + lane * 4) = o;
    }
}
typedef short mbf16x8 __attribute__((ext_vector_type(8)));
typedef float mf32x4 __attribute__((ext_vector_type(4)));
__device__ __forceinline__ mf32x4 meta_gemm16(const bf16_t* __restrict__ A16, const bf16_t* __restrict__ Bt, int nb, int lane) {
    const int fr = lane & 15, fq = lane >> 4; mf32x4 acc = {0.f, 0.f, 0.f, 0.f};
    const bf16_t* ap = A16 + fr * 1024 + fq * 8; const bf16_t* bp = Bt + (size_t)(16 * nb + fr) * 1024 + fq * 8;
#pragma unroll 8
    for (int kk = 0; kk < 32; ++kk) { const mbf16x8 a = *(const mbf16x8*)(ap + kk * 32), b = *(const mbf16x8*)(bp + kk * 32); acc = __builtin_amdgcn_mfma_f32_16x16x32_bf16(a, b, acc, 0, 0, 0); }
    return acc;
}
__device__ __forceinline__ void ld16(const bf16_t* p, float (&x)[16]) {
    const uint4 a = *(const uint4*)p, b = *(const uint4*)(p + 8);
    const unsigned w[8] = {a.x, a.y, a.z, a.w, b.x, b.y, b.z, b.w};
#pragma unroll
    for (int j = 0; j < 8; ++j) { x[2 * j] = __uint_as_float(w[j] << 16); x[2 * j + 1] = __uint_as_float(w[j] & 0xffff0000u); }
}
__device__ __forceinline__ void fox_meta(int h, int lane, const bf16_t* __restrict__ PROJ, const float* __restrict__ CUM, bf16_t* MIX) {
    const int t = lane >> 2, dq = lane & 3, row = MR + t;
    float ln2 = LN2F, m = -1e30f; asm volatile("" : "+v"(ln2), "+v"(m));
    float q[16], o[16], x[16];
    ld16(PROJ + (size_t)row * NP + C_FQ + h * 64 + dq * 16, q);
#pragma unroll
    for (int d = 0; d < 16; ++d) { q[d] *= ln2; o[d] = 0.f; }
    const float cq = CUM[(size_t)h * MTP + row];
    float lsum = 0.f;
    for (int kk = 0; kk < 16; ++kk) {
        const int krow = MR + kk;
        ld16(PROJ + (size_t)krow * NP + C_FK + h * 64 + dq * 16, x);
        float sc = 0.f;
#pragma unroll
        for (int d = 0; d < 16; ++d) sc += q[d] * x[d];
        sc += shx(sc, 1, lane); sc += shx(sc, 2, lane);
        sc += cq - CUM[(size_t)h * MTP + krow];
        ld16(PROJ + (size_t)krow * NP + C_FV + h * 64 + dq * 16, x);
        if (kk <= t) {
            if (sc > m) { const float a = fexp(m - sc); lsum *= a;
#pragma unroll
                for (int d = 0; d < 16; ++d) o[d] *= a;
                m = sc; }
            const float p = fexp(sc - m); lsum += p;
#pragma unroll
            for (int d = 0; d < 16; ++d) o[d] += p * x[d];
        }
    }
    const float inv = 1.f / lsum;
    ld16(PROJ + (size_t)row * NP + C_FZ + h * 64 + dq * 16, x);
    bf16_t* mp = MIX + (size_t)row * DM + M_A + h * 64 + dq * 16;
#pragma unroll
    for (int d = 0; d < 16; d += 2) *(unsigned*)(mp + d) = pk2(o[d] * inv * silu(x[d]), o[d + 1] * inv * silu(x[d + 1]));
}
__device__ __forceinline__ void diff_meta(int h, int lane, const bf16_t* __restrict__ PROJ, const float* __restrict__ subln_g_l, float lam, float li, bf16_t* MIX) {
    const int ri = lane >> 2, qq = lane & 3, row = MR + ri;
    const float posq = (float)ri, slope = 1.f / (float)(1 << (2 * h + 2));
    float res[32], x[16], y[16];
    for (int c = 0; c < 2; ++c) {
        float ln2 = LN2F, m = -1e30f; asm volatile("" : "+v"(ln2), "+v"(m));
        float q[16], o[32];
        ld16(PROJ + (size_t)row * NP + C_DQ + h * 128 + c * 64 + qq * 16, q);
#pragma unroll
        for (int d = 0; d < 16; ++d) q[d] *= ln2;
#pragma unroll
        for (int d = 0; d < 32; ++d) o[d] = 0.f;
        float lsum = 0.f;
        for (int kk = 0; kk < 16; ++kk) {
            const int krow = MR + kk;
            ld16(PROJ + (size_t)krow * NP + C_DK + h * 128 + c * 64 + qq * 16, x);
            float sc = 0.f;
#pragma unroll
            for (int d = 0; d < 16; ++d) sc += q[d] * x[d];
            sc += shx(sc, 1, lane); sc += shx(sc, 2, lane);
            sc -= slope * fabsf(posq - (float)kk);
            ld16(PROJ + (size_t)krow * NP + C_DV + h * 128 + qq * 32, x);
            ld16(PROJ + (size_t)krow * NP + C_DV + h * 128 + qq * 32 + 16, y);
            if (sc > m) { const float a = fexp(m - sc); lsum *= a;
#pragma unroll
                for (int d = 0; d < 32; ++d) o[d] *= a;
                m = sc; }
            const float p = fexp(sc - m); lsum += p;
#pragma unroll
            for (int d = 0; d < 16; ++d) { o[d] += p * x[d]; o[16 + d] += p * y[d]; }
        }
        const float inv = 1.f / lsum;
        if (c == 0) {
#pragma unroll
            for (int d = 0; d < 32; ++d) res[d] = o[d] * inv;
        } else {
#pragma unroll
            for (int d = 0; d < 32; ++d) res[d] -= lam * o[d] * inv;
        }
    }
    float ss = 0.f;
#pragma unroll
    for (int d = 0; d < 32; ++d) ss += res[d] * res[d];
    ss += shx(ss, 1, lane); ss += shx(ss, 2, lane);
    const float rstd = rsqrtf(ss * (1.f / 128.f) + 1e-5f) * (1.f - li);
    ld16(PROJ + (size_t)row * NP + C_DZ + h * 128 + qq * 32, x);
    ld16(PROJ + (size_t)row * NP + C_DZ + h * 128 + qq * 32 + 16, y);
    bf16_t* mp = MIX + (size_t)row * DM + M_B + h * 128 + qq * 32;
    const float* gp = subln_g_l + qq * 32;
#pragma unroll
    for (int d = 0; d < 16; d += 2) {
        *(unsigned*)(mp + d) = pk2(res[d] * rstd * gp[d] * silu(x[d]), res[d + 1] * rstd * gp[d + 1] * silu(x[d + 1]));
        *(unsigned*)(mp + 16 + d) = pk2(res[16 + d] * rstd * gp[16 + d] * silu(y[d]), res[17 + d] * rstd * gp[17 + d] * silu(y[d + 1])); }
}
__device__ __forceinline__ void pool_meta(int j, int g, int lane, const bf16_t* __restrict__ PROJ, const float* __restrict__ wpool_l, const float* __restrict__ pscale_l, bf16_t* MIX) {
    const int w = 2 << g, cnt = (j + 1) < w ? (j + 1) : w, row = MR + j;
    float s = 0.f;
    for (int i = 0; i < cnt; ++i) s += bf2f(PROJ[(size_t)(MR + j - i) * NP + C_PU + g * 64 + lane]);
    const float pooled = s / (float)cnt - bf2f(PROJ[(size_t)row * NP + C_PU + g * 64 + lane]);
    float y = 0.f;
    for (int i = 0; i < 64; ++i) y += shl(pooled, i) * wpool_l[(g * 64 + i) * 64 + lane];
    const float z = bf2f(PROJ[(size_t)row * NP + C_PZ + g * 64 + lane]);
    MIX[(size_t)row * DM + M_C + g * 64 + lane] = f2bf(y * pscale_l[g * 64 + lane] * silu(z));
}

namespace pg8 {
#define PG8_LAS __attribute__((address_space(3)))
typedef unsigned short bf16_t;
typedef short bf16x8 __attribute__((ext_vector_type(8)));
typedef float f32x4 __attribute__((ext_vector_type(4)));
typedef unsigned u32x4 __attribute__((ext_vector_type(4)));
constexpr int BM = 256, BK = 64, HALF = 128, HTB = HALF * BK * 2  , STAGE_BYTES = 8 * HTB, NXCD = 8, WGM = 8;

__host__ __device__ __forceinline__ int lds_byte(int r, int c) { const int st = (r >> 4) * 2 + (c >> 5), rr = r & 15, cc = c & 31, ob = rr * 64 + cc * 2; return st * 1024 + (ob ^ (((ob >> 9) & 1) << 5)); }
__host__ __device__ __forceinline__ void stage_rc(int b, int& R, int& C) { const int st = b / 1024, sb = b % 1024, swz = sb ^ (((sb >> 9) & 1) << 5); R = (st >> 1) * 16 + swz / 64; C = (st & 1) * 32 + (swz % 64) / 2; }
__host__ __device__ __forceinline__ int perm32(int rho) { const int n = rho >> 4, i = rho & 15; return 8 * (i >> 2) + 4 * n + (i & 3); }

struct Unit { int pm, pn; };
struct Gemm { const bf16_t* A; const bf16_t* Bt; int M, N, K; };

struct StaticOrder {
    int nM, nN, nwg, G, c;
    __host__ __device__ void init(int M, int N, int G_, int c_) { nM = M / BM; nN = N / BM; nwg = nM * nN; G = G_; c = c_; }
    __host__ __device__ bool next(int i, Unit& u) const {
        const long L = (long)i * G + c; if (L >= nwg) return false;
        int wgid = (int)L; { const int q = nwg / NXCD, r = nwg % NXCD, xcd = wgid % NXCD, off = wgid / NXCD; wgid = (xcd < r ? xcd * (q + 1) : r * (q + 1) + (xcd - r) * q) + off; }
        const int nig = WGM * nN, gid = wgid / nig, fm = gid * WGM, gsz = (nM - fm) < WGM ? (nM - fm) : WGM;
        u.pm = fm + ((wgid % nig) % gsz); u.pn = (wgid % nig) / gsz; return true;
    }
    __device__ __forceinline__ void a_ready(const Unit&) const {}
    __device__ __forceinline__ void done(const Unit&) const {}
};

__device__ __forceinline__ unsigned cvt_pk_bf16(float lo, float hi) { unsigned r; asm volatile("v_cvt_pk_bf16_f32 %0, %1, %2" : "=v"(r) : "v"(lo), "v"(hi)); return r; }
struct EpiProj {
    static constexpr bool PERM = true, AFTER_DRAIN = false;
    bf16_t* O; int ldc; float qscale; unsigned* kmx; const ssq_t* ss;
    __device__ __forceinline__ void operator()(const f32x4 (&acc)[2][2][4][2], const Unit& u, int wr, int wc, int fr, int fq) const {
        const int row0 = u.pm * BM + wr * 64 + fr, col0 = u.pn * BM + wc * 32 + 8 * fq;
        const float sc = (u.pn == 0 || u.pn == 4 || u.pn == 5) ? qscale : 1.f;
        const bool nrm = (u.pn <= 1) || (u.pn >= 4 && u.pn <= 7);
        float part[2][2][4];
#pragma unroll
        for (int ai = 0; ai < 2; ++ai)
#pragma unroll
            for (int m = 0; m < 4; ++m) { bf16_t* rowp = O + (size_t)(row0 + ai * HALF + m * 16) * ldc + col0;
                const float rs = sc * rsqrtf(ss_val(ss[row0 + ai * HALF + m * 16]) * (1.f / 1024.f) + 1e-6f);
#pragma unroll
                for (int bj = 0; bj < 2; ++bj) { const f32x4 v0 = acc[ai][bj][m][0] * rs, v1 = acc[ai][bj][m][1] * rs;
                    part[ai][bj][m] = (v0[0] * v0[0] + v0[1] * v0[1]) + (v0[2] * v0[2] + v0[3] * v0[3]) + (v1[0] * v1[0] + v1[1] * v1[1]) + (v1[2] * v1[2] + v1[3] * v1[3]);
                    u32x4 w; w.x = cvt_pk_bf16(v0[0], v0[1]); w.y = cvt_pk_bf16(v0[2], v0[3]); w.z = cvt_pk_bf16(v1[0], v1[1]); w.w = cvt_pk_bf16(v1[2], v1[3]);
                    *(u32x4*)(rowp + bj * HALF) = w; } }
        if (nrm) {
            const int lane = fr + 16 * fq;
#pragma unroll
            for (int ai = 0; ai < 2; ++ai)
#pragma unroll
                for (int bj = 0; bj < 2; ++bj) {
                    float mx = 0.f;
#pragma unroll
                    for (int m = 0; m < 4; ++m) { float p = part[ai][bj][m]; p += shx(p, 16, lane); p += shx(p, 32, lane); mx = fmaxf(mx, p); }
                    mx = fmaxf(mx, shx(mx, 1, lane)); mx = fmaxf(mx, shx(mx, 2, lane)); mx = fmaxf(mx, shx(mx, 4, lane)); mx = fmaxf(mx, shx(mx, 8, lane));
                    if (lane == 0) { const int R = u.pm * BM + ai * HALF + wr * 64, col = u.pn * BM + bj * HALF + wc * 32;
                        const int st = col < 512 ? (col >> 6) : 8 + ((col - 1024) >> 6), half = (col >> 5) & 1;
                        atomicMax(kmx + ((st * 2 + half) * 8 + (R >> 12)) * 64 + ((R & 4095) >> 6), __float_as_uint(mx)); }
                }
        }
    }
};
struct EpiResidB {
    static constexpr bool PERM = true, AFTER_DRAIN = false;
    bf16_t* H; int ldc; ssq_t* ssn;
    __device__ __forceinline__ void operator()(const f32x4 (&acc)[2][2][4][2], const Unit& u, int wr, int wc, int fr, int fq) const {
        const int row0 = u.pm * BM + wr * 64 + fr, col0 = u.pn * BM + wc * 32 + 8 * fq, lane = fr + 16 * fq;
#pragma unroll
        for (int ai = 0; ai < 2; ++ai)
#pragma unroll
            for (int m = 0; m < 4; ++m) { const int row = row0 + ai * HALF + m * 16; bf16_t* rowp = H + (size_t)row * ldc + col0; float q = 0.f;
#pragma unroll
                for (int bj = 0; bj < 2; ++bj) { const u32x4 b = *(const u32x4*)(rowp + bj * HALF); const f32x4 a0 = acc[ai][bj][m][0], a1 = acc[ai][bj][m][1];
                    u32x4 w;
                    w.x = cvt_pk_bf16(__uint_as_float(b.x << 16) + a0[0], __uint_as_float(b.x & 0xffff0000u) + a0[1]);
                    w.y = cvt_pk_bf16(__uint_as_float(b.y << 16) + a0[2], __uint_as_float(b.y & 0xffff0000u) + a0[3]);
                    w.z = cvt_pk_bf16(__uint_as_float(b.z << 16) + a1[0], __uint_as_float(b.z & 0xffff0000u) + a1[1]);
                    w.w = cvt_pk_bf16(__uint_as_float(b.w << 16) + a1[2], __uint_as_float(b.w & 0xffff0000u) + a1[3]);
                    *(u32x4*)(rowp + bj * HALF) = w;
#pragma unroll
                    for (int k = 0; k < 4; ++k) { const float lo = __uint_as_float(w[k] << 16), hi = __uint_as_float(w[k] & 0xffff0000u); q += lo * lo + hi * hi; } }
                q += shx(q, 16, lane); q += shx(q, 32, lane);
                if (fq == 0) atomicAdd(ssn + row, ss_fix(q)); }
    }
};
template <class Epi, class Sched, bool ALIGN_EPI = false, bool SP2 = false>
__device__ __forceinline__ void gemm_phase(PG8_LAS unsigned char* lds, const Gemm g, const Sched& S, const Epi& E) {
    int tid_ = threadIdx.x; asm volatile("" : "+v"(tid_));
    const int tid = tid_, wid = __builtin_amdgcn_readfirstlane(tid >> 6), lane = tid & 63, wr = wid >> 2, wc = wid & 3, fr = lane & 15, fq = lane >> 4;
    const int K = g.K, nt = K / BK;
    unsigned voffA[2], voffB[2];
#pragma unroll
    for (int i = 0; i < 2; ++i) { int R, C; stage_rc(tid * 16 + i * 8192, R, C); const int Rb = Epi::PERM ? ((R & ~31) + perm32(R & 31)) : R;
        voffA[i] = (unsigned)(R * K + C) * 2u; voffB[i] = (unsigned)(Rb * K + C) * 2u; }
    const size_t kstep = (size_t)(BK * 2);
    const size_t hstep = (size_t)HALF * K * 2;
    const size_t tstep = 2 * hstep;
    const unsigned ldsw = (unsigned)wid * 1024u;
    const int aoff = lds_byte(wr * 64 + fr, fq * 8), boff = lds_byte(wc * 32 + fr, fq * 8);
#define PG8_SA(b, h) (((b) * 2 + (h)) * HTB)
#define PG8_SB(b, h) ((4 + (b) * 2 + (h)) * HTB)
#define PG8_STAGE(bufoff, gbase, voff) do { _Pragma("unroll") for (int _i = 0; _i < 2; ++_i) \
        __builtin_amdgcn_global_load_lds((const unsigned*)((const char*)(gbase) + (voff)[_i]), (PG8_LAS unsigned*)(lds + (bufoff) + ldsw + _i * 8192), 16, 0, 0); } while (0)
#define PG8_LDA(dst, b, h) do { _Pragma("unroll") for (int m = 0; m < 4; ++m) _Pragma("unroll") for (int k = 0; k < 2; ++k) dst[m][k] = *(const PG8_LAS bf16x8*)(lds + PG8_SA(b, h) + aoff + m * 2048 + k * 1024); } while (0)
#define PG8_LDB(dst, b, h) do { _Pragma("unroll") for (int n = 0; n < 2; ++n) _Pragma("unroll") for (int k = 0; k < 2; ++k) dst[n][k] = *(const PG8_LAS bf16x8*)(lds + PG8_SB(b, h) + boff + n * 2048 + k * 1024); } while (0)
#define PG8_MMA(ai, bj, At, Bt) do { __builtin_amdgcn_s_setprio(1); _Pragma("unroll") for (int m = 0; m < 4; ++m) _Pragma("unroll") for (int n = 0; n < 2; ++n) _Pragma("unroll") for (int k = 0; k < 2; ++k) \
        acc[ai][bj][m][n] = __builtin_amdgcn_mfma_f32_16x16x32_bf16(Bt[n][k], At[m][k], acc[ai][bj][m][n], 0, 0, 0); __builtin_amdgcn_s_setprio(0); } while (0)
#define PG8_WAIT_V(n) asm volatile("s_waitcnt vmcnt(" #n ")" ::: "memory")
#define PG8_WAIT_L(n) asm volatile("s_waitcnt lgkmcnt(" #n ")" ::: "memory")
#define PG8_BAR __builtin_amdgcn_s_barrier()
#define PG8_SCHED __builtin_amdgcn_sched_barrier(0)
    Unit cur, nxt; int ui = 0;
    if (!S.next(0, cur)) return;
    f32x4 acc[2][2][4][2];
#pragma unroll
    for (int a = 0; a < 2; ++a)
#pragma unroll
        for (int b = 0; b < 2; ++b)
#pragma unroll
            for (int m = 0; m < 4; ++m)
#pragma unroll
                for (int n = 0; n < 2; ++n) acc[a][b][m][n] = (f32x4){0.f, 0.f, 0.f, 0.f};
    bf16x8 At[4][2], B0[2][2], B1[2][2];
    const char* cA = (const char*)g.A + (size_t)cur.pm * tstep; const char* cB = (const char*)g.Bt + (size_t)cur.pn * tstep;
    S.a_ready(cur);
    if constexpr (SP2) {
        PG8_STAGE(PG8_SB(0, 0), cB, voffB); PG8_STAGE(PG8_SB(0, 1), cB + hstep, voffB); PG8_STAGE(PG8_SA(0, 0), cA, voffA); PG8_STAGE(PG8_SA(0, 1), cA + hstep, voffA);
        if (wr == 1) PG8_BAR;
        PG8_WAIT_V(2); PG8_BAR;
        PG8_STAGE(PG8_SB(1, 0), cB + kstep, voffB); PG8_STAGE(PG8_SA(1, 0), cA + kstep, voffA); PG8_STAGE(PG8_SB(1, 1), cB + hstep + kstep, voffB);
        PG8_WAIT_V(6); PG8_BAR;
    } else {
        PG8_STAGE(PG8_SB(0, 0), cB, voffB); PG8_STAGE(PG8_SA(0, 0), cA, voffA); PG8_STAGE(PG8_SB(0, 1), cB + hstep, voffB); PG8_STAGE(PG8_SA(0, 1), cA + hstep, voffA);
        if (wr == 1) PG8_BAR;
        PG8_WAIT_V(4); PG8_BAR;
        PG8_STAGE(PG8_SB(1, 0), cB + kstep, voffB); PG8_STAGE(PG8_SA(1, 0), cA + kstep, voffA); PG8_STAGE(PG8_SB(1, 1), cB + hstep + kstep, voffB);
        PG8_WAIT_V(6); PG8_BAR;
    }
    for (;;) {
        const bool has_next = S.next(ui + 1, nxt);
        const char* nA = has_next ? (const char*)g.A + (size_t)nxt.pm * tstep : cA; const char* nB = has_next ? (const char*)g.Bt + (size_t)nxt.pn * tstep : cB;
        for (int t = 0; t < nt; t += 2) {
            const bool last = (t == nt - 2);
            const char* a1 = cA + (size_t)(t + 1) * kstep;
            const char* a2 = last ? nA : cA + (size_t)(t + 2) * kstep; const char* b2 = last ? nB : cB + (size_t)(t + 2) * kstep;
            const char* a3 = a2 + kstep; const char* b3 = b2 + kstep;
            if (last && has_next) S.a_ready(nxt);
            if constexpr (SP2) {
            PG8_LDB(B0, 0, 0); PG8_LDB(B1, 0, 1); PG8_SCHED; PG8_LDA(At, 0, 0); PG8_STAGE(PG8_SA(1, 1), a1 + hstep, voffA);
            PG8_WAIT_V(8); PG8_WAIT_L(0); PG8_BAR; PG8_MMA(0, 0, At, B0); PG8_MMA(0, 1, At, B1); PG8_BAR; PG8_SCHED;
            PG8_LDA(At, 0, 1); PG8_STAGE(PG8_SB(0, 0), b2, voffB); PG8_STAGE(PG8_SB(0, 1), b2 + hstep, voffB); PG8_STAGE(PG8_SA(0, 0), a2, voffA);
            PG8_WAIT_V(8); PG8_WAIT_L(0); PG8_BAR; PG8_MMA(1, 0, At, B0); PG8_MMA(1, 1, At, B1); PG8_BAR; PG8_SCHED;
            PG8_LDB(B0, 1, 0); PG8_LDB(B1, 1, 1); PG8_SCHED; PG8_LDA(At, 1, 0); PG8_STAGE(PG8_SA(0, 1), a2 + hstep, voffA);
            PG8_WAIT_V(8); PG8_WAIT_L(0); PG8_BAR; PG8_MMA(0, 0, At, B0); PG8_MMA(0, 1, At, B1); PG8_BAR; PG8_SCHED;
            PG8_LDA(At, 1, 1); PG8_STAGE(PG8_SB(1, 0), b3, voffB); PG8_STAGE(PG8_SB(1, 1), b3 + hstep, voffB); PG8_STAGE(PG8_SA(1, 0), a3, voffA);
            PG8_WAIT_V(8); PG8_WAIT_L(0); PG8_BAR; PG8_MMA(1, 0, At, B0); PG8_MMA(1, 1, At, B1); PG8_BAR; PG8_SCHED;
            } else {
            PG8_LDB(B0, 0, 0); PG8_SCHED; PG8_LDA(At, 0, 0); PG8_STAGE(PG8_SA(1, 1), a1 + hstep, voffA);
            PG8_WAIT_L(8); PG8_BAR; PG8_WAIT_L(0); PG8_MMA(0, 0, At, B0); PG8_BAR; PG8_SCHED;
            PG8_LDB(B1, 0, 1); PG8_STAGE(PG8_SB(0, 0), b2, voffB);
            PG8_BAR; PG8_WAIT_L(0); PG8_MMA(0, 1, At, B1); PG8_BAR;
            PG8_LDA(At, 0, 1); PG8_STAGE(PG8_SA(0, 0), a2, voffA);
            PG8_BAR; PG8_WAIT_L(0); PG8_MMA(1, 0, At, B0); PG8_BAR; PG8_SCHED;
            PG8_STAGE(PG8_SB(0, 1), b2 + hstep, voffB);
            PG8_WAIT_V(6); PG8_BAR; PG8_MMA(1, 1, At, B1); PG8_BAR;
            PG8_LDB(B0, 1, 0); PG8_SCHED; PG8_LDA(At, 1, 0); PG8_STAGE(PG8_SA(0, 1), a2 + hstep, voffA);
            PG8_WAIT_L(8); PG8_BAR; PG8_WAIT_L(0); PG8_MMA(0, 0, At, B0); PG8_BAR; PG8_SCHED;
            PG8_LDB(B1, 1, 1); PG8_STAGE(PG8_SB(1, 0), b3, voffB);
            PG8_BAR; PG8_WAIT_L(0); PG8_MMA(0, 1, At, B1); PG8_BAR;
            PG8_LDA(At, 1, 1); PG8_STAGE(PG8_SA(1, 0), a3, voffA);
            PG8_BAR; PG8_WAIT_L(0); PG8_MMA(1, 0, At, B0); PG8_BAR; PG8_SCHED;
            PG8_STAGE(PG8_SB(1, 1), b3 + hstep, voffB);
            PG8_WAIT_V(6); PG8_BAR; PG8_MMA(1, 1, At, B1); PG8_BAR;
            }
        }
        if constexpr (ALIGN_EPI) { if (wr == 0) PG8_BAR; }
        if constexpr (!Epi::AFTER_DRAIN) { E(acc, cur, wr, wc, fr, fq); S.done(cur); }
        if (!has_next) break;
#pragma unroll
        for (int a = 0; a < 2; ++a)
#pragma unroll
            for (int b = 0; b < 2; ++b)
#pragma unroll
                for (int m = 0; m < 4; ++m)
#pragma unroll
                    for (int n = 0; n < 2; ++n) acc[a][b][m][n] = (f32x4){0.f, 0.f, 0.f, 0.f};
        cur = nxt; cA = nA; cB = nB; ++ui;
        if constexpr (ALIGN_EPI) { if (wr == 1) PG8_BAR; }
    }
    PG8_WAIT_V(0);
    if constexpr (!ALIGN_EPI) { if (wr == 0) PG8_BAR; }
    PG8_BAR;
    if constexpr (Epi::AFTER_DRAIN) { E.fused(acc, cur, wr, wc, fr, fq, lds, wid, lane); S.done(cur); }
#undef PG8_SA
#undef PG8_SB
#undef PG8_STAGE
#undef PG8_LDA
#undef PG8_LDB
#undef PG8_MMA
#undef PG8_WAIT_V
#undef PG8_WAIT_L
#undef PG8_BAR
#undef PG8_SCHED
}
}
namespace att {
typedef float f32x16 __attribute__((ext_vector_type(16)));
typedef float f32x4 __attribute__((ext_vector_type(4)));
typedef short bf16x8 __attribute__((ext_vector_type(8)));
typedef short s16x4 __attribute__((ext_vector_type(4)));
typedef unsigned u32x4 __attribute__((ext_vector_type(4)));
#define ALAS __attribute__((address_space(3)))
constexpr int KCS = 1040, VDS = 4160, KBUF = 8 * KCS, VBUF = 4 * VDS, NSLOT = 3;
constexpr int KBOFF = KBUF + VBUF, STG0 = KBOFF + 256, STG1 = 2 * KBUF + VBUF;
template <int MODE> struct Geo { static constexpr int STG = MODE == 0 ? STG0 : STG1, VOFF = MODE == 0 ? KBUF : 2 * KBUF; };
constexpr int L_WSF = NSLOT * STG1, L_OST = L_WSF + 8 * 256, L_END = L_OST + 8 * 4096;
constexpr float LOG2E = 1.4426950408889634f, C2 = 0.125f * LOG2E, THR = 8.f, NEGBIG = -1e30f;
__device__ __forceinline__ int crow(int r, int hi) { return (r & 3) + 8 * (r >> 2) + 4 * hi; }
__device__ __forceinline__ unsigned cvtpk(float lo, float hi) { typedef float f2 __attribute__((ext_vector_type(2))); typedef __bf16 b2 __attribute__((ext_vector_type(2))); f2 v = {lo, hi}; b2 b = __builtin_convertvector(v, b2); return __builtin_bit_cast(unsigned, b); }
__device__ __forceinline__ s16x4 vtr(const ALAS unsigned char* p) { typedef short v4i16_t __attribute__((ext_vector_type(4))); return __builtin_bit_cast(s16x4, __builtin_amdgcn_ds_read_tr16_b64_v4i16((ALAS v4i16_t*)p)); }
__device__ __forceinline__ float bfl(unsigned w) { return __uint_as_float(w << 16); }
__device__ __forceinline__ float bfh(unsigned w) { return __uint_as_float(w & 0xffff0000u); }
__device__ __forceinline__ float silu_f(float x) { return x * __builtin_amdgcn_rcpf(1.f + fexp(-x)); }
__device__ __forceinline__ void glds16(const void* gsrc, unsigned lds_dst) { unsigned keep;
    asm volatile("s_mov_b32 %0, m0\n\ts_mov_b32 m0, %2\n\ts_nop 0\n\tglobal_load_lds_dwordx4 %1, off\n\ts_mov_b32 m0, %0" : "=&s"(keep) : "v"(gsrc), "s"(lds_dst) : "memory"); }
__device__ __forceinline__ void glds4(const void* gsrc, unsigned lds_dst) { unsigned keep;
    asm volatile("s_mov_b32 %0, m0\n\ts_mov_b32 m0, %2\n\ts_nop 0\n\tglobal_load_lds_dword %1, off\n\ts_mov_b32 m0, %0" : "=&s"(keep) : "v"(gsrc), "s"(lds_dst) : "memory"); }
#define ATT_SBAR0() __builtin_amdgcn_sched_barrier(0)
#define ATT_WAIT_BAR(N) asm volatile("s_waitcnt vmcnt(" #N ") lgkmcnt(0)\n\ts_barrier" ::: "memory")

template <int MODE> __device__ __forceinline__ void dma_k(unsigned slot, const bf16_t* __restrict__ PROJ, const float* __restrict__ CUM, size_t krow0, int kcol, int h, int wid, int lane) {
    if (MODE == 0 && wid == 0) glds4(CUM + (size_t)h * MTP + krow0 + lane, (unsigned)__builtin_amdgcn_readfirstlane(slot + KBOFF));
    glds16(PROJ + (krow0 + lane) * NP + kcol + wid * 8, (unsigned)__builtin_amdgcn_readfirstlane(slot + wid * KCS));
    if (MODE == 1) glds16(PROJ + (krow0 + lane) * NP + kcol + 64 + wid * 8, (unsigned)__builtin_amdgcn_readfirstlane(slot + KBUF + wid * KCS));
}
template <int MODE> __device__ __forceinline__ void dma_v(unsigned slot, const bf16_t* __restrict__ PROJ, size_t krow0, int vcol, int wid, int lane) {
    const bf16_t* vs = PROJ + (krow0 + (wid & 3) * 16 + (lane >> 2)) * NP + vcol + (wid >> 2) * 32 + (lane & 3) * 8;
    glds16(vs, (unsigned)__builtin_amdgcn_readfirstlane(slot + Geo<MODE>::VOFF + (wid >> 2) * VDS + (wid & 3) * 1024));
    if (MODE == 1) glds16(vs + 64, (unsigned)__builtin_amdgcn_readfirstlane(slot + Geo<MODE>::VOFF + (2 + (wid >> 2)) * VDS + (wid & 3) * 1024));
}

template <int MODE, bool DIAG> __device__ __forceinline__ bool qs_front(const ALAS unsigned char* buf, const ALAS unsigned char* vprev, s16x4 (&vl)[8], s16x4 (&vh)[8], const bf16x8 (&qr)[4], const ALAS bf16x8* qlds, f32x16& p0, f32x16& p1, float& mhat, float& l,
        int kidx0, bool meta, int qw0, float slope2, float koffL, ALAS float* wsf, int lane) {
    constexpr bool diag = DIAG;
    const int r32 = lane & 31, hi = lane >> 5;
    {
      const ALAS unsigned char* vb = vprev + Geo<MODE>::VOFF + ((lane >> 4) & 1) * 32 + (lane & 3) * 8 + (4 * hi + ((lane & 15) >> 2)) * 64; asm volatile("" : "+v"(vb));
#pragma unroll
      for (int i = 0; i < (MODE == 0 ? 8 : 4); ++i) { vl[i] = vtr(vb + (i & 1) * VDS + (i >> 1) * 1024); vh[i] = vtr(vb + (i & 1) * VDS + (i >> 1) * 1024 + 512); } }
    asm volatile("" : "+v"(slope2), "+s"(kidx0));
    if (MODE == 0) {
        const ALAS f32x4* kbp = (const ALAS f32x4*)(buf + KBOFF + hi * 16); asm volatile("" : "+v"(kbp));
#pragma unroll
        for (int g = 0; g < 4; ++g) { const f32x4 a = kbp[2 * g], b = kbp[8 + 2 * g];
#pragma unroll
            for (int j = 0; j < 4; ++j) { p0[4 * g + j] = fmaf(a[j], -LOG2E, -mhat - koffL); p1[4 * g + j] = fmaf(b[j], -LOG2E, -mhat - koffL); } }
    } else {
        if (!diag) {
            const float base = slope2 * (float)(kidx0 + 4 * hi - qw0) - mhat;
#pragma unroll
            for (int r = 0; r < 16; ++r) { const int c = (r & 3) + 8 * (r >> 2); p0[r] = fmaf((float)c, slope2, base); p1[r] = fmaf((float)(c + 32), slope2, base); }
            if (meta) {
#pragma unroll
                for (int r = 0; r < 16; ++r) { if ((r >> 2) >= 2) p0[r] = NEGBIG; p1[r] = NEGBIG; }
            }
        } else {
            const float dq = (float)(qw0 + r32 - kidx0 - 4 * hi), fr = (float)r32;
#pragma unroll
            for (int r = 0; r < 16; ++r) { const int c = (r & 3) + 8 * (r >> 2);
                p0[r] = slope2 * (fr - fabsf(dq - (float)c)) - mhat; p1[r] = slope2 * (fr - fabsf(dq - (float)(c + 32))) - mhat; }
        }
    }
    bf16x8 qfr[4];
#pragma unroll
    for (int d0 = 0; d0 < 4; ++d0) qfr[d0] = MODE == 0 ? qr[d0] : qlds[d0 * 64];
    if (MODE == 1) ATT_SBAR0();
    { const ALAS unsigned char* kb = buf + hi * KCS + r32 * 16; asm volatile("" : "+v"(kb));
#pragma unroll
      for (int d0 = 0; d0 < 4; ++d0) {
          const bf16x8 k0 = *(const ALAS bf16x8*)(kb + d0 * 2 * KCS), k1 = *(const ALAS bf16x8*)(kb + d0 * 2 * KCS + 512);
          const bf16x8 qf = qfr[d0];
          p0 = __builtin_amdgcn_mfma_f32_32x32x16_bf16(k0, qf, p0, 0, 0, 0);
          p1 = __builtin_amdgcn_mfma_f32_32x32x16_bf16(k1, qf, p1, 0, 0, 0); } }
    if (MODE == 0 && diag) {
        const int lim = qw0 + r32 - kidx0 - 4 * hi;
#pragma unroll
        for (int r = 0; r < 16; ++r) { const int c = (r & 3) + 8 * (r >> 2); if (c > lim) p0[r] = NEGBIG; if (c + 32 > lim) p1[r] = NEGBIG; }
    }
    float rm;
    {
#define ATT_MX3(a, b, c) __builtin_fmaxf(__builtin_fmaxf((a), (b)), (c))
      float a = ATT_MX3(p0[0], p0[1], p1[0]), b = ATT_MX3(p0[2], p0[3], p1[1]); a = ATT_MX3(a, p1[2], p1[3]);
#pragma unroll
      for (int r = 4; r < 16; r += 4) { a = ATT_MX3(a, p0[r], p0[r + 1]); b = ATT_MX3(b, p0[r + 2], p0[r + 3]); a = ATT_MX3(a, p1[r], p1[r + 1]); b = ATT_MX3(b, p1[r + 2], p1[r + 3]); }
#undef ATT_MX3
      a = __builtin_fmaxf(a, b);
      auto rr = __builtin_amdgcn_permlane32_swap(__float_as_uint(a), __float_as_uint(a), false, false);
      rm = __builtin_fmaxf(__uint_as_float(rr[0]), __uint_as_float(rr[1])); }
    bool resc = false;
    if (__any(rm > THR)) {
        const float dl = fmaxf(rm, 0.f); mhat += dl;
#pragma unroll
        for (int r = 0; r < 16; ++r) { p0[r] -= dl; p1[r] -= dl; }
        const float f = __builtin_amdgcn_exp2f(-dl); l *= f; if (hi == 0) wsf[r32] = f; resc = true;
    }
    return resc;
}
#define ATT_SBAR() __builtin_amdgcn_sched_barrier(0)
#define ATT_PIN(x) asm volatile("" : "+v"(x))
#define ATT_VF(L, H, i) (bf16x8){L[i][0], L[i][1], L[i][2], L[i][3], H[i][0], H[i][1], H[i][2], H[i][3]}
template <int NDB> __device__ __forceinline__ void pv_exp(const ALAS unsigned char* vbuf, s16x4 (&vl)[8], s16x4 (&vh)[8], const u32x4 (&pwo)[4], f32x16 (&o)[NDB], f32x16& p0, f32x16& p1, u32x4 (&pwn)[4], float& l, int lane) {
    const int hi = lane >> 5;
    float s0 = 0.f, s1 = 0.f, s2 = 0.f, s3 = 0.f;
    ATT_SBAR();
    if (NDB == 2) {
#pragma unroll
        for (int k = 0; k < 8; ++k) {
            o[k & 1] = __builtin_amdgcn_mfma_f32_32x32x16_bf16(__builtin_bit_cast(bf16x8, pwo[k >> 1]), ATT_VF(vl, vh, k), o[k & 1], 0, 0, 0);
            p0[2 * k] = __builtin_amdgcn_exp2f(p0[2 * k]); p0[2 * k + 1] = __builtin_amdgcn_exp2f(p0[2 * k + 1]); p1[2 * k] = __builtin_amdgcn_exp2f(p1[2 * k]); p1[2 * k + 1] = __builtin_amdgcn_exp2f(p1[2 * k + 1]);
            s0 += p0[2 * k]; s1 += p0[2 * k + 1]; s2 += p1[2 * k]; s3 += p1[2 * k + 1];
            pwn[k >> 2][k & 3] = cvtpk(p0[2 * k], p0[2 * k + 1]); pwn[2 + (k >> 2)][k & 3] = cvtpk(p1[2 * k], p1[2 * k + 1]);
            ATT_PIN(p0); ATT_PIN(p1); ATT_PIN(s0); ATT_PIN(s1); ATT_PIN(s2); ATT_PIN(s3); ATT_PIN(pwn[k >> 2]); ATT_PIN(pwn[2 + (k >> 2)]);
            ATT_SBAR();
        }
    } else {
        const ALAS unsigned char* vb = vbuf + 2 * KBUF + ((lane >> 4) & 1) * 32 + (lane & 3) * 8 + (4 * hi + ((lane & 15) >> 2)) * 64; asm volatile("" : "+v"(vb));
        s16x4 (&wl)[8] = vl; s16x4 (&wh)[8] = vh;
#pragma unroll
        for (int k = 0; k < 16; ++k) {
            const int blk = 2 * (k >> 3) + (k & 1), ks = (k >> 1) & 3;
            o[blk] = __builtin_amdgcn_mfma_f32_32x32x16_bf16(__builtin_bit_cast(bf16x8, pwo[ks]), ATT_VF(wl, wh, k & 3), o[blk], 0, 0, 0);
            if (k + 4 < 16) { const int j = k + 4, jb = 2 * (j >> 3) + (j & 1), jk = (j >> 1) & 3; wl[k & 3] = vtr(vb + jb * VDS + jk * 1024); wh[k & 3] = vtr(vb + jb * VDS + jk * 1024 + 512); }
            if (k < 8) { p0[2 * k] = __builtin_amdgcn_exp2f(p0[2 * k]); p0[2 * k + 1] = __builtin_amdgcn_exp2f(p0[2 * k + 1]); s0 += p0[2 * k]; s1 += p0[2 * k + 1];
                pwn[k >> 2][k & 3] = cvtpk(p0[2 * k], p0[2 * k + 1]); ATT_PIN(p0); ATT_PIN(s0); ATT_PIN(s1); ATT_PIN(pwn[k >> 2]); }
            else { const int q = k - 8; p1[2 * q] = __builtin_amdgcn_exp2f(p1[2 * q]); p1[2 * q + 1] = __builtin_amdgcn_exp2f(p1[2 * q + 1]); s2 += p1[2 * q]; s3 += p1[2 * q + 1];
                pwn[2 + (q >> 2)][q & 3] = cvtpk(p1[2 * q], p1[2 * q + 1]); ATT_PIN(p1); ATT_PIN(s2); ATT_PIN(s3); ATT_PIN(pwn[2 + (q >> 2)]); }
            ATT_SBAR();
        }
    }
    l += (s0 + s1) + (s2 + s3);
}
template <int NDB> __device__ __forceinline__ void pv_only(const ALAS unsigned char* vbuf, const u32x4 (&pwo)[4], f32x16 (&o)[NDB], int lane) {
    const int hi = lane >> 5;
    const ALAS unsigned char* vb = vbuf + (NDB == 4 ? 2 * KBUF : KBUF) + ((lane >> 4) & 1) * 32 + (lane & 3) * 8 + (4 * hi + ((lane & 15) >> 2)) * 64; asm volatile("" : "+v"(vb));
#pragma unroll
    for (int d = 0; d < NDB; ++d) {
        s16x4 lo[4], hh[4];
#pragma unroll
        for (int ks = 0; ks < 4; ++ks) { lo[ks] = vtr(vb + d * VDS + ks * 1024); hh[ks] = vtr(vb + d * VDS + ks * 1024 + 512); }
#pragma unroll
        for (int ks = 0; ks < 4; ++ks) o[d] = __builtin_amdgcn_mfma_f32_32x32x16_bf16(__builtin_bit_cast(bf16x8, pwo[ks]), ATT_VF(lo, hh, ks), o[d], 0, 0, 0);
        ATT_SBAR();
    }
}
template <int NDB> __device__ __forceinline__ void rescale_o(f32x16 (&o)[NDB], const ALAS float* wsf, int lane) {
    const int hi = lane >> 5;
#pragma unroll
    for (int r = 0; r < 16; ++r) { const float f = wsf[crow(r, hi)];
#pragma unroll
        for (int d = 0; d < NDB; ++d) o[d][r] *= f; }
}
__device__ __forceinline__ u32x4 gate8(u32x4 v, u32x4 z) {
    u32x4 o;
#pragma unroll
    for (int j = 0; j < 4; ++j) { const float a = bfl(v[j]) * silu_f(bfl(z[j])), b = bfh(v[j]) * silu_f(bfh(z[j])); o[j] = cvtpk(a, b); }
    return o;
}


template <int NDB> __device__ __forceinline__ void stage_gate_store(const f32x16 (&res)[NDB], ALAS bf16_t* stg, const bf16_t* __restrict__ zbase, bf16_t* __restrict__ mbase, int lane) {
    const int r32 = lane & 31, hi = lane >> 5;
#pragma unroll
    for (int r = 0; r < 16; ++r) { const int orow = crow(r, hi);
#pragma unroll
        for (int d = 0; d < NDB; ++d) stg[orow * (NDB * 32) + d * 32 + r32] = f2bf(res[d][r]); }
    constexpr int CPR = NDB * 4;
    constexpr int RPP = 64 / CPR;
#pragma unroll
    for (int i = 0; i < 32 / RPP; ++i) {
        const int row = i * RPP + lane / CPR, ch = lane % CPR;
        const u32x4 v = *(const ALAS u32x4*)(stg + row * (NDB * 32) + ch * 8);
        const u32x4 z = *(const u32x4*)(zbase + (size_t)row * NP + ch * 8);
        *(u32x4*)(mbase + (size_t)row * DM + ch * 8) = gate8(v, z);
    }
}

template <int MODE> __device__ __forceinline__ void attn_unit(ALAS unsigned char* lds, const bf16_t* __restrict__ PROJ, const float* __restrict__ CUM, bf16_t* __restrict__ MIX,
        int b, int h, int qb, float lam, float li, const float* __restrict__ subg, float* park, const unsigned* __restrict__ kmx, const float* __restrict__ TOT) {
    constexpr int NDB = MODE == 1 ? 4 : 2, STG = Geo<MODE>::STG;
    int tid_ = threadIdx.x; asm volatile("" : "+v"(tid_));
    const int tid = tid_, lane = tid & 63, r32 = lane & 31, hi = lane >> 5, wid = __builtin_amdgcn_readfirstlane(tid >> 6);
    const int c = MODE == 1 ? (wid >> 2) : 0, wr = MODE == 1 ? (wid & 3) : wid;
    const int q0 = qb * (MODE == 1 ? 128 : 256), qw0 = q0 + wr * 32;
    const size_t rowb = (size_t)b * SEQ;
    const int band0 = q0 >> 6, NT = band0 + (MODE == 1 ? 2 : 4), my_last = band0 + (wr >> 1);
    ALAS float* wsf = (ALAS float*)(lds + L_WSF) + wid * 64;
    const unsigned ldsb = (unsigned)(size_t)lds;
    const float slope2 = MODE == 1 ? LOG2E / (float)(1 << (2 * h + 2)) : 0.f;
    float Pv = 0.f;
    if (MODE == 0) { const float tv = lane < 32 ? TOT[h * 320 + b * 32 + lane] : 0.f; float inc = tv;
#pragma unroll
        for (int o_ = 1; o_ < 32; o_ <<= 1) { const float t_ = shl(inc, lane >= o_ ? lane - o_ : lane); if (lane >= o_) inc += t_; }
        Pv = inc - tv; }
#define ATT_OFF(blk) __int_as_float(__builtin_amdgcn_readlane(__float_as_int(Pv), (blk)))
    const int qcol = MODE == 0 ? C_FQ + h * 64 : C_DQ + h * 128 + c * 64;
    const int kcol = MODE == 0 ? C_FK + h * 64 : C_DK + h * 128;
    const int vcol = MODE == 0 ? C_FV + h * 64 : C_DV + h * 128;
    dma_k<MODE>(ldsb, PROJ, CUM, rowb + (size_t)(NT - 1) * 64, kcol, h, wid, lane);
    dma_v<MODE>(ldsb, PROJ, rowb + (size_t)(NT - 1) * 64, vcol, wid, lane);
    dma_v<MODE>(ldsb + 2 * STG, PROJ, rowb + (size_t)(NT - 1) * 64, vcol, wid, lane);
    dma_k<MODE>(ldsb + STG, PROJ, CUM, rowb + (size_t)(NT - 2) * 64, kcol, h, wid, lane);
    bf16x8 qr[4];
    { const bf16_t* Qw = PROJ + (rowb + qw0 + r32) * NP + qcol + hi * 8;
#pragma unroll
      for (int d0 = 0; d0 < 4; ++d0) qr[d0] = *(const bf16x8*)(Qw + d0 * 16); }
    const ALAS bf16x8* qlds = (const ALAS bf16x8*)(lds + L_OST + wid * 4096) + lane;
    if (MODE == 1) {
#pragma unroll
        for (int d0 = 0; d0 < 4; ++d0) ((ALAS bf16x8*)qlds)[d0 * 64] = qr[d0];
    }
    float mhat = MODE == 0 ? -(CUM[(size_t)h * MTP + rowb + qw0] + ATT_OFF(qw0 >> 7)) * LOG2E : 0.f, l = 0.f;
    int T_min;
    { const int T = lane; const bool inband = T >= band0 && T < NT; bool need = inband;
#pragma unroll
      for (int cc = 0; cc < (MODE == 1 ? 2 : 1); ++cc) {
          const int sq = MODE == 0 ? h : 8 + h * 2 + cc, sk = MODE == 0 ? 4 + h : 16 + h * 2 + cc;
          const float k2 = __uint_as_float(kmx[((sk * 2 + 0) * 8 + b) * 64 + T]) + __uint_as_float(kmx[((sk * 2 + 1) * 8 + b) * 64 + T]);
          const float q2 = __uint_as_float(kmx[((sq * 2 + 0) * 8 + b) * 64 + T]) + __uint_as_float(kmx[((sq * 2 + 1) * 8 + b) * 64 + T]);
          const float kn = sqrtf(k2) * 1.01f;
          float qv = inband ? q2 : 0.f, kv = inband ? kn : 0.f;
#pragma unroll
          for (int m = 1; m < 64; m <<= 1) { qv = fmaxf(qv, shx(qv, m, lane)); kv = fmaxf(kv, shx(kv, m, lane)); }
          const float Qn = sqrtf(qv) * 1.01f, Lown = Qn * kv;
          float D;
          if (MODE == 0) { const int kr = T < band0 ? 64 * T + 63 : q0; D = ((CUM[(size_t)h * MTP + rowb + q0] + ATT_OFF(q0 >> 7)) - (CUM[(size_t)h * MTP + rowb + kr] + shl(Pv, kr >> 7))) * LOG2E; }
          else D = -slope2 * (float)(q0 - 64 * T - 63);
          need = need || (T < band0 && (Qn * kn + D + Lown > -40.f)); }
      const unsigned long long mask = __ballot(need);
      T_min = __builtin_amdgcn_readfirstlane((int)__builtin_ctzll(mask));
      if ((NT - T_min) & 1) T_min -= 1; }
    const int NTr = NT - T_min;
    f32x16 o[NDB];
#pragma unroll
    for (int d = 0; d < NDB; ++d)
#pragma unroll
        for (int r = 0; r < 16; ++r) o[d][r] = 0.f;
    u32x4 pwa[4], pwb[4]; f32x16 p0, p1; s16x4 vl[8], vh[8];
#pragma unroll
    for (int k = 0; k < 4; ++k) { pwa[k] = (u32x4){0u, 0u, 0u, 0u}; pwb[k] = (u32x4){0u, 0u, 0u, 0u}; }
    const int kbo = c * KBUF;
#define ATT_TROW(i) ((i) < NTr ? rowb + (size_t)(NT - 1 - (i)) * 64 : (size_t)MR)
#define ATT_STEP(i, PIN_, POUT_, WAITBAR_) do { \
        if ((i) + 2 <= NTr) dma_k<MODE>(ldsb + (unsigned)s_prev, PROJ, CUM, ATT_TROW((i) + 2), kcol, h, wid, lane); \
        if ((i) + 1 <= NTr) dma_v<MODE>(ldsb + (unsigned)s_next, PROJ, ATT_TROW((i) + 1), vcol, wid, lane); \
        const bool mt_ = ((i) == NTr); const int t_ = NT - 1 - (i); \
        if (mt_ || t_ <= my_last) { \
            bool resc_; const float koff_ = (MODE == 0 && !mt_) ? ATT_OFF(t_ >> 1) * LOG2E : 0.f;       \
            if ((!mt_) && t_ == my_last) resc_ = qs_front<MODE, true>(lds + s_cur + kbo, lds + s_prev, vl, vh, qr, qlds, p0, p1, mhat, l, 64 * t_, false, qw0, slope2, koff_, wsf, lane); \
            else resc_ = qs_front<MODE, false>(lds + s_cur + kbo, lds + s_prev, vl, vh, qr, qlds, p0, p1, mhat, l, mt_ ? -16 : 64 * t_, mt_, qw0, slope2, koff_, wsf, lane); \
            pv_exp<NDB>(lds + s_prev, vl, vh, PIN_, o, p0, p1, POUT_, l, lane); \
            if (resc_) rescale_o<NDB>(o, wsf, lane); \
        } \
        WAITBAR_; \
        { const int tt = s_prev; s_prev = s_cur; s_cur = s_next; s_next = tt; } } while (0)
#define ATT_WB_FULL() do { if (MODE == 0) ATT_WAIT_BAR(2); else ATT_WAIT_BAR(4); } while (0)
#define ATT_WB_VONLY() do { if (MODE == 0) ATT_WAIT_BAR(1); else ATT_WAIT_BAR(2); } while (0)
    ATT_WAIT_BAR(0);
    int s_prev = 2 * STG, s_cur = 0, s_next = STG;
#pragma clang loop unroll(disable)
    for (int i = 0; i < NTr - 2; i += 2) { ATT_STEP(i, pwa, pwb, ATT_WB_FULL()); ATT_STEP(i + 1, pwb, pwa, ATT_WB_FULL()); }
    ATT_STEP(NTr - 2, pwa, pwb, ATT_WB_FULL());
    ATT_STEP(NTr - 1, pwb, pwa, ATT_WB_VONLY());
    ATT_STEP(NTr, pwa, pwb, ATT_WAIT_BAR(0));
    pv_only<NDB>(lds + s_prev, pwb, o, lane);
#undef ATT_WB_FULL
#undef ATT_WB_VONLY
#undef ATT_STEP
#undef ATT_TROW
    ATT_WAIT_BAR(0);
    { auto rr = __builtin_amdgcn_permlane32_swap(__float_as_uint(l), __float_as_uint(l), false, false); l = __uint_as_float(rr[0]) + __uint_as_float(rr[1]); }
    if (hi == 0) wsf[32 + r32] = l;
    float rli[16];
#pragma unroll
    for (int r = 0; r < 16; ++r) rli[r] = __builtin_amdgcn_rcpf(wsf[32 + crow(r, hi)]);
#pragma unroll
    for (int d = 0; d < NDB; ++d)
#pragma unroll
        for (int r = 0; r < 16; ++r) o[d][r] *= rli[r];
    if (MODE == 1) {
        float* pk = park + wr * 4096 + lane;
        if (c == 1) {
#pragma unroll
            for (int d = 0; d < NDB; ++d) {
                float* pkd = pk + d * 1024; asm volatile("" : "+v"(pkd));
#pragma unroll
                for (int r = 0; r < 16; ++r) pkd[r * 64] = o[d][r];
            }
        }
        ATT_WAIT_BAR(0);
        if (c == 1) return;
#pragma unroll
        for (int d = 0; d < NDB; ++d) {
            const float* pb = pk + d * 1024; asm volatile("" : "+v"(pb));
#pragma unroll
            for (int r = 0; r < 16; ++r) o[d][r] -= lam * pb[r * 64];
            __builtin_amdgcn_sched_barrier(0);
        }
        float ss[16];
#pragma unroll
        for (int r = 0; r < 16; ++r) { float sm = 0.f;
#pragma unroll
            for (int d = 0; d < NDB; ++d) sm += o[d][r] * o[d][r];
            ss[r] = sm; }
#pragma unroll
        for (int m = 1; m < 32; m <<= 1)
#pragma unroll
            for (int r = 0; r < 16; ++r) ss[r] += shx(ss[r], m, lane);
        float gc[NDB];
#pragma unroll
        for (int d = 0; d < NDB; ++d) gc[d] = subg[32 * d + r32] * (1.f - li);
#pragma unroll
        for (int r = 0; r < 16; ++r) { const float rs = rsqrtf(ss[r] * (1.f / 128.f) + 1e-5f);
#pragma unroll
            for (int d = 0; d < NDB; ++d) o[d][r] *= rs * gc[d]; }
    }
    ALAS bf16_t* stg = (ALAS bf16_t*)(lds + L_OST + (MODE == 1 ? wr * 8192 : wid * 4096));
    const int zcol = MODE == 0 ? C_FZ + h * 64 : C_DZ + h * 128, mcol = MODE == 0 ? M_A + h * 64 : M_B + h * 128;
    stage_gate_store<NDB>(o, stg, PROJ + (rowb + qw0) * NP + zcol, MIX + (rowb + qw0) * DM + mcol, lane);
#undef ATT_OFF
}

__device__ __forceinline__ void pool_unit(ALAS unsigned char* lds, const bf16_t* __restrict__ PROJ, const bf16_t* __restrict__ WPT_l, const float* __restrict__ pscale_l, bf16_t* __restrict__ MIX, int unit) {
    int tid_ = threadIdx.x; asm volatile("" : "+v"(tid_));
    const int tid = tid_, lane = tid & 63, r32 = lane & 31, hi = lane >> 5, wid = __builtin_amdgcn_readfirstlane(tid >> 6);
    const int g = wid & 3, win = 2 << g; const float invw = 1.f / (float)win;
    const int Rw = unit * 128 + (wid >> 2) * 64, b = Rw >> 12, tw = Rw & 4095;
    ALAS bf16_t* stg = (ALAS bf16_t*)(lds + L_OST + wid * 4096);
    bf16x8 wb[2][4];
#pragma unroll
    for (int nb = 0; nb < 2; ++nb)
#pragma unroll
        for (int ks = 0; ks < 4; ++ks) wb[nb][ks] = *(const bf16x8*)(WPT_l + ((g * 64 + 32 * nb + r32) * 64 + 16 * ks + 8 * hi));
    const float ps0 = pscale_l[g * 64 + r32], ps1 = pscale_l[g * 64 + 32 + r32];
    for (int blk = 0; blk < 2; ++blk) {
        const int t = tw + 32 * blk + r32;
        f32x16 acc[2];
#pragma unroll
        for (int r = 0; r < 16; ++r) { acc[0][r] = 0.f; acc[1][r] = 0.f; }
#pragma unroll
        for (int ks = 0; ks < 4; ++ks) {
            const int c0 = C_PU + g * 64 + 16 * ks + 8 * hi;
            float s[8], own[8];
#pragma unroll
            for (int j = 0; j < 8; ++j) { s[j] = 0.f; own[j] = 0.f; }
            for (int i = 0; i < win; ++i) {
                const int ti = t - i; const size_t row = ti >= 0 ? (size_t)b * SEQ + ti : (size_t)(MR + 16 + ti);
                const u32x4 v = *(const u32x4*)(PROJ + row * NP + c0);
#pragma unroll
                for (int j = 0; j < 4; ++j) { const float lo = bfl(v[j]), hh = bfh(v[j]); s[2 * j] += lo; s[2 * j + 1] += hh; if (i == 0) { own[2 * j] = lo; own[2 * j + 1] = hh; } }
            }
            u32x4 pa;
#pragma unroll
            for (int j = 0; j < 4; ++j) pa[j] = cvtpk(s[2 * j] * invw - own[2 * j], s[2 * j + 1] * invw - own[2 * j + 1]);
            const bf16x8 af = __builtin_bit_cast(bf16x8, pa);
            acc[0] = __builtin_amdgcn_mfma_f32_32x32x16_bf16(af, wb[0][ks], acc[0], 0, 0, 0);
            acc[1] = __builtin_amdgcn_mfma_f32_32x32x16_bf16(af, wb[1][ks], acc[1], 0, 0, 0);
        }
#pragma unroll
        for (int r = 0; r < 16; ++r) { acc[0][r] *= ps0; acc[1][r] *= ps1; }
        const size_t row0 = (size_t)Rw + 32 * blk;
        stage_gate_store<2>(acc, stg, PROJ + row0 * NP + C_PZ + g * 64, MIX + row0 * DM + M_C + g * 64, lane);
    }
}
#undef ALAS
}


#ifndef PG8_SP2
#define PG8_SP2 true
#endif
#ifndef PG8_ALIGN
#define PG8_ALIGN true
#endif
constexpr int NWAVES = 8;
constexpr int RING_OFF = 0, RING_BYTES = 143360;
constexpr int LDSCTL_OFF = RING_BYTES, MISC_OFF = LDSCTL_OFF + 320;
constexpr int LDS_BYTES = RING_BYTES + 1024;
constexpr int CW_TMO = 0, CW_CODE = 1, CW_BAR = 4096, CW_Q = 16384;
constexpr size_t CTL_ZERO_BYTES = 1 * MiB;
static_assert(att::L_END <= RING_BYTES, "attention LDS map");
#define GAS __attribute__((address_space(1)))
#define LAS __attribute__((address_space(3)))
typedef unsigned short bf16;
typedef unsigned v4u __attribute__((ext_vector_type(4)));
typedef float f32x4 __attribute__((ext_vector_type(4)));
typedef short bf16x8 __attribute__((ext_vector_type(8)));
typedef GAS unsigned gu32;
typedef GAS unsigned long long gu64;
#define RLX_AGENT __ATOMIC_RELAXED, __HIP_MEMORY_SCOPE_AGENT
#define LDS_WAIT() asm volatile("s_waitcnt lgkmcnt(0)" ::: "memory")
#define VM_WAIT() asm volatile("s_waitcnt vmcnt(0)" ::: "memory")
__device__ __forceinline__ unsigned long long rt() { return __builtin_amdgcn_s_memrealtime(); }

#define XB_TMO      128
#define XB_XCNT(j)  (256  + 64 * (j))
#define XB_XSUB(j)  (1280 + 64 * (j))
#define XB_XGEN(j)  (2304 + 64 * (j))
#define XB_TOP      3328
#define XB_TOPGEN   3392
#define XCD_BAR_WORDS 3456
#define XB_SPIN_CAP (1u << 18)

__device__ __forceinline__ unsigned xb_ld(unsigned* p)              { return __hip_atomic_load(p, __ATOMIC_RELAXED, __HIP_MEMORY_SCOPE_AGENT); }
__device__ __forceinline__ unsigned xb_add(unsigned* p, unsigned v) { return __hip_atomic_fetch_add(p, v, __ATOMIC_RELAXED, __HIP_MEMORY_SCOPE_AGENT); }
__device__ __forceinline__ unsigned xb_xcc_id() { return (unsigned)__builtin_amdgcn_s_getreg((3 << 11) | 20) & 0xFu; }
#define XB_SPIN(cond, bar) do { unsigned _sp = 0; while (cond) { __builtin_amdgcn_s_sleep(1); \
    if ((++_sp & 255u) == 0u) { if (xb_ld(&(bar)[XB_TMO])) break; if (_sp > XB_SPIN_CAP) { atomicAdd(&(bar)[XB_TMO], 1u); break; } } } } while (0)

struct XcdBarrier {
    unsigned* bar; unsigned x;
    volatile LAS unsigned* st;
};

__device__ __forceinline__ XcdBarrier xcd_barrier_post(unsigned* bar, volatile LAS unsigned* st) {
    XcdBarrier b; b.bar = bar; b.x = xb_xcc_id(); b.st = st;
    if (threadIdx.x == 0) (void)xb_add(&bar[XB_XCNT(b.x)], 1u);
    return b;
}
__device__ __forceinline__ void xcd_barrier_complete(unsigned* bar, unsigned x, unsigned& nloc, unsigned& nx) {
    const unsigned G = gridDim.x * gridDim.y * gridDim.z;
    unsigned sum, cnt, mine, sp = 0u;
    for (;;) {
        sum = 0u; cnt = 0u; mine = 0u;
#pragma unroll
        for (unsigned j = 0; j < 16; ++j) { const unsigned c = xb_ld(&bar[XB_XCNT(j)]); sum += c; cnt += (c > 0u) ? 1u : 0u; mine = (j == x) ? c : mine; }
        if (sum == G) break;
        __builtin_amdgcn_s_sleep(1);
        if ((++sp & 255u) == 0u) { if (xb_ld(&bar[XB_TMO])) break; if (sp > XB_SPIN_CAP) { atomicAdd(&bar[XB_TMO], 1u); break; } }
    }
    nloc = mine > 0u ? mine : 1u; nx = cnt > 0u ? cnt : 1u;
}

__device__ __forceinline__ void xcd_barrier(const XcdBarrier& b) {
    asm volatile("s_waitcnt vmcnt(0)" ::: "memory");
    __syncthreads();
    if (threadIdx.x == 0) {
        unsigned* bar = b.bar;
        __builtin_amdgcn_s_waitcnt(0);
        unsigned nloc = b.st[0], nx = b.st[1];
        if (nloc == 0u) { xcd_barrier_complete(bar, b.x, nloc, nx); b.st[0] = nloc; b.st[1] = nx; }
        const unsigned old = xb_add(&bar[XB_XSUB(b.x)], 1u);
        const unsigned gen = old / nloc;
        if (old + 1u == (gen + 1u) * nloc) {
            __builtin_amdgcn_fence(__ATOMIC_RELEASE, "agent");
            asm volatile("s_waitcnt vmcnt(0)" ::: "memory");
            const unsigned og = xb_add(&bar[XB_TOP], 1u);
            const unsigned tg = og / nx;
            if (og + 1u == (tg + 1u) * nx) xb_add(&bar[XB_TOPGEN], 1u);
            else XB_SPIN(xb_ld(&bar[XB_TOPGEN]) == tg, bar);
            __builtin_amdgcn_fence(__ATOMIC_ACQUIRE, "agent");
            xb_add(&bar[XB_XGEN(b.x)], 1u);
            asm volatile("s_waitcnt vmcnt(0)" ::: "memory");
        } else {
            XB_SPIN(xb_ld(&bar[XB_XGEN(b.x)]) == gen, bar);
            __builtin_amdgcn_fence(__ATOMIC_ACQUIRE, "agent");
            asm volatile("s_waitcnt vmcnt(0)" ::: "memory");
        }
    }
    __syncthreads();
}

__device__ __forceinline__ void transpose_item(const float* __restrict__ W, int ldw, int col0, const float* __restrict__ gk, bf16_t* WT, int K, LAS float* scr, int k0, int n0dst, int lane) {
    float v[32];
    const float* src = W + (size_t)(k0 + (lane >> 5)) * ldw + col0 + (lane & 31);
#pragma unroll
    for (int i = 0; i < 32; ++i) v[i] = src[(size_t)(2 * i) * ldw];
    const int c = lane & 7;
    float g[8];
#pragma unroll
    for (int j = 0; j < 8; ++j) g[j] = gk ? gk[k0 + 8 * c + j] : 1.f;
#pragma unroll
    for (int i = 0; i < 32; ++i) scr[(2 * i + (lane >> 5)) * 33 + (lane & 31)] = v[i];
    LDS_WAIT(); asm volatile("" ::: "memory");
#pragma unroll
    for (int j = 0; j < 4; ++j) { const int n = (lane >> 3) + 8 * j; const LAS float* s = scr + (8 * c) * 33 + n;
        v4u o; o.x = pk2(s[0 * 33] * g[0], s[1 * 33] * g[1]); o.y = pk2(s[2 * 33] * g[2], s[3 * 33] * g[3]); o.z = pk2(s[4 * 33] * g[4], s[5 * 33] * g[5]); o.w = pk2(s[6 * 33] * g[6], s[7 * 33] * g[7]);
        *(GAS v4u*)(WT + (size_t)(n0dst + n) * K + k0 + 8 * c) = o; }
    LDS_WAIT(); asm volatile("" ::: "memory");
}

constexpr int NPH = 14;
struct Args { const float* in[14]; float* out; unsigned char* ws; int ph_lo, ph_hi; };
__global__ void __launch_bounds__(NWAVES * 64, 2) mk_fwd(Args args) {
    extern __shared__ __attribute__((aligned(16))) unsigned char lds[];
    LAS unsigned char* ldsp = (LAS unsigned char*)lds;
    volatile LAS unsigned* MISC = (volatile LAS unsigned*)(ldsp + MISC_OFF);
    gu32* ctl = (gu32*)(args.ws + WS_CTL);
    for (int u = threadIdx.x; u < (LDS_BYTES - LDSCTL_OFF) / 4; u += NWAVES * 64) ((LAS unsigned*)(ldsp + LDSCTL_OFF))[u] = 0u;
    __syncthreads();
    XcdBarrier bar = xcd_barrier_post((unsigned*)(ctl + CW_BAR), MISC + 8);
    const int lo = args.ph_lo, hi = args.ph_hi;
    for (int ph_ = lo; ph_ < hi; ++ph_) {
        int ph = ph_, bid = (int)blockIdx.x, G = (int)gridDim.x;
        typedef const __attribute__((address_space(4))) Args* KArgs;
        KArgs ap = (KArgs)__builtin_amdgcn_kernarg_segment_ptr(); asm volatile("" : "+s"(ap));
        unsigned char* ws = ap->ws; unsigned* barw = bar.bar;
        asm volatile("" : "+s"(ph), "+s"(bid), "+s"(G), "+s"(ws), "+s"(barw));
        int tid_ = threadIdx.x; asm volatile("" : "+v"(tid_));
        const int tid = tid_, lane = tid & 63, wave = __builtin_amdgcn_readfirstlane(tid >> 6);
        const int gw = bid * NWAVES + wave, NGW = G * NWAVES;
        const int gt = bid * (NWAVES * 64) + tid, NT = G * NWAVES * 64;
        bf16_t* W1T = (bf16_t*)(ws + WS_W1T); bf16_t* W2T = (bf16_t*)(ws + WS_W2T);
        bf16_t* WFGB = (bf16_t*)(ws + WS_WFG); float* LAM = (float*)(ws + WS_LAM); float* TOT = (float*)(ws + WS_TOT);
        bf16_t* WPT = (bf16_t*)(ws + WS_WPT); unsigned* KMX = (unsigned*)(ws + WS_KMX);
        ssq_t* SS = (ssq_t*)(ws + WS_SS); float* CUM = (float*)(ws + WS_CUM);
        bf16_t* HB = (bf16_t*)(ws + WS_HB); bf16_t* MIX = (bf16_t*)(ws + WS_MIX); bf16_t* PROJ = (bf16_t*)(ws + WS_PROJ);
        if (ph == 0) {
            const float* norm_g = ap->in[2]; const float* w_in = ap->in[3]; const float* w_pool = ap->in[10]; const float* w_out = ap->in[12];
            LAS float* scr = (LAS float*)(ldsp + RING_OFF + wave * 16384);
            constexpr int NIT1 = DEPTH * 16 * 112, NIT2 = DEPTH * 16 * 32;
            for (int it = gw; it < NIT1 + NIT2; it += NGW) {
                if (it < NIT1) { const int l = it / 1792, r = it % 1792, kb = r / 112, nb = r % 112, n0 = 32 * nb, col0 = n0 < 1024 ? n0 : n0 + 4;
                    transpose_item(w_in + (size_t)l * 1024 * IN_DIM, IN_DIM, col0, norm_g + l * 1024, W1T + (size_t)l * NP * 1024, 1024, scr, 64 * kb, n0, lane); }
                else { const int r0 = it - NIT1, l = r0 / 512, r = r0 % 512, kb = r / 32, nb = r % 32;
                    transpose_item(w_out + (size_t)l * 1024 * 1024, 1024, 32 * nb, nullptr, W2T + (size_t)l * 1024 * 1024, 1024, scr, 64 * kb, 32 * nb, lane); }
            }
            for (int i = gt; i < DEPTH * 16 * 1024; i += NT) { const int k = i & 1023, c = (i >> 10) & 15, l = i >> 14;
                WFGB[i] = c < 4 ? f2bf(w_in[((size_t)l * 1024 + k) * IN_DIM + 1024 + c] * norm_g[l * 1024 + k]) : (bf16_t)0; }
            for (int i = gt; i < DEPTH * 4 * 64 * 64; i += NT) { const int c = i & 63, d = (i >> 6) & 63, lg = i >> 12; WPT[i] = f2bf(w_pool[((size_t)lg * 64 + c) * 64 + d]); }
            unsigned zz = 0u; float big = 1e30f; asm volatile("" : "+v"(zz), "+v"(big));
            for (int i = gt; i < 48 * NP / 8; i += NT) ((uint4*)(PROJ + (size_t)(MR + 16) * NP))[i] = make_uint4(zz, zz, zz, zz);
            for (int i = gt; i < 48 * 4; i += NT) CUM[(size_t)(i / 48) * MTP + MR + 16 + (i % 48)] = big;
            for (int i = gt; i < MTP; i += NT) SS[MTP + i] = (ssq_t)zz;
            for (int i = gt; i < KMX_WORDS; i += NT) KMX[i] = zz;
            if (gt < DEPTH) { const int l = gt; float s1 = 0.f, s2 = 0.f;
                for (int i = 0; i < 64; ++i) { s1 += ap->in[5][l * 64 + i] * ap->in[6][l * 64 + i]; s2 += ap->in[7][l * 64 + i] * ap->in[8][l * 64 + i]; }
                float c08 = 0.8f; asm volatile("" : "+v"(c08));
                const float li0 = c08 - 0.6f * fexp(-0.3f * (float)l);
                LAM[l] = fexp(s1) - fexp(s2) + li0; LAM[4 + l] = li0; }
            for (int row = gw; row < MT; row += NGW) entry_row(row, lane, ap->in[0], ap->in[1], HB, SS);
        } else if (ph <= 12) {
            const int l = (ph - 1) / 3, sub = (ph - 1) % 3;
            ssq_t* ssl = SS + (size_t)(l & 1) * MTP;
            ssq_t* ssn = SS + (size_t)((l + 1) & 1) * MTP;
            if (sub == 0) {
                { unsigned zz = 0u; asm volatile("" : "+v"(zz)); for (int i = gt; i < MTP; i += NT) ssn[i] = (ssq_t)zz; }
                {   LAS float* lf = (LAS float*)(ldsp + RING_OFF);
                    const bf16_t* wfg = WFGB + (size_t)l * 16 * 1024; const float* bfl = ap->in[4] + l * 4;
                    for (int blk = bid; blk < 257; blk += G) {
                        const bool mb = blk == 256; const int r0 = mb ? MR : 128 * blk + 16 * wave;
                        if (!mb || wave == 0) {
                            const mf32x4 acc = meta_gemm16(HB + (size_t)r0 * DM, wfg, 0, lane);
                            const int fr = lane & 15, fq = lane >> 4;
                            if (fr < 4) {
#pragma unroll
                                for (int j = 0; j < 4; ++j) { const int row = r0 + 4 * fq + j; const float rstd = rsqrtf(ss_val(ssl[row]) * (1.f / 1024.f) + 1e-6f);
                                    lf[((mb ? 0 : 16 * wave) + 4 * fq + j) * 4 + fr] = log_sigmoid(acc[j] * rstd + bfl[fr]); } }
                        }
                        __syncthreads();
                        if (!mb) { if (wave < 4) { const int h = wave; const float a = lf[(2 * lane) * 4 + h], b2 = lf[(2 * lane + 1) * 4 + h]; const float sm = a + b2; float inc = sm;
#pragma unroll
                                for (int o = 1; o < 64; o <<= 1) { const float t = shl(inc, lane >= o ? lane - o : lane); if (lane >= o) inc += t; }
                                *(float2*)(CUM + (size_t)h * MTP + 128 * blk + 2 * lane) = make_float2(inc - b2, inc);
                                if (lane == 63) TOT[h * 320 + blk] = inc; } }
                        else { if (wave == 0 && lane < 4) { const int h = lane; float c = 0.f; for (int j = 15; j >= 0; --j) { CUM[(size_t)h * MTP + MR + j] = -c; c += lf[j * 4 + h]; } } }
                        __syncthreads();
                    }
                }
                if (wave == 1) { for (int nb = bid; nb < NP / 16; nb += G) {
                    const mf32x4 acc = meta_gemm16(HB + (size_t)MR * DM, W1T + (size_t)l * NP * 1024, nb, lane);
                    const int col = 16 * nb + (lane & 15), fq = lane >> 4; const float sc = (col < 256 || (col >= 1024 && col < 1536)) ? att::C2 : 1.f;
#pragma unroll
                    for (int j = 0; j < 4; ++j) PROJ[(size_t)(MR + 4 * fq + j) * NP + col] = f2bf(acc[j] * sc * rsqrtf(ss_val(ssl[MR + 4 * fq + j]) * (1.f / 1024.f) + 1e-6f)); } }
                pg8::Gemm g{HB, W1T + (size_t)l * NP * 1024, MR, NP, 1024}; pg8::StaticOrder S; S.init(MR, NP, G, bid);
                pg8::EpiProj E{PROJ, NP, att::C2, KMX, ssl};
#ifndef DIAG_NO_GEMM
                pg8::gemm_phase<pg8::EpiProj, pg8::StaticOrder, PG8_ALIGN, PG8_SP2>(ldsp + RING_OFF, g, S, E);
#endif
            } else if (sub == 1) {
                const float li = __int_as_float(__builtin_amdgcn_readfirstlane(__float_as_int(LAM[4 + l])));
                const float lam = __int_as_float(__builtin_amdgcn_readfirstlane(__float_as_int(LAM[l])));
                const float* subg = ap->in[9] + l * 128;
                float* park = (float*)(ws + WS_RES) + (size_t)bid * 4 * 4096;
#ifndef DIAG_NO_META
                if (bid == G - 1) {
                    if (wave < 4) fox_meta(wave, lane, PROJ, CUM, MIX); else diff_meta(wave - 4, lane, PROJ, subg, lam, li, MIX);
                    for (int tk = wave; tk < 64; tk += NWAVES) pool_meta(tk >> 2, tk & 3, lane, PROJ, ap->in[10] + (size_t)l * 4 * 64 * 64, ap->in[11] + l * 256, MIX);
                }
#endif
                gu32* qcnt = (gu32*)(ws + WS_CTL) + CW_Q + l * 8 * 64;
                const int xcc = (int)(bar.x & 7u);
                for (int qi = 0; qi < 8; ++qi) {
                    const int x = (xcc + qi) & 7;
                    for (;;) {
                        if (tid == 0) MISC[16] = __hip_atomic_fetch_add(qcnt + x * 64, 1u, __ATOMIC_RELAXED, __HIP_MEMORY_SCOPE_AGENT);
                        __syncthreads();
                        const int u = (int)MISC[16];
                        __syncthreads();
                        if (u >= 224) break;
                        if (u < 128) {
#ifndef DIAG_NO_DIFF
                            const int qb_ = 31 - (u >> 2), h_ = 3 - (u & 3), b_ = (x - h_) & 7;
                            att::attn_unit<1>(ldsp + RING_OFF, PROJ, CUM, MIX, b_, h_, qb_, lam, li, subg, park, KMX, TOT);
#endif
                        } else if (u < 192) {
#ifndef DIAG_NO_FOX
                            const int v = u - 128, qb_ = 15 - (v >> 2), h_ = 3 - (v & 3), b_ = (x - h_) & 7;
                            att::attn_unit<0>(ldsp + RING_OFF, PROJ, CUM, MIX, b_, h_, qb_, lam, li, subg, park, KMX, TOT);
#endif
                        } else {
#ifndef DIAG_NO_POOL
                            att::pool_unit(ldsp + RING_OFF, PROJ, WPT + (size_t)l * 4 * 64 * 64, ap->in[11] + l * 256, MIX, x * 32 + (u - 192));
#endif
                        }
                    }
                }
            } else {
                { unsigned zz = 0u; asm volatile("" : "+v"(zz)); for (int i = gt; i < KMX_WORDS; i += NT) KMX[i] = zz; }
                if (wave == 0) { for (int nb = bid; nb < 64; nb += G) {
                    const mf32x4 acc = meta_gemm16(MIX + (size_t)MR * DM, W2T + (size_t)l * 1024 * 1024, nb, lane);
                    const int col = 16 * nb + (lane & 15), fq = lane >> 4;
#pragma unroll
                    for (int j = 0; j < 4; ++j) { bf16_t* hp = HB + (size_t)(MR + 4 * fq + j) * DM + col; const bf16_t nv = f2bf(bf2f(*hp) + acc[j]); *hp = nv;
                        float q = bf2f(nv); q *= q; q += shx(q, 1, lane); q += shx(q, 2, lane); q += shx(q, 4, lane); q += shx(q, 8, lane);
                        if ((lane & 15) == 0) atomicAdd(ssn + MR + 4 * fq + j, ss_fix(q)); } } }
                pg8::Gemm g{MIX, W2T + (size_t)l * 1024 * 1024, MR, 1024, 1024}; pg8::StaticOrder S; S.init(MR, 1024, G, bid);
                pg8::EpiResidB E{HB, 1024, ssn};
#ifndef DIAG_NO_GEMM
                pg8::gemm_phase<pg8::EpiResidB, pg8::StaticOrder, PG8_ALIGN, PG8_SP2>(ldsp + RING_OFF, g, S, E);
#endif
            }
        } else {
            for (int row = gw; row < MR; row += NGW) final_row(row, lane, HB, SS + (size_t)(DEPTH & 1) * MTP, ap->out, ap->in[13]);
        }
        if (ph_ + 1 < hi) { XcdBarrier b2 = bar; b2.bar = barw; xcd_barrier(b2); }
    }
}

#ifndef MK_PER_PHASE
#define MK_PER_PHASE 0
#endif
extern "C" void kernel_launch(void* const* d_in, const int* in_sizes, int n_in, void* d_out, int out_size, void* d_ws, size_t ws_size, hipStream_t stream) {
    static int g_grid = 0;
    if (g_grid == 0) {
        int dev = 0, cus = 0, per_cu = 0;
        hipGetDevice(&dev); hipDeviceGetAttribute(&cus, hipDeviceAttributeMultiprocessorCount, dev);
        hipFuncSetAttribute((const void*)mk_fwd, hipFuncAttributeMaxDynamicSharedMemorySize, LDS_BYTES);
        hipOccupancyMaxActiveBlocksPerMultiprocessor(&per_cu, (const void*)mk_fwd, NWAVES * 64, LDS_BYTES);
        (void)hipGetLastError();
        g_grid = cus > 0 ? cus : 256;
    }
    hipMemsetAsync((unsigned char*)d_ws + WS_CTL, 0, CTL_ZERO_BYTES, stream);
    Args a{};
    for (int i = 0; i < 14; ++i) a.in[i] = (const float*)d_in[i];
    a.out = (float*)d_out; a.ws = (unsigned char*)d_ws;
#if MK_PER_PHASE
    for (int p = 0; p < NPH; ++p) { a.ph_lo = p; a.ph_hi = p + 1; hipLaunchKernelGGL(mk_fwd, dim3(g_grid), dim3(NWAVES * 64), LDS_BYTES, stream, a); }
#else
    a.ph_lo = 0; a.ph_hi = NPH;
    hipLaunchKernelGGL(mk_fwd, dim3(g_grid), dim3(NWAVES * 64), LDS_BYTES, stream, a);
#endif
}
```

```cpp
#include <hip/hip_runtime.h>
#include <stdint.h>

typedef unsigned short bf16_t;
__device__ __forceinline__ float bf2f(bf16_t v) { return __uint_as_float(((unsigned)v) << 16); }
__device__ __forceinline__ bf16_t f2bf(float f) { unsigned u = __float_as_uint(f); return (bf16_t)((u + 0x7fffu + ((u >> 16) & 1u)) >> 16); }

constexpr int BATCH = 8, SEQ = 4096, DM = 1024, DEPTH = 4, NMETA = 16;
constexpr int MR = BATCH * SEQ;
constexpr int MT = MR + NMETA;
constexpr int IN_DIM = 3588, NP = 3584;
constexpr int C_FQ = 0, C_FK = 256, C_FV = 512, C_FZ = 768, C_DQ = 1024, C_DK = 1536, C_DV = 2048, C_DZ = 2560, C_PU = 3072, C_PZ = 3328;
constexpr int M_A = 0, M_B = 256, M_C = 768;
constexpr float LN2F = 0.6931471805599453f;
__device__ __forceinline__ unsigned pk2(float lo, float hi) { return (unsigned)f2bf(lo) | ((unsigned)f2bf(hi) << 16); }

constexpr size_t MiB = 1u << 20;
constexpr size_t WS_CTL = 0;
constexpr size_t WS_W1T = 2 * MiB;
constexpr size_t WS_W2T = 30 * MiB;
constexpr size_t WS_WFG = 38 * MiB;
constexpr size_t WS_LAM = 38 * MiB + 196608;
constexpr size_t WS_TOT = 38 * MiB + 131072;
constexpr size_t WS_WPT = 38 * MiB + 262144;
constexpr size_t WS_KMX = 38 * MiB + 524288;
constexpr int KMX_WORDS = 24 * 2 * 8 * 64;
constexpr int MTP = MR + 64;
constexpr size_t WS_SS = 39 * MiB;
typedef unsigned long long ssq_t;
__device__ __forceinline__ ssq_t ss_fix(float q) { return (ssq_t)(q * 16777216.f); }
__device__ __forceinline__ float ss_val(ssq_t v) { return (float)v * (1.f / 16777216.f); }
constexpr size_t WS_CUM = 40 * MiB;
constexpr size_t WS_HB = 42 * MiB;
constexpr size_t WS_MIX = 108 * MiB;
constexpr size_t WS_PROJ = 174 * MiB;
constexpr size_t WS_RES = 400 * MiB;
constexpr size_t WS_END = 464 * MiB;

__device__ __forceinline__ float shx(float v, int m, int lane) { return __int_as_float(__builtin_amdgcn_ds_bpermute((lane ^ m) << 2, __float_as_int(v))); }
__device__ __forceinline__ float shl(float v, int src) { return __int_as_float(__builtin_amdgcn_ds_bpermute(src << 2, __float_as_int(v))); }
__device__ __forceinline__ float wave_sum(float v, int lane) {
#pragma unroll
    for (int o = 1; o < 64; o <<= 1) v += shx(v, o, lane);
    return v;
}
__device__ __forceinline__ float fexp(float x) { return __builtin_amdgcn_exp2f(x * 1.4426950408889634f); }
__device__ __forceinline__ float log_sigmoid(float x) { return fminf(x, 0.f) - __builtin_amdgcn_logf(1.f + fexp(-fabsf(x))) * 0.6931471805599453f; }
__device__ __forceinline__ float silu(float x) { return x / (1.f + fexp(-x)); }

__device__ __forceinline__ void entry_row(int row, int lane, const float* __restrict__ xreal, const float* __restrict__ xmeta, bf16_t* HB, ssq_t* SS0) {
    const float* hp = row < MR ? xreal + (size_t)row * DM : xmeta + (size_t)(row - MR) * DM;
    float ss = 0.f;
#pragma unroll
    for (int j = 0; j < 4; ++j) { const float4 v = *(const float4*)(hp + j * 256 + lane * 4);
        const unsigned w0 = pk2(v.x, v.y), w1 = pk2(v.z, v.w);
        const float a0 = __uint_as_float(w0 << 16), a1 = __uint_as_float(w0 & 0xffff0000u), a2 = __uint_as_float(w1 << 16), a3 = __uint_as_float(w1 & 0xffff0000u);
        ss += (a0 * a0 + a1 * a1) + (a2 * a2 + a3 * a3);
        *(uint2*)(HB + (size_t)row * DM + j * 256 + lane * 4) = make_uint2(w0, w1); }
    ss = wave_sum(ss, lane);
    if (lane == 0) SS0[row] = ss_fix(ss);
}
__device__ __forceinline__ void final_row(int row, int lane, const bf16_t* __restrict__ HB, const ssq_t* __restrict__ SSf, float* OUT, const float* __restrict__ final_g) {
    const float rstd = rsqrtf(ss_val(SSf[row]) * (1.f / DM) + 1e-6f);
#pragma unroll
    for (int j = 0; j < 4; ++j) {
        const uint2 w = *(const uint2*)(HB + (size_t)row * DM + j * 256 + lane * 4);
        const float4 g = *(const float4*)(final_g + j * 256 + lane * 4);
        float4 o; o.x = __uint_as_float(w.x << 16) * rstd * g.x; o.y = __uint_as_float(w.x & 0xffff0000u) * rstd * g.y; o.z = __uint_as_float(w.y << 16) * rstd * g.z; o.w = __uint_as_float(w.y & 0xffff0000u) * rstd * g.w;
        *(float4*)(OUT + (size_t)row * DM + j * 256 + lane * 4) = o;
    }
}
typedef short mbf16x8 __attribute__((ext_vector_type(8)));
typedef float mf32x4 __attribute__((ext_vector_type(4)));
__device__ __forceinline__ mf32x4 meta_gemm16(const bf16_t* __restrict__ A16, const bf16_t* __restrict__ Bt, int nb, int lane) {
    const int fr = lane & 15, fq = lane >> 4; mf32x4 acc = {0.f, 0.f, 0.f, 0.f};
    const bf16_t* ap = A16 + fr * 1024 + fq * 8; const bf16_t* bp = Bt + (size_t)(16 * nb + fr) * 1024 + fq * 8;
#pragma unroll 16
    for (int kk = 0; kk < 32; ++kk) { const mbf16x8 a = *(const mbf16x8*)(ap + kk * 32), b = *(const mbf16x8*)(bp + kk * 32); acc = __builtin_amdgcn_mfma_f32_16x16x32_bf16(a, b, acc, 0, 0, 0); }
    return acc;
}
__device__ __forceinline__ void ld16(const bf16_t* p, float (&x)[16]) {
    const uint4 a = *(const uint4*)p, b = *(const uint4*)(p + 8);
    const unsigned w[8] = {a.x, a.y, a.z, a.w, b.x, b.y, b.z, b.w};
#pragma unroll
    for (int j = 0; j < 8; ++j) { x[2 * j] = __uint_as_float(w[j] << 16); x[2 * j + 1] = __uint_as_float(w[j] & 0xffff0000u); }
}
__device__ __forceinline__ mf32x4 meta_gemm16_k8(const bf16_t* __restrict__ A16, const bf16_t* __restrict__ Bt, int nb, int wave, int lane, __attribute__((address_space(3))) float* red) {
    const int fr = lane & 15, fq = lane >> 4; mf32x4 acc = {0.f, 0.f, 0.f, 0.f};
    const bf16_t* ap = A16 + fr * 1024 + fq * 8 + wave * 128; const bf16_t* bp = Bt + (size_t)(16 * nb + fr) * 1024 + fq * 8 + wave * 128;
    mbf16x8 a[4], b[4];
#pragma unroll
    for (int kk = 0; kk < 4; ++kk) { a[kk] = *(const mbf16x8*)(ap + kk * 32); b[kk] = *(const mbf16x8*)(bp + kk * 32); }
#pragma unroll
    for (int kk = 0; kk < 4; ++kk) acc = __builtin_amdgcn_mfma_f32_16x16x32_bf16(a[kk], b[kk], acc, 0, 0, 0);
    *(__attribute__((address_space(3))) mf32x4*)(red + (wave * 64 + lane) * 4) = acc;
    __syncthreads();
    mf32x4 sum = {0.f, 0.f, 0.f, 0.f};
#pragma unroll
    for (int w = 0; w < 8; ++w) sum += *(const __attribute__((address_space(3))) mf32x4*)(red + (w * 64 + lane) * 4);
    __syncthreads();
    return sum;
}
__device__ __forceinline__ void fox_meta(int h, int lane, const bf16_t* __restrict__ PROJ, const float* __restrict__ CUM, bf16_t* MIX) {
    const int t = lane >> 2, dq = lane & 3, row = MR + t;
    float ln2 = LN2F, m = -1e30f; asm volatile("" : "+v"(ln2), "+v"(m));
    float q[16], o[16], x[16];
    ld16(PROJ + (size_t)row * NP + C_FQ + h * 64 + dq * 16, q);
#pragma unroll
    for (int d = 0; d < 16; ++d) { q[d] *= ln2; o[d] = 0.f; }
    const float cq = CUM[(size_t)h * MTP + row];
    float lsum = 0.f;
    for (int kk = 0; kk < 16; ++kk) {
        const int krow = MR + kk;
        ld16(PROJ + (size_t)krow * NP + C_FK + h * 64 + dq * 16, x);
        float sc = 0.f;
#pragma unroll
        for (int d = 0; d < 16; ++d) sc += q[d] * x[d];
        sc += shx(sc, 1, lane); sc += shx(sc, 2, lane);
        sc += cq - CUM[(size_t)h * MTP + krow];
        ld16(PROJ + (size_t)krow * NP + C_FV + h * 64 + dq * 16, x);
        if (kk <= t) {
            if (sc > m) { const float a = fexp(m - sc); lsum *= a;
#pragma unroll
                for (int d = 0; d < 16; ++d) o[d] *= a;
                m = sc; }
            const float p = fexp(sc - m); lsum += p;
#pragma unroll
            for (int d = 0; d < 16; ++d) o[d] += p * x[d];
        }
    }
    const float inv = 1.f / lsum;
    ld16(PROJ + (size_t)row * NP + C_FZ + h * 64 + dq * 16, x);
    bf16_t* mp = MIX + (size_t)row * DM + M_A + h * 64 + dq * 16;
#pragma unroll
    for (int d = 0; d < 16; d += 2) *(unsigned*)(mp + d) = pk2(o[d] * inv * silu(x[d]), o[d + 1] * inv * silu(x[d + 1]));
}
__device__ __forceinline__ void diff_meta(int h, int lane, const bf16_t* __restrict__ PROJ, const float* __restrict__ subln_g_l, float lam, float li, bf16_t* MIX) {
    const int ri = lane >> 2, qq = lane & 3, row = MR + ri;
    const float posq = (float)ri, slope = 1.f / (float)(1 << (2 * h + 2));
    float res[32], x[16], y[16];
    for (int c = 0; c < 2; ++c) {
        float ln2 = LN2F, m = -1e30f; asm volatile("" : "+v"(ln2), "+v"(m));
        float q[16], o[32];
        ld16(PROJ + (size_t)row * NP + C_DQ + h * 128 + c * 64 + qq * 16, q);
#pragma unroll
        for (int d = 0; d < 16; ++d) q[d] *= ln2;
#pragma unroll
        for (int d = 0; d < 32; ++d) o[d] = 0.f;
        float lsum = 0.f;
        for (int kk = 0; kk < 16; ++kk) {
            const int krow = MR + kk;
            ld16(PROJ + (size_t)krow * NP + C_DK + h * 128 + c * 64 + qq * 16, x);
            float sc = 0.f;
#pragma unroll
            for (int d = 0; d < 16; ++d) sc += q[d] * x[d];
            sc += shx(sc, 1, lane); sc += shx(sc, 2, lane);
            sc -= slope * fabsf(posq - (float)kk);
            ld16(PROJ + (size_t)krow * NP + C_DV + h * 128 + qq * 32, x);
            ld16(PROJ + (size_t)krow * NP + C_DV + h * 128 + qq * 32 + 16, y);
            if (sc > m) { const float a = fexp(m - sc); lsum *= a;
#pragma unroll
                for (int d = 0; d < 32; ++d) o[d] *= a;
                m = sc; }
            const float p = fexp(sc - m); lsum += p;
#pragma unroll
            for (int d = 0; d < 16; ++d) { o[d] += p * x[d]; o[16 + d] += p * y[d]; }
        }
        const float inv = 1.f / lsum;
        if (c == 0) {
#pragma unroll
            for (int d = 0; d < 32; ++d) res[d] = o[d] * inv;
        } else {
#pragma unroll
            for (int d = 0; d < 32; ++d) res[d] -= lam * o[d] * inv;
        }
    }
    float ss = 0.f;
#pragma unroll
    for (int d = 0; d < 32; ++d) ss += res[d] * res[d];
    ss += shx(ss, 1, lane); ss += shx(ss, 2, lane);
    const float rstd = rsqrtf(ss * (1.f / 128.f) + 1e-5f) * (1.f - li);
    ld16(PROJ + (size_t)row * NP + C_DZ + h * 128 + qq * 32, x);
    ld16(PROJ + (size_t)row * NP + C_DZ + h * 128 + qq * 32 + 16, y);
    bf16_t* mp = MIX + (size_t)row * DM + M_B + h * 128 + qq * 32;
    const float* gp = subln_g_l + qq * 32;
#pragma unroll
    for (int d = 0; d < 16; d += 2) {
        *(unsigned*)(mp + d) = pk2(res[d] * rstd * gp[d] * silu(x[d]), res[d + 1] * rstd * gp[d + 1] * silu(x[d + 1]));
        *(unsigned*)(mp + 16 + d) = pk2(res[16 + d] * rstd * gp[16 + d] * silu(y[d]), res[17 + d] * rstd * gp[17 + d] * silu(y[d + 1])); }
}
__device__ __forceinline__ void pool_meta(int j, int g, int lane, const bf16_t* __restrict__ PROJ, const float* __restrict__ wpool_l, const float* __restrict__ pscale_l, bf16_t* MIX) {
    const int w = 2 << g, cnt = (j + 1) < w ? (j + 1) : w, row = MR + j;
    float s = 0.f;
    for (int i = 0; i < cnt; ++i) s += bf2f(PROJ[(size_t)(MR + j - i) * NP + C_PU + g * 64 + lane]);
    const float pooled = s / (float)cnt - bf2f(PROJ[(size_t)row * NP + C_PU + g * 64 + lane]);
    float y = 0.f;
    for (int i = 0; i < 64; ++i) y += shl(pooled, i) * wpool_l[(g * 64 + i) * 64 + lane];
    const float z = bf2f(PROJ[(size_t)row * NP + C_PZ + g * 64 + lane]);
    MIX[(size_t)row * DM + M_C + g * 64 + lane] = f2bf(y * pscale_l[g * 64 + lane] * silu(z));
}

namespace pg8 {
#define PG8_LAS __attribute__((address_space(3)))
typedef unsigned short bf16_t;
typedef short bf16x8 __attribute__((ext_vector_type(8)));
typedef float f32x4 __attribute__((ext_vector_type(4)));
typedef unsigned u32x4 __attribute__((ext_vector_type(4)));
constexpr int BM = 256, BK = 64, HALF = 128, HTB = HALF * BK * 2  , STAGE_BYTES = 8 * HTB, NXCD = 8, WGM = 8;

__host__ __device__ __forceinline__ int lds_byte(int r, int c) { const int st = (r >> 4) * 2 + (c >> 5), rr = r & 15, cc = c & 31, ob = rr * 64 + cc * 2; return st * 1024 + (ob ^ (((ob >> 9) & 1) << 5)); }
__host__ __device__ __forceinline__ void stage_rc(int b, int& R, int& C) { const int st = b / 1024, sb = b % 1024, swz = sb ^ (((sb >> 9) & 1) << 5); R = (st >> 1) * 16 + swz / 64; C = (st & 1) * 32 + (swz % 64) / 2; }
__host__ __device__ __forceinline__ int perm32(int rho) { const int n = rho >> 4, i = rho & 15; return 8 * (i >> 2) + 4 * n + (i & 3); }

struct Unit { int pm, pn; };
struct Gemm { const bf16_t* A; const bf16_t* Bt; int M, N, K; };

struct StaticOrder {
    int nM, nN, nwg, G, c;
    __host__ __device__ void init(int M, int N, int G_, int c_) { nM = M / BM; nN = N / BM; nwg = nM * nN; G = G_; c = c_; }
    __host__ __device__ bool next(int i, Unit& u) const {
        const long L = (long)i * G + c; if (L >= nwg) return false;
        int wgid = (int)L; { const int q = nwg / NXCD, r = nwg % NXCD, xcd = wgid % NXCD, off = wgid / NXCD; wgid = (xcd < r ? xcd * (q + 1) : r * (q + 1) + (xcd - r) * q) + off; }
        const int nig = WGM * nN, gid = wgid / nig, fm = gid * WGM, gsz = (nM - fm) < WGM ? (nM - fm) : WGM;
        u.pm = fm + ((wgid % nig) % gsz); u.pn = (wgid % nig) / gsz; return true;
    }
    __device__ __forceinline__ void a_ready(const Unit&) const {}
    __device__ __forceinline__ void done(const Unit&) const {}
};

__device__ __forceinline__ unsigned cvt_pk_bf16(float lo, float hi) { unsigned r; asm volatile("v_cvt_pk_bf16_f32 %0, %1, %2" : "=v"(r) : "v"(lo), "v"(hi)); return r; }
struct EpiProj {
    static constexpr bool PERM = true, AFTER_DRAIN = false;
    bf16_t* O; int ldc; float qscale; unsigned* kmx; const ssq_t* ss;
    __device__ __forceinline__ void operator()(const f32x4 (&acc)[2][2][4][2], const Unit& u, int wr, int wc, int fr, int fq) const {
        const int row0 = u.pm * BM + wr * 64 + fr, col0 = u.pn * BM + wc * 32 + 8 * fq;
        const float sc = (u.pn == 0 || u.pn == 4 || u.pn == 5) ? qscale : 1.f;
        const bool nrm = (u.pn <= 1) || (u.pn >= 4 && u.pn <= 7);
        float part[2][2][4];
#pragma unroll
        for (int ai = 0; ai < 2; ++ai)
#pragma unroll
            for (int m = 0; m < 4; ++m) { bf16_t* rowp = O + (size_t)(row0 + ai * HALF + m * 16) * ldc + col0;
                const float rs = sc * rsqrtf(ss_val(ss[row0 + ai * HALF + m * 16]) * (1.f / 1024.f) + 1e-6f);
#pragma unroll
                for (int bj = 0; bj < 2; ++bj) { const f32x4 v0 = acc[ai][bj][m][0] * rs, v1 = acc[ai][bj][m][1] * rs;
                    part[ai][bj][m] = (v0[0] * v0[0] + v0[1] * v0[1]) + (v0[2] * v0[2] + v0[3] * v0[3]) + (v1[0] * v1[0] + v1[1] * v1[1]) + (v1[2] * v1[2] + v1[3] * v1[3]);
                    u32x4 w; w.x = cvt_pk_bf16(v0[0], v0[1]); w.y = cvt_pk_bf16(v0[2], v0[3]); w.z = cvt_pk_bf16(v1[0], v1[1]); w.w = cvt_pk_bf16(v1[2], v1[3]);
                    *(u32x4*)(rowp + bj * HALF) = w; } }
        if (nrm) {
            const int lane = fr + 16 * fq;
#pragma unroll
            for (int ai = 0; ai < 2; ++ai)
#pragma unroll
                for (int bj = 0; bj < 2; ++bj) {
                    float mx = 0.f;
#pragma unroll
                    for (int m = 0; m < 4; ++m) { float p = part[ai][bj][m]; p += shx(p, 16, lane); p += shx(p, 32, lane); mx = fmaxf(mx, p); }
                    mx = fmaxf(mx, shx(mx, 1, lane)); mx = fmaxf(mx, shx(mx, 2, lane)); mx = fmaxf(mx, shx(mx, 4, lane)); mx = fmaxf(mx, shx(mx, 8, lane));
                    if (lane == 0) { const int R = u.pm * BM + ai * HALF + wr * 64, col = u.pn * BM + bj * HALF + wc * 32;
                        const int st = col < 512 ? (col >> 6) : 8 + ((col - 1024) >> 6), half = (col >> 5) & 1;
                        atomicMax(kmx + ((st * 2 + half) * 8 + (R >> 12)) * 64 + ((R & 4095) >> 6), __float_as_uint(mx)); }
                }
        }
    }
};
struct EpiResidB {
    static constexpr bool PERM = true, AFTER_DRAIN = false;
    bf16_t* H; int ldc; ssq_t* ssn;
    __device__ __forceinline__ void operator()(const f32x4 (&acc)[2][2][4][2], const Unit& u, int wr, int wc, int fr, int fq) const {
        const int row0 = u.pm * BM + wr * 64 + fr, col0 = u.pn * BM + wc * 32 + 8 * fq, lane = fr + 16 * fq;
#pragma unroll
        for (int ai = 0; ai < 2; ++ai)
#pragma unroll
            for (int m = 0; m < 4; ++m) { const int row = row0 + ai * HALF + m * 16; bf16_t* rowp = H + (size_t)row * ldc + col0; float q = 0.f;
#pragma unroll
                for (int bj = 0; bj < 2; ++bj) { const u32x4 b = *(const u32x4*)(rowp + bj * HALF); const f32x4 a0 = acc[ai][bj][m][0], a1 = acc[ai][bj][m][1];
                    u32x4 w;
                    w.x = cvt_pk_bf16(__uint_as_float(b.x << 16) + a0[0], __uint_as_float(b.x & 0xffff0000u) + a0[1]);
                    w.y = cvt_pk_bf16(__uint_as_float(b.y << 16) + a0[2], __uint_as_float(b.y & 0xffff0000u) + a0[3]);
                    w.z = cvt_pk_bf16(__uint_as_float(b.z << 16) + a1[0], __uint_as_float(b.z & 0xffff0000u) + a1[1]);
                    w.w = cvt_pk_bf16(__uint_as_float(b.w << 16) + a1[2], __uint_as_float(b.w & 0xffff0000u) + a1[3]);
                    *(u32x4*)(rowp + bj * HALF) = w;
#pragma unroll
                    for (int k = 0; k < 4; ++k) { const float lo = __uint_as_float(w[k] << 16), hi = __uint_as_float(w[k] & 0xffff0000u); q += lo * lo + hi * hi; } }
                q += shx(q, 16, lane); q += shx(q, 32, lane);
                if (fq == 0) atomicAdd(ssn + row, ss_fix(q)); }
    }
};
template <class Epi, class Sched, bool ALIGN_EPI = false, bool SP2 = false>
__device__ __forceinline__ void gemm_phase(PG8_LAS unsigned char* lds, const Gemm g, const Sched& S, const Epi& E) {
    int tid_ = threadIdx.x; asm volatile("" : "+v"(tid_));
    const int tid = tid_, wid = __builtin_amdgcn_readfirstlane(tid >> 6), lane = tid & 63, wr = wid >> 2, wc = wid & 3, fr = lane & 15, fq = lane >> 4;
    const int K = g.K, nt = K / BK;
    unsigned voffA[2], voffB[2];
#pragma unroll
    for (int i = 0; i < 2; ++i) { int R, C; stage_rc(tid * 16 + i * 8192, R, C); const int Rb = Epi::PERM ? ((R & ~31) + perm32(R & 31)) : R;
        voffA[i] = (unsigned)(R * K + C) * 2u; voffB[i] = (unsigned)(Rb * K + C) * 2u; }
    const size_t kstep = (size_t)(BK * 2);
    const size_t hstep = (size_t)HALF * K * 2;
    const size_t tstep = 2 * hstep;
    const unsigned ldsw = (unsigned)wid * 1024u;
    const int aoff = lds_byte(wr * 64 + fr, fq * 8), boff = lds_byte(wc * 32 + fr, fq * 8);
#define PG8_SA(b, h) (((b) * 2 + (h)) * HTB)
#define PG8_SB(b, h) ((4 + (b) * 2 + (h)) * HTB)
#define PG8_STAGE(bufoff, gbase, voff) do { _Pragma("unroll") for (int _i = 0; _i < 2; ++_i) \
        __builtin_amdgcn_global_load_lds((const unsigned*)((const char*)(gbase) + (voff)[_i]), (PG8_LAS unsigned*)(lds + (bufoff) + ldsw + _i * 8192), 16, 0, 0); } while (0)
#define PG8_LDA(dst, b, h) do { _Pragma("unroll") for (int m = 0; m < 4; ++m) _Pragma("unroll") for (int k = 0; k < 2; ++k) dst[m][k] = *(const PG8_LAS bf16x8*)(lds + PG8_SA(b, h) + aoff + m * 2048 + k * 1024); } while (0)
#define PG8_LDB(dst, b, h) do { _Pragma("unroll") for (int n = 0; n < 2; ++n) _Pragma("unroll") for (int k = 0; k < 2; ++k) dst[n][k] = *(const PG8_LAS bf16x8*)(lds + PG8_SB(b, h) + boff + n * 2048 + k * 1024); } while (0)
#define PG8_MMA(ai, bj, At, Bt) do { __builtin_amdgcn_s_setprio(1); _Pragma("unroll") for (int m = 0; m < 4; ++m) _Pragma("unroll") for (int n = 0; n < 2; ++n) _Pragma("unroll") for (int k = 0; k < 2; ++k) \
        acc[ai][bj][m][n] = __builtin_amdgcn_mfma_f32_16x16x32_bf16(Bt[n][k], At[m][k], acc[ai][bj][m][n], 0, 0, 0); __builtin_amdgcn_s_setprio(0); } while (0)
#define PG8_WAIT_V(n) asm volatile("s_waitcnt vmcnt(" #n ")" ::: "memory")
#define PG8_WAIT_L(n) asm volatile("s_waitcnt lgkmcnt(" #n ")" ::: "memory")
#define PG8_BAR __builtin_amdgcn_s_barrier()
#define PG8_SCHED __builtin_amdgcn_sched_barrier(0)
    Unit cur, nxt; int ui = 0;
    if (!S.next(0, cur)) return;
    f32x4 acc[2][2][4][2];
#pragma unroll
    for (int a = 0; a < 2; ++a)
#pragma unroll
        for (int b = 0; b < 2; ++b)
#pragma unroll
            for (int m = 0; m < 4; ++m)
#pragma unroll
                for (int n = 0; n < 2; ++n) acc[a][b][m][n] = (f32x4){0.f, 0.f, 0.f, 0.f};
    bf16x8 At[4][2], B0[2][2], B1[2][2];
    const char* cA = (const char*)g.A + (size_t)cur.pm * tstep; const char* cB = (const char*)g.Bt + (size_t)cur.pn * tstep;
    S.a_ready(cur);
    if constexpr (SP2) {
        PG8_STAGE(PG8_SB(0, 0), cB, voffB); PG8_STAGE(PG8_SB(0, 1), cB + hstep, voffB); PG8_STAGE(PG8_SA(0, 0), cA, voffA); PG8_STAGE(PG8_SA(0, 1), cA + hstep, voffA);
        if (wr == 1) PG8_BAR;
        PG8_WAIT_V(2); PG8_BAR;
        PG8_STAGE(PG8_SB(1, 0), cB + kstep, voffB); PG8_STAGE(PG8_SA(1, 0), cA + kstep, voffA); PG8_STAGE(PG8_SB(1, 1), cB + hstep + kstep, voffB);
        PG8_WAIT_V(6); PG8_BAR;
    } else {
        PG8_STAGE(PG8_SB(0, 0), cB, voffB); PG8_STAGE(PG8_SA(0, 0), cA, voffA); PG8_STAGE(PG8_SB(0, 1), cB + hstep, voffB); PG8_STAGE(PG8_SA(0, 1), cA + hstep, voffA);
        if (wr == 1) PG8_BAR;
        PG8_WAIT_V(4); PG8_BAR;
        PG8_STAGE(PG8_SB(1, 0), cB + kstep, voffB); PG8_STAGE(PG8_SA(1, 0), cA + kstep, voffA); PG8_STAGE(PG8_SB(1, 1), cB + hstep + kstep, voffB);
        PG8_WAIT_V(6); PG8_BAR;
    }
    for (;;) {
        const bool has_next = S.next(ui + 1, nxt);
        const char* nA = has_next ? (const char*)g.A + (size_t)nxt.pm * tstep : cA; const char* nB = has_next ? (const char*)g.Bt + (size_t)nxt.pn * tstep : cB;
        for (int t = 0; t < nt; t += 2) {
            const bool last = (t == nt - 2);
            const char* a1 = cA + (size_t)(t + 1) * kstep;
            const char* a2 = last ? nA : cA + (size_t)(t + 2) * kstep; const char* b2 = last ? nB : cB + (size_t)(t + 2) * kstep;
            const char* a3 = a2 + kstep; const char* b3 = b2 + kstep;
            if (last && has_next) S.a_ready(nxt);
            if constexpr (SP2) {
            PG8_LDB(B0, 0, 0); PG8_LDB(B1, 0, 1); PG8_SCHED; PG8_LDA(At, 0, 0); PG8_STAGE(PG8_SA(1, 1), a1 + hstep, voffA);
            PG8_WAIT_V(8); PG8_WAIT_L(0); PG8_BAR; PG8_MMA(0, 0, At, B0); PG8_MMA(0, 1, At, B1); PG8_BAR; PG8_SCHED;
            PG8_LDA(At, 0, 1); PG8_STAGE(PG8_SB(0, 0), b2, voffB); PG8_STAGE(PG8_SB(0, 1), b2 + hstep, voffB); PG8_STAGE(PG8_SA(0, 0), a2, voffA);
            PG8_WAIT_V(8); PG8_WAIT_L(0); PG8_BAR; PG8_MMA(1, 0, At, B0); PG8_MMA(1, 1, At, B1); PG8_BAR; PG8_SCHED;
            PG8_LDB(B0, 1, 0); PG8_LDB(B1, 1, 1); PG8_SCHED; PG8_LDA(At, 1, 0); PG8_STAGE(PG8_SA(0, 1), a2 + hstep, voffA);
            PG8_WAIT_V(8); PG8_WAIT_L(0); PG8_BAR; PG8_MMA(0, 0, At, B0); PG8_MMA(0, 1, At, B1); PG8_BAR; PG8_SCHED;
            PG8_LDA(At, 1, 1); PG8_STAGE(PG8_SB(1, 0), b3, voffB); PG8_STAGE(PG8_SB(1, 1), b3 + hstep, voffB); PG8_STAGE(PG8_SA(1, 0), a3, voffA);
            PG8_WAIT_V(8); PG8_WAIT_L(0); PG8_BAR; PG8_MMA(1, 0, At, B0); PG8_MMA(1, 1, At, B1); PG8_BAR; PG8_SCHED;
            } else {
            PG8_LDB(B0, 0, 0); PG8_SCHED; PG8_LDA(At, 0, 0); PG8_STAGE(PG8_SA(1, 1), a1 + hstep, voffA);
            PG8_WAIT_L(8); PG8_BAR; PG8_WAIT_L(0); PG8_MMA(0, 0, At, B0); PG8_BAR; PG8_SCHED;
            PG8_LDB(B1, 0, 1); PG8_STAGE(PG8_SB(0, 0), b2, voffB);
            PG8_BAR; PG8_WAIT_L(0); PG8_MMA(0, 1, At, B1); PG8_BAR;
            PG8_LDA(At, 0, 1); PG8_STAGE(PG8_SA(0, 0), a2, voffA);
            PG8_BAR; PG8_WAIT_L(0); PG8_MMA(1, 0, At, B0); PG8_BAR; PG8_SCHED;
            PG8_STAGE(PG8_SB(0, 1), b2 + hstep, voffB);
            PG8_WAIT_V(6); PG8_BAR; PG8_MMA(1, 1, At, B1); PG8_BAR;
            PG8_LDB(B0, 1, 0); PG8_SCHED; PG8_LDA(At, 1, 0); PG8_STAGE(PG8_SA(0, 1), a2 + hstep, voffA);
            PG8_WAIT_L(8); PG8_BAR; PG8_WAIT_L(0); PG8_MMA(0, 0, At, B0); PG8_BAR; PG8_SCHED;
            PG8_LDB(B1, 1, 1); PG8_STAGE(PG8_SB(1, 0), b3, voffB);
            PG8_BAR; PG8_WAIT_L(0); PG8_MMA(0, 1, At, B1); PG8_BAR;
            PG8_LDA(At, 1, 1); PG8_STAGE(PG8_SA(1, 0), a3, voffA);
            PG8_BAR; PG8_WAIT_L(0); PG8_MMA(1, 0, At, B0); PG8_BAR; PG8_SCHED;
            PG8_STAGE(PG8_SB(1, 1), b3 + hstep, voffB);
            PG8_WAIT_V(6); PG8_BAR; PG8_MMA(1, 1, At, B1); PG8_BAR;
            }
        }
        if constexpr (ALIGN_EPI) { if (wr == 0) PG8_BAR; }
        if constexpr (!Epi::AFTER_DRAIN) { E(acc, cur, wr, wc, fr, fq); S.done(cur); }
        if (!has_next) break;
#pragma unroll
        for (int a = 0; a < 2; ++a)
#pragma unroll
            for (int b = 0; b < 2; ++b)
#pragma unroll
                for (int m = 0; m < 4; ++m)
#pragma unroll
                    for (int n = 0; n < 2; ++n) acc[a][b][m][n] = (f32x4){0.f, 0.f, 0.f, 0.f};
        cur = nxt; cA = nA; cB = nB; ++ui;
        if constexpr (ALIGN_EPI) { if (wr == 1) PG8_BAR; }
    }
    PG8_WAIT_V(0);
    if constexpr (!ALIGN_EPI) { if (wr == 0) PG8_BAR; }
    PG8_BAR;
    if constexpr (Epi::AFTER_DRAIN) { E.fused(acc, cur, wr, wc, fr, fq, lds, wid, lane); S.done(cur); }
#undef PG8_SA
#undef PG8_SB
#undef PG8_STAGE
#undef PG8_LDA
#undef PG8_LDB
#undef PG8_MMA
#undef PG8_WAIT_V
#undef PG8_WAIT_L
#undef PG8_BAR
#undef PG8_SCHED
}
}
namespace att {
typedef float f32x16 __attribute__((ext_vector_type(16)));
typedef float f32x4 __attribute__((ext_vector_type(4)));
typedef short bf16x8 __attribute__((ext_vector_type(8)));
typedef short s16x4 __attribute__((ext_vector_type(4)));
typedef unsigned u32x4 __attribute__((ext_vector_type(4)));
#define ALAS __attribute__((address_space(3)))
constexpr int KCS = 1040, VDS = 4160, KBUF = 8 * KCS, VBUF = 4 * VDS, NSLOT = 3;
constexpr int KBOFF = KBUF + VBUF, STG0 = KBOFF + 256, STG1 = 2 * KBUF + VBUF;
template <int MODE> struct Geo { static constexpr int STG = MODE == 0 ? STG0 : STG1, VOFF = MODE == 0 ? KBUF : 2 * KBUF; };
constexpr int L_WSF = NSLOT * STG1, L_OST = L_WSF + 8 * 256, L_END = L_OST + 8 * 4096;
constexpr float LOG2E = 1.4426950408889634f, C2 = 0.125f * LOG2E, THR = 8.f, NEGBIG = -1e30f;
__device__ __forceinline__ int crow(int r, int hi) { return (r & 3) + 8 * (r >> 2) + 4 * hi; }
__device__ __forceinline__ unsigned cvtpk(float lo, float hi) { typedef float f2 __attribute__((ext_vector_type(2))); typedef __bf16 b2 __attribute__((ext_vector_type(2))); f2 v = {lo, hi}; b2 b = __builtin_convertvector(v, b2); return __builtin_bit_cast(unsigned, b); }
__device__ __forceinline__ s16x4 vtr(const ALAS unsigned char* p) { typedef short v4i16_t __attribute__((ext_vector_type(4))); return __builtin_bit_cast(s16x4, __builtin_amdgcn_ds_read_tr16_b64_v4i16((ALAS v4i16_t*)p)); }
__device__ __forceinline__ float bfl(unsigned w) { return __uint_as_float(w << 16); }
__device__ __forceinline__ float bfh(unsigned w) { return __uint_as_float(w & 0xffff0000u); }
__device__ __forceinline__ float silu_f(float x) { return x * __builtin_amdgcn_rcpf(1.f + fexp(-x)); }
__device__ __forceinline__ void glds16(const void* gsrc, unsigned lds_dst) { unsigned keep;
    asm volatile("s_mov_b32 %0, m0\n\ts_mov_b32 m0, %2\n\ts_nop 0\n\tglobal_load_lds_dwordx4 %1, off\n\ts_mov_b32 m0, %0" : "=&s"(keep) : "v"(gsrc), "s"(lds_dst) : "memory"); }
__device__ __forceinline__ void glds4(const void* gsrc, unsigned lds_dst) { unsigned keep;
    asm volatile("s_mov_b32 %0, m0\n\ts_mov_b32 m0, %2\n\ts_nop 0\n\tglobal_load_lds_dword %1, off\n\ts_mov_b32 m0, %0" : "=&s"(keep) : "v"(gsrc), "s"(lds_dst) : "memory"); }
#define ATT_SBAR0() __builtin_amdgcn_sched_barrier(0)
#define ATT_WAIT_BAR(N) asm volatile("s_waitcnt vmcnt(" #N ") lgkmcnt(0)\n\ts_barrier" ::: "memory")

template <int MODE> __device__ __forceinline__ void dma_k(unsigned slot, const bf16_t* __restrict__ PROJ, const float* __restrict__ CUM, size_t krow0, int kcol, int h, int wid, int lane) {
    if (MODE == 0 && wid == 0) glds4(CUM + (size_t)h * MTP + krow0 + lane, (unsigned)__builtin_amdgcn_readfirstlane(slot + KBOFF));
    glds16(PROJ + (krow0 + lane) * NP + kcol + wid * 8, (unsigned)__builtin_amdgcn_readfirstlane(slot + wid * KCS));
    if (MODE == 1) glds16(PROJ + (krow0 + lane) * NP + kcol + 64 + wid * 8, (unsigned)__builtin_amdgcn_readfirstlane(slot + KBUF + wid * KCS));
}
template <int MODE> __device__ __forceinline__ void dma_v(unsigned slot, const bf16_t* __restrict__ PROJ, size_t krow0, int vcol, int wid, int lane) {
    const bf16_t* vs = PROJ + (krow0 + (wid & 3) * 16 + (lane >> 2)) * NP + vcol + (wid >> 2) * 32 + (lane & 3) * 8;
    glds16(vs, (unsigned)__builtin_amdgcn_readfirstlane(slot + Geo<MODE>::VOFF + (wid >> 2) * VDS + (wid & 3) * 1024));
    if (MODE == 1) glds16(vs + 64, (unsigned)__builtin_amdgcn_readfirstlane(slot + Geo<MODE>::VOFF + (2 + (wid >> 2)) * VDS + (wid & 3) * 1024));
}

template <int MODE, bool DIAG, bool META> __device__ __forceinline__ bool qs_front(const ALAS unsigned char* buf, const ALAS unsigned char* vprev, s16x4 (&vl)[8], s16x4 (&vh)[8], const bf16x8 (&qr)[4], const ALAS bf16x8* qlds, f32x16& p0, f32x16& p1, float& mhat, float& l,
        int kidx0, int qw0, float slope2, float koffL, ALAS float* wsf, int lane) {
    constexpr bool diag = DIAG, meta = META;
    const int r32 = lane & 31, hi = lane >> 5;
    {
      const ALAS unsigned char* vb = vprev + Geo<MODE>::VOFF + ((lane >> 4) & 1) * 32 + (lane & 3) * 8 + (4 * hi + ((lane & 15) >> 2)) * 64; asm volatile("" : "+v"(vb));
#pragma unroll
      for (int i = 0; i < (MODE == 0 ? 8 : 4); ++i) { vl[i] = vtr(vb + (i & 1) * VDS + (i >> 1) * 1024); vh[i] = vtr(vb + (i & 1) * VDS + (i >> 1) * 1024 + 512); } }
    asm volatile("" : "+v"(slope2), "+s"(kidx0));
    if (MODE == 0) {
        const ALAS f32x4* kbp = (const ALAS f32x4*)(buf + KBOFF + hi * 16); asm volatile("" : "+v"(kbp));
#pragma unroll
        for (int g = 0; g < 4; ++g) { const f32x4 a = kbp[2 * g], b = kbp[8 + 2 * g];
#pragma unroll
            for (int j = 0; j < 4; ++j) { p0[4 * g + j] = fmaf(a[j], -LOG2E, -mhat - koffL); p1[4 * g + j] = fmaf(b[j], -LOG2E, -mhat - koffL); } }
    } else {
        if (!diag) {
            const float base = slope2 * (float)(kidx0 + 4 * hi - qw0) - mhat;
#pragma unroll
            for (int r = 0; r < 16; ++r) { const int c = (r & 3) + 8 * (r >> 2); p0[r] = fmaf((float)c, slope2, base); p1[r] = fmaf((float)(c + 32), slope2, base); }
            if (meta) {
#pragma unroll
                for (int r = 0; r < 16; ++r) { if ((r >> 2) >= 2) p0[r] = NEGBIG; p1[r] = NEGBIG; }
            }
        } else {
            const float dq = (float)(qw0 + r32 - kidx0 - 4 * hi), fr = (float)r32;
#pragma unroll
            for (int r = 0; r < 16; ++r) { const int c = (r & 3) + 8 * (r >> 2);
                p0[r] = slope2 * (fr - fabsf(dq - (float)c)) - mhat; p1[r] = slope2 * (fr - fabsf(dq - (float)(c + 32))) - mhat; }
        }
    }
    bf16x8 qfr[4];
#pragma unroll
    for (int d0 = 0; d0 < 4; ++d0) qfr[d0] = MODE == 0 ? qr[d0] : qlds[d0 * 64];
    if (MODE == 1) ATT_SBAR0();
    { const ALAS unsigned char* kb = buf + hi * KCS + r32 * 16; asm volatile("" : "+v"(kb));
#pragma unroll
      for (int d0 = 0; d0 < 4; ++d0) {
          const bf16x8 k0 = *(const ALAS bf16x8*)(kb + d0 * 2 * KCS), k1 = *(const ALAS bf16x8*)(kb + d0 * 2 * KCS + 512);
          const bf16x8 qf = qfr[d0];
          p0 = __builtin_amdgcn_mfma_f32_32x32x16_bf16(k0, qf, p0, 0, 0, 0);
          p1 = __builtin_amdgcn_mfma_f32_32x32x16_bf16(k1, qf, p1, 0, 0, 0); } }
    if (MODE == 0 && diag) {
        const int lim = qw0 + r32 - kidx0 - 4 * hi;
#pragma unroll
        for (int r = 0; r < 16; ++r) { const int c = (r & 3) + 8 * (r >> 2); if (c > lim) p0[r] = NEGBIG; if (c + 32 > lim) p1[r] = NEGBIG; }
    }
    float rm;
    {
#define ATT_MX3(a, b, c) __builtin_fmaxf(__builtin_fmaxf((a), (b)), (c))
      float a = ATT_MX3(p0[0], p0[1], p1[0]), b = ATT_MX3(p0[2], p0[3], p1[1]); a = ATT_MX3(a, p1[2], p1[3]);
#pragma unroll
      for (int r = 4; r < 16; r += 4) { a = ATT_MX3(a, p0[r], p0[r + 1]); b = ATT_MX3(b, p0[r + 2], p0[r + 3]); a = ATT_MX3(a, p1[r], p1[r + 1]); b = ATT_MX3(b, p1[r + 2], p1[r + 3]); }
#undef ATT_MX3
      a = __builtin_fmaxf(a, b);
      auto rr = __builtin_amdgcn_permlane32_swap(__float_as_uint(a), __float_as_uint(a), false, false);
      rm = __builtin_fmaxf(__uint_as_float(rr[0]), __uint_as_float(rr[1])); }
    bool resc = false;
    if (__any(rm > THR)) {
        const float dl = fmaxf(rm, 0.f); mhat += dl;
#pragma unroll
        for (int r = 0; r < 16; ++r) { p0[r] -= dl; p1[r] -= dl; }
        const float f = __builtin_amdgcn_exp2f(-dl); l *= f; if (hi == 0) wsf[r32] = f; resc = true;
    }
    return resc;
}
#define ATT_SBAR() __builtin_amdgcn_sched_barrier(0)
#define ATT_PIN(x) asm volatile("" : "+v"(x))
#define ATT_VF(L, H, i) (bf16x8){L[i][0], L[i][1], L[i][2], L[i][3], H[i][0], H[i][1], H[i][2], H[i][3]}
template <int NDB> __device__ __forceinline__ void pv_exp(const ALAS unsigned char* vbuf, s16x4 (&vl)[8], s16x4 (&vh)[8], const u32x4 (&pwo)[4], f32x16 (&o)[NDB], f32x16& p0, f32x16& p1, u32x4 (&pwn)[4], float& l, int lane) {
    const int hi = lane >> 5;
    float s0 = 0.f, s1 = 0.f, s2 = 0.f, s3 = 0.f;
    ATT_SBAR();
    if (NDB == 2) {
#pragma unroll
        for (int k = 0; k < 8; ++k) {
            o[k & 1] = __builtin_amdgcn_mfma_f32_32x32x16_bf16(__builtin_bit_cast(bf16x8, pwo[k >> 1]), ATT_VF(vl, vh, k), o[k & 1], 0, 0, 0);
            p0[2 * k] = __builtin_amdgcn_exp2f(p0[2 * k]); p0[2 * k + 1] = __builtin_amdgcn_exp2f(p0[2 * k + 1]); p1[2 * k] = __builtin_amdgcn_exp2f(p1[2 * k]); p1[2 * k + 1] = __builtin_amdgcn_exp2f(p1[2 * k + 1]);
            s0 += p0[2 * k]; s1 += p0[2 * k + 1]; s2 += p1[2 * k]; s3 += p1[2 * k + 1];
            pwn[k >> 2][k & 3] = cvtpk(p0[2 * k], p0[2 * k + 1]); pwn[2 + (k >> 2)][k & 3] = cvtpk(p1[2 * k], p1[2 * k + 1]);
            ATT_PIN(p0); ATT_PIN(p1); ATT_PIN(s0); ATT_PIN(s1); ATT_PIN(s2); ATT_PIN(s3); ATT_PIN(pwn[k >> 2]); ATT_PIN(pwn[2 + (k >> 2)]);
            ATT_SBAR();
        }
    } else {
        const ALAS unsigned char* vb = vbuf + 2 * KBUF + ((lane >> 4) & 1) * 32 + (lane & 3) * 8 + (4 * hi + ((lane & 15) >> 2)) * 64; asm volatile("" : "+v"(vb));
        s16x4 (&wl)[8] = vl; s16x4 (&wh)[8] = vh;
#pragma unroll
        for (int k = 0; k < 16; ++k) {
            const int blk = 2 * (k >> 3) + (k & 1), ks = (k >> 1) & 3;
            o[blk] = __builtin_amdgcn_mfma_f32_32x32x16_bf16(__builtin_bit_cast(bf16x8, pwo[ks]), ATT_VF(wl, wh, k & 3), o[blk], 0, 0, 0);
            if (k + 4 < 16) { const int j = k + 4, jb = 2 * (j >> 3) + (j & 1), jk = (j >> 1) & 3; wl[k & 3] = vtr(vb + jb * VDS + jk * 1024); wh[k & 3] = vtr(vb + jb * VDS + jk * 1024 + 512); }
            if (k < 8) { p0[2 * k] = __builtin_amdgcn_exp2f(p0[2 * k]); p0[2 * k + 1] = __builtin_amdgcn_exp2f(p0[2 * k + 1]); s0 += p0[2 * k]; s1 += p0[2 * k + 1];
                pwn[k >> 2][k & 3] = cvtpk(p0[2 * k], p0[2 * k + 1]); ATT_PIN(p0); ATT_PIN(s0); ATT_PIN(s1); ATT_PIN(pwn[k >> 2]); }
            else { const int q = k - 8; p1[2 * q] = __builtin_amdgcn_exp2f(p1[2 * q]); p1[2 * q + 1] = __builtin_amdgcn_exp2f(p1[2 * q + 1]); s2 += p1[2 * q]; s3 += p1[2 * q + 1];
                pwn[2 + (q >> 2)][q & 3] = cvtpk(p1[2 * q], p1[2 * q + 1]); ATT_PIN(p1); ATT_PIN(s2); ATT_PIN(s3); ATT_PIN(pwn[2 + (q >> 2)]); }
            ATT_SBAR();
        }
    }
    l += (s0 + s1) + (s2 + s3);
}
template <int NDB> __device__ __forceinline__ void pv_only(const ALAS unsigned char* vbuf, const u32x4 (&pwo)[4], f32x16 (&o)[NDB], int lane) {
    const int hi = lane >> 5;
    const ALAS unsigned char* vb = vbuf + (NDB == 4 ? 2 * KBUF : KBUF) + ((lane >> 4) & 1) * 32 + (lane & 3) * 8 + (4 * hi + ((lane & 15) >> 2)) * 64; asm volatile("" : "+v"(vb));
#pragma unroll
    for (int d = 0; d < NDB; ++d) {
        s16x4 lo[4], hh[4];
#pragma unroll
        for (int ks = 0; ks < 4; ++ks) { lo[ks] = vtr(vb + d * VDS + ks * 1024); hh[ks] = vtr(vb + d * VDS + ks * 1024 + 512); }
#pragma unroll
        for (int ks = 0; ks < 4; ++ks) o[d] = __builtin_amdgcn_mfma_f32_32x32x16_bf16(__builtin_bit_cast(bf16x8, pwo[ks]), ATT_VF(lo, hh, ks), o[d], 0, 0, 0);
        ATT_SBAR();
    }
}
template <int NDB> __device__ __forceinline__ void rescale_o(f32x16 (&o)[NDB], const ALAS float* wsf, int lane) {
    const int hi = lane >> 5;
#pragma unroll
    for (int r = 0; r < 16; ++r) { const float f = wsf[crow(r, hi)];
#pragma unroll
        for (int d = 0; d < NDB; ++d) o[d][r] *= f; }
}
__device__ __forceinline__ u32x4 gate8(u32x4 v, u32x4 z) {
    u32x4 o;
#pragma unroll
    for (int j = 0; j < 4; ++j) { const float a = bfl(v[j]) * silu_f(bfl(z[j])), b = bfh(v[j]) * silu_f(bfh(z[j])); o[j] = cvtpk(a, b); }
    return o;
}


template <int NDB> __device__ __forceinline__ void stage_gate_store(const f32x16 (&res)[NDB], ALAS bf16_t* stg, const bf16_t* __restrict__ zbase, bf16_t* __restrict__ mbase, int lane) {
    const int r32 = lane & 31, hi = lane >> 5;
    constexpr int CPR = NDB * 4;
    constexpr int RPP = 64 / CPR;
    u32x4 z[32 / RPP];
#pragma unroll
    for (int i = 0; i < 32 / RPP; ++i) { const int row = i * RPP + lane / CPR, ch = lane % CPR; z[i] = *(const u32x4*)(zbase + (size_t)row * NP + ch * 8); }
#pragma unroll
    for (int r = 0; r < 16; ++r) { const int orow = crow(r, hi);
#pragma unroll
        for (int d = 0; d < NDB; ++d) stg[orow * (NDB * 32) + d * 32 + r32] = f2bf(res[d][r]); }
#pragma unroll
    for (int i = 0; i < 32 / RPP; ++i) {
        const int row = i * RPP + lane / CPR, ch = lane % CPR;
        const u32x4 v = *(const ALAS u32x4*)(stg + row * (NDB * 32) + ch * 8);
        *(u32x4*)(mbase + (size_t)row * DM + ch * 8) = gate8(v, z[i]);
    }
}

template <int MODE> __device__ __forceinline__ void attn_unit(ALAS unsigned char* lds, const bf16_t* __restrict__ PROJ, const float* __restrict__ CUM, bf16_t* __restrict__ MIX,
        int b, int h, int qb, float lam, float li, const float* __restrict__ subg, float* park, const unsigned* __restrict__ kmx, const float* __restrict__ TOT,
        unsigned __attribute__((address_space(1)))* qhead, volatile ALAS unsigned* misc) {
    constexpr int NDB = MODE == 1 ? 4 : 2, STG = Geo<MODE>::STG;
    int tid_ = threadIdx.x; asm volatile("" : "+v"(tid_));
    const int tid = tid_, lane = tid & 63, r32 = lane & 31, hi = lane >> 5, wid = __builtin_amdgcn_readfirstlane(tid >> 6);
    const int c = MODE == 1 ? (wid >> 2) : 0, wr = MODE == 1 ? (wid & 3) : wid;
    const int q0 = qb * (MODE == 1 ? 128 : 256), qw0 = q0 + wr * 32;
    const size_t rowb = (size_t)b * SEQ;
    const int band0 = q0 >> 6, NT = band0 + (MODE == 1 ? 2 : 4), my_last = band0 + (wr >> 1);
    ALAS float* wsf = (ALAS float*)(lds + L_WSF) + wid * 64;
    const unsigned ldsb = (unsigned)(size_t)lds;
    const float slope2 = MODE == 1 ? LOG2E / (float)(1 << (2 * h + 2)) : 0.f;
    const int qcol = MODE == 0 ? C_FQ + h * 64 : C_DQ + h * 128 + c * 64;
    const int kcol = MODE == 0 ? C_FK + h * 64 : C_DK + h * 128;
    const int vcol = MODE == 0 ? C_FV + h * 64 : C_DV + h * 128;
    dma_k<MODE>(ldsb, PROJ, CUM, rowb + (size_t)(NT - 1) * 64, kcol, h, wid, lane);
    dma_v<MODE>(ldsb, PROJ, rowb + (size_t)(NT - 1) * 64, vcol, wid, lane);
    dma_v<MODE>(ldsb + 2 * STG, PROJ, rowb + (size_t)(NT - 1) * 64, vcol, wid, lane);
    dma_k<MODE>(ldsb + STG, PROJ, CUM, rowb + (size_t)(NT - 2) * 64, kcol, h, wid, lane);
    const int T = lane; const bool inband = T >= band0 && T < NT;
    bf16x8 qr[4];
    { const bf16_t* Qw = PROJ + (rowb + qw0 + r32) * NP + qcol + hi * 8;
#pragma unroll
      for (int d0 = 0; d0 < 4; ++d0) qr[d0] = *(const bf16x8*)(Qw + d0 * 16); }
    const float tv = (MODE == 0 && lane < 32) ? TOT[h * 320 + b * 32 + lane] : 0.f;
    const int kr = (MODE == 0 && T < band0) ? 64 * T + 63 : q0;
    const float c_w0 = MODE == 0 ? CUM[(size_t)h * MTP + rowb + qw0] : 0.f, c_q0 = MODE == 0 ? CUM[(size_t)h * MTP + rowb + q0] : 0.f, c_kr = MODE == 0 ? CUM[(size_t)h * MTP + rowb + kr] : 0.f;
    float k2v[2], q2v[2];
#pragma unroll
    for (int cc = 0; cc < (MODE == 1 ? 2 : 1); ++cc) { const int sq = MODE == 0 ? h : 8 + h * 2 + cc, sk = MODE == 0 ? 4 + h : 16 + h * 2 + cc;
        k2v[cc] = __uint_as_float(kmx[((sk * 2 + 0) * 8 + b) * 64 + T]) + __uint_as_float(kmx[((sk * 2 + 1) * 8 + b) * 64 + T]);
        q2v[cc] = __uint_as_float(kmx[((sq * 2 + 0) * 8 + b) * 64 + T]) + __uint_as_float(kmx[((sq * 2 + 1) * 8 + b) * 64 + T]); }
    float Pv = 0.f;
    if (MODE == 0) { float inc = tv;
#pragma unroll
        for (int o_ = 1; o_ < 32; o_ <<= 1) { const float t_ = shl(inc, lane >= o_ ? lane - o_ : lane); if (lane >= o_) inc += t_; }
        Pv = inc - tv; }
#define ATT_OFF(blk) __int_as_float(__builtin_amdgcn_readlane(__float_as_int(Pv), (blk)))
    const ALAS bf16x8* qlds = (const ALAS bf16x8*)(lds + L_OST + wid * 4096) + lane;
    if (MODE == 1) {
#pragma unroll
        for (int d0 = 0; d0 < 4; ++d0) ((ALAS bf16x8*)qlds)[d0 * 64] = qr[d0];
    }
    float mhat = MODE == 0 ? -(c_w0 + ATT_OFF(qw0 >> 7)) * LOG2E : 0.f, l = 0.f;
    int T_min;
    { bool need = inband;
#pragma unroll
      for (int cc = 0; cc < (MODE == 1 ? 2 : 1); ++cc) {
          const float kn = sqrtf(k2v[cc]) * 1.01f;
          float qv = inband ? q2v[cc] : 0.f, kv = inband ? kn : 0.f;
#pragma unroll
          for (int m = 1; m < 64; m <<= 1) { qv = fmaxf(qv, shx(qv, m, lane)); kv = fmaxf(kv, shx(kv, m, lane)); }
          const float Qn = sqrtf(qv) * 1.01f, Lown = Qn * kv;
          float D;
          if (MODE == 0) D = ((c_q0 + ATT_OFF(q0 >> 7)) - (c_kr + shl(Pv, kr >> 7))) * LOG2E;
          else D = -slope2 * (float)(q0 - 64 * T - 63);
          need = need || (T < band0 && (Qn * kn + D + Lown > -40.f)); }
      const unsigned long long mask = __ballot(need);
      T_min = __builtin_amdgcn_readfirstlane((int)__builtin_ctzll(mask));
      if ((NT - T_min) & 1) T_min -= 1; }
    const int NTr = NT - T_min;
    f32x16 o[NDB];
#pragma unroll
    for (int d = 0; d < NDB; ++d)
#pragma unroll
        for (int r = 0; r < 16; ++r) o[d][r] = 0.f;
    u32x4 pwa[4], pwb[4]; f32x16 p0, p1; s16x4 vl[8], vh[8];
#pragma unroll
    for (int k = 0; k < 4; ++k) { pwa[k] = (u32x4){0u, 0u, 0u, 0u}; pwb[k] = (u32x4){0u, 0u, 0u, 0u}; }
    const int kbo = c * KBUF;
#define ATT_TROW(i) ((i) < NTr ? rowb + (size_t)(NT - 1 - (i)) * 64 : (size_t)MR)
#define ATT_STEP(i, PIN_, POUT_, WAITBAR_) do { \
        if ((i) + 2 <= NTr) dma_k<MODE>(ldsb + (unsigned)s_prev, PROJ, CUM, ATT_TROW((i) + 2), kcol, h, wid, lane); \
        if ((i) + 1 <= NTr) dma_v<MODE>(ldsb + (unsigned)s_next, PROJ, ATT_TROW((i) + 1), vcol, wid, lane); \
        const bool mt_ = ((i) == NTr); const int t_ = NT - 1 - (i); \
        if (mt_ || t_ <= my_last) { \
            bool resc_; const float koff_ = (MODE == 0 && !mt_) ? ATT_OFF(t_ >> 1) * LOG2E : 0.f;       \
            if (mt_) resc_ = qs_front<MODE, false, true>(lds + s_cur + kbo, lds + s_prev, vl, vh, qr, qlds, p0, p1, mhat, l, -16, qw0, slope2, koff_, wsf, lane); \
            else if (t_ == my_last) resc_ = qs_front<MODE, true, false>(lds + s_cur + kbo, lds + s_prev, vl, vh, qr, qlds, p0, p1, mhat, l, 64 * t_, qw0, slope2, koff_, wsf, lane); \
            else resc_ = qs_front<MODE, false, false>(lds + s_cur + kbo, lds + s_prev, vl, vh, qr, qlds, p0, p1, mhat, l, 64 * t_, qw0, slope2, koff_, wsf, lane); \
            pv_exp<NDB>(lds + s_prev, vl, vh, PIN_, o, p0, p1, POUT_, l, lane); \
            if (resc_) rescale_o<NDB>(o, wsf, lane); \
        } \
        WAITBAR_; \
        { const int tt = s_prev; s_prev = s_cur; s_cur = s_next; s_next = tt; } } while (0)
#define ATT_WB_FULL() do { if (MODE == 0) ATT_WAIT_BAR(2); else ATT_WAIT_BAR(4); } while (0)
#define ATT_WB_VONLY() do { if (MODE == 0) ATT_WAIT_BAR(1); else ATT_WAIT_BAR(2); } while (0)
    ATT_WAIT_BAR(0);
    int s_prev = 2 * STG, s_cur = 0, s_next = STG;
#pragma clang loop unroll(disable)
    for (int i = 0; i < NTr - 2; i += 2) { ATT_STEP(i, pwa, pwb, ATT_WB_FULL()); ATT_STEP(i + 1, pwb, pwa, ATT_WB_FULL()); }
    ATT_STEP(NTr - 2, pwa, pwb, ATT_WB_FULL());
    ATT_STEP(NTr - 1, pwb, pwa, ATT_WB_VONLY());
    ATT_STEP(NTr, pwa, pwb, ATT_WAIT_BAR(0));
    pv_only<NDB>(lds + s_prev, pwb, o, lane);
#undef ATT_WB_FULL
#undef ATT_WB_VONLY
#undef ATT_STEP
#undef ATT_TROW
    ATT_WAIT_BAR(0);
    { auto rr = __builtin_amdgcn_permlane32_swap(__float_as_uint(l), __float_as_uint(l), false, false); l = __uint_as_float(rr[0]) + __uint_as_float(rr[1]); }
    if (hi == 0) wsf[32 + r32] = l;
    float rli[16];
#pragma unroll
    for (int r = 0; r < 16; ++r) rli[r] = __builtin_amdgcn_rcpf(wsf[32 + crow(r, hi)]);
#pragma unroll
    for (int d = 0; d < NDB; ++d)
#pragma unroll
        for (int r = 0; r < 16; ++r) o[d][r] *= rli[r];
    if (MODE == 1) {
        ALAS float* pk = (ALAS float*)(lds + wr * 16384) + lane;
        if (c == 1) {
#pragma unroll
            for (int d = 0; d < NDB; ++d)
#pragma unroll
                for (int r = 0; r < 16; ++r) pk[(d * 16 + r) * 64] = o[d][r];
        }
        ATT_WAIT_BAR(0);
        if (c == 1) return;
#pragma unroll
        for (int d = 0; d < NDB; ++d)
#pragma unroll
            for (int r = 0; r < 16; ++r) o[d][r] -= lam * pk[(d * 16 + r) * 64];
        float ss[16];
#pragma unroll
        for (int r = 0; r < 16; ++r) { float sm = 0.f;
#pragma unroll
            for (int d = 0; d < NDB; ++d) sm += o[d][r] * o[d][r];
            ss[r] = sm; }
#pragma unroll
        for (int m = 1; m < 32; m <<= 1)
#pragma unroll
            for (int r = 0; r < 16; ++r) ss[r] += shx(ss[r], m, lane);
        float gc[NDB];
#pragma unroll
        for (int d = 0; d < NDB; ++d) gc[d] = subg[32 * d + r32] * li;
#pragma unroll
        for (int r = 0; r < 16; ++r) { const float rs = rsqrtf(ss[r] * (1.f / 128.f) + 1e-5f);
#pragma unroll
            for (int d = 0; d < NDB; ++d) o[d][r] *= rs * gc[d]; }
    }
    unsigned nxt_ = 0u;
    if (tid == 0) nxt_ = __hip_atomic_fetch_add(qhead, 1u, __ATOMIC_RELAXED, __HIP_MEMORY_SCOPE_AGENT);
    ALAS bf16_t* stg = (ALAS bf16_t*)(lds + L_OST + (MODE == 1 ? wr * 8192 : wid * 4096));
    const int zcol = MODE == 0 ? C_FZ + h * 64 : C_DZ + h * 128, mcol = MODE == 0 ? M_A + h * 64 : M_B + h * 128;
    stage_gate_store<NDB>(o, stg, PROJ + (rowb + qw0) * NP + zcol, MIX + (rowb + qw0) * DM + mcol, lane);
    if (tid == 0) misc[16] = nxt_;
#undef ATT_OFF
}

template <int WIN> __device__ __forceinline__ void pool_rows(const bf16_t* __restrict__ PROJ, bf16_t* __restrict__ MIX, const bf16x8 (&wb)[2][4], float ps0, float ps1, ALAS bf16_t* stg,
        int b, int tw, int Rw, int g, int lane) {
    const int r32 = lane & 31, hi = lane >> 5; const float invw = 1.f / (float)WIN;
    for (int blk = 0; blk < 2; ++blk) {
        const int t = tw + 32 * blk + r32;
        f32x16 acc[2];
#pragma unroll
        for (int r = 0; r < 16; ++r) { acc[0][r] = 0.f; acc[1][r] = 0.f; }
#pragma unroll
        for (int ks = 0; ks < 4; ++ks) {
            const int c0 = C_PU + g * 64 + 16 * ks + 8 * hi;
            u32x4 v[WIN];
#pragma unroll
            for (int i = 0; i < WIN; ++i) { const int ti = t - i; const size_t row = ti >= 0 ? (size_t)b * SEQ + ti : (size_t)(MR + 16 + ti); v[i] = *(const u32x4*)(PROJ + row * NP + c0); }
            float sm[8];
#pragma unroll
            for (int j = 0; j < 8; ++j) sm[j] = 0.f;
#pragma unroll
            for (int i = 0; i < WIN; ++i)
#pragma unroll
                for (int j = 0; j < 4; ++j) { sm[2 * j] += bfl(v[i][j]); sm[2 * j + 1] += bfh(v[i][j]); }
            u32x4 pa;
#pragma unroll
            for (int j = 0; j < 4; ++j) pa[j] = cvtpk(sm[2 * j] * invw - bfl(v[0][j]), sm[2 * j + 1] * invw - bfh(v[0][j]));
            const bf16x8 af = __builtin_bit_cast(bf16x8, pa);
            acc[0] = __builtin_amdgcn_mfma_f32_32x32x16_bf16(af, wb[0][ks], acc[0], 0, 0, 0);
            acc[1] = __builtin_amdgcn_mfma_f32_32x32x16_bf16(af, wb[1][ks], acc[1], 0, 0, 0);
        }
#pragma unroll
        for (int r = 0; r < 16; ++r) { acc[0][r] *= ps0; acc[1][r] *= ps1; }
        const size_t row0 = (size_t)Rw + 32 * blk;
        stage_gate_store<2>(acc, stg, PROJ + row0 * NP + C_PZ + g * 64, MIX + row0 * DM + M_C + g * 64, lane);
    }
}
__device__ __forceinline__ void pool_unit(ALAS unsigned char* lds, const bf16_t* __restrict__ PROJ, const bf16_t* __restrict__ WPT_l, const float* __restrict__ pscale_l, bf16_t* __restrict__ MIX, int unit,
        unsigned __attribute__((address_space(1)))* qhead, volatile ALAS unsigned* misc) {
    int tid_ = threadIdx.x; asm volatile("" : "+v"(tid_));
    const int tid = tid_, lane = tid & 63, r32 = lane & 31, hi = lane >> 5, wid = __builtin_amdgcn_readfirstlane(tid >> 6);
    const int g = wid & 3;
    const int Rw = unit * 128 + (wid >> 2) * 64, b = Rw >> 12, tw = Rw & 4095;
    ALAS bf16_t* stg = (ALAS bf16_t*)(lds + L_OST + wid * 4096);
    bf16x8 wb[2][4];
#pragma unroll
    for (int nb = 0; nb < 2; ++nb)
#pragma unroll
        for (int ks = 0; ks < 4; ++ks) wb[nb][ks] = *(const bf16x8*)(WPT_l + ((g * 64 + 32 * nb + r32) * 64 + 16 * ks + 8 * hi));
    const float ps0 = pscale_l[g * 64 + r32], ps1 = pscale_l[g * 64 + 32 + r32];
    unsigned nxt_ = 0u; if (tid == 0) nxt_ = __hip_atomic_fetch_add(qhead, 1u, __ATOMIC_RELAXED, __HIP_MEMORY_SCOPE_AGENT);
    if (g == 0) pool_rows<2>(PROJ, MIX, wb, ps0, ps1, stg, b, tw, Rw, g, lane);
    else if (g == 1) pool_rows<4>(PROJ, MIX, wb, ps0, ps1, stg, b, tw, Rw, g, lane);
    else if (g == 2) pool_rows<8>(PROJ, MIX, wb, ps0, ps1, stg, b, tw, Rw, g, lane);
    else pool_rows<16>(PROJ, MIX, wb, ps0, ps1, stg, b, tw, Rw, g, lane);
    if (tid == 0) misc[16] = nxt_;
}
#undef ALAS
}


#ifndef PG8_SP2
#define PG8_SP2 true
#endif
#ifndef PG8_ALIGN
#define PG8_ALIGN true
#endif
constexpr int NWAVES = 8;
constexpr int RING_OFF = 0, RING_BYTES = 143360;
constexpr int LDSCTL_OFF = RING_BYTES, MISC_OFF = LDSCTL_OFF + 320;
constexpr int LDS_BYTES = RING_BYTES + 1024;
constexpr int CW_TMO = 0, CW_CODE = 1, CW_BAR = 4096, CW_Q = 16384;
constexpr size_t CTL_ZERO_BYTES = 1 * MiB;
static_assert(att::L_END <= RING_BYTES, "attention LDS map");
#define GAS __attribute__((address_space(1)))
#define LAS __attribute__((address_space(3)))
typedef unsigned short bf16;
typedef unsigned v4u __attribute__((ext_vector_type(4)));
typedef float f32x4 __attribute__((ext_vector_type(4)));
typedef short bf16x8 __attribute__((ext_vector_type(8)));
typedef GAS unsigned gu32;
typedef GAS unsigned long long gu64;
#define RLX_AGENT __ATOMIC_RELAXED, __HIP_MEMORY_SCOPE_AGENT
#define LDS_WAIT() asm volatile("s_waitcnt lgkmcnt(0)" ::: "memory")
#define VM_WAIT() asm volatile("s_waitcnt vmcnt(0)" ::: "memory")
__device__ __forceinline__ unsigned long long rt() { return __builtin_amdgcn_s_memrealtime(); }

#define XB_TMO      128
#define XB_XCNT(j)  (256  + 64 * (j))
#define XB_XSUB(j)  (1280 + 64 * (j))
#define XB_XGEN(j)  (2304 + 64 * (j))
#define XB_TOP      3328
#define XB_TOPGEN   3392
#define XCD_BAR_WORDS 3456
#define XB_SPIN_CAP (1u << 18)

__device__ __forceinline__ unsigned xb_ld(unsigned* p)              { return __hip_atomic_load(p, __ATOMIC_RELAXED, __HIP_MEMORY_SCOPE_AGENT); }
__device__ __forceinline__ unsigned xb_add(unsigned* p, unsigned v) { return __hip_atomic_fetch_add(p, v, __ATOMIC_RELAXED, __HIP_MEMORY_SCOPE_AGENT); }
__device__ __forceinline__ unsigned xb_xcc_id() { return (unsigned)__builtin_amdgcn_s_getreg((3 << 11) | 20) & 0xFu; }
#define XB_SPIN(cond, bar) do { unsigned _sp = 0; while (cond) { __builtin_amdgcn_s_sleep(1); \
    if ((++_sp & 255u) == 0u) { if (xb_ld(&(bar)[XB_TMO])) break; if (_sp > XB_SPIN_CAP) { atomicAdd(&(bar)[XB_TMO], 1u); break; } } } } while (0)

struct XcdBarrier {
    unsigned* bar; unsigned x;
    volatile LAS unsigned* st;
};

__device__ __forceinline__ XcdBarrier xcd_barrier_post(unsigned* bar, volatile LAS unsigned* st) {
    XcdBarrier b; b.bar = bar; b.x = xb_xcc_id(); b.st = st;
    if (threadIdx.x == 0) (void)xb_add(&bar[XB_XCNT(b.x)], 1u);
    return b;
}
__device__ __forceinline__ void xcd_barrier_complete(unsigned* bar, unsigned x, unsigned& nloc, unsigned& nx) {
    const unsigned G = gridDim.x * gridDim.y * gridDim.z;
    unsigned sum, cnt, mine, sp = 0u;
    for (;;) {
        sum = 0u; cnt = 0u; mine = 0u;
#pragma unroll
        for (unsigned j = 0; j < 16; ++j) { const unsigned c = xb_ld(&bar[XB_XCNT(j)]); sum += c; cnt += (c > 0u) ? 1u : 0u; mine = (j == x) ? c : mine; }
        if (sum == G) break;
        __builtin_amdgcn_s_sleep(1);
        if ((++sp & 255u) == 0u) { if (xb_ld(&bar[XB_TMO])) break; if (sp > XB_SPIN_CAP) { atomicAdd(&bar[XB_TMO], 1u); break; } }
    }
    nloc = mine > 0u ? mine : 1u; nx = cnt > 0u ? cnt : 1u;
}

__device__ __forceinline__ void xcd_barrier(const XcdBarrier& b) {
    asm volatile("s_waitcnt vmcnt(0)" ::: "memory");
    __syncthreads();
    if (threadIdx.x == 0) {
        unsigned* bar = b.bar;
        __builtin_amdgcn_s_waitcnt(0);
        unsigned nloc = b.st[0], nx = b.st[1];
        if (nloc == 0u) { xcd_barrier_complete(bar, b.x, nloc, nx); b.st[0] = nloc; b.st[1] = nx; }
        const unsigned old = xb_add(&bar[XB_XSUB(b.x)], 1u);
        const unsigned gen = old / nloc;
        if (old + 1u == (gen + 1u) * nloc) {
            __builtin_amdgcn_fence(__ATOMIC_RELEASE, "agent");
            asm volatile("s_waitcnt vmcnt(0)" ::: "memory");
            const unsigned og = xb_add(&bar[XB_TOP], 1u);
            const unsigned tg = og / nx;
            if (og + 1u == (tg + 1u) * nx) xb_add(&bar[XB_TOPGEN], 1u);
            else XB_SPIN(xb_ld(&bar[XB_TOPGEN]) == tg, bar);
            __builtin_amdgcn_fence(__ATOMIC_ACQUIRE, "agent");
            xb_add(&bar[XB_XGEN(b.x)], 1u);
            asm volatile("s_waitcnt vmcnt(0)" ::: "memory");
        } else {
            XB_SPIN(xb_ld(&bar[XB_XGEN(b.x)]) == gen, bar);
            __builtin_amdgcn_fence(__ATOMIC_ACQUIRE, "agent");
            asm volatile("s_waitcnt vmcnt(0)" ::: "memory");
        }
    }
    __syncthreads();
}

__device__ __forceinline__ void transpose_item(const float* __restrict__ W, int ldw, int col0, const float* __restrict__ gk, bf16_t* WT, int K, LAS float* scr, int k0, int n0dst, int lane) {
    float v[32];
    const float* src = W + (size_t)(k0 + (lane >> 5)) * ldw + col0 + (lane & 31);
#pragma unroll
    for (int i = 0; i < 32; ++i) v[i] = src[(size_t)(2 * i) * ldw];
    const int c = lane & 7;
    float g[8];
#pragma unroll
    for (int j = 0; j < 8; ++j) g[j] = gk ? gk[k0 + 8 * c + j] : 1.f;
#pragma unroll
    for (int i = 0; i < 32; ++i) scr[(2 * i + (lane >> 5)) * 33 + (lane & 31)] = v[i];
    LDS_WAIT(); asm volatile("" ::: "memory");
#pragma unroll
    for (int j = 0; j < 4; ++j) { const int n = (lane >> 3) + 8 * j; const LAS float* s = scr + (8 * c) * 33 + n;
        v4u o; o.x = pk2(s[0 * 33] * g[0], s[1 * 33] * g[1]); o.y = pk2(s[2 * 33] * g[2], s[3 * 33] * g[3]); o.z = pk2(s[4 * 33] * g[4], s[5 * 33] * g[5]); o.w = pk2(s[6 * 33] * g[6], s[7 * 33] * g[7]);
        *(GAS v4u*)(WT + (size_t)(n0dst + n) * K + k0 + 8 * c) = o; }
    LDS_WAIT(); asm volatile("" ::: "memory");
}

constexpr int NPH = 14;
struct Args { const float* in[14]; float* out; unsigned char* ws; int ph_lo, ph_hi; };
__global__ void __launch_bounds__(NWAVES * 64, 2) mk_fwd(Args args) {
    extern __shared__ __attribute__((aligned(16))) unsigned char lds[];
    LAS unsigned char* ldsp = (LAS unsigned char*)lds;
    volatile LAS unsigned* MISC = (volatile LAS unsigned*)(ldsp + MISC_OFF);
    gu32* ctl = (gu32*)(args.ws + WS_CTL);
    for (int u = threadIdx.x; u < (LDS_BYTES - LDSCTL_OFF) / 4; u += NWAVES * 64) ((LAS unsigned*)(ldsp + LDSCTL_OFF))[u] = 0u;
    __syncthreads();
    XcdBarrier bar = xcd_barrier_post((unsigned*)(ctl + CW_BAR), MISC + 8);
    const int lo = args.ph_lo, hi = args.ph_hi;
    for (int ph_ = lo; ph_ < hi; ++ph_) {
        int ph = ph_, bid = (int)blockIdx.x, G = (int)gridDim.x;
        typedef const __attribute__((address_space(4))) Args* KArgs;
        KArgs ap = (KArgs)__builtin_amdgcn_kernarg_segment_ptr(); asm volatile("" : "+s"(ap));
        unsigned char* ws = ap->ws; unsigned* barw = bar.bar;
        asm volatile("" : "+s"(ph), "+s"(bid), "+s"(G), "+s"(ws), "+s"(barw));
        int tid_ = threadIdx.x; asm volatile("" : "+v"(tid_));
        const int tid = tid_, lane = tid & 63, wave = __builtin_amdgcn_readfirstlane(tid >> 6);
        const int gw = bid * NWAVES + wave, NGW = G * NWAVES;
        const int gt = bid * (NWAVES * 64) + tid, NT = G * NWAVES * 64;
        bf16_t* W1T = (bf16_t*)(ws + WS_W1T); bf16_t* W2T = (bf16_t*)(ws + WS_W2T);
        bf16_t* WFGB = (bf16_t*)(ws + WS_WFG); float* LAM = (float*)(ws + WS_LAM); float* TOT = (float*)(ws + WS_TOT);
        bf16_t* WPT = (bf16_t*)(ws + WS_WPT); unsigned* KMX = (unsigned*)(ws + WS_KMX);
        ssq_t* SS = (ssq_t*)(ws + WS_SS); float* CUM = (float*)(ws + WS_CUM);
        bf16_t* HB = (bf16_t*)(ws + WS_HB); bf16_t* MIX = (bf16_t*)(ws + WS_MIX); bf16_t* PROJ = (bf16_t*)(ws + WS_PROJ);
        if (ph == 0) {
            const float* norm_g = ap->in[2]; const float* w_in = ap->in[3]; const float* w_pool = ap->in[10]; const float* w_out = ap->in[12];
            LAS float* scr = (LAS float*)(ldsp + RING_OFF + wave * 16384);
            constexpr int NIT1 = DEPTH * 16 * 112, NIT2 = DEPTH * 16 * 32;
            for (int it = gw; it < NIT1 + NIT2; it += NGW) {
                if (it < NIT1) { const int l = it / 1792, r = it % 1792, kb = r / 112, nb = r % 112, n0 = 32 * nb, col0 = n0 < 1024 ? n0 : n0 + 4;
                    transpose_item(w_in + (size_t)l * 1024 * IN_DIM, IN_DIM, col0, norm_g + l * 1024, W1T + (size_t)l * NP * 1024, 1024, scr, 64 * kb, n0, lane); }
                else { const int r0 = it - NIT1, l = r0 / 512, r = r0 % 512, kb = r / 32, nb = r % 32;
                    transpose_item(w_out + (size_t)l * 1024 * 1024, 1024, 32 * nb, nullptr, W2T + (size_t)l * 1024 * 1024, 1024, scr, 64 * kb, 32 * nb, lane); }
            }
            for (int i = gt; i < DEPTH * 16 * 1024; i += NT) { const int k = i & 1023, c = (i >> 10) & 15, l = i >> 14;
                WFGB[i] = c < 4 ? f2bf(w_in[((size_t)l * 1024 + k) * IN_DIM + 1024 + c] * norm_g[l * 1024 + k]) : (bf16_t)0; }
            for (int i = gt; i < DEPTH * 4 * 64 * 64; i += NT) { const int c = i & 63, d = (i >> 6) & 63, lg = i >> 12; WPT[i] = f2bf(w_pool[((size_t)lg * 64 + c) * 64 + d]); }
            unsigned zz = 0u; float big = 1e30f; asm volatile("" : "+v"(zz), "+v"(big));
            for (int i = gt; i < 48 * NP / 8; i += NT) ((uint4*)(PROJ + (size_t)(MR + 16) * NP))[i] = make_uint4(zz, zz, zz, zz);
            for (int i = gt; i < 48 * 4; i += NT) CUM[(size_t)(i / 48) * MTP + MR + 16 + (i % 48)] = big;
            for (int i = gt; i < MTP; i += NT) SS[MTP + i] = (ssq_t)zz;
            for (int i = gt; i < KMX_WORDS; i += NT) KMX[i] = zz;
            if (gt < DEPTH) { const int l = gt; float s1 = 0.f, s2 = 0.f;
                for (int i = 0; i < 64; ++i) { s1 += ap->in[5][l * 64 + i] * ap->in[6][l * 64 + i]; s2 += ap->in[7][l * 64 + i] * ap->in[8][l * 64 + i]; }
                float c08 = 0.8f; asm volatile("" : "+v"(c08));
                const float li0 = c08 - 0.6f * fexp(-0.3f * (float)l);
                LAM[l] = fexp(s1) - fexp(s2) + li0; LAM[4 + l] = li0; }
            { int lane_p = threadIdx.x & 63; asm volatile("" : "+v"(lane_p));
              for (int row = gw; row < MT; row += NGW) entry_row(row, lane_p, ap->in[0], ap->in[1], HB, SS); }
        } else if (ph <= 12) {
            const int l = (ph - 1) / 3, sub = (ph - 1) % 3;
            ssq_t* ssl = SS + (size_t)(l & 1) * MTP;
            ssq_t* ssn = SS + (size_t)((l + 1) & 1) * MTP;
            if (sub == 0) {
                { unsigned zz = 0u; asm volatile("" : "+v"(zz)); for (int i = gt; i < MTP; i += NT) ssn[i] = (ssq_t)zz; }
                {   LAS float* lf = (LAS float*)(ldsp + RING_OFF);
                    const bf16_t* wfg = WFGB + (size_t)l * 16 * 1024; const float* bfl = ap->in[4] + l * 4;
                    for (int blk = bid; blk < 257; blk += G) {
                        const bool mb = blk == 256; const int r0 = mb ? MR : 128 * blk + 16 * wave;
                        if (!mb || wave == 0) {
                            const mf32x4 acc = meta_gemm16(HB + (size_t)r0 * DM, wfg, 0, lane);
                            const int fr = lane & 15, fq = lane >> 4;
                            if (fr < 4) {
#pragma unroll
                                for (int j = 0; j < 4; ++j) { const int row = r0 + 4 * fq + j; const float rstd = rsqrtf(ss_val(ssl[row]) * (1.f / 1024.f) + 1e-6f);
                                    lf[((mb ? 0 : 16 * wave) + 4 * fq + j) * 4 + fr] = log_sigmoid(acc[j] * rstd + bfl[fr]); } }
                        }
                        __syncthreads();
                        if (!mb) { if (wave < 4) { const int h = wave; const float a = lf[(2 * lane) * 4 + h], b2 = lf[(2 * lane + 1) * 4 + h]; const float sm = a + b2; float inc = sm;
#pragma unroll
                                for (int o = 1; o < 64; o <<= 1) { const float t = shl(inc, lane >= o ? lane - o : lane); if (lane >= o) inc += t; }
                                *(float2*)(CUM + (size_t)h * MTP + 128 * blk + 2 * lane) = make_float2(inc - b2, inc);
                                if (lane == 63) TOT[h * 320 + blk] = inc; } }
                        else { if (wave == 0 && lane < 4) { const int h = lane; float c = 0.f; for (int j = 15; j >= 0; --j) { CUM[(size_t)h * MTP + MR + j] = -c; c += lf[j * 4 + h]; } } }
                        __syncthreads();
                    }
                }
                for (int nb = bid; nb < NP / 16; nb += G) {
                    const mf32x4 acc = meta_gemm16_k8(HB + (size_t)MR * DM, W1T + (size_t)l * NP * 1024, nb, wave, lane, (LAS float*)(ldsp + RING_OFF));
                    if (wave == 0) { const int col = 16 * nb + (lane & 15), fq = lane >> 4; const float sc = (col < 256 || (col >= 1024 && col < 1536)) ? att::C2 : 1.f;
#pragma unroll
                        for (int j = 0; j < 4; ++j) PROJ[(size_t)(MR + 4 * fq + j) * NP + col] = f2bf(acc[j] * sc * rsqrtf(ss_val(ssl[MR + 4 * fq + j]) * (1.f / 1024.f) + 1e-6f)); } }
                pg8::Gemm g{HB, W1T + (size_t)l * NP * 1024, MR, NP, 1024}; pg8::StaticOrder S; S.init(MR, NP, G, bid);
                pg8::EpiProj E{PROJ, NP, att::C2, KMX, ssl};
#ifndef DIAG_NO_GEMM
                pg8::gemm_phase<pg8::EpiProj, pg8::StaticOrder, PG8_ALIGN, PG8_SP2>(ldsp + RING_OFF, g, S, E);
#endif
            } else if (sub == 1) {
                const float li_raw = __int_as_float(__builtin_amdgcn_readfirstlane(__float_as_int(LAM[4 + l])));
                const float li = li_raw;
                const float oml = __int_as_float(__builtin_amdgcn_readfirstlane(__float_as_int(1.f - li_raw)));
                const float lam = __int_as_float(__builtin_amdgcn_readfirstlane(__float_as_int(LAM[l])));
                const float* subg = ap->in[9] + l * 128;
                float* park = (float*)(ws + WS_RES) + (size_t)bid * 4 * 4096;
#ifndef DIAG_NO_META
                if (bid == G - 1) {
                    if (wave < 4) fox_meta(wave, lane, PROJ, CUM, MIX); else diff_meta(wave - 4, lane, PROJ, subg, lam, li, MIX);
                    for (int tk = wave; tk < 64; tk += NWAVES) pool_meta(tk >> 2, tk & 3, lane, PROJ, ap->in[10] + (size_t)l * 4 * 64 * 64, ap->in[11] + l * 256, MIX);
                }
#endif
                gu32* qcnt = (gu32*)(ws + WS_CTL) + CW_Q + l * 8 * 64;
                int x = (int)(bar.x & 7u);
                if (tid == 0) MISC[16] = __hip_atomic_fetch_add(qcnt + x * 64, 1u, __ATOMIC_RELAXED, __HIP_MEMORY_SCOPE_AGENT);
                for (;;) {
                    __syncthreads();
                    int u = (int)MISC[16];
                    __syncthreads();
                    if (u >= 224) {
                        if (tid == 0) { int pick = -1;
#pragma unroll
                            for (int j = 1; j < 8; ++j) { const int xx = (x + j) & 7; if (pick < 0 && __hip_atomic_load(qcnt + xx * 64, __ATOMIC_RELAXED, __HIP_MEMORY_SCOPE_AGENT) < 224u) pick = xx; }
                            MISC[17] = (unsigned)pick;
                            if (pick >= 0) MISC[16] = __hip_atomic_fetch_add(qcnt + pick * 64, 1u, __ATOMIC_RELAXED, __HIP_MEMORY_SCOPE_AGENT); }
                        __syncthreads();
                        const int pick = (int)MISC[17];
                        if (pick < 0) break;
                        x = pick; continue;
                    }
                    gu32* qh = qcnt + x * 64;
                    if (u < 128) {
#ifndef DIAG_NO_DIFF
                        const int qb_ = 31 - (u >> 2), h_ = 3 - (u & 3), b_ = (x - h_) & 7;
                        att::attn_unit<1>(ldsp + RING_OFF, PROJ, CUM, MIX, b_, h_, qb_, lam, oml, subg, park, KMX, TOT, qh, MISC);
#endif
                    } else if (u < 192) {
#ifndef DIAG_NO_FOX
                        const int v = u - 128, qb_ = 15 - (v >> 2), h_ = 3 - (v & 3), b_ = (x - h_) & 7;
                        att::attn_unit<0>(ldsp + RING_OFF, PROJ, CUM, MIX, b_, h_, qb_, lam, oml, subg, park, KMX, TOT, qh, MISC);
#endif
                    } else {
#ifndef DIAG_NO_POOL
                        att::pool_unit(ldsp + RING_OFF, PROJ, WPT + (size_t)l * 4 * 64 * 64, ap->in[11] + l * 256, MIX, x * 32 + (u - 192), qh, MISC);
#endif
                    }
                }
            } else {
                { unsigned zz = 0u; asm volatile("" : "+v"(zz)); for (int i = gt; i < KMX_WORDS; i += NT) KMX[i] = zz; }
                for (int nb = bid; nb < 64; nb += G) {
                    const mf32x4 acc = meta_gemm16_k8(MIX + (size_t)MR * DM, W2T + (size_t)l * 1024 * 1024, nb, wave, lane, (LAS float*)(ldsp + RING_OFF));
                    if (wave == 0) { const int col = 16 * nb + (lane & 15), fq = lane >> 4;
#pragma unroll
                        for (int j = 0; j < 4; ++j) { bf16_t* hp = HB + (size_t)(MR + 4 * fq + j) * DM + col; const bf16_t nv = f2bf(bf2f(*hp) + acc[j]); *hp = nv;
                            float q = bf2f(nv); q *= q; q += shx(q, 1, lane); q += shx(q, 2, lane); q += shx(q, 4, lane); q += shx(q, 8, lane);
                            if ((lane & 15) == 0) atomicAdd(ssn + MR + 4 * fq + j, ss_fix(q)); } } }
                pg8::Gemm g{MIX, W2T + (size_t)l * 1024 * 1024, MR, 1024, 1024}; pg8::StaticOrder S; S.init(MR, 1024, G, bid);
                pg8::EpiResidB E{HB, 1024, ssn};
#ifndef DIAG_NO_GEMM
                pg8::gemm_phase<pg8::EpiResidB, pg8::StaticOrder, PG8_ALIGN, PG8_SP2>(ldsp + RING_OFF, g, S, E);
#endif
            }
        } else {
            for (int row = gw; row < MR; row += NGW) final_row(row, lane, HB, SS + (size_t)(DEPTH & 1) * MTP, ap->out, ap->in[13]);
        }
        if (ph_ + 1 < hi) { XcdBarrier b2 = bar; b2.bar = barw; xcd_barrier(b2); }
    }
}

#ifndef MK_PER_PHASE
#define MK_PER_PHASE 0
#endif
extern "C" void kernel_launch(void* const* d_in, const int* in_sizes, int n_in, void* d_out, int out_size, void* d_ws, size_t ws_size, hipStream_t stream) {
    static int g_grid = 0;
    if (g_grid == 0) {
        int dev = 0, cus = 0, per_cu = 0;
        hipGetDevice(&dev); hipDeviceGetAttribute(&cus, hipDeviceAttributeMultiprocessorCount, dev);
        hipFuncSetAttribute((const void*)mk_fwd, hipFuncAttributeMaxDynamicSharedMemorySize, LDS_BYTES);
        hipOccupancyMaxActiveBlocksPerMultiprocessor(&per_cu, (const void*)mk_fwd, NWAVES * 64, LDS_BYTES);
        (void)hipGetLastError();
        g_grid = cus > 0 ? cus : 256;
    }
    hipMemsetAsync((unsigned char*)d_ws + WS_CTL, 0, CTL_ZERO_BYTES, stream);
    Args a{};
    for (int i = 0; i < 14; ++i) a.in[i] = (const float*)d_in[i];
    a.out = (float*)d_out; a.ws = (unsigned char*)d_ws;
#if MK_PER_PHASE
    for (int p = 0; p < NPH; ++p) { a.ph_lo = p; a.ph_hi = p + 1; hipLaunchKernelGGL(mk_fwd, dim3(g_grid), dim3(NWAVES * 64), LDS_BYTES, stream, a); }
#else
    a.ph_lo = 0; a.ph_hi = NPH;
    hipLaunchKernelGGL(mk_fwd, dim3(g_grid), dim3(NWAVES * 64), LDS_BYTES, stream, a);
#endif
}
```

```cpp
#include <hip/hip_runtime.h>
#include <stdint.h>

typedef unsigned short bf16_t;
__device__ __forceinline__ float bf2f(bf16_t v) { return __uint_as_float(((unsigned)v) << 16); }
__device__ __forceinline__ bf16_t f2bf(float f) { unsigned u = __float_as_uint(f); return (bf16_t)((u + 0x7fffu + ((u >> 16) & 1u)) >> 16); }

constexpr int BATCH = 8, SEQ = 4096, DM = 1024, DEPTH = 4, NMETA = 16;
constexpr int MR = BATCH * SEQ;
constexpr int MT = MR + NMETA;
constexpr int IN_DIM = 3588, NP = 3584;
constexpr int C_FQ = 0, C_FK = 256, C_FV = 512, C_FZ = 768, C_DQ = 1024, C_DK = 1536, C_DV = 2048, C_DZ = 2560, C_PU = 3072, C_PZ = 3328;
constexpr int M_A = 0, M_B = 256, M_C = 768;
constexpr float LN2F = 0.6931471805599453f;
__device__ __forceinline__ unsigned pk2(float lo, float hi) { return (unsigned)f2bf(lo) | ((unsigned)f2bf(hi) << 16); }

constexpr size_t MiB = 1u << 20;
constexpr size_t WS_CTL = 0;
constexpr size_t WS_W1T = 2 * MiB;
constexpr size_t WS_W2T = 30 * MiB;
constexpr size_t WS_WFG = 38 * MiB;
constexpr size_t WS_LAM = 38 * MiB + 196608;
constexpr size_t WS_TOT = 38 * MiB + 131072;
constexpr size_t WS_WPT = 38 * MiB + 262144;
constexpr size_t WS_KMX = 38 * MiB + 524288;
constexpr int KMX_WORDS = 24 * 2 * 8 * 64;
constexpr int MTP = MR + 64;
constexpr size_t WS_SS = 39 * MiB;
typedef unsigned long long ssq_t;
__device__ __forceinline__ ssq_t ss_fix(float q) { return (ssq_t)(q * 16777216.f); }
__device__ __forceinline__ float ss_val(ssq_t v) { return (float)v * (1.f / 16777216.f); }
constexpr size_t WS_CUM = 40 * MiB;
constexpr size_t WS_HB = 42 * MiB;
constexpr size_t WS_MIX = 108 * MiB;
constexpr size_t WS_PROJ = 174 * MiB;
constexpr size_t WS_RES = 400 * MiB;
constexpr size_t WS_END = 464 * MiB;

__device__ __forceinline__ float shx(float v, int m, int lane) { return __int_as_float(__builtin_amdgcn_ds_bpermute((lane ^ m) << 2, __float_as_int(v))); }
__device__ __forceinline__ float shl(float v, int src) { return __int_as_float(__builtin_amdgcn_ds_bpermute(src << 2, __float_as_int(v))); }
__device__ __forceinline__ float wave_sum(float v, int lane) {
#pragma unroll
    for (int o = 1; o < 64; o <<= 1) v += shx(v, o, lane);
    return v;
}
__device__ __forceinline__ float fexp(float x) { return __builtin_amdgcn_exp2f(x * 1.4426950408889634f); }
__device__ __forceinline__ float log_sigmoid(float x) { return fminf(x, 0.f) - __builtin_amdgcn_logf(1.f + fexp(-fabsf(x))) * 0.6931471805599453f; }
__device__ __forceinline__ float silu(float x) { return x / (1.f + fexp(-x)); }

__device__ __forceinline__ void entry_row(int row, int lane, const float* __restrict__ xreal, const float* __restrict__ xmeta, bf16_t* HB, ssq_t* SS0) {
    const float* hp = row < MR ? xreal + (size_t)row * DM : xmeta + (size_t)(row - MR) * DM;
    float ss = 0.f;
#pragma unroll
    for (int j = 0; j < 4; ++j) { const float4 v = *(const float4*)(hp + j * 256 + lane * 4);
        const unsigned w0 = pk2(v.x, v.y), w1 = pk2(v.z, v.w);
        const float a0 = __uint_as_float(w0 << 16), a1 = __uint_as_float(w0 & 0xffff0000u), a2 = __uint_as_float(w1 << 16), a3 = __uint_as_float(w1 & 0xffff0000u);
        ss += (a0 * a0 + a1 * a1) + (a2 * a2 + a3 * a3);
        *(uint2*)(HB + (size_t)row * DM + j * 256 + lane * 4) = make_uint2(w0, w1); }
    ss = wave_sum(ss, lane);
    if (lane == 0) SS0[row] = ss_fix(ss);
}
__device__ __forceinline__ void final_row(int row, int lane, const bf16_t* __restrict__ HB, const ssq_t* __restrict__ SSf, float* OUT, const float* __restrict__ final_g) {
    const float rstd = rsqrtf(ss_val(SSf[row]) * (1.f / DM) + 1e-6f);
#pragma unroll
    for (int j = 0; j < 4; ++j) {
        const uint2 w = *(const uint2*)(HB + (size_t)row * DM + j * 256 + lane * 4);
        const float4 g = *(const float4*)(final_g + j * 256 + lane * 4);
        float4 o; o.x = __uint_as_float(w.x << 16) * rstd * g.x; o.y = __uint_as_float(w.x & 0xffff0000u) * rstd * g.y; o.z = __uint_as_float(w.y << 16) * rstd * g.z; o.w = __uint_as_float(w.y & 0xffff0000u) * rstd * g.w;
        *(float4*)(OUT + (size_t)row * DM + j * 256 + lane * 4) = o;
    }
}
typedef short mbf16x8 __attribute__((ext_vector_type(8)));
typedef float mf32x4 __attribute__((ext_vector_type(4)));
__device__ __forceinline__ mf32x4 meta_gemm16(const bf16_t* __restrict__ A16, const bf16_t* __restrict__ Bt, int nb, int lane) {
    const int fr = lane & 15, fq = lane >> 4; mf32x4 acc = {0.f, 0.f, 0.f, 0.f};
    const bf16_t* ap = A16 + fr * 1024 + fq * 8; const bf16_t* bp = Bt + (size_t)(16 * nb + fr) * 1024 + fq * 8;
#pragma unroll 16
    for (int kk = 0; kk < 32; ++kk) { const mbf16x8 a = *(const mbf16x8*)(ap + kk * 32), b = *(const mbf16x8*)(bp + kk * 32); acc = __builtin_amdgcn_mfma_f32_16x16x32_bf16(a, b, acc, 0, 0, 0); }
    return acc;
}
__device__ __forceinline__ void ld16(const bf16_t* p, float (&x)[16]) {
    const uint4 a = *(const uint4*)p, b = *(const uint4*)(p + 8);
    const unsigned w[8] = {a.x, a.y, a.z, a.w, b.x, b.y, b.z, b.w};
#pragma unroll
    for (int j = 0; j < 8; ++j) { x[2 * j] = __uint_as_float(w[j] << 16); x[2 * j + 1] = __uint_as_float(w[j] & 0xffff0000u); }
}
__device__ __forceinline__ mf32x4 meta_gemm16_k8(const bf16_t* __restrict__ A16, const bf16_t* __restrict__ Bt, int nb, int wave, int lane, __attribute__((address_space(3))) float* red) {
    const int fr = lane & 15, fq = lane >> 4; mf32x4 acc = {0.f, 0.f, 0.f, 0.f};
    const bf16_t* ap = A16 + fr * 1024 + fq * 8 + wave * 128; const bf16_t* bp = Bt + (size_t)(16 * nb + fr) * 1024 + fq * 8 + wave * 128;
    mbf16x8 a[4], b[4];
#pragma unroll
    for (int kk = 0; kk < 4; ++kk) { a[kk] = *(const mbf16x8*)(ap + kk * 32); b[kk] = *(const mbf16x8*)(bp + kk * 32); }
#pragma unroll
    for (int kk = 0; kk < 4; ++kk) acc = __builtin_amdgcn_mfma_f32_16x16x32_bf16(a[kk], b[kk], acc, 0, 0, 0);
    *(__attribute__((address_space(3))) mf32x4*)(red + (wave * 64 + lane) * 4) = acc;
    __syncthreads();
    mf32x4 sum = {0.f, 0.f, 0.f, 0.f};
#pragma unroll
    for (int w = 0; w < 8; ++w) sum += *(const __attribute__((address_space(3))) mf32x4*)(red + (w * 64 + lane) * 4);
    __syncthreads();
    return sum;
}
__device__ __forceinline__ void fox_meta(int h, int lane, const bf16_t* __restrict__ PROJ, const float* __restrict__ CUM, bf16_t* MIX) {
    const int t = lane >> 2, dq = lane & 3, row = MR + t;
    float ln2 = LN2F, m = -1e30f; asm volatile("" : "+v"(ln2), "+v"(m));
    float q[16], o[16], x[16];
    ld16(PROJ + (size_t)row * NP + C_FQ + h * 64 + dq * 16, q);
#pragma unroll
    for (int d = 0; d < 16; ++d) { q[d] *= ln2; o[d] = 0.f; }
    const float cq = CUM[(size_t)h * MTP + row];
    float lsum = 0.f;
    for (int kk = 0; kk < 16; ++kk) {
        const int krow = MR + kk;
        ld16(PROJ + (size_t)krow * NP + C_FK + h * 64 + dq * 16, x);
        float sc = 0.f;
#pragma unroll
        for (int d = 0; d < 16; ++d) sc += q[d] * x[d];
        sc += shx(sc, 1, lane); sc += shx(sc, 2, lane);
        sc += cq - CUM[(size_t)h * MTP + krow];
        ld16(PROJ + (size_t)krow * NP + C_FV + h * 64 + dq * 16, x);
        if (kk <= t) {
            if (sc > m) { const float a = fexp(m - sc); lsum *= a;
#pragma unroll
                for (int d = 0; d < 16; ++d) o[d] *= a;
                m = sc; }
            const float p = fexp(sc - m); lsum += p;
#pragma unroll
            for (int d = 0; d < 16; ++d) o[d] += p * x[d];
        }
    }
    const float inv = 1.f / lsum;
    ld16(PROJ + (size_t)row * NP + C_FZ + h * 64 + dq * 16, x);
    bf16_t* mp = MIX + (size_t)row * DM + M_A + h * 64 + dq * 16;
#pragma unroll
    for (int d = 0; d < 16; d += 2) *(unsigned*)(mp + d) = pk2(o[d] * inv * silu(x[d]), o[d + 1] * inv * silu(x[d + 1]));
}
__device__ __forceinline__ void diff_meta(int h, int lane, const bf16_t* __restrict__ PROJ, const float* __restrict__ subln_g_l, float lam, float li, bf16_t* MIX) {
    const int ri = lane >> 2, qq = lane & 3, row = MR + ri;
    const float posq = (float)ri, slope = 1.f / (float)(1 << (2 * h + 2));
    float res[32], x[16], y[16];
    for (int c = 0; c < 2; ++c) {
        float ln2 = LN2F, m = -1e30f; asm volatile("" : "+v"(ln2), "+v"(m));
        float q[16], o[32];
        ld16(PROJ + (size_t)row * NP + C_DQ + h * 128 + c * 64 + qq * 16, q);
#pragma unroll
        for (int d = 0; d < 16; ++d) q[d] *= ln2;
#pragma unroll
        for (int d = 0; d < 32; ++d) o[d] = 0.f;
        float lsum = 0.f;
        for (int kk = 0; kk < 16; ++kk) {
            const int krow = MR + kk;
            ld16(PROJ + (size_t)krow * NP + C_DK + h * 128 + c * 64 + qq * 16, x);
            float sc = 0.f;
#pragma unroll
            for (int d = 0; d < 16; ++d) sc += q[d] * x[d];
            sc += shx(sc, 1, lane); sc += shx(sc, 2, lane);
            sc -= slope * fabsf(posq - (float)kk);
            ld16(PROJ + (size_t)krow * NP + C_DV + h * 128 + qq * 32, x);
            ld16(PROJ + (size_t)krow * NP + C_DV + h * 128 + qq * 32 + 16, y);
            if (sc > m) { const float a = fexp(m - sc); lsum *= a;
#pragma unroll
                for (int d = 0; d < 32; ++d) o[d] *= a;
                m = sc; }
            const float p = fexp(sc - m); lsum += p;
#pragma unroll
            for (int d = 0; d < 16; ++d) { o[d] += p * x[d]; o[16 + d] += p * y[d]; }
        }
        const float inv = 1.f / lsum;
        if (c == 0) {
#pragma unroll
            for (int d = 0; d < 32; ++d) res[d] = o[d] * inv;
        } else {
#pragma unroll
            for (int d = 0; d < 32; ++d) res[d] -= lam * o[d] * inv;
        }
    }
    float ss = 0.f;
#pragma unroll
    for (int d = 0; d < 32; ++d) ss += res[d] * res[d];
    ss += shx(ss, 1, lane); ss += shx(ss, 2, lane);
    const float rstd = rsqrtf(ss * (1.f / 128.f) + 1e-5f) * (1.f - li);
    ld16(PROJ + (size_t)row * NP + C_DZ + h * 128 + qq * 32, x);
    ld16(PROJ + (size_t)row * NP + C_DZ + h * 128 + qq * 32 + 16, y);
    bf16_t* mp = MIX + (size_t)row * DM + M_B + h * 128 + qq * 32;
    const float* gp = subln_g_l + qq * 32;
#pragma unroll
    for (int d = 0; d < 16; d += 2) {
        *(unsigned*)(mp + d) = pk2(res[d] * rstd * gp[d] * silu(x[d]), res[d + 1] * rstd * gp[d + 1] * silu(x[d + 1]));
        *(unsigned*)(mp + 16 + d) = pk2(res[16 + d] * rstd * gp[16 + d] * silu(y[d]), res[17 + d] * rstd * gp[17 + d] * silu(y[d + 1])); }
}
__device__ __forceinline__ void pool_meta(int j, int g, int lane, const bf16_t* __restrict__ PROJ, const float* __restrict__ wpool_l, const float* __restrict__ pscale_l, bf16_t* MIX) {
    const int w = 2 << g, cnt = (j + 1) < w ? (j + 1) : w, row = MR + j;
    float s = 0.f;
    for (int i = 0; i < cnt; ++i) s += bf2f(PROJ[(size_t)(MR + j - i) * NP + C_PU + g * 64 + lane]);
    const float pooled = s / (float)cnt - bf2f(PROJ[(size_t)row * NP + C_PU + g * 64 + lane]);
    float y = 0.f;
    for (int i = 0; i < 64; ++i) y += shl(pooled, i) * wpool_l[(g * 64 + i) * 64 + lane];
    const float z = bf2f(PROJ[(size_t)row * NP + C_PZ + g * 64 + lane]);
    MIX[(size_t)row * DM + M_C + g * 64 + lane] = f2bf(y * pscale_l[g * 64 + lane] * silu(z));
}

namespace pg8 {
#define PG8_LAS __attribute__((address_space(3)))
typedef unsigned short bf16_t;
typedef short bf16x8 __attribute__((ext_vector_type(8)));
typedef float f32x4 __attribute__((ext_vector_type(4)));
typedef unsigned u32x4 __attribute__((ext_vector_type(4)));
constexpr int BM = 256, BK = 64, HALF = 128, HTB = HALF * BK * 2  , STAGE_BYTES = 8 * HTB, NXCD = 8, WGM = 8;

__host__ __device__ __forceinline__ int lds_byte(int r, int c) { const int st = (r >> 4) * 2 + (c >> 5), rr = r & 15, cc = c & 31, ob = rr * 64 + cc * 2; return st * 1024 + (ob ^ (((ob >> 9) & 1) << 5)); }
__host__ __device__ __forceinline__ void stage_rc(int b, int& R, int& C) { const int st = b / 1024, sb = b % 1024, swz = sb ^ (((sb >> 9) & 1) << 5); R = (st >> 1) * 16 + swz / 64; C = (st & 1) * 32 + (swz % 64) / 2; }
__host__ __device__ __forceinline__ int perm32(int rho) { const int n = rho >> 4, i = rho & 15; return 8 * (i >> 2) + 4 * n + (i & 3); }

struct Unit { int pm, pn; };
struct Gemm { const bf16_t* A; const bf16_t* Bt; int M, N, K; };

struct StaticOrder {
    int nM, nN, nwg, G, c;
    __host__ __device__ void init(int M, int N, int G_, int c_) { nM = M / BM; nN = N / BM; nwg = nM * nN; G = G_; c = c_; }
    __host__ __device__ bool next(int i, Unit& u) const {
        const long L = (long)i * G + c; if (L >= nwg) return false;
        int wgid = (int)L; { const int q = nwg / NXCD, r = nwg % NXCD, xcd = wgid % NXCD, off = wgid / NXCD; wgid = (xcd < r ? xcd * (q + 1) : r * (q + 1) + (xcd - r) * q) + off; }
        const int nig = WGM * nN, gid = wgid / nig, fm = gid * WGM, gsz = (nM - fm) < WGM ? (nM - fm) : WGM;
        u.pm = fm + ((wgid % nig) % gsz); u.pn = (wgid % nig) / gsz; return true;
    }
    __device__ __forceinline__ void a_ready(const Unit&) const {}
    __device__ __forceinline__ void done(const Unit&) const {}
};

__device__ __forceinline__ unsigned cvt_pk_bf16(float lo, float hi) { unsigned r; asm volatile("v_cvt_pk_bf16_f32 %0, %1, %2" : "=v"(r) : "v"(lo), "v"(hi)); return r; }
struct EpiProj {
    static constexpr bool PERM = true, AFTER_DRAIN = false;
    bf16_t* O; int ldc; float qscale; unsigned* kmx; const ssq_t* ss;
    __device__ __forceinline__ void operator()(const f32x4 (&acc)[2][2][4][2], const Unit& u, int wr, int wc, int fr, int fq) const {
        const int row0 = u.pm * BM + wr * 64 + fr, col0 = u.pn * BM + wc * 32 + 8 * fq;
        const float sc = (u.pn == 0 || u.pn == 4 || u.pn == 5) ? qscale : 1.f;
        const bool nrm = (u.pn <= 1) || (u.pn >= 4 && u.pn <= 7);
        float part[2][2][4];
#pragma unroll
        for (int ai = 0; ai < 2; ++ai)
#pragma unroll
            for (int m = 0; m < 4; ++m) { bf16_t* rowp = O + (size_t)(row0 + ai * HALF + m * 16) * ldc + col0;
                const float rs = sc * rsqrtf(ss_val(ss[row0 + ai * HALF + m * 16]) * (1.f / 1024.f) + 1e-6f);
#pragma unroll
                for (int bj = 0; bj < 2; ++bj) { const f32x4 v0 = acc[ai][bj][m][0] * rs, v1 = acc[ai][bj][m][1] * rs;
                    part[ai][bj][m] = (v0[0] * v0[0] + v0[1] * v0[1]) + (v0[2] * v0[2] + v0[3] * v0[3]) + (v1[0] * v1[0] + v1[1] * v1[1]) + (v1[2] * v1[2] + v1[3] * v1[3]);
                    u32x4 w; w.x = cvt_pk_bf16(v0[0], v0[1]); w.y = cvt_pk_bf16(v0[2], v0[3]); w.z = cvt_pk_bf16(v1[0], v1[1]); w.w = cvt_pk_bf16(v1[2], v1[3]);
                    *(u32x4*)(rowp + bj * HALF) = w; } }
        if (nrm) {
            const int lane = fr + 16 * fq;
#pragma unroll
            for (int ai = 0; ai < 2; ++ai)
#pragma unroll
                for (int bj = 0; bj < 2; ++bj) {
                    float mx = 0.f;
#pragma unroll
                    for (int m = 0; m < 4; ++m) { float p = part[ai][bj][m]; p += shx(p, 16, lane); p += shx(p, 32, lane); mx = fmaxf(mx, p); }
                    mx = fmaxf(mx, shx(mx, 1, lane)); mx = fmaxf(mx, shx(mx, 2, lane)); mx = fmaxf(mx, shx(mx, 4, lane)); mx = fmaxf(mx, shx(mx, 8, lane));
                    if (lane == 0) { const int R = u.pm * BM + ai * HALF + wr * 64, col = u.pn * BM + bj * HALF + wc * 32;
                        const int st = col < 512 ? (col >> 6) : 8 + ((col - 1024) >> 6), half = (col >> 5) & 1;
                        atomicMax(kmx + ((st * 2 + half) * 8 + (R >> 12)) * 64 + ((R & 4095) >> 6), __float_as_uint(mx)); }
                }
        }
    }
};
struct EpiResidB {
    static constexpr bool PERM = true, AFTER_DRAIN = false;
    bf16_t* H; int ldc; ssq_t* ssn;
    __device__ __forceinline__ void operator()(const f32x4 (&acc)[2][2][4][2], const Unit& u, int wr, int wc, int fr, int fq) const {
        const int row0 = u.pm * BM + wr * 64 + fr, col0 = u.pn * BM + wc * 32 + 8 * fq, lane = fr + 16 * fq;
#pragma unroll
        for (int ai = 0; ai < 2; ++ai)
#pragma unroll
            for (int m = 0; m < 4; ++m) { const int row = row0 + ai * HALF + m * 16; bf16_t* rowp = H + (size_t)row * ldc + col0; float q = 0.f;
#pragma unroll
                for (int bj = 0; bj < 2; ++bj) { const u32x4 b = *(const u32x4*)(rowp + bj * HALF); const f32x4 a0 = acc[ai][bj][m][0], a1 = acc[ai][bj][m][1];
                    u32x4 w;
                    w.x = cvt_pk_bf16(__uint_as_float(b.x << 16) + a0[0], __uint_as_float(b.x & 0xffff0000u) + a0[1]);
                    w.y = cvt_pk_bf16(__uint_as_float(b.y << 16) + a0[2], __uint_as_float(b.y & 0xffff0000u) + a0[3]);
                    w.z = cvt_pk_bf16(__uint_as_float(b.z << 16) + a1[0], __uint_as_float(b.z & 0xffff0000u) + a1[1]);
                    w.w = cvt_pk_bf16(__uint_as_float(b.w << 16) + a1[2], __uint_as_float(b.w & 0xffff0000u) + a1[3]);
                    *(u32x4*)(rowp + bj * HALF) = w;
#pragma unroll
                    for (int k = 0; k < 4; ++k) { const float lo = __uint_as_float(w[k] << 16), hi = __uint_as_float(w[k] & 0xffff0000u); q += lo * lo + hi * hi; } }
                q += shx(q, 16, lane); q += shx(q, 32, lane);
                if (fq == 0) atomicAdd(ssn + row, ss_fix(q)); }
    }
};
template <class Epi, class Sched, bool ALIGN_EPI = false, bool SP2 = false>
__device__ __forceinline__ void gemm_phase(PG8_LAS unsigned char* lds, const Gemm g, const Sched& S, const Epi& E) {
    int tid_ = threadIdx.x; asm volatile("" : "+v"(tid_));
    const int tid = tid_, wid = __builtin_amdgcn_readfirstlane(tid >> 6), lane = tid & 63, wr = wid >> 2, wc = wid & 3, fr = lane & 15, fq = lane >> 4;
    const int K = g.K, nt = K / BK;
    unsigned voffA[2], voffB[2];
#pragma unroll
    for (int i = 0; i < 2; ++i) { int R, C; stage_rc(tid * 16 + i * 8192, R, C); const int Rb = Epi::PERM ? ((R & ~31) + perm32(R & 31)) : R;
        voffA[i] = (unsigned)(R * K + C) * 2u; voffB[i] = (unsigned)(Rb * K + C) * 2u; }
    const size_t kstep = (size_t)(BK * 2);
    const size_t hstep = (size_t)HALF * K * 2;
    const size_t tstep = 2 * hstep;
    const unsigned ldsw = (unsigned)wid * 1024u;
    const int aoff = lds_byte(wr * 64 + fr, fq * 8), boff = lds_byte(wc * 32 + fr, fq * 8);
#define PG8_SA(b, h) (((b) * 2 + (h)) * HTB)
#define PG8_SB(b, h) ((4 + (b) * 2 + (h)) * HTB)
#define PG8_STAGE(bufoff, gbase, voff) do { _Pragma("unroll") for (int _i = 0; _i < 2; ++_i) \
        __builtin_amdgcn_global_load_lds((const unsigned*)((const char*)(gbase) + (voff)[_i]), (PG8_LAS unsigned*)(lds + (bufoff) + ldsw + _i * 8192), 16, 0, 0); } while (0)
#define PG8_LDA(dst, b, h) do { _Pragma("unroll") for (int m = 0; m < 4; ++m) _Pragma("unroll") for (int k = 0; k < 2; ++k) dst[m][k] = *(const PG8_LAS bf16x8*)(lds + PG8_SA(b, h) + aoff + m * 2048 + k * 1024); } while (0)
#define PG8_LDB(dst, b, h) do { _Pragma("unroll") for (int n = 0; n < 2; ++n) _Pragma("unroll") for (int k = 0; k < 2; ++k) dst[n][k] = *(const PG8_LAS bf16x8*)(lds + PG8_SB(b, h) + boff + n * 2048 + k * 1024); } while (0)
#define PG8_MMA(ai, bj, At, Bt) do { __builtin_amdgcn_s_setprio(1); _Pragma("unroll") for (int m = 0; m < 4; ++m) _Pragma("unroll") for (int n = 0; n < 2; ++n) _Pragma("unroll") for (int k = 0; k < 2; ++k) \
        acc[ai][bj][m][n] = __builtin_amdgcn_mfma_f32_16x16x32_bf16(Bt[n][k], At[m][k], acc[ai][bj][m][n], 0, 0, 0); __builtin_amdgcn_s_setprio(0); } while (0)
#define PG8_WAIT_V(n) asm volatile("s_waitcnt vmcnt(" #n ")" ::: "memory")
#define PG8_WAIT_L(n) asm volatile("s_waitcnt lgkmcnt(" #n ")" ::: "memory")
#define PG8_BAR __builtin_amdgcn_s_barrier()
#define PG8_SCHED __builtin_amdgcn_sched_barrier(0)
    Unit cur, nxt; int ui = 0;
    if (!S.next(0, cur)) return;
    f32x4 acc[2][2][4][2];
#pragma unroll
    for (int a = 0; a < 2; ++a)
#pragma unroll
        for (int b = 0; b < 2; ++b)
#pragma unroll
            for (int m = 0; m < 4; ++m)
#pragma unroll
                for (int n = 0; n < 2; ++n) acc[a][b][m][n] = (f32x4){0.f, 0.f, 0.f, 0.f};
    bf16x8 At[4][2], B0[2][2], B1[2][2];
    const char* cA = (const char*)g.A + (size_t)cur.pm * tstep; const char* cB = (const char*)g.Bt + (size_t)cur.pn * tstep;
    S.a_ready(cur);
    if constexpr (SP2) {
        PG8_STAGE(PG8_SB(0, 0), cB, voffB); PG8_STAGE(PG8_SB(0, 1), cB + hstep, voffB); PG8_STAGE(PG8_SA(0, 0), cA, voffA); PG8_STAGE(PG8_SA(0, 1), cA + hstep, voffA);
        if (wr == 1) PG8_BAR;
        PG8_WAIT_V(2); PG8_BAR;
        PG8_STAGE(PG8_SB(1, 0), cB + kstep, voffB); PG8_STAGE(PG8_SA(1, 0), cA + kstep, voffA); PG8_STAGE(PG8_SB(1, 1), cB + hstep + kstep, voffB);
        PG8_WAIT_V(6); PG8_BAR;
    } else {
        PG8_STAGE(PG8_SB(0, 0), cB, voffB); PG8_STAGE(PG8_SA(0, 0), cA, voffA); PG8_STAGE(PG8_SB(0, 1), cB + hstep, voffB); PG8_STAGE(PG8_SA(0, 1), cA + hstep, voffA);
        if (wr == 1) PG8_BAR;
        PG8_WAIT_V(4); PG8_BAR;
        PG8_STAGE(PG8_SB(1, 0), cB + kstep, voffB); PG8_STAGE(PG8_SA(1, 0), cA + kstep, voffA); PG8_STAGE(PG8_SB(1, 1), cB + hstep + kstep, voffB);
        PG8_WAIT_V(6); PG8_BAR;
    }
    for (;;) {
        const bool has_next = S.next(ui + 1, nxt);
        const char* nA = has_next ? (const char*)g.A + (size_t)nxt.pm * tstep : cA; const char* nB = has_next ? (const char*)g.Bt + (size_t)nxt.pn * tstep : cB;
        for (int t = 0; t < nt; t += 2) {
            const bool last = (t == nt - 2);
            const char* a1 = cA + (size_t)(t + 1) * kstep;
            const char* a2 = last ? nA : cA + (size_t)(t + 2) * kstep; const char* b2 = last ? nB : cB + (size_t)(t + 2) * kstep;
            const char* a3 = a2 + kstep; const char* b3 = b2 + kstep;
            if (last && has_next) S.a_ready(nxt);
            if constexpr (SP2) {
            PG8_LDB(B0, 0, 0); PG8_LDB(B1, 0, 1); PG8_SCHED; PG8_LDA(At, 0, 0); PG8_STAGE(PG8_SA(1, 1), a1 + hstep, voffA);
            PG8_WAIT_V(8); PG8_WAIT_L(0); PG8_BAR; PG8_MMA(0, 0, At, B0); PG8_MMA(0, 1, At, B1); PG8_BAR; PG8_SCHED;
            PG8_LDA(At, 0, 1); PG8_STAGE(PG8_SB(0, 0), b2, voffB); PG8_STAGE(PG8_SB(0, 1), b2 + hstep, voffB); PG8_STAGE(PG8_SA(0, 0), a2, voffA);
            PG8_WAIT_V(8); PG8_WAIT_L(0); PG8_BAR; PG8_MMA(1, 0, At, B0); PG8_MMA(1, 1, At, B1); PG8_BAR; PG8_SCHED;
            PG8_LDB(B0, 1, 0); PG8_LDB(B1, 1, 1); PG8_SCHED; PG8_LDA(At, 1, 0); PG8_STAGE(PG8_SA(0, 1), a2 + hstep, voffA);
            PG8_WAIT_V(8); PG8_WAIT_L(0); PG8_BAR; PG8_MMA(0, 0, At, B0); PG8_MMA(0, 1, At, B1); PG8_BAR; PG8_SCHED;
            PG8_LDA(At, 1, 1); PG8_STAGE(PG8_SB(1, 0), b3, voffB); PG8_STAGE(PG8_SB(1, 1), b3 + hstep, voffB); PG8_STAGE(PG8_SA(1, 0), a3, voffA);
            PG8_WAIT_V(8); PG8_WAIT_L(0); PG8_BAR; PG8_MMA(1, 0, At, B0); PG8_MMA(1, 1, At, B1); PG8_BAR; PG8_SCHED;
            } else {
            PG8_LDB(B0, 0, 0); PG8_SCHED; PG8_LDA(At, 0, 0); PG8_STAGE(PG8_SA(1, 1), a1 + hstep, voffA);
            PG8_WAIT_L(8); PG8_BAR; PG8_WAIT_L(0); PG8_MMA(0, 0, At, B0); PG8_BAR; PG8_SCHED;
            PG8_LDB(B1, 0, 1); PG8_STAGE(PG8_SB(0, 0), b2, voffB);
            PG8_BAR; PG8_WAIT_L(0); PG8_MMA(0, 1, At, B1); PG8_BAR;
            PG8_LDA(At, 0, 1); PG8_STAGE(PG8_SA(0, 0), a2, voffA);
            PG8_BAR; PG8_WAIT_L(0); PG8_MMA(1, 0, At, B0); PG8_BAR; PG8_SCHED;
            PG8_STAGE(PG8_SB(0, 1), b2 + hstep, voffB);
            PG8_WAIT_V(6); PG8_BAR; PG8_MMA(1, 1, At, B1); PG8_BAR;
            PG8_LDB(B0, 1, 0); PG8_SCHED; PG8_LDA(At, 1, 0); PG8_STAGE(PG8_SA(0, 1), a2 + hstep, voffA);
            PG8_WAIT_L(8); PG8_BAR; PG8_WAIT_L(0); PG8_MMA(0, 0, At, B0); PG8_BAR; PG8_SCHED;
            PG8_LDB(B1, 1, 1); PG8_STAGE(PG8_SB(1, 0), b3, voffB);
            PG8_BAR; PG8_WAIT_L(0); PG8_MMA(0, 1, At, B1); PG8_BAR;
            PG8_LDA(At, 1, 1); PG8_STAGE(PG8_SA(1, 0), a3, voffA);
            PG8_BAR; PG8_WAIT_L(0); PG8_MMA(1, 0, At, B0); PG8_BAR; PG8_SCHED;
            PG8_STAGE(PG8_SB(1, 1), b3 + hstep, voffB);
            PG8_WAIT_V(6); PG8_BAR; PG8_MMA(1, 1, At, B1); PG8_BAR;
            }
        }
        if constexpr (ALIGN_EPI) { if (wr == 0) PG8_BAR; }
        if constexpr (!Epi::AFTER_DRAIN) { E(acc, cur, wr, wc, fr, fq); S.done(cur); }
        if (!has_next) break;
#pragma unroll
        for (int a = 0; a < 2; ++a)
#pragma unroll
            for (int b = 0; b < 2; ++b)
#pragma unroll
                for (int m = 0; m < 4; ++m)
#pragma unroll
                    for (int n = 0; n < 2; ++n) acc[a][b][m][n] = (f32x4){0.f, 0.f, 0.f, 0.f};
        cur = nxt; cA = nA; cB = nB; ++ui;
        if constexpr (ALIGN_EPI) { if (wr == 1) PG8_BAR; }
    }
    PG8_WAIT_V(0);
    if constexpr (!ALIGN_EPI) { if (wr == 0) PG8_BAR; }
    PG8_BAR;
    if constexpr (Epi::AFTER_DRAIN) { E.fused(acc, cur, wr, wc, fr, fq, lds, wid, lane); S.done(cur); }
#undef PG8_SA
#undef PG8_SB
#undef PG8_STAGE
#undef PG8_LDA
#undef PG8_LDB
#undef PG8_MMA
#undef PG8_WAIT_V
#undef PG8_WAIT_L
#undef PG8_BAR
#undef PG8_SCHED
}
}
namespace att {
typedef float f32x16 __attribute__((ext_vector_type(16)));
typedef float f32x4 __attribute__((ext_vector_type(4)));
typedef short bf16x8 __attribute__((ext_vector_type(8)));
typedef short s16x4 __attribute__((ext_vector_type(4)));
typedef unsigned u32x4 __attribute__((ext_vector_type(4)));
#define ALAS __attribute__((address_space(3)))
constexpr int KCS = 1040, VDS = 4160, KBUF = 8 * KCS, VBUF = 4 * VDS, NSLOT = 3;
constexpr int KBOFF = KBUF + VBUF, STG0 = KBOFF + 256, STG1 = 2 * KBUF + VBUF;
template <int MODE> struct Geo { static constexpr int STG = MODE == 0 ? STG0 : STG1, VOFF = MODE == 0 ? KBUF : 2 * KBUF; };
constexpr int L_WSF = NSLOT * STG1, L_OST = L_WSF + 8 * 256, L_END = L_OST + 8 * 4096;
constexpr float LOG2E = 1.4426950408889634f, C2 = 0.125f * LOG2E, THR = 8.f, NEGBIG = -1e30f;
__device__ __forceinline__ int crow(int r, int hi) { return (r & 3) + 8 * (r >> 2) + 4 * hi; }
__device__ __forceinline__ unsigned cvtpk(float lo, float hi) { typedef float f2 __attribute__((ext_vector_type(2))); typedef __bf16 b2 __attribute__((ext_vector_type(2))); f2 v = {lo, hi}; b2 b = __builtin_convertvector(v, b2); return __builtin_bit_cast(unsigned, b); }
__device__ __forceinline__ s16x4 vtr(const ALAS unsigned char* p) { typedef short v4i16_t __attribute__((ext_vector_type(4))); return __builtin_bit_cast(s16x4, __builtin_amdgcn_ds_read_tr16_b64_v4i16((ALAS v4i16_t*)p)); }
__device__ __forceinline__ float bfl(unsigned w) { return __uint_as_float(w << 16); }
__device__ __forceinline__ float bfh(unsigned w) { return __uint_as_float(w & 0xffff0000u); }
__device__ __forceinline__ float silu_f(float x) { return x * __builtin_amdgcn_rcpf(1.f + fexp(-x)); }
__device__ __forceinline__ void glds16(const void* gsrc, unsigned lds_dst) { unsigned keep;
    asm volatile("s_mov_b32 %0, m0\n\ts_mov_b32 m0, %2\n\ts_nop 0\n\tglobal_load_lds_dwordx4 %1, off\n\ts_mov_b32 m0, %0" : "=&s"(keep) : "v"(gsrc), "s"(lds_dst) : "memory"); }
__device__ __forceinline__ void glds4(const void* gsrc, unsigned lds_dst) { unsigned keep;
    asm volatile("s_mov_b32 %0, m0\n\ts_mov_b32 m0, %2\n\ts_nop 0\n\tglobal_load_lds_dword %1, off\n\ts_mov_b32 m0, %0" : "=&s"(keep) : "v"(gsrc), "s"(lds_dst) : "memory"); }
#define ATT_SBAR0() __builtin_amdgcn_sched_barrier(0)
#define ATT_WAIT_BAR(N) asm volatile("s_waitcnt vmcnt(" #N ") lgkmcnt(0)\n\ts_barrier" ::: "memory")

template <int MODE> __device__ __forceinline__ void dma_k(unsigned slot, const bf16_t* __restrict__ PROJ, const float* __restrict__ CUM, size_t krow0, int kcol, int h, int wid, int lane) {
    if (MODE == 0 && wid == 0) glds4(CUM + (size_t)h * MTP + krow0 + lane, (unsigned)__builtin_amdgcn_readfirstlane(slot + KBOFF));
    glds16(PROJ + (krow0 + lane) * NP + kcol + wid * 8, (unsigned)__builtin_amdgcn_readfirstlane(slot + wid * KCS));
    if (MODE == 1) glds16(PROJ + (krow0 + lane) * NP + kcol + 64 + wid * 8, (unsigned)__builtin_amdgcn_readfirstlane(slot + KBUF + wid * KCS));
}
template <int MODE> __device__ __forceinline__ void dma_v(unsigned slot, const bf16_t* __restrict__ PROJ, size_t krow0, int vcol, int wid, int lane) {
    const bf16_t* vs = PROJ + (krow0 + (wid & 3) * 16 + (lane >> 2)) * NP + vcol + (wid >> 2) * 32 + (lane & 3) * 8;
    glds16(vs, (unsigned)__builtin_amdgcn_readfirstlane(slot + Geo<MODE>::VOFF + (wid >> 2) * VDS + (wid & 3) * 1024));
    if (MODE == 1) glds16(vs + 64, (unsigned)__builtin_amdgcn_readfirstlane(slot + Geo<MODE>::VOFF + (2 + (wid >> 2)) * VDS + (wid & 3) * 1024));
}

template <int MODE, bool DIAG, bool META> __device__ __forceinline__ bool qs_front(const ALAS unsigned char* buf, const ALAS unsigned char* vprev, s16x4 (&vl)[8], s16x4 (&vh)[8], const bf16x8 (&qr)[4], const ALAS bf16x8* qlds, f32x16& p0, f32x16& p1, float& mhat, float& l,
        int kidx0, int qw0, float slope2, float koffL, bool nomax, ALAS float* wsf, int lane) {
    constexpr bool diag = DIAG, meta = META;
    const int r32 = lane & 31, hi = lane >> 5;
    {
      const ALAS unsigned char* vb = vprev + Geo<MODE>::VOFF + ((lane >> 4) & 1) * 32 + (lane & 3) * 8 + (4 * hi + ((lane & 15) >> 2)) * 64; asm volatile("" : "+v"(vb));
#pragma unroll
      for (int i = 0; i < (MODE == 0 ? 8 : 4); ++i) { vl[i] = vtr(vb + (i & 1) * VDS + (i >> 1) * 1024); vh[i] = vtr(vb + (i & 1) * VDS + (i >> 1) * 1024 + 512); } }
    asm volatile("" : "+v"(slope2), "+s"(kidx0));
    if (MODE == 0) {
        const ALAS f32x4* kbp = (const ALAS f32x4*)(buf + KBOFF + hi * 16); asm volatile("" : "+v"(kbp));
#pragma unroll
        for (int g = 0; g < 4; ++g) { const f32x4 a = kbp[2 * g], b = kbp[8 + 2 * g];
#pragma unroll
            for (int j = 0; j < 4; ++j) { p0[4 * g + j] = fmaf(a[j], -LOG2E, -mhat - koffL); p1[4 * g + j] = fmaf(b[j], -LOG2E, -mhat - koffL); } }
    } else {
        if (!diag) {
            const float base = slope2 * (float)(kidx0 + 4 * hi - qw0) - mhat;
#pragma unroll
            for (int r = 0; r < 16; ++r) { const int c = (r & 3) + 8 * (r >> 2); p0[r] = fmaf((float)c, slope2, base); p1[r] = fmaf((float)(c + 32), slope2, base); }
            if (meta) {
#pragma unroll
                for (int r = 0; r < 16; ++r) { if ((r >> 2) >= 2) p0[r] = NEGBIG; p1[r] = NEGBIG; }
            }
        } else {
            const float dq = (float)(qw0 + r32 - kidx0 - 4 * hi), fr = (float)r32;
#pragma unroll
            for (int r = 0; r < 16; ++r) { const int c = (r & 3) + 8 * (r >> 2);
                p0[r] = slope2 * (fr - fabsf(dq - (float)c)) - mhat; p1[r] = slope2 * (fr - fabsf(dq - (float)(c + 32))) - mhat; }
        }
    }
    bf16x8 qfr[4];
#pragma unroll
    for (int d0 = 0; d0 < 4; ++d0) qfr[d0] = MODE == 0 ? qr[d0] : qlds[d0 * 64];
    if (MODE == 1) ATT_SBAR0();
    { const ALAS unsigned char* kb = buf + hi * KCS + r32 * 16; asm volatile("" : "+v"(kb));
#pragma unroll
      for (int d0 = 0; d0 < 4; ++d0) {
          const bf16x8 k0 = *(const ALAS bf16x8*)(kb + d0 * 2 * KCS), k1 = *(const ALAS bf16x8*)(kb + d0 * 2 * KCS + 512);
          const bf16x8 qf = qfr[d0];
          p0 = __builtin_amdgcn_mfma_f32_32x32x16_bf16(k0, qf, p0, 0, 0, 0);
          p1 = __builtin_amdgcn_mfma_f32_32x32x16_bf16(k1, qf, p1, 0, 0, 0); } }
    if (MODE == 0 && diag) {
        const int lim = qw0 + r32 - kidx0 - 4 * hi;
#pragma unroll
        for (int r = 0; r < 16; ++r) { const int c = (r & 3) + 8 * (r >> 2); if (c > lim) p0[r] = NEGBIG; if (c + 32 > lim) p1[r] = NEGBIG; }
    }
    bool resc = false;
    if (META || !nomax) {
        float rm;
        {
#define ATT_MX3(a, b, c) __builtin_fmaxf(__builtin_fmaxf((a), (b)), (c))
          float a = ATT_MX3(p0[0], p0[1], p1[0]), b = ATT_MX3(p0[2], p0[3], p1[1]); a = ATT_MX3(a, p1[2], p1[3]);
#pragma unroll
          for (int r = 4; r < 16; r += 4) { a = ATT_MX3(a, p0[r], p0[r + 1]); b = ATT_MX3(b, p0[r + 2], p0[r + 3]); a = ATT_MX3(a, p1[r], p1[r + 1]); b = ATT_MX3(b, p1[r + 2], p1[r + 3]); }
#undef ATT_MX3
          a = __builtin_fmaxf(a, b);
          auto rr = __builtin_amdgcn_permlane32_swap(__float_as_uint(a), __float_as_uint(a), false, false);
          rm = __builtin_fmaxf(__uint_as_float(rr[0]), __uint_as_float(rr[1])); }
        if (__any(rm > THR)) {
            const float dl = fmaxf(rm, 0.f); mhat += dl;
#pragma unroll
            for (int r = 0; r < 16; ++r) { p0[r] -= dl; p1[r] -= dl; }
            const float f = __builtin_amdgcn_exp2f(-dl); l *= f; if (hi == 0) wsf[r32] = f; resc = true;
        }
    }
    return resc;
}
#define ATT_SBAR() __builtin_amdgcn_sched_barrier(0)
#define ATT_PIN(x) asm volatile("" : "+v"(x))
#define ATT_VF(L, H, i) (bf16x8){L[i][0], L[i][1], L[i][2], L[i][3], H[i][0], H[i][1], H[i][2], H[i][3]}
template <int NDB> __device__ __forceinline__ void pv_exp(const ALAS unsigned char* vbuf, s16x4 (&vl)[8], s16x4 (&vh)[8], const u32x4 (&pwo)[4], f32x16 (&o)[NDB], f32x16& p0, f32x16& p1, u32x4 (&pwn)[4], float& l, int lane) {
    const int hi = lane >> 5;
    float s0 = 0.f, s1 = 0.f, s2 = 0.f, s3 = 0.f;
    ATT_SBAR();
    if (NDB == 2) {
#pragma unroll
        for (int k = 0; k < 8; ++k) {
            o[k & 1] = __builtin_amdgcn_mfma_f32_32x32x16_bf16(__builtin_bit_cast(bf16x8, pwo[k >> 1]), ATT_VF(vl, vh, k), o[k & 1], 0, 0, 0);
            p0[2 * k] = __builtin_amdgcn_exp2f(p0[2 * k]); p0[2 * k + 1] = __builtin_amdgcn_exp2f(p0[2 * k + 1]); p1[2 * k] = __builtin_amdgcn_exp2f(p1[2 * k]); p1[2 * k + 1] = __builtin_amdgcn_exp2f(p1[2 * k + 1]);
            s0 += p0[2 * k]; s1 += p0[2 * k + 1]; s2 += p1[2 * k]; s3 += p1[2 * k + 1];
            pwn[k >> 2][k & 3] = cvtpk(p0[2 * k], p0[2 * k + 1]); pwn[2 + (k >> 2)][k & 3] = cvtpk(p1[2 * k], p1[2 * k + 1]);
            ATT_PIN(p0); ATT_PIN(p1); ATT_PIN(s0); ATT_PIN(s1); ATT_PIN(s2); ATT_PIN(s3); ATT_PIN(pwn[k >> 2]); ATT_PIN(pwn[2 + (k >> 2)]);
            ATT_SBAR();
        }
    } else {
        const ALAS unsigned char* vb = vbuf + 2 * KBUF + ((lane >> 4) & 1) * 32 + (lane & 3) * 8 + (4 * hi + ((lane & 15) >> 2)) * 64; asm volatile("" : "+v"(vb));
        s16x4 (&wl)[8] = vl; s16x4 (&wh)[8] = vh;
#pragma unroll
        for (int k = 0; k < 16; ++k) {
            const int blk = 2 * (k >> 3) + (k & 1), ks = (k >> 1) & 3;
            o[blk] = __builtin_amdgcn_mfma_f32_32x32x16_bf16(__builtin_bit_cast(bf16x8, pwo[ks]), ATT_VF(wl, wh, k & 3), o[blk], 0, 0, 0);
            if (k + 4 < 16) { const int j = k + 4, jb = 2 * (j >> 3) + (j & 1), jk = (j >> 1) & 3; wl[k & 3] = vtr(vb + jb * VDS + jk * 1024); wh[k & 3] = vtr(vb + jb * VDS + jk * 1024 + 512); }
            if (k < 8) { p0[2 * k] = __builtin_amdgcn_exp2f(p0[2 * k]); p0[2 * k + 1] = __builtin_amdgcn_exp2f(p0[2 * k + 1]); s0 += p0[2 * k]; s1 += p0[2 * k + 1];
                pwn[k >> 2][k & 3] = cvtpk(p0[2 * k], p0[2 * k + 1]); ATT_PIN(p0); ATT_PIN(s0); ATT_PIN(s1); ATT_PIN(pwn[k >> 2]); }
            else { const int q = k - 8; p1[2 * q] = __builtin_amdgcn_exp2f(p1[2 * q]); p1[2 * q + 1] = __builtin_amdgcn_exp2f(p1[2 * q + 1]); s2 += p1[2 * q]; s3 += p1[2 * q + 1];
                pwn[2 + (q >> 2)][q & 3] = cvtpk(p1[2 * q], p1[2 * q + 1]); ATT_PIN(p1); ATT_PIN(s2); ATT_PIN(s3); ATT_PIN(pwn[2 + (q >> 2)]); }
            ATT_SBAR();
        }
    }
    l += (s0 + s1) + (s2 + s3);
}
template <int NDB> __device__ __forceinline__ void pv_only(const ALAS unsigned char* vbuf, const u32x4 (&pwo)[4], f32x16 (&o)[NDB], int lane) {
    const int hi = lane >> 5;
    const ALAS unsigned char* vb = vbuf + (NDB == 4 ? 2 * KBUF : KBUF) + ((lane >> 4) & 1) * 32 + (lane & 3) * 8 + (4 * hi + ((lane & 15) >> 2)) * 64; asm volatile("" : "+v"(vb));
#pragma unroll
    for (int d = 0; d < NDB; ++d) {
        s16x4 lo[4], hh[4];
#pragma unroll
        for (int ks = 0; ks < 4; ++ks) { lo[ks] = vtr(vb + d * VDS + ks * 1024); hh[ks] = vtr(vb + d * VDS + ks * 1024 + 512); }
#pragma unroll
        for (int ks = 0; ks < 4; ++ks) o[d] = __builtin_amdgcn_mfma_f32_32x32x16_bf16(__builtin_bit_cast(bf16x8, pwo[ks]), ATT_VF(lo, hh, ks), o[d], 0, 0, 0);
        ATT_SBAR();
    }
}
template <int NDB> __device__ __forceinline__ void rescale_o(f32x16 (&o)[NDB], const ALAS float* wsf, int lane) {
    const int hi = lane >> 5;
#pragma unroll
    for (int r = 0; r < 16; ++r) { const float f = wsf[crow(r, hi)];
#pragma unroll
        for (int d = 0; d < NDB; ++d) o[d][r] *= f; }
}
__device__ __forceinline__ u32x4 gate8(u32x4 v, u32x4 z) {
    u32x4 o;
#pragma unroll
    for (int j = 0; j < 4; ++j) { const float a = bfl(v[j]) * silu_f(bfl(z[j])), b = bfh(v[j]) * silu_f(bfh(z[j])); o[j] = cvtpk(a, b); }
    return o;
}


template <int NDB> __device__ __forceinline__ void stage_gate_store(const f32x16 (&res)[NDB], ALAS bf16_t* stg, const bf16_t* __restrict__ zbase, bf16_t* __restrict__ mbase, int lane) {
    const int r32 = lane & 31, hi = lane >> 5;
    constexpr int CPR = NDB * 4;
    constexpr int RPP = 64 / CPR;
    u32x4 z[32 / RPP];
#pragma unroll
    for (int i = 0; i < 32 / RPP; ++i) { const int row = i * RPP + lane / CPR, ch = lane % CPR; z[i] = *(const u32x4*)(zbase + (size_t)row * NP + ch * 8); }
#pragma unroll
    for (int r = 0; r < 16; ++r) { const int orow = crow(r, hi);
#pragma unroll
        for (int d = 0; d < NDB; ++d) stg[orow * (NDB * 32) + d * 32 + r32] = f2bf(res[d][r]); }
#pragma unroll
    for (int i = 0; i < 32 / RPP; ++i) {
        const int row = i * RPP + lane / CPR, ch = lane % CPR;
        const u32x4 v = *(const ALAS u32x4*)(stg + row * (NDB * 32) + ch * 8);
        *(u32x4*)(mbase + (size_t)row * DM + ch * 8) = gate8(v, z[i]);
    }
}

template <int MODE> __device__ __forceinline__ void attn_unit(ALAS unsigned char* lds, const bf16_t* __restrict__ PROJ, const float* __restrict__ CUM, bf16_t* __restrict__ MIX,
        int b, int h, int qb, float lam, float li, const float* __restrict__ subg, float* park, const unsigned* __restrict__ kmx, const float* __restrict__ TOT,
        unsigned __attribute__((address_space(1)))* qhead, volatile ALAS unsigned* misc) {
    constexpr int NDB = MODE == 1 ? 4 : 2, STG = Geo<MODE>::STG;
    int tid_ = threadIdx.x; asm volatile("" : "+v"(tid_));
    const int tid = tid_, lane = tid & 63, r32 = lane & 31, hi = lane >> 5, wid = __builtin_amdgcn_readfirstlane(tid >> 6);
    const int c = MODE == 1 ? (wid >> 2) : 0, wr = MODE == 1 ? (wid & 3) : wid;
    const int q0 = qb * (MODE == 1 ? 128 : 256), qw0 = q0 + wr * 32;
    const size_t rowb = (size_t)b * SEQ;
    const int band0 = q0 >> 6, NT = band0 + (MODE == 1 ? 2 : 4), my_last = band0 + (wr >> 1);
    ALAS float* wsf = (ALAS float*)(lds + L_WSF) + wid * 64;
    const unsigned ldsb = (unsigned)(size_t)lds;
    const float slope2 = MODE == 1 ? LOG2E / (float)(1 << (2 * h + 2)) : 0.f;
    const int qcol = MODE == 0 ? C_FQ + h * 64 : C_DQ + h * 128 + c * 64;
    const int kcol = MODE == 0 ? C_FK + h * 64 : C_DK + h * 128;
    const int vcol = MODE == 0 ? C_FV + h * 64 : C_DV + h * 128;
    dma_k<MODE>(ldsb, PROJ, CUM, rowb + (size_t)(NT - 1) * 64, kcol, h, wid, lane);
    dma_v<MODE>(ldsb, PROJ, rowb + (size_t)(NT - 1) * 64, vcol, wid, lane);
    dma_v<MODE>(ldsb + 2 * STG, PROJ, rowb + (size_t)(NT - 1) * 64, vcol, wid, lane);
    dma_k<MODE>(ldsb + STG, PROJ, CUM, rowb + (size_t)(NT - 2) * 64, kcol, h, wid, lane);
    const int T = lane; const bool inband = T >= band0 && T < NT;
    bf16x8 qr[4];
    { const bf16_t* Qw = PROJ + (rowb + qw0 + r32) * NP + qcol + hi * 8;
#pragma unroll
      for (int d0 = 0; d0 < 4; ++d0) qr[d0] = *(const bf16x8*)(Qw + d0 * 16); }
    const float tv = (MODE == 0 && lane < 32) ? TOT[h * 320 + b * 32 + lane] : 0.f;
    const int kr = (MODE == 0 && T < band0) ? 64 * T + 63 : q0;
    const float c_w0 = MODE == 0 ? CUM[(size_t)h * MTP + rowb + qw0] : 0.f, c_q0 = MODE == 0 ? CUM[(size_t)h * MTP + rowb + q0] : 0.f, c_kr = MODE == 0 ? CUM[(size_t)h * MTP + rowb + kr] : 0.f;
    const float c_lraw = MODE == 0 ? CUM[(size_t)h * MTP + rowb + q0 + 255] : 0.f;
    float k2v[2], q2v[2];
#pragma unroll
    for (int cc = 0; cc < (MODE == 1 ? 2 : 1); ++cc) { const int sq = MODE == 0 ? h : 8 + h * 2 + cc, sk = MODE == 0 ? 4 + h : 16 + h * 2 + cc;
        k2v[cc] = __uint_as_float(kmx[((sk * 2 + 0) * 8 + b) * 64 + T]) + __uint_as_float(kmx[((sk * 2 + 1) * 8 + b) * 64 + T]);
        q2v[cc] = __uint_as_float(kmx[((sq * 2 + 0) * 8 + b) * 64 + T]) + __uint_as_float(kmx[((sq * 2 + 1) * 8 + b) * 64 + T]); }
    float Pv = 0.f;
    if (MODE == 0) { float inc = tv;
#pragma unroll
        for (int o_ = 1; o_ < 32; o_ <<= 1) { const float t_ = shl(inc, lane >= o_ ? lane - o_ : lane); if (lane >= o_) inc += t_; }
        Pv = inc - tv; }
#define ATT_OFF(blk) __int_as_float(__builtin_amdgcn_readlane(__float_as_int(Pv), (blk)))
    const ALAS bf16x8* qlds = (const ALAS bf16x8*)(lds + L_OST + wid * 4096) + lane;
    if (MODE == 1) {
#pragma unroll
        for (int d0 = 0; d0 < 4; ++d0) ((ALAS bf16x8*)qlds)[d0 * 64] = qr[d0];
    }
    float mhat = MODE == 0 ? -(c_w0 + ATT_OFF(qw0 >> 7)) * LOG2E : 0.f, l = 0.f;
    const float c_last = MODE == 0 ? (c_lraw + ATT_OFF((q0 + 255) >> 7)) - ATT_OFF(q0 >> 7) : 0.f;
    int T_min; bool nomax;
    { bool need = inband; float sbound = 0.f;
#pragma unroll
      for (int cc = 0; cc < (MODE == 1 ? 2 : 1); ++cc) {
          const float kn = sqrtf(k2v[cc]) * 1.01f;
          float qv = inband ? q2v[cc] : 0.f, kv = inband ? kn : 0.f;
#pragma unroll
          for (int m = 1; m < 64; m <<= 1) { qv = fmaxf(qv, shx(qv, m, lane)); kv = fmaxf(kv, shx(kv, m, lane)); }
          const float Qn = sqrtf(qv) * 1.01f, Lown = Qn * kv;
          float D;
          if (MODE == 0) D = ((c_q0 + ATT_OFF(q0 >> 7)) - (c_kr + shl(Pv, kr >> 7))) * LOG2E;
          else D = -slope2 * (float)(q0 - 64 * T - 63);
          need = need || (T < band0 && (Qn * kn + D + Lown > -40.f));
          const float bpos = MODE == 0 ? (c_q0 - c_last) * LOG2E : 31.f * slope2;
          if (T < NT) sbound = fmaxf(sbound, Qn * kn + bpos); }
      const unsigned long long mask = __ballot(need);
      T_min = __builtin_amdgcn_readfirstlane((int)__builtin_ctzll(mask));
      if ((NT - T_min) & 1) T_min -= 1;
      nomax = __all(sbound <= 60.f) != 0; }
    const int NTr = NT - T_min;
    f32x16 o[NDB];
#pragma unroll
    for (int d = 0; d < NDB; ++d)
#pragma unroll
        for (int r = 0; r < 16; ++r) o[d][r] = 0.f;
    u32x4 pwa[4], pwb[4]; f32x16 p0, p1; s16x4 vl[8], vh[8];
#pragma unroll
    for (int k = 0; k < 4; ++k) { pwa[k] = (u32x4){0u, 0u, 0u, 0u}; pwb[k] = (u32x4){0u, 0u, 0u, 0u}; }
    const int kbo = c * KBUF;
#define ATT_TROW(i) ((i) < NTr ? rowb + (size_t)(NT - 1 - (i)) * 64 : (size_t)MR)
#define ATT_STEP(i, PIN_, POUT_, WAITBAR_) do { \
        if ((i) + 2 <= NTr) dma_k<MODE>(ldsb + (unsigned)s_prev, PROJ, CUM, ATT_TROW((i) + 2), kcol, h, wid, lane); \
        if ((i) + 1 <= NTr) dma_v<MODE>(ldsb + (unsigned)s_next, PROJ, ATT_TROW((i) + 1), vcol, wid, lane); \
        const bool mt_ = ((i) == NTr); const int t_ = NT - 1 - (i); \
        if (mt_ || t_ <= my_last) { \
            bool resc_; const float koff_ = (MODE == 0 && !mt_) ? ATT_OFF(t_ >> 1) * LOG2E : 0.f;       \
            if (mt_) resc_ = qs_front<MODE, false, true>(lds + s_cur + kbo, lds + s_prev, vl, vh, qr, qlds, p0, p1, mhat, l, -16, qw0, slope2, koff_, nomax, wsf, lane); \
            else if (t_ == my_last) resc_ = qs_front<MODE, true, false>(lds + s_cur + kbo, lds + s_prev, vl, vh, qr, qlds, p0, p1, mhat, l, 64 * t_, qw0, slope2, koff_, nomax, wsf, lane); \
            else resc_ = qs_front<MODE, false, false>(lds + s_cur + kbo, lds + s_prev, vl, vh, qr, qlds, p0, p1, mhat, l, 64 * t_, qw0, slope2, koff_, nomax, wsf, lane); \
            pv_exp<NDB>(lds + s_prev, vl, vh, PIN_, o, p0, p1, POUT_, l, lane); \
            if (resc_) rescale_o<NDB>(o, wsf, lane); \
        } \
        WAITBAR_; \
        { const int tt = s_prev; s_prev = s_cur; s_cur = s_next; s_next = tt; } } while (0)
#define ATT_WB_FULL() do { if (MODE == 0) ATT_WAIT_BAR(2); else ATT_WAIT_BAR(4); } while (0)
#define ATT_WB_VONLY() do { if (MODE == 0) ATT_WAIT_BAR(1); else ATT_WAIT_BAR(2); } while (0)
    ATT_WAIT_BAR(0);
    int s_prev = 2 * STG, s_cur = 0, s_next = STG;
#pragma clang loop unroll(disable)
    for (int i = 0; i < NTr - 2; i += 2) { ATT_STEP(i, pwa, pwb, ATT_WB_FULL()); ATT_STEP(i + 1, pwb, pwa, ATT_WB_FULL()); }
    ATT_STEP(NTr - 2, pwa, pwb, ATT_WB_FULL());
    ATT_STEP(NTr - 1, pwb, pwa, ATT_WB_VONLY());
    ATT_STEP(NTr, pwa, pwb, ATT_WAIT_BAR(0));
    pv_only<NDB>(lds + s_prev, pwb, o, lane);
#undef ATT_WB_FULL
#undef ATT_WB_VONLY
#undef ATT_STEP
#undef ATT_TROW
    ATT_WAIT_BAR(0);
    { auto rr = __builtin_amdgcn_permlane32_swap(__float_as_uint(l), __float_as_uint(l), false, false); l = __uint_as_float(rr[0]) + __uint_as_float(rr[1]); }
    if (hi == 0) wsf[32 + r32] = l;
    float rli[16];
#pragma unroll
    for (int r = 0; r < 16; ++r) rli[r] = __builtin_amdgcn_rcpf(wsf[32 + crow(r, hi)]);
#pragma unroll
    for (int d = 0; d < NDB; ++d)
#pragma unroll
        for (int r = 0; r < 16; ++r) o[d][r] *= rli[r];
    if (MODE == 1) {
        ALAS float* pk = (ALAS float*)(lds + wr * 16384) + lane;
        if (c == 1) {
#pragma unroll
            for (int d = 0; d < NDB; ++d)
#pragma unroll
                for (int r = 0; r < 16; ++r) pk[(d * 16 + r) * 64] = o[d][r];
        }
        ATT_WAIT_BAR(0);
        if (c == 1) return;
#pragma unroll
        for (int d = 0; d < NDB; ++d)
#pragma unroll
            for (int r = 0; r < 16; ++r) o[d][r] -= lam * pk[(d * 16 + r) * 64];
        float ss[16];
#pragma unroll
        for (int r = 0; r < 16; ++r) { float sm = 0.f;
#pragma unroll
            for (int d = 0; d < NDB; ++d) sm += o[d][r] * o[d][r];
            ss[r] = sm; }
#pragma unroll
        for (int m = 1; m < 32; m <<= 1)
#pragma unroll
            for (int r = 0; r < 16; ++r) ss[r] += shx(ss[r], m, lane);
        float gc[NDB];
#pragma unroll
        for (int d = 0; d < NDB; ++d) gc[d] = subg[32 * d + r32] * li;
#pragma unroll
        for (int r = 0; r < 16; ++r) { const float rs = rsqrtf(ss[r] * (1.f / 128.f) + 1e-5f);
#pragma unroll
            for (int d = 0; d < NDB; ++d) o[d][r] *= rs * gc[d]; }
    }
    unsigned nxt_ = 0u;
    if (tid == 0) nxt_ = __hip_atomic_fetch_add(qhead, 1u, __ATOMIC_RELAXED, __HIP_MEMORY_SCOPE_AGENT);
    ALAS bf16_t* stg = (ALAS bf16_t*)(lds + L_OST + (MODE == 1 ? wr * 8192 : wid * 4096));
    const int zcol = MODE == 0 ? C_FZ + h * 64 : C_DZ + h * 128, mcol = MODE == 0 ? M_A + h * 64 : M_B + h * 128;
    stage_gate_store<NDB>(o, stg, PROJ + (rowb + qw0) * NP + zcol, MIX + (rowb + qw0) * DM + mcol, lane);
    if (tid == 0) misc[16] = nxt_;
#undef ATT_OFF
}

template <int WIN> __device__ __forceinline__ void pool_rows(const bf16_t* __restrict__ PROJ, bf16_t* __restrict__ MIX, const bf16x8 (&wb)[2][4], float ps0, float ps1, ALAS bf16_t* stg,
        int b, int tw, int Rw, int g, int lane) {
    const int r32 = lane & 31, hi = lane >> 5; const float invw = 1.f / (float)WIN;
    for (int blk = 0; blk < 2; ++blk) {
        const int t = tw + 32 * blk + r32;
        f32x16 acc[2];
#pragma unroll
        for (int r = 0; r < 16; ++r) { acc[0][r] = 0.f; acc[1][r] = 0.f; }
#pragma unroll
        for (int ks = 0; ks < 4; ++ks) {
            const int c0 = C_PU + g * 64 + 16 * ks + 8 * hi;
            u32x4 v[WIN];
#pragma unroll
            for (int i = 0; i < WIN; ++i) { const int ti = t - i; const size_t row = ti >= 0 ? (size_t)b * SEQ + ti : (size_t)(MR + 16 + ti); v[i] = *(const u32x4*)(PROJ + row * NP + c0); }
            float sm[8];
#pragma unroll
            for (int j = 0; j < 8; ++j) sm[j] = 0.f;
#pragma unroll
            for (int i = 0; i < WIN; ++i)
#pragma unroll
                for (int j = 0; j < 4; ++j) { sm[2 * j] += bfl(v[i][j]); sm[2 * j + 1] += bfh(v[i][j]); }
            u32x4 pa;
#pragma unroll
            for (int j = 0; j < 4; ++j) pa[j] = cvtpk(sm[2 * j] * invw - bfl(v[0][j]), sm[2 * j + 1] * invw - bfh(v[0][j]));
            const bf16x8 af = __builtin_bit_cast(bf16x8, pa);
            acc[0] = __builtin_amdgcn_mfma_f32_32x32x16_bf16(af, wb[0][ks], acc[0], 0, 0, 0);
            acc[1] = __builtin_amdgcn_mfma_f32_32x32x16_bf16(af, wb[1][ks], acc[1], 0, 0, 0);
        }
#pragma unroll
        for (int r = 0; r < 16; ++r) { acc[0][r] *= ps0; acc[1][r] *= ps1; }
        const size_t row0 = (size_t)Rw + 32 * blk;
        stage_gate_store<2>(acc, stg, PROJ + row0 * NP + C_PZ + g * 64, MIX + row0 * DM + M_C + g * 64, lane);
    }
}
__device__ __forceinline__ void pool_unit(ALAS unsigned char* lds, const bf16_t* __restrict__ PROJ, const bf16_t* __restrict__ WPT_l, const float* __restrict__ pscale_l, bf16_t* __restrict__ MIX, int unit,
        unsigned __attribute__((address_space(1)))* qhead, volatile ALAS unsigned* misc) {
    int tid_ = threadIdx.x; asm volatile("" : "+v"(tid_));
    const int tid = tid_, lane = tid & 63, r32 = lane & 31, hi = lane >> 5, wid = __builtin_amdgcn_readfirstlane(tid >> 6);
    const int g = wid & 3;
    const int Rw = unit * 128 + (wid >> 2) * 64, b = Rw >> 12, tw = Rw & 4095;
    ALAS bf16_t* stg = (ALAS bf16_t*)(lds + L_OST + wid * 4096);
    bf16x8 wb[2][4];
#pragma unroll
    for (int nb = 0; nb < 2; ++nb)
#pragma unroll
        for (int ks = 0; ks < 4; ++ks) wb[nb][ks] = *(const bf16x8*)(WPT_l + ((g * 64 + 32 * nb + r32) * 64 + 16 * ks + 8 * hi));
    const float ps0 = pscale_l[g * 64 + r32], ps1 = pscale_l[g * 64 + 32 + r32];
    unsigned nxt_ = 0u; if (tid == 0) nxt_ = __hip_atomic_fetch_add(qhead, 1u, __ATOMIC_RELAXED, __HIP_MEMORY_SCOPE_AGENT);
    if (g == 0) pool_rows<2>(PROJ, MIX, wb, ps0, ps1, stg, b, tw, Rw, g, lane);
    else if (g == 1) pool_rows<4>(PROJ, MIX, wb, ps0, ps1, stg, b, tw, Rw, g, lane);
    else if (g == 2) pool_rows<8>(PROJ, MIX, wb, ps0, ps1, stg, b, tw, Rw, g, lane);
    else pool_rows<16>(PROJ, MIX, wb, ps0, ps1, stg, b, tw, Rw, g, lane);
    if (tid == 0) misc[16] = nxt_;
}
#undef ALAS
}


#ifndef PG8_SP2
#define PG8_SP2 true
#endif
#ifndef PG8_ALIGN
#define PG8_ALIGN true
#endif
constexpr int NWAVES = 8;
constexpr int RING_OFF = 0, RING_BYTES = 143360;
constexpr int LDSCTL_OFF = RING_BYTES, MISC_OFF = LDSCTL_OFF + 320;
constexpr int LDS_BYTES = RING_BYTES + 1024;
constexpr int CW_TMO = 0, CW_CODE = 1, CW_BAR = 4096, CW_Q = 16384;
constexpr size_t CTL_ZERO_BYTES = 1 * MiB;
static_assert(att::L_END <= RING_BYTES, "attention LDS map");
#define GAS __attribute__((address_space(1)))
#define LAS __attribute__((address_space(3)))
typedef unsigned short bf16;
typedef unsigned v4u __attribute__((ext_vector_type(4)));
typedef float f32x4 __attribute__((ext_vector_type(4)));
typedef short bf16x8 __attribute__((ext_vector_type(8)));
typedef GAS unsigned gu32;
typedef GAS unsigned long long gu64;
#define RLX_AGENT __ATOMIC_RELAXED, __HIP_MEMORY_SCOPE_AGENT
#define LDS_WAIT() asm volatile("s_waitcnt lgkmcnt(0)" ::: "memory")
#define VM_WAIT() asm volatile("s_waitcnt vmcnt(0)" ::: "memory")
__device__ __forceinline__ unsigned long long rt() { return __builtin_amdgcn_s_memrealtime(); }

#define XB_TMO      128
#define XB_XCNT(j)  (256  + 64 * (j))
#define XB_XSUB(j)  (1280 + 64 * (j))
#define XB_XGEN(j)  (2304 + 64 * (j))
#define XB_TOP      3328
#define XB_TOPGEN   3392
#define XCD_BAR_WORDS 3456
#define XB_SPIN_CAP (1u << 18)

__device__ __forceinline__ unsigned xb_ld(unsigned* p)              { return __hip_atomic_load(p, __ATOMIC_RELAXED, __HIP_MEMORY_SCOPE_AGENT); }
__device__ __forceinline__ unsigned xb_add(unsigned* p, unsigned v) { return __hip_atomic_fetch_add(p, v, __ATOMIC_RELAXED, __HIP_MEMORY_SCOPE_AGENT); }
__device__ __forceinline__ unsigned xb_xcc_id() { return (unsigned)__builtin_amdgcn_s_getreg((3 << 11) | 20) & 0xFu; }
#define XB_SPIN(cond, bar) do { unsigned _sp = 0; while (cond) { __builtin_amdgcn_s_sleep(1); \
    if ((++_sp & 255u) == 0u) { if (xb_ld(&(bar)[XB_TMO])) break; if (_sp > XB_SPIN_CAP) { atomicAdd(&(bar)[XB_TMO], 1u); break; } } } } while (0)

struct XcdBarrier {
    unsigned* bar; unsigned x;
    volatile LAS unsigned* st;
};

__device__ __forceinline__ XcdBarrier xcd_barrier_post(unsigned* bar, volatile LAS unsigned* st) {
    XcdBarrier b; b.bar = bar; b.x = xb_xcc_id(); b.st = st;
    if (threadIdx.x == 0) (void)xb_add(&bar[XB_XCNT(b.x)], 1u);
    return b;
}
__device__ __forceinline__ void xcd_barrier_complete(unsigned* bar, unsigned x, unsigned& nloc, unsigned& nx) {
    const unsigned G = gridDim.x * gridDim.y * gridDim.z;
    unsigned sum, cnt, mine, sp = 0u;
    for (;;) {
        sum = 0u; cnt = 0u; mine = 0u;
#pragma unroll
        for (unsigned j = 0; j < 16; ++j) { const unsigned c = xb_ld(&bar[XB_XCNT(j)]); sum += c; cnt += (c > 0u) ? 1u : 0u; mine = (j == x) ? c : mine; }
        if (sum == G) break;
        __builtin_amdgcn_s_sleep(1);
        if ((++sp & 255u) == 0u) { if (xb_ld(&bar[XB_TMO])) break; if (sp > XB_SPIN_CAP) { atomicAdd(&bar[XB_TMO], 1u); break; } }
    }
    nloc = mine > 0u ? mine : 1u; nx = cnt > 0u ? cnt : 1u;
}

__device__ __forceinline__ void xcd_barrier(const XcdBarrier& b) {
    asm volatile("s_waitcnt vmcnt(0)" ::: "memory");
    __syncthreads();
    if (threadIdx.x == 0) {
        unsigned* bar = b.bar;
        __builtin_amdgcn_s_waitcnt(0);
        unsigned nloc = b.st[0], nx = b.st[1];
        if (nloc == 0u) { xcd_barrier_complete(bar, b.x, nloc, nx); b.st[0] = nloc; b.st[1] = nx; }
        const unsigned old = xb_add(&bar[XB_XSUB(b.x)], 1u);
        const unsigned gen = old / nloc;
        if (old + 1u == (gen + 1u) * nloc) {
            __builtin_amdgcn_fence(__ATOMIC_RELEASE, "agent");
            asm volatile("s_waitcnt vmcnt(0)" ::: "memory");
            const unsigned og = xb_add(&bar[XB_TOP], 1u);
            const unsigned tg = og / nx;
            if (og + 1u == (tg + 1u) * nx) xb_add(&bar[XB_TOPGEN], 1u);
            else XB_SPIN(xb_ld(&bar[XB_TOPGEN]) == tg, bar);
            __builtin_amdgcn_fence(__ATOMIC_ACQUIRE, "agent");
            xb_add(&bar[XB_XGEN(b.x)], 1u);
            asm volatile("s_waitcnt vmcnt(0)" ::: "memory");
        } else {
            XB_SPIN(xb_ld(&bar[XB_XGEN(b.x)]) == gen, bar);
            __builtin_amdgcn_fence(__ATOMIC_ACQUIRE, "agent");
            asm volatile("s_waitcnt vmcnt(0)" ::: "memory");
        }
    }
    __syncthreads();
}

__device__ __forceinline__ void transpose_item(const float* __restrict__ W, int ldw, int col0, const float* __restrict__ gk, bf16_t* WT, int K, LAS float* scr, int k0, int n0dst, int lane) {
    float v[32];
    const float* src = W + (size_t)(k0 + (lane >> 5)) * ldw + col0 + (lane & 31);
#pragma unroll
    for (int i = 0; i < 32; ++i) v[i] = src[(size_t)(2 * i) * ldw];
    const int c = lane & 7;
    float g[8];
#pragma unroll
    for (int j = 0; j < 8; ++j) g[j] = gk ? gk[k0 + 8 * c + j] : 1.f;
#pragma unroll
    for (int i = 0; i < 32; ++i) scr[(2 * i + (lane >> 5)) * 33 + (lane & 31)] = v[i];
    LDS_WAIT(); asm volatile("" ::: "memory");
#pragma unroll
    for (int j = 0; j < 4; ++j) { const int n = (lane >> 3) + 8 * j; const LAS float* s = scr + (8 * c) * 33 + n;
        v4u o; o.x = pk2(s[0 * 33] * g[0], s[1 * 33] * g[1]); o.y = pk2(s[2 * 33] * g[2], s[3 * 33] * g[3]); o.z = pk2(s[4 * 33] * g[4], s[5 * 33] * g[5]); o.w = pk2(s[6 * 33] * g[6], s[7 * 33] * g[7]);
        *(GAS v4u*)(WT + (size_t)(n0dst + n) * K + k0 + 8 * c) = o; }
    LDS_WAIT(); asm volatile("" ::: "memory");
}

constexpr int NPH = 14;
struct Args { const float* in[14]; float* out; unsigned char* ws; int ph_lo, ph_hi; };
__global__ void __launch_bounds__(NWAVES * 64, 2) mk_fwd(Args args) {
    extern __shared__ __attribute__((aligned(16))) unsigned char lds[];
    LAS unsigned char* ldsp = (LAS unsigned char*)lds;
    volatile LAS unsigned* MISC = (volatile LAS unsigned*)(ldsp + MISC_OFF);
    gu32* ctl = (gu32*)(args.ws + WS_CTL);
    for (int u = threadIdx.x; u < (LDS_BYTES - LDSCTL_OFF) / 4; u += NWAVES * 64) ((LAS unsigned*)(ldsp + LDSCTL_OFF))[u] = 0u;
    __syncthreads();
    XcdBarrier bar = xcd_barrier_post((unsigned*)(ctl + CW_BAR), MISC + 8);
    const int lo = args.ph_lo, hi = args.ph_hi;
    for (int ph_ = lo; ph_ < hi; ++ph_) {
        int ph = ph_, bid = (int)blockIdx.x, G = (int)gridDim.x;
        typedef const __attribute__((address_space(4))) Args* KArgs;
        KArgs ap = (KArgs)__builtin_amdgcn_kernarg_segment_ptr(); asm volatile("" : "+s"(ap));
        unsigned char* ws = ap->ws; unsigned* barw = bar.bar;
        asm volatile("" : "+s"(ph), "+s"(bid), "+s"(G), "+s"(ws), "+s"(barw));
        int tid_ = threadIdx.x; asm volatile("" : "+v"(tid_));
        const int tid = tid_, lane = tid & 63, wave = __builtin_amdgcn_readfirstlane(tid >> 6);
        const int gw = bid * NWAVES + wave, NGW = G * NWAVES;
        const int gt = bid * (NWAVES * 64) + tid, NT = G * NWAVES * 64;
        bf16_t* W1T = (bf16_t*)(ws + WS_W1T); bf16_t* W2T = (bf16_t*)(ws + WS_W2T);
        bf16_t* WFGB = (bf16_t*)(ws + WS_WFG); float* LAM = (float*)(ws + WS_LAM); float* TOT = (float*)(ws + WS_TOT);
        bf16_t* WPT = (bf16_t*)(ws + WS_WPT); unsigned* KMX = (unsigned*)(ws + WS_KMX);
        ssq_t* SS = (ssq_t*)(ws + WS_SS); float* CUM = (float*)(ws + WS_CUM);
        bf16_t* HB = (bf16_t*)(ws + WS_HB); bf16_t* MIX = (bf16_t*)(ws + WS_MIX); bf16_t* PROJ = (bf16_t*)(ws + WS_PROJ);
        if (ph == 0) {
            const float* norm_g = ap->in[2]; const float* w_in = ap->in[3]; const float* w_pool = ap->in[10]; const float* w_out = ap->in[12];
            LAS float* scr = (LAS float*)(ldsp + RING_OFF + wave * 16384);
            constexpr int NIT1 = DEPTH * 16 * 112, NIT2 = DEPTH * 16 * 32;
            for (int it = gw; it < NIT1 + NIT2; it += NGW) {
                if (it < NIT1) { const int l = it / 1792, r = it % 1792, kb = r / 112, nb = r % 112, n0 = 32 * nb, col0 = n0 < 1024 ? n0 : n0 + 4;
                    transpose_item(w_in + (size_t)l * 1024 * IN_DIM, IN_DIM, col0, norm_g + l * 1024, W1T + (size_t)l * NP * 1024, 1024, scr, 64 * kb, n0, lane); }
                else { const int r0 = it - NIT1, l = r0 / 512, r = r0 % 512, kb = r / 32, nb = r % 32;
                    transpose_item(w_out + (size_t)l * 1024 * 1024, 1024, 32 * nb, nullptr, W2T + (size_t)l * 1024 * 1024, 1024, scr, 64 * kb, 32 * nb, lane); }
            }
            for (int i = gt; i < DEPTH * 16 * 1024; i += NT) { const int k = i & 1023, c = (i >> 10) & 15, l = i >> 14;
                WFGB[i] = c < 4 ? f2bf(w_in[((size_t)l * 1024 + k) * IN_DIM + 1024 + c] * norm_g[l * 1024 + k]) : (bf16_t)0; }
            for (int i = gt; i < DEPTH * 4 * 64 * 64; i += NT) { const int c = i & 63, d = (i >> 6) & 63, lg = i >> 12; WPT[i] = f2bf(w_pool[((size_t)lg * 64 + c) * 64 + d]); }
            unsigned zz = 0u; float big = 1e30f; asm volatile("" : "+v"(zz), "+v"(big));
            for (int i = gt; i < 48 * NP / 8; i += NT) ((uint4*)(PROJ + (size_t)(MR + 16) * NP))[i] = make_uint4(zz, zz, zz, zz);
            for (int i = gt; i < 48 * 4; i += NT) CUM[(size_t)(i / 48) * MTP + MR + 16 + (i % 48)] = big;
            for (int i = gt; i < MTP; i += NT) SS[MTP + i] = (ssq_t)zz;
            for (int i = gt; i < KMX_WORDS; i += NT) KMX[i] = zz;
            if (gt < DEPTH) { const int l = gt; float s1 = 0.f, s2 = 0.f;
                for (int i = 0; i < 64; ++i) { s1 += ap->in[5][l * 64 + i] * ap->in[6][l * 64 + i]; s2 += ap->in[7][l * 64 + i] * ap->in[8][l * 64 + i]; }
                float c08 = 0.8f; asm volatile("" : "+v"(c08));
                const float li0 = c08 - 0.6f * fexp(-0.3f * (float)l);
                LAM[l] = fexp(s1) - fexp(s2) + li0; LAM[4 + l] = li0; }
            { int lane_p = threadIdx.x & 63; asm volatile("" : "+v"(lane_p));
              for (int row = gw; row < MT; row += NGW) entry_row(row, lane_p, ap->in[0], ap->in[1], HB, SS); }
        } else if (ph <= 12) {
            const int l = (ph - 1) / 3, sub = (ph - 1) % 3;
            ssq_t* ssl = SS + (size_t)(l & 1) * MTP;
            ssq_t* ssn = SS + (size_t)((l + 1) & 1) * MTP;
            if (sub == 0) {
                { unsigned zz = 0u; asm volatile("" : "+v"(zz)); for (int i = gt; i < MTP; i += NT) ssn[i] = (ssq_t)zz; }
                {   LAS float* lf = (LAS float*)(ldsp + RING_OFF);
                    const bf16_t* wfg = WFGB + (size_t)l * 16 * 1024; const float* bfl = ap->in[4] + l * 4;
                    for (int blk = bid; blk < 257; blk += G) {
                        const bool mb = blk == 256; const int r0 = mb ? MR : 128 * blk + 16 * wave;
                        if (!mb || wave == 0) {
                            const mf32x4 acc = meta_gemm16(HB + (size_t)r0 * DM, wfg, 0, lane);
                            const int fr = lane & 15, fq = lane >> 4;
                            if (fr < 4) {
#pragma unroll
                                for (int j = 0; j < 4; ++j) { const int row = r0 + 4 * fq + j; const float rstd = rsqrtf(ss_val(ssl[row]) * (1.f / 1024.f) + 1e-6f);
                                    lf[((mb ? 0 : 16 * wave) + 4 * fq + j) * 4 + fr] = log_sigmoid(acc[j] * rstd + bfl[fr]); } }
                        }
                        __syncthreads();
                        if (!mb) { if (wave < 4) { const int h = wave; const float a = lf[(2 * lane) * 4 + h], b2 = lf[(2 * lane + 1) * 4 + h]; const float sm = a + b2; float inc = sm;
#pragma unroll
                                for (int o = 1; o < 64; o <<= 1) { const float t = shl(inc, lane >= o ? lane - o : lane); if (lane >= o) inc += t; }
                                *(float2*)(CUM + (size_t)h * MTP + 128 * blk + 2 * lane) = make_float2(inc - b2, inc);
                                if (lane == 63) TOT[h * 320 + blk] = inc; } }
                        else { if (wave == 0 && lane < 4) { const int h = lane; float c = 0.f; for (int j = 15; j >= 0; --j) { CUM[(size_t)h * MTP + MR + j] = -c; c += lf[j * 4 + h]; } } }
                        __syncthreads();
                    }
                }
                for (int nb = bid; nb < NP / 16; nb += G) {
                    const mf32x4 acc = meta_gemm16_k8(HB + (size_t)MR * DM, W1T + (size_t)l * NP * 1024, nb, wave, lane, (LAS float*)(ldsp + RING_OFF));
                    if (wave == 0) { const int col = 16 * nb + (lane & 15), fq = lane >> 4; const float sc = (col < 256 || (col >= 1024 && col < 1536)) ? att::C2 : 1.f;
#pragma unroll
                        for (int j = 0; j < 4; ++j) PROJ[(size_t)(MR + 4 * fq + j) * NP + col] = f2bf(acc[j] * sc * rsqrtf(ss_val(ssl[MR + 4 * fq + j]) * (1.f / 1024.f) + 1e-6f)); } }
                pg8::Gemm g{HB, W1T + (size_t)l * NP * 1024, MR, NP, 1024}; pg8::StaticOrder S; S.init(MR, NP, G, bid);
                pg8::EpiProj E{PROJ, NP, att::C2, KMX, ssl};
#ifndef DIAG_NO_GEMM
                pg8::gemm_phase<pg8::EpiProj, pg8::StaticOrder, PG8_ALIGN, PG8_SP2>(ldsp + RING_OFF, g, S, E);
#endif
            } else if (sub == 1) {
                const float li_raw = __int_as_float(__builtin_amdgcn_readfirstlane(__float_as_int(LAM[4 + l])));
                const float li = li_raw;
                const float oml = __int_as_float(__builtin_amdgcn_readfirstlane(__float_as_int(1.f - li_raw)));
                const float lam = __int_as_float(__builtin_amdgcn_readfirstlane(__float_as_int(LAM[l])));
                const float* subg = ap->in[9] + l * 128;
                float* park = (float*)(ws + WS_RES) + (size_t)bid * 4 * 4096;
#ifndef DIAG_NO_META
                if (bid == G - 1) {
                    if (wave < 4) fox_meta(wave, lane, PROJ, CUM, MIX); else diff_meta(wave - 4, lane, PROJ, subg, lam, li, MIX);
                    for (int tk = wave; tk < 64; tk += NWAVES) pool_meta(tk >> 2, tk & 3, lane, PROJ, ap->in[10] + (size_t)l * 4 * 64 * 64, ap->in[11] + l * 256, MIX);
                }
#endif
                gu32* qcnt = (gu32*)(ws + WS_CTL) + CW_Q + l * 8 * 64;
                int x = (int)(bar.x & 7u);
                if (tid == 0) MISC[16] = __hip_atomic_fetch_add(qcnt + x * 64, 1u, __ATOMIC_RELAXED, __HIP_MEMORY_SCOPE_AGENT);
                for (;;) {
                    __syncthreads();
                    int u = (int)MISC[16];
                    __syncthreads();
                    if (u >= 224) {
                        if (tid == 0) { int pick = -1;
#pragma unroll
                            for (int j = 1; j < 8; ++j) { const int xx = (x + j) & 7; if (pick < 0 && __hip_atomic_load(qcnt + xx * 64, __ATOMIC_RELAXED, __HIP_MEMORY_SCOPE_AGENT) < 224u) pick = xx; }
                            MISC[17] = (unsigned)pick;
                            if (pick >= 0) MISC[16] = __hip_atomic_fetch_add(qcnt + pick * 64, 1u, __ATOMIC_RELAXED, __HIP_MEMORY_SCOPE_AGENT); }
                        __syncthreads();
                        const int pick = (int)MISC[17];
                        if (pick < 0) break;
                        x = pick; continue;
                    }
                    gu32* qh = qcnt + x * 64;
                    if (u < 128) {
#ifndef DIAG_NO_DIFF
                        const int qb_ = 31 - (u >> 2), h_ = 3 - (u & 3), b_ = (x - h_) & 7;
                        att::attn_unit<1>(ldsp + RING_OFF, PROJ, CUM, MIX, b_, h_, qb_, lam, oml, subg, park, KMX, TOT, qh, MISC);
#endif
                    } else if (u < 192) {
#ifndef DIAG_NO_FOX
                        const int v = u - 128, qb_ = 15 - (v >> 2), h_ = 3 - (v & 3), b_ = (x - h_) & 7;
                        att::attn_unit<0>(ldsp + RING_OFF, PROJ, CUM, MIX, b_, h_, qb_, lam, oml, subg, park, KMX, TOT, qh, MISC);
#endif
                    } else {
#ifndef DIAG_NO_POOL
                        att::pool_unit(ldsp + RING_OFF, PROJ, WPT + (size_t)l * 4 * 64 * 64, ap->in[11] + l * 256, MIX, x * 32 + (u - 192), qh, MISC);
#endif
                    }
                }
            } else {
                { unsigned zz = 0u; asm volatile("" : "+v"(zz)); for (int i = gt; i < KMX_WORDS; i += NT) KMX[i] = zz; }
                for (int nb = bid; nb < 64; nb += G) {
                    const mf32x4 acc = meta_gemm16_k8(MIX + (size_t)MR * DM, W2T + (size_t)l * 1024 * 1024, nb, wave, lane, (LAS float*)(ldsp + RING_OFF));
                    if (wave == 0) { const int col = 16 * nb + (lane & 15), fq = lane >> 4;
#pragma unroll
                        for (int j = 0; j < 4; ++j) { bf16_t* hp = HB + (size_t)(MR + 4 * fq + j) * DM + col; const bf16_t nv = f2bf(bf2f(*hp) + acc[j]); *hp = nv;
                            float q = bf2f(nv); q *= q; q += shx(q, 1, lane); q += shx(q, 2, lane); q += shx(q, 4, lane); q += shx(q, 8, lane);
                            if ((lane & 15) == 0) atomicAdd(ssn + MR + 4 * fq + j, ss_fix(q)); } } }
                pg8::Gemm g{MIX, W2T + (size_t)l * 1024 * 1024, MR, 1024, 1024}; pg8::StaticOrder S; S.init(MR, 1024, G, bid);
                pg8::EpiResidB E{HB, 1024, ssn};
#ifndef DIAG_NO_GEMM
                pg8::gemm_phase<pg8::EpiResidB, pg8::StaticOrder, PG8_ALIGN, PG8_SP2>(ldsp + RING_OFF, g, S, E);
#endif
            }
        } else {
            for (int row = gw; row < MR; row += NGW) final_row(row, lane, HB, SS + (size_t)(DEPTH & 1) * MTP, ap->out, ap->in[13]);
        }
        if (ph_ + 1 < hi) { XcdBarrier b2 = bar; b2.bar = barw; xcd_barrier(b2); }
    }
}

#ifndef MK_PER_PHASE
#define MK_PER_PHASE 0
#endif
extern "C" void kernel_launch(void* const* d_in, const int* in_sizes, int n_in, void* d_out, int out_size, void* d_ws, size_t ws_size, hipStream_t stream) {
    static int g_grid = 0;
    if (g_grid == 0) {
        int dev = 0, cus = 0, per_cu = 0;
        hipGetDevice(&dev); hipDeviceGetAttribute(&cus, hipDeviceAttributeMultiprocessorCount, dev);
        hipFuncSetAttribute((const void*)mk_fwd, hipFuncAttributeMaxDynamicSharedMemorySize, LDS_BYTES);
        hipOccupancyMaxActiveBlocksPerMultiprocessor(&per_cu, (const void*)mk_fwd, NWAVES * 64, LDS_BYTES);
        (void)hipGetLastError();
        g_grid = cus > 0 ? cus : 256;
    }
    hipMemsetAsync((unsigned char*)d_ws + WS_CTL, 0, CTL_ZERO_BYTES, stream);
    Args a{};
    for (int i = 0; i < 14; ++i) a.in[i] = (const float*)d_in[i];
    a.out = (float*)d_out; a.ws = (unsigned char*)d_ws;
#if MK_PER_PHASE
    for (int p = 0; p < NPH; ++p) { a.ph_lo = p; a.ph_hi = p + 1; hipLaunchKernelGGL(mk_fwd, dim3(g_grid), dim3(NWAVES * 64), LDS_BYTES, stream, a); }
#else
    a.ph_lo = 0; a.ph_hi = NPH;
    hipLaunchKernelGGL(mk_fwd, dim3(g_grid), dim3(NWAVES * 64), LDS_BYTES, stream, a);
#endif
}
```

```cpp
#include <hip/hip_runtime.h>
#include <stdint.h>

typedef unsigned short bf16_t;
__device__ __forceinline__ float bf2f(bf16_t v) { return __uint_as_float(((unsigned)v) << 16); }
__device__ __forceinline__ bf16_t f2bf(float f) { unsigned u = __float_as_uint(f); return (bf16_t)((u + 0x7fffu + ((u >> 16) & 1u)) >> 16); }

constexpr int BATCH = 8, SEQ = 4096, DM = 1024, DEPTH = 4, NMETA = 16;
constexpr int MR = BATCH * SEQ;
constexpr int MT = MR + NMETA;
constexpr int IN_DIM = 3588, NP = 3584;
constexpr int C_FQ = 0, C_FK = 256, C_FV = 512, C_FZ = 768, C_DQ = 1024, C_DK = 1536, C_DV = 2048, C_DZ = 2560, C_PU = 3072, C_PZ = 3328;
constexpr int M_A = 0, M_B = 256, M_C = 768;
constexpr float LN2F = 0.6931471805599453f;
__device__ __forceinline__ unsigned pk2(float lo, float hi) { return (unsigned)f2bf(lo) | ((unsigned)f2bf(hi) << 16); }

constexpr size_t MiB = 1u << 20;
constexpr size_t WS_CTL = 0;
constexpr size_t WS_W1T = 2 * MiB;
constexpr size_t WS_W2T = 30 * MiB;
constexpr size_t WS_WFG = 38 * MiB;
constexpr size_t WS_LAM = 38 * MiB + 196608;
constexpr size_t WS_TOT = 38 * MiB + 131072;
constexpr size_t WS_WPT = 38 * MiB + 262144;
constexpr size_t WS_KMX = 38 * MiB + 524288;
constexpr int KMX_WORDS = 24 * 2 * 8 * 64;
constexpr int MTP = MR + 64;
constexpr size_t WS_SS = 39 * MiB;
typedef unsigned long long ssq_t;
__device__ __forceinline__ ssq_t ss_fix(float q) { return (ssq_t)(q * 16777216.f); }
__device__ __forceinline__ float ss_val(ssq_t v) { return (float)v * (1.f / 16777216.f); }
constexpr size_t WS_CUM = 40 * MiB;
constexpr size_t WS_HB = 42 * MiB;
constexpr size_t WS_MIX = 108 * MiB;
constexpr size_t WS_PROJ = 174 * MiB;
constexpr size_t WS_RES = 400 * MiB;
constexpr size_t WS_END = 464 * MiB;

__device__ __forceinline__ float shx(float v, int m, int lane) { return __int_as_float(__builtin_amdgcn_ds_bpermute((lane ^ m) << 2, __float_as_int(v))); }
__device__ __forceinline__ float shl(float v, int src) { return __int_as_float(__builtin_amdgcn_ds_bpermute(src << 2, __float_as_int(v))); }
__device__ __forceinline__ float wave_sum(float v, int lane) {
#pragma unroll
    for (int o = 1; o < 64; o <<= 1) v += shx(v, o, lane);
    return v;
}
__device__ __forceinline__ float fexp(float x) { return __builtin_amdgcn_exp2f(x * 1.4426950408889634f); }
__device__ __forceinline__ float log_sigmoid(float x) { return fminf(x, 0.f) - __builtin_amdgcn_logf(1.f + fexp(-fabsf(x))) * 0.6931471805599453f; }
__device__ __forceinline__ float silu(float x) { return x / (1.f + fexp(-x)); }

__device__ __forceinline__ void entry_row(int row, int lane, const float* __restrict__ xreal, const float* __restrict__ xmeta, bf16_t* HB, ssq_t* SS0) {
    const float* hp = row < MR ? xreal + (size_t)row * DM : xmeta + (size_t)(row - MR) * DM;
    float ss = 0.f;
#pragma unroll
    for (int j = 0; j < 4; ++j) { const float4 v = *(const float4*)(hp + j * 256 + lane * 4);
        const unsigned w0 = pk2(v.x, v.y), w1 = pk2(v.z, v.w);
        const float a0 = __uint_as_float(w0 << 16), a1 = __uint_as_float(w0 & 0xffff0000u), a2 = __uint_as_float(w1 << 16), a3 = __uint_as_float(w1 & 0xffff0000u);
        ss += (a0 * a0 + a1 * a1) + (a2 * a2 + a3 * a3);
        *(uint2*)(HB + (size_t)row * DM + j * 256 + lane * 4) = make_uint2(w0, w1); }
    ss = wave_sum(ss, lane);
    if (lane == 0) SS0[row] = ss_fix(ss);
}
__device__ __forceinline__ void final_row(int row, int lane, const bf16_t* __restrict__ HB, const ssq_t* __restrict__ SSf, float* OUT, const float* __restrict__ final_g) {
    const float rstd = rsqrtf(ss_val(SSf[row]) * (1.f / DM) + 1e-6f);
#pragma unroll
    for (int j = 0; j < 4; ++j) {
        const uint2 w = *(const uint2*)(HB + (size_t)row * DM + j * 256 + lane * 4);
        const float4 g = *(const float4*)(final_g + j * 256 + lane * 4);
        float4 o; o.x = __uint_as_float(w.x << 16) * rstd * g.x; o.y = __uint_as_float(w.x & 0xffff0000u) * rstd * g.y; o.z = __uint_as_float(w.y << 16) * rstd * g.z; o.w = __uint_as_float(w.y & 0xffff0000u) * rstd * g.w;
        *(float4*)(OUT + (size_t)row * DM + j * 256 + lane * 4) = o;
    }
}
__device__ __forceinline__ void entry_rows4(int row, int lane, const float* __restrict__ xreal, const float* __restrict__ xmeta, bf16_t* HB, ssq_t* SS0) {
    float4 v[4][4];
#pragma unroll
    for (int r = 0; r < 4; ++r) { const int rr = row + r < MT ? row + r : MT - 1; const float* hp = rr < MR ? xreal + (size_t)rr * DM : xmeta + (size_t)(rr - MR) * DM;
#pragma unroll
        for (int j = 0; j < 4; ++j) v[r][j] = *(const float4*)(hp + j * 256 + lane * 4); }
#pragma unroll
    for (int r = 0; r < 4; ++r) { const int rr = row + r; if (rr >= MT) break; float ss = 0.f;
#pragma unroll
        for (int j = 0; j < 4; ++j) { const unsigned w0 = pk2(v[r][j].x, v[r][j].y), w1 = pk2(v[r][j].z, v[r][j].w);
            const float a0 = __uint_as_float(w0 << 16), a1 = __uint_as_float(w0 & 0xffff0000u), a2 = __uint_as_float(w1 << 16), a3 = __uint_as_float(w1 & 0xffff0000u);
            ss += (a0 * a0 + a1 * a1) + (a2 * a2 + a3 * a3);
            *(uint2*)(HB + (size_t)rr * DM + j * 256 + lane * 4) = make_uint2(w0, w1); }
        ss = wave_sum(ss, lane);
        if (lane == 0) SS0[rr] = ss_fix(ss); }
}
__device__ __forceinline__ void final_rows4(int row, int lane, const bf16_t* __restrict__ HB, const ssq_t* __restrict__ SSf, float* OUT, const float* __restrict__ final_g) {
    uint2 w[4][4]; float rstd[4];
#pragma unroll
    for (int r = 0; r < 4; ++r) { rstd[r] = rsqrtf(ss_val(SSf[row + r]) * (1.f / DM) + 1e-6f);
#pragma unroll
        for (int j = 0; j < 4; ++j) w[r][j] = *(const uint2*)(HB + (size_t)(row + r) * DM + j * 256 + lane * 4); }
#pragma unroll
    for (int j = 0; j < 4; ++j) { const float4 g = *(const float4*)(final_g + j * 256 + lane * 4);
#pragma unroll
        for (int r = 0; r < 4; ++r) { float4 o; o.x = __uint_as_float(w[r][j].x << 16) * rstd[r] * g.x; o.y = __uint_as_float(w[r][j].x & 0xffff0000u) * rstd[r] * g.y;
            o.z = __uint_as_float(w[r][j].y << 16) * rstd[r] * g.z; o.w = __uint_as_float(w[r][j].y & 0xffff0000u) * rstd[r] * g.w;
            *(float4*)(OUT + (size_t)(row + r) * DM + j * 256 + lane * 4) = o; } }
}
typedef short mbf16x8 __attribute__((ext_vector_type(8)));
typedef float mf32x4 __attribute__((ext_vector_type(4)));
__device__ __forceinline__ mf32x4 meta_gemm16(const bf16_t* __restrict__ A16, const bf16_t* __restrict__ Bt, int nb, int lane) {
    const int fr = lane & 15, fq = lane >> 4; mf32x4 acc = {0.f, 0.f, 0.f, 0.f};
    const bf16_t* ap = A16 + fr * 1024 + fq * 8; const bf16_t* bp = Bt + (size_t)(16 * nb + fr) * 1024 + fq * 8;
#pragma unroll 16
    for (int kk = 0; kk < 32; ++kk) { const mbf16x8 a = *(const mbf16x8*)(ap + kk * 32), b = *(const mbf16x8*)(bp + kk * 32); acc = __builtin_amdgcn_mfma_f32_16x16x32_bf16(a, b, acc, 0, 0, 0); }
    return acc;
}
__device__ __forceinline__ void ld16(const bf16_t* p, float (&x)[16]) {
    const uint4 a = *(const uint4*)p, b = *(const uint4*)(p + 8);
    const unsigned w[8] = {a.x, a.y, a.z, a.w, b.x, b.y, b.z, b.w};
#pragma unroll
    for (int j = 0; j < 8; ++j) { x[2 * j] = __uint_as_float(w[j] << 16); x[2 * j + 1] = __uint_as_float(w[j] & 0xffff0000u); }
}
__device__ __forceinline__ mf32x4 meta_gemm16_k8(const bf16_t* __restrict__ A16, const bf16_t* __restrict__ Bt, int nb, int wave, int lane, __attribute__((address_space(3))) float* red) {
    const int fr = lane & 15, fq = lane >> 4; mf32x4 acc = {0.f, 0.f, 0.f, 0.f};
    const bf16_t* ap = A16 + fr * 1024 + fq * 8 + wave * 128; const bf16_t* bp = Bt + (size_t)(16 * nb + fr) * 1024 + fq * 8 + wave * 128;
    mbf16x8 a[4], b[4];
#pragma unroll
    for (int kk = 0; kk < 4; ++kk) { a[kk] = *(const mbf16x8*)(ap + kk * 32); b[kk] = *(const mbf16x8*)(bp + kk * 32); }
#pragma unroll
    for (int kk = 0; kk < 4; ++kk) acc = __builtin_amdgcn_mfma_f32_16x16x32_bf16(a[kk], b[kk], acc, 0, 0, 0);
    *(__attribute__((address_space(3))) mf32x4*)(red + (wave * 64 + lane) * 4) = acc;
    __syncthreads();
    mf32x4 sum = {0.f, 0.f, 0.f, 0.f};
#pragma unroll
    for (int w = 0; w < 8; ++w) sum += *(const __attribute__((address_space(3))) mf32x4*)(red + (w * 64 + lane) * 4);
    __syncthreads();
    return sum;
}
__device__ __forceinline__ void fox_meta(int h, int lane, const bf16_t* __restrict__ PROJ, const float* __restrict__ CUM, bf16_t* MIX) {
    const int t = lane >> 2, dq = lane & 3, row = MR + t;
    float ln2 = LN2F, m = -1e30f; asm volatile("" : "+v"(ln2), "+v"(m));
    float q[16], o[16], x[16];
    ld16(PROJ + (size_t)row * NP + C_FQ + h * 64 + dq * 16, q);
#pragma unroll
    for (int d = 0; d < 16; ++d) { q[d] *= ln2; o[d] = 0.f; }
    const float cq = CUM[(size_t)h * MTP + row];
    float lsum = 0.f;
    for (int kk = 0; kk < 16; ++kk) {
        const int krow = MR + kk;
        ld16(PROJ + (size_t)krow * NP + C_FK + h * 64 + dq * 16, x);
        float sc = 0.f;
#pragma unroll
        for (int d = 0; d < 16; ++d) sc += q[d] * x[d];
        sc += shx(sc, 1, lane); sc += shx(sc, 2, lane);
        sc += cq - CUM[(size_t)h * MTP + krow];
        ld16(PROJ + (size_t)krow * NP + C_FV + h * 64 + dq * 16, x);
        if (kk <= t) {
            if (sc > m) { const float a = fexp(m - sc); lsum *= a;
#pragma unroll
                for (int d = 0; d < 16; ++d) o[d] *= a;
                m = sc; }
            const float p = fexp(sc - m); lsum += p;
#pragma unroll
            for (int d = 0; d < 16; ++d) o[d] += p * x[d];
        }
    }
    const float inv = 1.f / lsum;
    ld16(PROJ + (size_t)row * NP + C_FZ + h * 64 + dq * 16, x);
    bf16_t* mp = MIX + (size_t)row * DM + M_A + h * 64 + dq * 16;
#pragma unroll
    for (int d = 0; d < 16; d += 2) *(unsigned*)(mp + d) = pk2(o[d] * inv * silu(x[d]), o[d + 1] * inv * silu(x[d + 1]));
}
__device__ __forceinline__ void diff_meta(int h, int lane, const bf16_t* __restrict__ PROJ, const float* __restrict__ subln_g_l, float lam, float li, bf16_t* MIX) {
    const int ri = lane >> 2, qq = lane & 3, row = MR + ri;
    const float posq = (float)ri, slope = 1.f / (float)(1 << (2 * h + 2));
    float res[32], x[16], y[16];
    for (int c = 0; c < 2; ++c) {
        float ln2 = LN2F, m = -1e30f; asm volatile("" : "+v"(ln2), "+v"(m));
        float q[16], o[32];
        ld16(PROJ + (size_t)row * NP + C_DQ + h * 128 + c * 64 + qq * 16, q);
#pragma unroll
        for (int d = 0; d < 16; ++d) q[d] *= ln2;
#pragma unroll
        for (int d = 0; d < 32; ++d) o[d] = 0.f;
        float lsum = 0.f;
        for (int kk = 0; kk < 16; ++kk) {
            const int krow = MR + kk;
            ld16(PROJ + (size_t)krow * NP + C_DK + h * 128 + c * 64 + qq * 16, x);
            float sc = 0.f;
#pragma unroll
            for (int d = 0; d < 16; ++d) sc += q[d] * x[d];
            sc += shx(sc, 1, lane); sc += shx(sc, 2, lane);
            sc -= slope * fabsf(posq - (float)kk);
            ld16(PROJ + (size_t)krow * NP + C_DV + h * 128 + qq * 32, x);
            ld16(PROJ + (size_t)krow * NP + C_DV + h * 128 + qq * 32 + 16, y);
            if (sc > m) { const float a = fexp(m - sc); lsum *= a;
#pragma unroll
                for (int d = 0; d < 32; ++d) o[d] *= a;
                m = sc; }
            const float p = fexp(sc - m); lsum += p;
#pragma unroll
            for (int d = 0; d < 16; ++d) { o[d] += p * x[d]; o[16 + d] += p * y[d]; }
        }
        const float inv = 1.f / lsum;
        if (c == 0) {
#pragma unroll
            for (int d = 0; d < 32; ++d) res[d] = o[d] * inv;
        } else {
#pragma unroll
            for (int d = 0; d < 32; ++d) res[d] -= lam * o[d] * inv;
        }
    }
    float ss = 0.f;
#pragma unroll
    for (int d = 0; d < 32; ++d) ss += res[d] * res[d];
    ss += shx(ss, 1, lane); ss += shx(ss, 2, lane);
    const float rstd = rsqrtf(ss * (1.f / 128.f) + 1e-5f) * (1.f - li);
    ld16(PROJ + (size_t)row * NP + C_DZ + h * 128 + qq * 32, x);
    ld16(PROJ + (size_t)row * NP + C_DZ + h * 128 + qq * 32 + 16, y);
    bf16_t* mp = MIX + (size_t)row * DM + M_B + h * 128 + qq * 32;
    const float* gp = subln_g_l + qq * 32;
#pragma unroll
    for (int d = 0; d < 16; d += 2) {
        *(unsigned*)(mp + d) = pk2(res[d] * rstd * gp[d] * silu(x[d]), res[d + 1] * rstd * gp[d + 1] * silu(x[d + 1]));
        *(unsigned*)(mp + 16 + d) = pk2(res[16 + d] * rstd * gp[16 + d] * silu(y[d]), res[17 + d] * rstd * gp[17 + d] * silu(y[d + 1])); }
}
__device__ __forceinline__ void pool_meta(int j, int g, int lane, const bf16_t* __restrict__ PROJ, const float* __restrict__ wpool_l, const float* __restrict__ pscale_l, bf16_t* MIX) {
    const int w = 2 << g, cnt = (j + 1) < w ? (j + 1) : w, row = MR + j;
    float s = 0.f;
    for (int i = 0; i < cnt; ++i) s += bf2f(PROJ[(size_t)(MR + j - i) * NP + C_PU + g * 64 + lane]);
    const float pooled = s / (float)cnt - bf2f(PROJ[(size_t)row * NP + C_PU + g * 64 + lane]);
    float y = 0.f;
    for (int i = 0; i < 64; ++i) y += shl(pooled, i) * wpool_l[(g * 64 + i) * 64 + lane];
    const float z = bf2f(PROJ[(size_t)row * NP + C_PZ + g * 64 + lane]);
    MIX[(size_t)row * DM + M_C + g * 64 + lane] = f2bf(y * pscale_l[g * 64 + lane] * silu(z));
}

template <class T> __device__ __forceinline__ T* as_global(T* p) { __attribute__((address_space(1))) T* g = (__attribute__((address_space(1))) T*)p; asm volatile("" : "+s"(g)); return (T*)g; }
namespace pg8 {
#define PG8_LAS __attribute__((address_space(3)))
typedef unsigned short bf16_t;
typedef short bf16x8 __attribute__((ext_vector_type(8)));
typedef float f32x4 __attribute__((ext_vector_type(4)));
typedef unsigned u32x4 __attribute__((ext_vector_type(4)));
constexpr int BM = 256, BK = 64, HALF = 128, HTB = HALF * BK * 2  , STAGE_BYTES = 8 * HTB, NXCD = 8, WGM = 8;

__host__ __device__ __forceinline__ int lds_byte(int r, int c) { const int st = (r >> 4) * 2 + (c >> 5), rr = r & 15, cc = c & 31, ob = rr * 64 + cc * 2; return st * 1024 + (ob ^ (((ob >> 9) & 1) << 5)); }
__host__ __device__ __forceinline__ void stage_rc(int b, int& R, int& C) { const int st = b / 1024, sb = b % 1024, swz = sb ^ (((sb >> 9) & 1) << 5); R = (st >> 1) * 16 + swz / 64; C = (st & 1) * 32 + (swz % 64) / 2; }
__host__ __device__ __forceinline__ int perm32(int rho) { const int n = rho >> 4, i = rho & 15; return 8 * (i >> 2) + 4 * n + (i & 3); }

struct Unit { int pm, pn; };
struct Gemm { const bf16_t* A; const bf16_t* Bt; int M, N, K; };

struct StaticOrder {
    int nM, nN, nwg, G, c;
    __host__ __device__ void init(int M, int N, int G_, int c_) { nM = M / BM; nN = N / BM; nwg = nM * nN; G = G_; c = c_; }
    __host__ __device__ bool next(int i, Unit& u) const {
        const long L = (long)i * G + c; if (L >= nwg) return false;
        int wgid = (int)L; { const int q = nwg / NXCD, r = nwg % NXCD, xcd = wgid % NXCD, off = wgid / NXCD; wgid = (xcd < r ? xcd * (q + 1) : r * (q + 1) + (xcd - r) * q) + off; }
        const int nig = WGM * nN, gid = wgid / nig, fm = gid * WGM, gsz = (nM - fm) < WGM ? (nM - fm) : WGM;
        u.pm = fm + ((wgid % nig) % gsz); u.pn = (wgid % nig) / gsz; return true;
    }
    __device__ __forceinline__ void a_ready(const Unit&) const {}
    __device__ __forceinline__ void done(const Unit&) const {}
};

__device__ __forceinline__ unsigned cvt_pk_bf16(float lo, float hi) { unsigned r; asm volatile("v_cvt_pk_bf16_f32 %0, %1, %2" : "=v"(r) : "v"(lo), "v"(hi)); return r; }
struct EpiProj {
    static constexpr bool PERM = true, AFTER_DRAIN = false;
    bf16_t* O; int ldc; float qscale; unsigned* kmx; const ssq_t* ss;
    template <bool NRM> __device__ __forceinline__ void body(const f32x4 (&acc)[2][2][4][2], const Unit& u, int wr, int wc, int fr, int fq, bf16_t* Og, const float (&rs)[2][4], unsigned* kmxg) const {
        const int row0 = u.pm * BM + wr * 64 + fr, col0 = u.pn * BM + wc * 32 + 8 * fq;
        float part[2][2][4];
#pragma unroll
        for (int ai = 0; ai < 2; ++ai)
#pragma unroll
            for (int m = 0; m < 4; ++m) { bf16_t* rowp = Og + (size_t)(row0 + ai * HALF + m * 16) * ldc + col0; const float r = rs[ai][m];
#pragma unroll
                for (int bj = 0; bj < 2; ++bj) { const f32x4 v0 = acc[ai][bj][m][0] * r, v1 = acc[ai][bj][m][1] * r;
                    if (NRM) part[ai][bj][m] = (v0[0] * v0[0] + v0[1] * v0[1]) + (v0[2] * v0[2] + v0[3] * v0[3]) + (v1[0] * v1[0] + v1[1] * v1[1]) + (v1[2] * v1[2] + v1[3] * v1[3]);
                    u32x4 w; w.x = cvt_pk_bf16(v0[0], v0[1]); w.y = cvt_pk_bf16(v0[2], v0[3]); w.z = cvt_pk_bf16(v1[0], v1[1]); w.w = cvt_pk_bf16(v1[2], v1[3]);
                    *(u32x4*)(rowp + bj * HALF) = w; } }
        if (NRM) {
            const int lane = fr + 16 * fq;
#pragma unroll
            for (int ai = 0; ai < 2; ++ai)
#pragma unroll
                for (int bj = 0; bj < 2; ++bj) {
                    float mx = 0.f;
#pragma unroll
                    for (int m = 0; m < 4; ++m) { float p = part[ai][bj][m]; p += shx(p, 16, lane); p += shx(p, 32, lane); mx = fmaxf(mx, p); }
                    mx = fmaxf(mx, shx(mx, 1, lane)); mx = fmaxf(mx, shx(mx, 2, lane)); mx = fmaxf(mx, shx(mx, 4, lane)); mx = fmaxf(mx, shx(mx, 8, lane));
                    if (lane == 0) { const int R = u.pm * BM + ai * HALF + wr * 64, col = u.pn * BM + bj * HALF + wc * 32;
                        const int st = col < 512 ? (col >> 6) : 8 + ((col - 1024) >> 6), half = (col >> 5) & 1;
                        atomicMax(kmxg + ((st * 2 + half) * 8 + (R >> 12)) * 64 + ((R & 4095) >> 6), __float_as_uint(mx)); }
                }
        }
    }
    __device__ __forceinline__ void operator()(const f32x4 (&acc)[2][2][4][2], const Unit& u, int wr, int wc, int fr, int fq) const {
        bf16_t* const Og = as_global(O); const ssq_t* const ssg = as_global(ss); unsigned* const kmxg = as_global(kmx);
        const int row0 = u.pm * BM + wr * 64 + fr;
        const float sc = (u.pn == 0 || u.pn == 4 || u.pn == 5) ? qscale : 1.f;
        ssq_t sv[2][4]; float rs[2][4];
#pragma unroll
        for (int ai = 0; ai < 2; ++ai)
#pragma unroll
            for (int m = 0; m < 4; ++m) sv[ai][m] = ssg[row0 + ai * HALF + m * 16];
#pragma unroll
        for (int ai = 0; ai < 2; ++ai)
#pragma unroll
            for (int m = 0; m < 4; ++m) rs[ai][m] = sc * rsqrtf(ss_val(sv[ai][m]) * (1.f / 1024.f) + 1e-6f);
        if ((u.pn <= 1) || (u.pn >= 4 && u.pn <= 7)) body<true>(acc, u, wr, wc, fr, fq, Og, rs, kmxg); else body<false>(acc, u, wr, wc, fr, fq, Og, rs, kmxg);
    }
};
struct EpiResidB {
    static constexpr bool PERM = true, AFTER_DRAIN = false;
    bf16_t* H; int ldc; ssq_t* ssn;
    __device__ __forceinline__ void operator()(const f32x4 (&acc)[2][2][4][2], const Unit& u, int wr, int wc, int fr, int fq) const {
        const int row0 = u.pm * BM + wr * 64 + fr, col0 = u.pn * BM + wc * 32 + 8 * fq, lane = fr + 16 * fq;
        bf16_t* const Hg = as_global(H); ssq_t* const ssg = as_global(ssn);
        u32x4 bv[2][4][2];
#pragma unroll
        for (int ai = 0; ai < 2; ++ai)
#pragma unroll
            for (int m = 0; m < 4; ++m)
#pragma unroll
                for (int bj = 0; bj < 2; ++bj) bv[ai][m][bj] = *(const u32x4*)(Hg + (size_t)(row0 + ai * HALF + m * 16) * ldc + col0 + bj * HALF);
#pragma unroll
        for (int ai = 0; ai < 2; ++ai)
#pragma unroll
            for (int m = 0; m < 4; ++m) { const int row = row0 + ai * HALF + m * 16; bf16_t* rowp = Hg + (size_t)row * ldc + col0; float q = 0.f;
#pragma unroll
                for (int bj = 0; bj < 2; ++bj) { const u32x4 b = bv[ai][m][bj]; const f32x4 a0 = acc[ai][bj][m][0], a1 = acc[ai][bj][m][1];
                    u32x4 w;
                    w.x = cvt_pk_bf16(__uint_as_float(b.x << 16) + a0[0], __uint_as_float(b.x & 0xffff0000u) + a0[1]);
                    w.y = cvt_pk_bf16(__uint_as_float(b.y << 16) + a0[2], __uint_as_float(b.y & 0xffff0000u) + a0[3]);
                    w.z = cvt_pk_bf16(__uint_as_float(b.z << 16) + a1[0], __uint_as_float(b.z & 0xffff0000u) + a1[1]);
                    w.w = cvt_pk_bf16(__uint_as_float(b.w << 16) + a1[2], __uint_as_float(b.w & 0xffff0000u) + a1[3]);
                    *(u32x4*)(rowp + bj * HALF) = w;
#pragma unroll
                    for (int k = 0; k < 4; ++k) { const float lo = __uint_as_float(w[k] << 16), hi = __uint_as_float(w[k] & 0xffff0000u); q += lo * lo + hi * hi; } }
                q += shx(q, 16, lane); q += shx(q, 32, lane);
                if (fq == 0) atomicAdd(ssg + row, ss_fix(q)); }
    }
};
template <class Epi, class Sched, bool ALIGN_EPI = false, bool SP2 = false>
__device__ __forceinline__ void gemm_phase(PG8_LAS unsigned char* lds, const Gemm g, const Sched& S, const Epi& E) {
    int tid_ = threadIdx.x; asm volatile("" : "+v"(tid_));
    const int tid = tid_, wid = __builtin_amdgcn_readfirstlane(tid >> 6), lane = tid & 63, wr = wid >> 2, wc = wid & 3, fr = lane & 15, fq = lane >> 4;
    const int K = g.K, nt = K / BK;
    unsigned voffA[2], voffB[2];
#pragma unroll
    for (int i = 0; i < 2; ++i) { int R, C; stage_rc(tid * 16 + i * 8192, R, C); const int Rb = Epi::PERM ? ((R & ~31) + perm32(R & 31)) : R;
        voffA[i] = (unsigned)(R * K + C) * 2u; voffB[i] = (unsigned)(Rb * K + C) * 2u; }
    const size_t kstep = (size_t)(BK * 2);
    const size_t hstep = (size_t)HALF * K * 2;
    const size_t tstep = 2 * hstep;
    const unsigned ldsw = (unsigned)wid * 1024u;
    const int aoff = lds_byte(wr * 64 + fr, fq * 8), boff = lds_byte(wc * 32 + fr, fq * 8);
#define PG8_SA(b, h) (((b) * 2 + (h)) * HTB)
#define PG8_SB(b, h) ((4 + (b) * 2 + (h)) * HTB)
#define PG8_STAGE(bufoff, gbase, voff) do { _Pragma("unroll") for (int _i = 0; _i < 2; ++_i) \
        __builtin_amdgcn_global_load_lds((const unsigned*)((const char*)(gbase) + (voff)[_i]), (PG8_LAS unsigned*)(lds + (bufoff) + ldsw + _i * 8192), 16, 0, 0); } while (0)
#define PG8_LDA(dst, b, h) do { _Pragma("unroll") for (int m = 0; m < 4; ++m) _Pragma("unroll") for (int k = 0; k < 2; ++k) dst[m][k] = *(const PG8_LAS bf16x8*)(lds + PG8_SA(b, h) + aoff + m * 2048 + k * 1024); } while (0)
#define PG8_LDB(dst, b, h) do { _Pragma("unroll") for (int n = 0; n < 2; ++n) _Pragma("unroll") for (int k = 0; k < 2; ++k) dst[n][k] = *(const PG8_LAS bf16x8*)(lds + PG8_SB(b, h) + boff + n * 2048 + k * 1024); } while (0)
#define PG8_MMA(ai, bj, At, Bt) do { __builtin_amdgcn_s_setprio(1); _Pragma("unroll") for (int m = 0; m < 4; ++m) _Pragma("unroll") for (int n = 0; n < 2; ++n) _Pragma("unroll") for (int k = 0; k < 2; ++k) \
        acc[ai][bj][m][n] = __builtin_amdgcn_mfma_f32_16x16x32_bf16(Bt[n][k], At[m][k], acc[ai][bj][m][n], 0, 0, 0); __builtin_amdgcn_s_setprio(0); } while (0)
#define PG8_WAIT_V(n) asm volatile("s_waitcnt vmcnt(" #n ")" ::: "memory")
#define PG8_WAIT_L(n) asm volatile("s_waitcnt lgkmcnt(" #n ")" ::: "memory")
#define PG8_BAR __builtin_amdgcn_s_barrier()
#define PG8_SCHED __builtin_amdgcn_sched_barrier(0)
    Unit cur, nxt; int ui = 0;
    if (!S.next(0, cur)) return;
    f32x4 acc[2][2][4][2];
#pragma unroll
    for (int a = 0; a < 2; ++a)
#pragma unroll
        for (int b = 0; b < 2; ++b)
#pragma unroll
            for (int m = 0; m < 4; ++m)
#pragma unroll
                for (int n = 0; n < 2; ++n) acc[a][b][m][n] = (f32x4){0.f, 0.f, 0.f, 0.f};
    bf16x8 At[4][2], B0[2][2], B1[2][2];
    const char* cA = (const char*)g.A + (size_t)cur.pm * tstep; const char* cB = (const char*)g.Bt + (size_t)cur.pn * tstep;
    S.a_ready(cur);
    if constexpr (SP2) {
        PG8_STAGE(PG8_SB(0, 0), cB, voffB); PG8_STAGE(PG8_SB(0, 1), cB + hstep, voffB); PG8_STAGE(PG8_SA(0, 0), cA, voffA); PG8_STAGE(PG8_SA(0, 1), cA + hstep, voffA);
        if (wr == 1) PG8_BAR;
        PG8_WAIT_V(2); PG8_BAR;
        PG8_STAGE(PG8_SB(1, 0), cB + kstep, voffB); PG8_STAGE(PG8_SA(1, 0), cA + kstep, voffA); PG8_STAGE(PG8_SB(1, 1), cB + hstep + kstep, voffB);
        PG8_WAIT_V(6); PG8_BAR;
    } else {
        PG8_STAGE(PG8_SB(0, 0), cB, voffB); PG8_STAGE(PG8_SA(0, 0), cA, voffA); PG8_STAGE(PG8_SB(0, 1), cB + hstep, voffB); PG8_STAGE(PG8_SA(0, 1), cA + hstep, voffA);
        if (wr == 1) PG8_BAR;
        PG8_WAIT_V(4); PG8_BAR;
        PG8_STAGE(PG8_SB(1, 0), cB + kstep, voffB); PG8_STAGE(PG8_SA(1, 0), cA + kstep, voffA); PG8_STAGE(PG8_SB(1, 1), cB + hstep + kstep, voffB);
        PG8_WAIT_V(6); PG8_BAR;
    }
    for (;;) {
        const bool has_next = S.next(ui + 1, nxt);
        const char* nA = has_next ? (const char*)g.A + (size_t)nxt.pm * tstep : cA; const char* nB = has_next ? (const char*)g.Bt + (size_t)nxt.pn * tstep : cB;
        for (int t = 0; t < nt; t += 2) {
            const bool last = (t == nt - 2);
            const char* a1 = cA + (size_t)(t + 1) * kstep;
            const char* a2 = last ? nA : cA + (size_t)(t + 2) * kstep; const char* b2 = last ? nB : cB + (size_t)(t + 2) * kstep;
            const char* a3 = a2 + kstep; const char* b3 = b2 + kstep;
            if (last && has_next) S.a_ready(nxt);
            if constexpr (SP2) {
            PG8_LDB(B0, 0, 0); PG8_LDB(B1, 0, 1); PG8_SCHED; PG8_LDA(At, 0, 0); PG8_STAGE(PG8_SA(1, 1), a1 + hstep, voffA);
            PG8_WAIT_V(8); PG8_WAIT_L(0); PG8_BAR; PG8_MMA(0, 0, At, B0); PG8_MMA(0, 1, At, B1); PG8_BAR; PG8_SCHED;
            PG8_LDA(At, 0, 1); PG8_STAGE(PG8_SB(0, 0), b2, voffB); PG8_STAGE(PG8_SB(0, 1), b2 + hstep, voffB); PG8_STAGE(PG8_SA(0, 0), a2, voffA);
            PG8_WAIT_V(8); PG8_WAIT_L(0); PG8_BAR; PG8_MMA(1, 0, At, B0); PG8_MMA(1, 1, At, B1); PG8_BAR; PG8_SCHED;
            PG8_LDB(B0, 1, 0); PG8_LDB(B1, 1, 1); PG8_SCHED; PG8_LDA(At, 1, 0); PG8_STAGE(PG8_SA(0, 1), a2 + hstep, voffA);
            PG8_WAIT_V(8); PG8_WAIT_L(0); PG8_BAR; PG8_MMA(0, 0, At, B0); PG8_MMA(0, 1, At, B1); PG8_BAR; PG8_SCHED;
            PG8_LDA(At, 1, 1); PG8_STAGE(PG8_SB(1, 0), b3, voffB); PG8_STAGE(PG8_SB(1, 1), b3 + hstep, voffB); PG8_STAGE(PG8_SA(1, 0), a3, voffA);
            PG8_WAIT_V(8); PG8_WAIT_L(0); PG8_BAR; PG8_MMA(1, 0, At, B0); PG8_MMA(1, 1, At, B1); PG8_BAR; PG8_SCHED;
            } else {
            PG8_LDB(B0, 0, 0); PG8_SCHED; PG8_LDA(At, 0, 0); PG8_STAGE(PG8_SA(1, 1), a1 + hstep, voffA);
            PG8_WAIT_L(8); PG8_BAR; PG8_WAIT_L(0); PG8_MMA(0, 0, At, B0); PG8_BAR; PG8_SCHED;
            PG8_LDB(B1, 0, 1); PG8_STAGE(PG8_SB(0, 0), b2, voffB);
            PG8_BAR; PG8_WAIT_L(0); PG8_MMA(0, 1, At, B1); PG8_BAR;
            PG8_LDA(At, 0, 1); PG8_STAGE(PG8_SA(0, 0), a2, voffA);
            PG8_BAR; PG8_WAIT_L(0); PG8_MMA(1, 0, At, B0); PG8_BAR; PG8_SCHED;
            PG8_STAGE(PG8_SB(0, 1), b2 + hstep, voffB);
            PG8_WAIT_V(6); PG8_BAR; PG8_MMA(1, 1, At, B1); PG8_BAR;
            PG8_LDB(B0, 1, 0); PG8_SCHED; PG8_LDA(At, 1, 0); PG8_STAGE(PG8_SA(0, 1), a2 + hstep, voffA);
            PG8_WAIT_L(8); PG8_BAR; PG8_WAIT_L(0); PG8_MMA(0, 0, At, B0); PG8_BAR; PG8_SCHED;
            PG8_LDB(B1, 1, 1); PG8_STAGE(PG8_SB(1, 0), b3, voffB);
            PG8_BAR; PG8_WAIT_L(0); PG8_MMA(0, 1, At, B1); PG8_BAR;
            PG8_LDA(At, 1, 1); PG8_STAGE(PG8_SA(1, 0), a3, voffA);
            PG8_BAR; PG8_WAIT_L(0); PG8_MMA(1, 0, At, B0); PG8_BAR; PG8_SCHED;
            PG8_STAGE(PG8_SB(1, 1), b3 + hstep, voffB);
            PG8_WAIT_V(6); PG8_BAR; PG8_MMA(1, 1, At, B1); PG8_BAR;
            }
        }
        if constexpr (ALIGN_EPI) { if (wr == 0) PG8_BAR; }
        if constexpr (!Epi::AFTER_DRAIN) { E(acc, cur, wr, wc, fr, fq); S.done(cur); }
        if (!has_next) break;
#pragma unroll
        for (int a = 0; a < 2; ++a)
#pragma unroll
            for (int b = 0; b < 2; ++b)
#pragma unroll
                for (int m = 0; m < 4; ++m)
#pragma unroll
                    for (int n = 0; n < 2; ++n) acc[a][b][m][n] = (f32x4){0.f, 0.f, 0.f, 0.f};
        cur = nxt; cA = nA; cB = nB; ++ui;
        if constexpr (ALIGN_EPI) { if (wr == 1) PG8_BAR; }
    }
    PG8_WAIT_V(0);
    if constexpr (!ALIGN_EPI) { if (wr == 0) PG8_BAR; }
    PG8_BAR;
    if constexpr (Epi::AFTER_DRAIN) { E.fused(acc, cur, wr, wc, fr, fq, lds, wid, lane); S.done(cur); }
#undef PG8_SA
#undef PG8_SB
#undef PG8_STAGE
#undef PG8_LDA
#undef PG8_LDB
#undef PG8_MMA
#undef PG8_WAIT_V
#undef PG8_WAIT_L
#undef PG8_BAR
#undef PG8_SCHED
}
}
namespace att {
typedef float f32x16 __attribute__((ext_vector_type(16)));
typedef float f32x4 __attribute__((ext_vector_type(4)));
typedef short bf16x8 __attribute__((ext_vector_type(8)));
typedef short s16x4 __attribute__((ext_vector_type(4)));
typedef unsigned u32x4 __attribute__((ext_vector_type(4)));
#define ALAS __attribute__((address_space(3)))
constexpr int KCS = 1040, VDS = 4160, KBUF = 8 * KCS, VBUF = 4 * VDS, NSLOT = 3;
constexpr int KBOFF = KBUF + VBUF, STG0 = KBOFF + 256, STG1 = 2 * KBUF + VBUF;
template <int MODE> struct Geo { static constexpr int STG = MODE == 0 ? STG0 : STG1, VOFF = MODE == 0 ? KBUF : 2 * KBUF; };
constexpr int L_WSF = NSLOT * STG1, L_OST = L_WSF + 8 * 256, L_END = L_OST + 8 * 4096;
constexpr float LOG2E = 1.4426950408889634f, C2 = 0.125f * LOG2E, THR = 8.f, NEGBIG = -1e30f;
__device__ __forceinline__ int crow(int r, int hi) { return (r & 3) + 8 * (r >> 2) + 4 * hi; }
__device__ __forceinline__ unsigned cvtpk(float lo, float hi) { typedef float f2 __attribute__((ext_vector_type(2))); typedef __bf16 b2 __attribute__((ext_vector_type(2))); f2 v = {lo, hi}; b2 b = __builtin_convertvector(v, b2); return __builtin_bit_cast(unsigned, b); }
__device__ __forceinline__ s16x4 vtr(const ALAS unsigned char* p) { typedef short v4i16_t __attribute__((ext_vector_type(4))); return __builtin_bit_cast(s16x4, __builtin_amdgcn_ds_read_tr16_b64_v4i16((ALAS v4i16_t*)p)); }
__device__ __forceinline__ float bfl(unsigned w) { return __uint_as_float(w << 16); }
__device__ __forceinline__ float bfh(unsigned w) { return __uint_as_float(w & 0xffff0000u); }
__device__ __forceinline__ float silu_f(float x) { return x * __builtin_amdgcn_rcpf(1.f + fexp(-x)); }
__device__ __forceinline__ void glds16(const void* gsrc, unsigned lds_dst) { unsigned keep;
    asm volatile("s_mov_b32 %0, m0\n\ts_mov_b32 m0, %2\n\ts_nop 0\n\tglobal_load_lds_dwordx4 %1, off\n\ts_mov_b32 m0, %0" : "=&s"(keep) : "v"(gsrc), "s"(lds_dst) : "memory"); }
__device__ __forceinline__ void glds4(const void* gsrc, unsigned lds_dst) { unsigned keep;
    asm volatile("s_mov_b32 %0, m0\n\ts_mov_b32 m0, %2\n\ts_nop 0\n\tglobal_load_lds_dword %1, off\n\ts_mov_b32 m0, %0" : "=&s"(keep) : "v"(gsrc), "s"(lds_dst) : "memory"); }
#define ATT_SBAR0() __builtin_amdgcn_sched_barrier(0)
#define ATT_WAIT_BAR(N) asm volatile("s_waitcnt vmcnt(" #N ") lgkmcnt(0)\n\ts_barrier" ::: "memory")

template <int MODE> __device__ __forceinline__ void dma_k(unsigned slot, const bf16_t* __restrict__ PROJ, const float* __restrict__ CUM, size_t krow0, int kcol, int h, int wid, int lane) {
    if (MODE == 0 && wid == 0) glds4(CUM + (size_t)h * MTP + krow0 + lane, (unsigned)__builtin_amdgcn_readfirstlane(slot + KBOFF));
    glds16(PROJ + (krow0 + lane) * NP + kcol + wid * 8, (unsigned)__builtin_amdgcn_readfirstlane(slot + wid * KCS));
    if (MODE == 1) glds16(PROJ + (krow0 + lane) * NP + kcol + 64 + wid * 8, (unsigned)__builtin_amdgcn_readfirstlane(slot + KBUF + wid * KCS));
}
template <int MODE> __device__ __forceinline__ void dma_v(unsigned slot, const bf16_t* __restrict__ PROJ, size_t krow0, int vcol, int wid, int lane) {
    const bf16_t* vs = PROJ + (krow0 + (wid & 3) * 16 + (lane >> 2)) * NP + vcol + (wid >> 2) * 32 + (lane & 3) * 8;
    glds16(vs, (unsigned)__builtin_amdgcn_readfirstlane(slot + Geo<MODE>::VOFF + (wid >> 2) * VDS + (wid & 3) * 1024));
    if (MODE == 1) glds16(vs + 64, (unsigned)__builtin_amdgcn_readfirstlane(slot + Geo<MODE>::VOFF + (2 + (wid >> 2)) * VDS + (wid & 3) * 1024));
}

template <int MODE, bool DIAG, bool META> __device__ __forceinline__ bool qs_front(const ALAS unsigned char* buf, const ALAS unsigned char* vprev, s16x4 (&vl)[8], s16x4 (&vh)[8], const bf16x8 (&qr)[4], const ALAS bf16x8* qlds, f32x16& p0, f32x16& p1, float& mhat, float& l,
        int kidx0, int qw0, float slope2, float koffL, bool nomax, ALAS float* wsf, int lane) {
    constexpr bool diag = DIAG, meta = META;
    const int r32 = lane & 31, hi = lane >> 5;
    {
      const ALAS unsigned char* vb = vprev + Geo<MODE>::VOFF + ((lane >> 4) & 1) * 32 + (lane & 3) * 8 + (4 * hi + ((lane & 15) >> 2)) * 64; asm volatile("" : "+v"(vb));
#pragma unroll
      for (int i = 0; i < (MODE == 0 ? 8 : 4); ++i) { vl[i] = vtr(vb + (i & 1) * VDS + (i >> 1) * 1024); vh[i] = vtr(vb + (i & 1) * VDS + (i >> 1) * 1024 + 512); } }
    asm volatile("" : "+v"(slope2), "+s"(kidx0));
    if (MODE == 0) {
        const ALAS f32x4* kbp = (const ALAS f32x4*)(buf + KBOFF + hi * 16); asm volatile("" : "+v"(kbp));
#pragma unroll
        for (int g = 0; g < 4; ++g) { const f32x4 a = kbp[2 * g], b = kbp[8 + 2 * g];
#pragma unroll
            for (int j = 0; j < 4; ++j) { p0[4 * g + j] = fmaf(a[j], -LOG2E, -mhat - koffL); p1[4 * g + j] = fmaf(b[j], -LOG2E, -mhat - koffL); } }
    } else {
        if (!diag) {
            const float base = slope2 * (float)(kidx0 + 4 * hi - qw0) - mhat;
#pragma unroll
            for (int r = 0; r < 16; ++r) { const int c = (r & 3) + 8 * (r >> 2); p0[r] = fmaf((float)c, slope2, base); p1[r] = fmaf((float)(c + 32), slope2, base); }
            if (meta) {
#pragma unroll
                for (int r = 0; r < 16; ++r) { if ((r >> 2) >= 2) p0[r] = NEGBIG; p1[r] = NEGBIG; }
            }
        } else {
            const float dq = (float)(qw0 + r32 - kidx0 - 4 * hi), fr = (float)r32;
#pragma unroll
            for (int r = 0; r < 16; ++r) { const int c = (r & 3) + 8 * (r >> 2);
                p0[r] = slope2 * (fr - fabsf(dq - (float)c)) - mhat; p1[r] = slope2 * (fr - fabsf(dq - (float)(c + 32))) - mhat; }
        }
    }
    bf16x8 qfr[4];
#pragma unroll
    for (int d0 = 0; d0 < 4; ++d0) qfr[d0] = MODE == 0 ? qr[d0] : qlds[d0 * 64];
    if (MODE == 1) ATT_SBAR0();
    __builtin_amdgcn_s_setprio(1);
    { const ALAS unsigned char* kb = buf + hi * KCS + r32 * 16; asm volatile("" : "+v"(kb));
#pragma unroll
      for (int d0 = 0; d0 < 4; ++d0) {
          const bf16x8 k0 = *(const ALAS bf16x8*)(kb + d0 * 2 * KCS), k1 = *(const ALAS bf16x8*)(kb + d0 * 2 * KCS + 512);
          const bf16x8 qf = qfr[d0];
          p0 = __builtin_amdgcn_mfma_f32_32x32x16_bf16(k0, qf, p0, 0, 0, 0);
          p1 = __builtin_amdgcn_mfma_f32_32x32x16_bf16(k1, qf, p1, 0, 0, 0); } }
    if (MODE == 0 && diag) {
        const int lim = qw0 + r32 - kidx0 - 4 * hi;
#pragma unroll
        for (int r = 0; r < 16; ++r) { const int c = (r & 3) + 8 * (r >> 2); if (c > lim) p0[r] = NEGBIG; if (c + 32 > lim) p1[r] = NEGBIG; }
    }
    bool resc = false;
    if (META || !nomax) {
        float rm;
        {
#define ATT_MX3(a, b, c) __builtin_fmaxf(__builtin_fmaxf((a), (b)), (c))
          float a = ATT_MX3(p0[0], p0[1], p1[0]), b = ATT_MX3(p0[2], p0[3], p1[1]); a = ATT_MX3(a, p1[2], p1[3]);
#pragma unroll
          for (int r = 4; r < 16; r += 4) { a = ATT_MX3(a, p0[r], p0[r + 1]); b = ATT_MX3(b, p0[r + 2], p0[r + 3]); a = ATT_MX3(a, p1[r], p1[r + 1]); b = ATT_MX3(b, p1[r + 2], p1[r + 3]); }
#undef ATT_MX3
          a = __builtin_fmaxf(a, b);
          auto rr = __builtin_amdgcn_permlane32_swap(__float_as_uint(a), __float_as_uint(a), false, false);
          rm = __builtin_fmaxf(__uint_as_float(rr[0]), __uint_as_float(rr[1])); }
        if (__any(rm > THR)) {
            const float dl = fmaxf(rm, 0.f); mhat += dl;
#pragma unroll
            for (int r = 0; r < 16; ++r) { p0[r] -= dl; p1[r] -= dl; }
            const float f = __builtin_amdgcn_exp2f(-dl); l *= f; if (hi == 0) wsf[r32] = f; resc = true;
        }
    }
    return resc;
}
#define ATT_SBAR() __builtin_amdgcn_sched_barrier(0)
#define ATT_PIN(x) asm volatile("" : "+v"(x))
#define ATT_VF(L, H, i) (bf16x8){L[i][0], L[i][1], L[i][2], L[i][3], H[i][0], H[i][1], H[i][2], H[i][3]}
template <int NDB> __device__ __forceinline__ void pv_exp(const ALAS unsigned char* vbuf, s16x4 (&vl)[8], s16x4 (&vh)[8], const u32x4 (&pwo)[4], f32x16 (&o)[NDB], f32x16& p0, f32x16& p1, u32x4 (&pwn)[4], float& l, int lane) {
    const int hi = lane >> 5;
    float s0 = 0.f, s1 = 0.f, s2 = 0.f, s3 = 0.f;
    ATT_SBAR();
    if (NDB == 2) {
#pragma unroll
        for (int k = 0; k < 8; ++k) {
            o[k & 1] = __builtin_amdgcn_mfma_f32_32x32x16_bf16(__builtin_bit_cast(bf16x8, pwo[k >> 1]), ATT_VF(vl, vh, k), o[k & 1], 0, 0, 0);
            p0[2 * k] = __builtin_amdgcn_exp2f(p0[2 * k]); p0[2 * k + 1] = __builtin_amdgcn_exp2f(p0[2 * k + 1]); p1[2 * k] = __builtin_amdgcn_exp2f(p1[2 * k]); p1[2 * k + 1] = __builtin_amdgcn_exp2f(p1[2 * k + 1]);
            s0 += p0[2 * k]; s1 += p0[2 * k + 1]; s2 += p1[2 * k]; s3 += p1[2 * k + 1];
            pwn[k >> 2][k & 3] = cvtpk(p0[2 * k], p0[2 * k + 1]); pwn[2 + (k >> 2)][k & 3] = cvtpk(p1[2 * k], p1[2 * k + 1]);
            ATT_PIN(p0); ATT_PIN(p1); ATT_PIN(s0); ATT_PIN(s1); ATT_PIN(s2); ATT_PIN(s3); ATT_PIN(pwn[k >> 2]); ATT_PIN(pwn[2 + (k >> 2)]);
            ATT_SBAR();
        }
    } else {
        const ALAS unsigned char* vb = vbuf + 2 * KBUF + ((lane >> 4) & 1) * 32 + (lane & 3) * 8 + (4 * hi + ((lane & 15) >> 2)) * 64; asm volatile("" : "+v"(vb));
        s16x4 (&wl)[8] = vl; s16x4 (&wh)[8] = vh;
#pragma unroll
        for (int k = 0; k < 16; ++k) {
            const int blk = 2 * (k >> 3) + (k & 1), ks = (k >> 1) & 3;
            o[blk] = __builtin_amdgcn_mfma_f32_32x32x16_bf16(__builtin_bit_cast(bf16x8, pwo[ks]), ATT_VF(wl, wh, k & 3), o[blk], 0, 0, 0);
            if (k + 4 < 16) { const int j = k + 4, jb = 2 * (j >> 3) + (j & 1), jk = (j >> 1) & 3; wl[k & 3] = vtr(vb + jb * VDS + jk * 1024); wh[k & 3] = vtr(vb + jb * VDS + jk * 1024 + 512); }
            if (k < 8) { p0[2 * k] = __builtin_amdgcn_exp2f(p0[2 * k]); p0[2 * k + 1] = __builtin_amdgcn_exp2f(p0[2 * k + 1]); s0 += p0[2 * k]; s1 += p0[2 * k + 1];
                pwn[k >> 2][k & 3] = cvtpk(p0[2 * k], p0[2 * k + 1]); ATT_PIN(p0); ATT_PIN(s0); ATT_PIN(s1); ATT_PIN(pwn[k >> 2]); }
            else { const int q = k - 8; p1[2 * q] = __builtin_amdgcn_exp2f(p1[2 * q]); p1[2 * q + 1] = __builtin_amdgcn_exp2f(p1[2 * q + 1]); s2 += p1[2 * q]; s3 += p1[2 * q + 1];
                pwn[2 + (q >> 2)][q & 3] = cvtpk(p1[2 * q], p1[2 * q + 1]); ATT_PIN(p1); ATT_PIN(s2); ATT_PIN(s3); ATT_PIN(pwn[2 + (q >> 2)]); }
            ATT_SBAR();
        }
    }
    l += (s0 + s1) + (s2 + s3);
}
template <int NDB> __device__ __forceinline__ void pv_only(const ALAS unsigned char* vbuf, const u32x4 (&pwo)[4], f32x16 (&o)[NDB], int lane) {
    const int hi = lane >> 5;
    const ALAS unsigned char* vb = vbuf + (NDB == 4 ? 2 * KBUF : KBUF) + ((lane >> 4) & 1) * 32 + (lane & 3) * 8 + (4 * hi + ((lane & 15) >> 2)) * 64; asm volatile("" : "+v"(vb));
#pragma unroll
    for (int d = 0; d < NDB; ++d) {
        s16x4 lo[4], hh[4];
#pragma unroll
        for (int ks = 0; ks < 4; ++ks) { lo[ks] = vtr(vb + d * VDS + ks * 1024); hh[ks] = vtr(vb + d * VDS + ks * 1024 + 512); }
#pragma unroll
        for (int ks = 0; ks < 4; ++ks) o[d] = __builtin_amdgcn_mfma_f32_32x32x16_bf16(__builtin_bit_cast(bf16x8, pwo[ks]), ATT_VF(lo, hh, ks), o[d], 0, 0, 0);
        ATT_SBAR();
    }
}
template <int NDB> __device__ __forceinline__ void rescale_o(f32x16 (&o)[NDB], const ALAS float* wsf, int lane) {
    const int hi = lane >> 5;
#pragma unroll
    for (int r = 0; r < 16; ++r) { const float f = wsf[crow(r, hi)];
#pragma unroll
        for (int d = 0; d < NDB; ++d) o[d][r] *= f; }
}
__device__ __forceinline__ u32x4 gate8(u32x4 v, u32x4 z) {
    u32x4 o;
#pragma unroll
    for (int j = 0; j < 4; ++j) { const float a = bfl(v[j]) * silu_f(bfl(z[j])), b = bfh(v[j]) * silu_f(bfh(z[j])); o[j] = cvtpk(a, b); }
    return o;
}


template <int NDB> __device__ __forceinline__ void gate_load(u32x4 (&z)[NDB * 2], const bf16_t* __restrict__ zbase, int lane) {
    constexpr int CPR = NDB * 4, RPP = 64 / CPR;
#pragma unroll
    for (int i = 0; i < 32 / RPP; ++i) { const int row = i * RPP + lane / CPR, ch = lane % CPR; z[i] = *(const u32x4*)(zbase + (size_t)row * NP + ch * 8); }
}
template <int NDB> __device__ __forceinline__ void stage_gate_store_z(const f32x16 (&res)[NDB], ALAS bf16_t* stg, const u32x4 (&z)[NDB * 2], bf16_t* __restrict__ mbase, int lane) {
    const int r32 = lane & 31, hi = lane >> 5;
    constexpr int CPR = NDB * 4, RPP = 64 / CPR;
#pragma unroll
    for (int r = 0; r < 16; ++r) { const int orow = crow(r, hi);
#pragma unroll
        for (int d = 0; d < NDB; ++d) stg[orow * (NDB * 32) + d * 32 + r32] = f2bf(res[d][r]); }
#pragma unroll
    for (int i = 0; i < 32 / RPP; ++i) {
        const int row = i * RPP + lane / CPR, ch = lane % CPR;
        const u32x4 v = *(const ALAS u32x4*)(stg + row * (NDB * 32) + ch * 8);
        *(u32x4*)(mbase + (size_t)row * DM + ch * 8) = gate8(v, z[i]);
    }
}
template <int NDB> __device__ __forceinline__ void stage_gate_store(const f32x16 (&res)[NDB], ALAS bf16_t* stg, const bf16_t* __restrict__ zbase, bf16_t* __restrict__ mbase, int lane) {
    u32x4 z[NDB * 2];
    gate_load<NDB>(z, zbase, lane);
    stage_gate_store_z<NDB>(res, stg, z, mbase, lane);
}

template <int MODE> __device__ __forceinline__ void attn_unit(ALAS unsigned char* lds, const bf16_t* __restrict__ PROJ, const float* __restrict__ CUM, bf16_t* __restrict__ MIX,
        int b, int h, int qb, float lam, float li, const float* __restrict__ subg, float* park, const unsigned* __restrict__ kmx, const float* __restrict__ TOT,
        unsigned __attribute__((address_space(1)))* qhead, volatile ALAS unsigned* misc) {
    constexpr int NDB = MODE == 1 ? 4 : 2, STG = Geo<MODE>::STG;
    int tid_ = threadIdx.x; asm volatile("" : "+v"(tid_));
    const int tid = tid_, lane = tid & 63, r32 = lane & 31, hi = lane >> 5, wid = __builtin_amdgcn_readfirstlane(tid >> 6);
    const int c = MODE == 1 ? (wid >> 2) : 0, wr = MODE == 1 ? (wid & 3) : wid;
    const int q0 = qb * (MODE == 1 ? 128 : 256), qw0 = q0 + wr * 32;
    const size_t rowb = (size_t)b * SEQ;
    const int band0 = q0 >> 6, NT = band0 + (MODE == 1 ? 2 : 4), my_last = band0 + (wr >> 1);
    ALAS float* wsf = (ALAS float*)(lds + L_WSF) + wid * 64;
    const unsigned ldsb = (unsigned)(size_t)lds;
    const float slope2 = MODE == 1 ? LOG2E / (float)(1 << (2 * h + 2)) : 0.f;
    const int qcol = MODE == 0 ? C_FQ + h * 64 : C_DQ + h * 128 + c * 64;
    const int kcol = MODE == 0 ? C_FK + h * 64 : C_DK + h * 128;
    const int vcol = MODE == 0 ? C_FV + h * 64 : C_DV + h * 128;
    dma_k<MODE>(ldsb, PROJ, CUM, rowb + (size_t)(NT - 1) * 64, kcol, h, wid, lane);
    dma_v<MODE>(ldsb, PROJ, rowb + (size_t)(NT - 1) * 64, vcol, wid, lane);
    dma_v<MODE>(ldsb + 2 * STG, PROJ, rowb + (size_t)(NT - 1) * 64, vcol, wid, lane);
    dma_k<MODE>(ldsb + STG, PROJ, CUM, rowb + (size_t)(NT - 2) * 64, kcol, h, wid, lane);
    const int T = lane; const bool inband = T >= band0 && T < NT;
    bf16x8 qr[4];
    { const bf16_t* Qw = PROJ + (rowb + qw0 + r32) * NP + qcol + hi * 8;
#pragma unroll
      for (int d0 = 0; d0 < 4; ++d0) qr[d0] = *(const bf16x8*)(Qw + d0 * 16); }
    const float tv = (MODE == 0 && lane < 32) ? TOT[h * 320 + b * 32 + lane] : 0.f;
    const int kr = (MODE == 0 && T < band0) ? 64 * T + 63 : q0;
    const float c_w0 = MODE == 0 ? CUM[(size_t)h * MTP + rowb + qw0] : 0.f, c_q0 = MODE == 0 ? CUM[(size_t)h * MTP + rowb + q0] : 0.f, c_kr = MODE == 0 ? CUM[(size_t)h * MTP + rowb + kr] : 0.f;
    const float c_lraw = MODE == 0 ? CUM[(size_t)h * MTP + rowb + q0 + 255] : 0.f;
    float k2v[2], q2v[2];
#pragma unroll
    for (int cc = 0; cc < (MODE == 1 ? 2 : 1); ++cc) { const int sq = MODE == 0 ? h : 8 + h * 2 + cc, sk = MODE == 0 ? 4 + h : 16 + h * 2 + cc;
        k2v[cc] = __uint_as_float(kmx[((sk * 2 + 0) * 8 + b) * 64 + T]) + __uint_as_float(kmx[((sk * 2 + 1) * 8 + b) * 64 + T]);
        q2v[cc] = __uint_as_float(kmx[((sq * 2 + 0) * 8 + b) * 64 + T]) + __uint_as_float(kmx[((sq * 2 + 1) * 8 + b) * 64 + T]); }
    float Pv = 0.f;
    if (MODE == 0) { float inc = tv;
#pragma unroll
        for (int o_ = 1; o_ < 32; o_ <<= 1) { const float t_ = shl(inc, lane >= o_ ? lane - o_ : lane); if (lane >= o_) inc += t_; }
        Pv = inc - tv; }
#define ATT_OFF(blk) __int_as_float(__builtin_amdgcn_readlane(__float_as_int(Pv), (blk)))
    const ALAS bf16x8* qlds = (const ALAS bf16x8*)(lds + L_OST + wid * 4096) + lane;
    if (MODE == 1) {
#pragma unroll
        for (int d0 = 0; d0 < 4; ++d0) ((ALAS bf16x8*)qlds)[d0 * 64] = qr[d0];
    }
    float mhat = MODE == 0 ? -(c_w0 + ATT_OFF(qw0 >> 7)) * LOG2E : 0.f, l = 0.f;
    const float c_last = MODE == 0 ? (c_lraw + ATT_OFF((q0 + 255) >> 7)) - ATT_OFF(q0 >> 7) : 0.f;
    int T_min; bool nomax;
    { bool need = inband; float sbound = 0.f;
#pragma unroll
      for (int cc = 0; cc < (MODE == 1 ? 2 : 1); ++cc) {
          const float kn = sqrtf(k2v[cc]) * 1.01f;
          float qv = inband ? q2v[cc] : 0.f, kv = inband ? kn : 0.f;
#pragma unroll
          for (int m = 1; m < 64; m <<= 1) { qv = fmaxf(qv, shx(qv, m, lane)); kv = fmaxf(kv, shx(kv, m, lane)); }
          const float Qn = sqrtf(qv) * 1.01f, Lown = Qn * kv;
          float D;
          if (MODE == 0) D = ((c_q0 + ATT_OFF(q0 >> 7)) - (c_kr + shl(Pv, kr >> 7))) * LOG2E;
          else D = -slope2 * (float)(q0 - 64 * T - 63);
          need = need || (T < band0 && (Qn * kn + D + Lown > -40.f));
          const float bpos = MODE == 0 ? (c_q0 - c_last) * LOG2E : 31.f * slope2;
          if (T < NT) sbound = fmaxf(sbound, Qn * kn + bpos); }
      const unsigned long long mask = __ballot(need);
      T_min = __builtin_amdgcn_readfirstlane((int)__builtin_ctzll(mask));
      if ((NT - T_min) & 1) T_min -= 1;
      nomax = __all(sbound <= 60.f) != 0; }
    const int NTr = NT - T_min;
    f32x16 o[NDB];
#pragma unroll
    for (int d = 0; d < NDB; ++d)
#pragma unroll
        for (int r = 0; r < 16; ++r) o[d][r] = 0.f;
    u32x4 pwa[4], pwb[4]; f32x16 p0, p1; s16x4 vl[8], vh[8];
#pragma unroll
    for (int k = 0; k < 4; ++k) { pwa[k] = (u32x4){0u, 0u, 0u, 0u}; pwb[k] = (u32x4){0u, 0u, 0u, 0u}; }
    const int kbo = c * KBUF;
#define ATT_TROW(i) ((i) < NTr ? rowb + (size_t)(NT - 1 - (i)) * 64 : (size_t)MR)
#define ATT_STEP(i, PIN_, POUT_, WAITBAR_) do { \
        if ((i) + 2 <= NTr) dma_k<MODE>(ldsb + (unsigned)s_prev, PROJ, CUM, ATT_TROW((i) + 2), kcol, h, wid, lane); \
        if ((i) + 1 <= NTr) dma_v<MODE>(ldsb + (unsigned)s_next, PROJ, ATT_TROW((i) + 1), vcol, wid, lane); \
        const bool mt_ = ((i) == NTr); const int t_ = NT - 1 - (i); \
        if (mt_ || t_ <= my_last) { \
            bool resc_; const float koff_ = (MODE == 0 && !mt_) ? ATT_OFF(t_ >> 1) * LOG2E : 0.f;       \
            if (mt_) resc_ = qs_front<MODE, false, true>(lds + s_cur + kbo, lds + s_prev, vl, vh, qr, qlds, p0, p1, mhat, l, -16, qw0, slope2, koff_, nomax, wsf, lane); \
            else if (t_ == my_last) resc_ = qs_front<MODE, true, false>(lds + s_cur + kbo, lds + s_prev, vl, vh, qr, qlds, p0, p1, mhat, l, 64 * t_, qw0, slope2, koff_, nomax, wsf, lane); \
            else resc_ = qs_front<MODE, false, false>(lds + s_cur + kbo, lds + s_prev, vl, vh, qr, qlds, p0, p1, mhat, l, 64 * t_, qw0, slope2, koff_, nomax, wsf, lane); \
            pv_exp<NDB>(lds + s_prev, vl, vh, PIN_, o, p0, p1, POUT_, l, lane); __builtin_amdgcn_s_setprio(0); \
            if (resc_) rescale_o<NDB>(o, wsf, lane); \
        } \
        WAITBAR_; \
        { const int tt = s_prev; s_prev = s_cur; s_cur = s_next; s_next = tt; } } while (0)
#define ATT_WB_FULL() do { if (MODE == 0) ATT_WAIT_BAR(2); else ATT_WAIT_BAR(4); } while (0)
#define ATT_WB_VONLY() do { if (MODE == 0) ATT_WAIT_BAR(1); else ATT_WAIT_BAR(2); } while (0)
    ATT_WAIT_BAR(0);
    int s_prev = 2 * STG, s_cur = 0, s_next = STG;
#pragma clang loop unroll(disable)
    for (int i = 0; i < NTr - 2; i += 2) { ATT_STEP(i, pwa, pwb, ATT_WB_FULL()); ATT_STEP(i + 1, pwb, pwa, ATT_WB_FULL()); }
    ATT_STEP(NTr - 2, pwa, pwb, ATT_WB_FULL());
    ATT_STEP(NTr - 1, pwb, pwa, ATT_WB_VONLY());
    ATT_STEP(NTr, pwa, pwb, ATT_WAIT_BAR(0));
    pv_only<NDB>(lds + s_prev, pwb, o, lane);
#undef ATT_WB_FULL
#undef ATT_WB_VONLY
#undef ATT_STEP
#undef ATT_TROW
    ATT_WAIT_BAR(0);
    { auto rr = __builtin_amdgcn_permlane32_swap(__float_as_uint(l), __float_as_uint(l), false, false); l = __uint_as_float(rr[0]) + __uint_as_float(rr[1]); }
    if (hi == 0) wsf[32 + r32] = l;
    float rli[16];
#pragma unroll
    for (int r = 0; r < 16; ++r) rli[r] = __builtin_amdgcn_rcpf(wsf[32 + crow(r, hi)]);
#pragma unroll
    for (int d = 0; d < NDB; ++d)
#pragma unroll
        for (int r = 0; r < 16; ++r) o[d][r] *= rli[r];
    if (MODE == 1) {
        ALAS float* pk = (ALAS float*)(lds + wr * 16384) + lane;
        if (c == 1) {
#pragma unroll
            for (int d = 0; d < NDB; ++d)
#pragma unroll
                for (int r = 0; r < 16; ++r) pk[(d * 16 + r) * 64] = o[d][r];
        }
        ATT_WAIT_BAR(0);
        if (c == 1) return;
#pragma unroll
        for (int d = 0; d < NDB; ++d)
#pragma unroll
            for (int r = 0; r < 16; ++r) o[d][r] -= lam * pk[(d * 16 + r) * 64];
        float ss[16];
#pragma unroll
        for (int r = 0; r < 16; ++r) { float sm = 0.f;
#pragma unroll
            for (int d = 0; d < NDB; ++d) sm += o[d][r] * o[d][r];
            ss[r] = sm; }
#pragma unroll
        for (int m = 1; m < 32; m <<= 1)
#pragma unroll
            for (int r = 0; r < 16; ++r) ss[r] += shx(ss[r], m, lane);
        float gc[NDB];
#pragma unroll
        for (int d = 0; d < NDB; ++d) gc[d] = subg[32 * d + r32] * li;
#pragma unroll
        for (int r = 0; r < 16; ++r) { const float rs = rsqrtf(ss[r] * (1.f / 128.f) + 1e-5f);
#pragma unroll
            for (int d = 0; d < NDB; ++d) o[d][r] *= rs * gc[d]; }
    }
    unsigned nxt_ = 0u;
    if (tid == 0) nxt_ = __hip_atomic_fetch_add(qhead, 1u, __ATOMIC_RELAXED, __HIP_MEMORY_SCOPE_AGENT);
    ALAS bf16_t* stg = (ALAS bf16_t*)(lds + L_OST + (MODE == 1 ? wr * 8192 : wid * 4096));
    const int zcol = MODE == 0 ? C_FZ + h * 64 : C_DZ + h * 128, mcol = MODE == 0 ? M_A + h * 64 : M_B + h * 128;
    stage_gate_store<NDB>(o, stg, PROJ + (rowb + qw0) * NP + zcol, MIX + (rowb + qw0) * DM + mcol, lane);
    if (tid == 0) misc[16] = nxt_;
#undef ATT_OFF
}

constexpr int PCS = 9 * 1024 + 64;
__device__ __forceinline__ void pool_unit(ALAS unsigned char* lds, const bf16_t* __restrict__ PROJ, const bf16_t* __restrict__ WPT_l, const float* __restrict__ pscale_l, bf16_t* __restrict__ MIX, int unit,
        unsigned __attribute__((address_space(1)))* qhead, volatile ALAS unsigned* misc) {
    int tid_ = threadIdx.x; asm volatile("" : "+v"(tid_));
    const int tid = tid_, lane = tid & 63, r32 = lane & 31, hi = lane >> 5, wid = __builtin_amdgcn_readfirstlane(tid >> 6);
    const int g = wid >> 1, half = wid & 1;
    const int Rw = unit * 128, b = Rw >> 12, tw = Rw & 4095;
    const unsigned ldsb = (unsigned)(size_t)lds;
    { const int sl = lane >> 2;
      const bf16_t* hsrc = PROJ + (size_t)(tw == 0 ? MR + sl : (size_t)b * SEQ + tw - 16 + sl) * NP + C_PU + g * 64 + half * 32 + (lane & 3) * 8;
      const bf16_t* src = PROJ + ((size_t)b * SEQ + tw + sl) * NP + C_PU + g * 64 + half * 32 + (lane & 3) * 8;
      const unsigned dst = ldsb + (unsigned)((g * 2 + half) * PCS);
      glds16(hsrc, (unsigned)__builtin_amdgcn_readfirstlane(dst));
#pragma unroll
      for (int sg = 1; sg < 9; ++sg) glds16(src + (size_t)(16 * (sg - 1)) * NP, (unsigned)__builtin_amdgcn_readfirstlane(dst + sg * 1024)); }
    const size_t row0 = (size_t)Rw + 64 * half;
    u32x4 z0[4], z1[4];
    gate_load<2>(z0, PROJ + row0 * NP + C_PZ + g * 64, lane);
    gate_load<2>(z1, PROJ + (row0 + 32) * NP + C_PZ + g * 64, lane);
    bf16x8 wb[2][4];
#pragma unroll
    for (int nb = 0; nb < 2; ++nb)
#pragma unroll
        for (int ks = 0; ks < 4; ++ks) { const bf16_t* wp = WPT_l + ((g * 64 + 32 * nb + r32) * 64 + 16 * ks + 4 * hi);
            const s16x4 lo = *(const s16x4*)wp, hh = *(const s16x4*)(wp + 8);
            wb[nb][ks] = (bf16x8){lo[0], lo[1], lo[2], lo[3], hh[0], hh[1], hh[2], hh[3]}; }
    const float ps0 = pscale_l[g * 64 + r32], ps1 = pscale_l[g * 64 + 32 + r32];
    unsigned nxt_ = 0u; if (tid == 0) nxt_ = __hip_atomic_fetch_add(qhead, 1u, __ATOMIC_RELAXED, __HIP_MEMORY_SCOPE_AGENT);
    bf16x8 band[3];
    { const int W = 2 << g, own = 16 + r32; const float invw = 1.f / (float)W;
#pragma unroll
      for (int sgi = 0; sgi < 3; ++sgi) { unsigned pk[4];
#pragma unroll
          for (int jj = 0; jj < 4; ++jj) { float wv[2];
#pragma unroll
              for (int e = 0; e < 2; ++e) { const int j = 2 * jj + e, sr = 16 * sgi + (j & 3) + 8 * (j >> 2) + 4 * hi;
                  wv[e] = (sr <= own && sr > own - W) ? invw : 0.f; if (sr == own) wv[e] -= 1.f; }
              pk[jj] = cvtpk(wv[0], wv[1]); }
          band[sgi] = __builtin_bit_cast(bf16x8, (u32x4){pk[0], pk[1], pk[2], pk[3]}); } }
    ALAS bf16_t* stg = (ALAS bf16_t*)(lds + L_OST + wid * 4096);
    ATT_WAIT_BAR(0);
    const ALAS unsigned char* vb = lds + (g * 2) * PCS + ((lane >> 4) & 1) * 32 + (lane & 3) * 8 + (4 * hi + ((lane & 15) >> 2)) * 64; asm volatile("" : "+v"(vb));
#pragma unroll
    for (int bi = 0; bi < 2; ++bi) {
        const int blk = 2 * half + bi;
        f32x16 D[2];
#pragma unroll
        for (int r = 0; r < 16; ++r) { D[0][r] = 0.f; D[1][r] = 0.f; }
#pragma unroll
        for (int sgi = 0; sgi < 3; ++sgi)
#pragma unroll
            for (int cb = 0; cb < 2; ++cb) { const ALAS unsigned char* pp = vb + cb * PCS + (2 * blk + sgi) * 1024;
                const s16x4 lo = vtr(pp), hh = vtr(pp + 512);
                D[cb] = __builtin_amdgcn_mfma_f32_32x32x16_bf16((bf16x8){lo[0], lo[1], lo[2], lo[3], hh[0], hh[1], hh[2], hh[3]}, band[sgi], D[cb], 0, 0, 0); }
        f32x16 acc[2];
#pragma unroll
        for (int r = 0; r < 16; ++r) { acc[0][r] = 0.f; acc[1][r] = 0.f; }
#pragma unroll
        for (int cb = 0; cb < 2; ++cb)
#pragma unroll
            for (int s2 = 0; s2 < 2; ++s2) { u32x4 pa;
#pragma unroll
                for (int j = 0; j < 4; ++j) pa[j] = cvtpk(D[cb][8 * s2 + 2 * j], D[cb][8 * s2 + 2 * j + 1]);
                const bf16x8 af = __builtin_bit_cast(bf16x8, pa);
                acc[0] = __builtin_amdgcn_mfma_f32_32x32x16_bf16(af, wb[0][2 * cb + s2], acc[0], 0, 0, 0);
                acc[1] = __builtin_amdgcn_mfma_f32_32x32x16_bf16(af, wb[1][2 * cb + s2], acc[1], 0, 0, 0); }
#pragma unroll
        for (int r = 0; r < 16; ++r) { acc[0][r] *= ps0; acc[1][r] *= ps1; }
        if (bi == 0) stage_gate_store_z<2>(acc, stg, z0, MIX + row0 * DM + M_C + g * 64, lane);
        else stage_gate_store_z<2>(acc, stg, z1, MIX + (row0 + 32) * DM + M_C + g * 64, lane);
    }
    ATT_WAIT_BAR(0);
    if (tid == 0) misc[16] = nxt_;
}
#undef ALAS
}


#ifndef PG8_SP2
#define PG8_SP2 true
#endif
#ifndef PG8_ALIGN
#define PG8_ALIGN true
#endif
constexpr int NWAVES = 8;
constexpr int RING_OFF = 0, RING_BYTES = 143360;
constexpr int LDSCTL_OFF = RING_BYTES, MISC_OFF = LDSCTL_OFF + 320;
constexpr int LDS_BYTES = RING_BYTES + 1024;
constexpr int CW_TMO = 0, CW_CODE = 1, CW_BAR = 4096, CW_Q = 16384;
constexpr size_t CTL_ZERO_BYTES = 1 * MiB;
static_assert(att::L_END <= RING_BYTES, "attention LDS map");
#define GAS __attribute__((address_space(1)))
#define LAS __attribute__((address_space(3)))
typedef unsigned short bf16;
typedef unsigned v4u __attribute__((ext_vector_type(4)));
typedef float f32x4 __attribute__((ext_vector_type(4)));
typedef short bf16x8 __attribute__((ext_vector_type(8)));
typedef GAS unsigned gu32;
typedef GAS unsigned long long gu64;
#define RLX_AGENT __ATOMIC_RELAXED, __HIP_MEMORY_SCOPE_AGENT
#define LDS_WAIT() asm volatile("s_waitcnt lgkmcnt(0)" ::: "memory")
#define VM_WAIT() asm volatile("s_waitcnt vmcnt(0)" ::: "memory")
__device__ __forceinline__ unsigned long long rt() { return __builtin_amdgcn_s_memrealtime(); }

#define XB_TMO      128
#define XB_XCNT(j)  (256  + 64 * (j))
#define XB_XSUB(j)  (1280 + 64 * (j))
#define XB_XGEN(j)  (2304 + 64 * (j))
#define XB_TOP      3328
#define XB_TOPGEN   3392
#define XCD_BAR_WORDS 3456
#define XB_SPIN_CAP (1u << 18)

__device__ __forceinline__ unsigned xb_ld(unsigned* p)              { return __hip_atomic_load(p, __ATOMIC_RELAXED, __HIP_MEMORY_SCOPE_AGENT); }
__device__ __forceinline__ unsigned xb_add(unsigned* p, unsigned v) { return __hip_atomic_fetch_add(p, v, __ATOMIC_RELAXED, __HIP_MEMORY_SCOPE_AGENT); }
__device__ __forceinline__ unsigned xb_xcc_id() { return (unsigned)__builtin_amdgcn_s_getreg((3 << 11) | 20) & 0xFu; }
#define XB_SPIN(cond, bar) do { unsigned _sp = 0; while (cond) { __builtin_amdgcn_s_sleep(1); \
    if ((++_sp & 255u) == 0u) { if (xb_ld(&(bar)[XB_TMO])) break; if (_sp > XB_SPIN_CAP) { atomicAdd(&(bar)[XB_TMO], 1u); break; } } } } while (0)

struct XcdBarrier {
    unsigned* bar; unsigned x;
    volatile LAS unsigned* st;
};

__device__ __forceinline__ XcdBarrier xcd_barrier_post(unsigned* bar, volatile LAS unsigned* st) {
    XcdBarrier b; b.bar = bar; b.x = xb_xcc_id(); b.st = st;
    if (threadIdx.x == 0) (void)xb_add(&bar[XB_XCNT(b.x)], 1u);
    return b;
}
__device__ __forceinline__ void xcd_barrier_complete(unsigned* bar, unsigned x, unsigned& nloc, unsigned& nx) {
    const unsigned G = gridDim.x * gridDim.y * gridDim.z;
    unsigned sum, cnt, mine, sp = 0u;
    for (;;) {
        sum = 0u; cnt = 0u; mine = 0u;
#pragma unroll
        for (unsigned j = 0; j < 16; ++j) { const unsigned c = xb_ld(&bar[XB_XCNT(j)]); sum += c; cnt += (c > 0u) ? 1u : 0u; mine = (j == x) ? c : mine; }
        if (sum == G) break;
        __builtin_amdgcn_s_sleep(1);
        if ((++sp & 255u) == 0u) { if (xb_ld(&bar[XB_TMO])) break; if (sp > XB_SPIN_CAP) { atomicAdd(&bar[XB_TMO], 1u); break; } }
    }
    nloc = mine > 0u ? mine : 1u; nx = cnt > 0u ? cnt : 1u;
}

__device__ __forceinline__ void xcd_barrier(const XcdBarrier& b) {
    asm volatile("s_waitcnt vmcnt(0)" ::: "memory");
    __syncthreads();
    if (threadIdx.x == 0) {
        unsigned* bar = b.bar;
        __builtin_amdgcn_s_waitcnt(0);
        unsigned nloc = b.st[0], nx = b.st[1];
        if (nloc == 0u) { xcd_barrier_complete(bar, b.x, nloc, nx); b.st[0] = nloc; b.st[1] = nx; }
        const unsigned old = xb_add(&bar[XB_XSUB(b.x)], 1u);
        const unsigned gen = old / nloc;
        if (old + 1u == (gen + 1u) * nloc) {
            __builtin_amdgcn_fence(__ATOMIC_RELEASE, "agent");
            asm volatile("s_waitcnt vmcnt(0)" ::: "memory");
            const unsigned og = xb_add(&bar[XB_TOP], 1u);
            const unsigned tg = og / nx;
            if (og + 1u == (tg + 1u) * nx) xb_add(&bar[XB_TOPGEN], 1u);
            else XB_SPIN(xb_ld(&bar[XB_TOPGEN]) == tg, bar);
            __builtin_amdgcn_fence(__ATOMIC_ACQUIRE, "agent");
            xb_add(&bar[XB_XGEN(b.x)], 1u);
            asm volatile("s_waitcnt vmcnt(0)" ::: "memory");
        } else {
            XB_SPIN(xb_ld(&bar[XB_XGEN(b.x)]) == gen, bar);
            __builtin_amdgcn_fence(__ATOMIC_ACQUIRE, "agent");
            asm volatile("s_waitcnt vmcnt(0)" ::: "memory");
        }
    }
    __syncthreads();
}

__device__ __forceinline__ void transpose_item(const float* __restrict__ W, int ldw, int col0, const float* __restrict__ gk, bf16_t* WT, int K, LAS float* scr, int k0, int n0dst, int lane) {
    float v[32];
    const float* src = W + (size_t)(k0 + (lane >> 5)) * ldw + col0 + (lane & 31);
#pragma unroll
    for (int i = 0; i < 32; ++i) v[i] = src[(size_t)(2 * i) * ldw];
    const int c = lane & 7;
    float g[8];
#pragma unroll
    for (int j = 0; j < 8; ++j) g[j] = gk ? gk[k0 + 8 * c + j] : 1.f;
#pragma unroll
    for (int i = 0; i < 32; ++i) scr[(2 * i + (lane >> 5)) * 33 + (lane & 31)] = v[i];
    LDS_WAIT(); asm volatile("" ::: "memory");
#pragma unroll
    for (int j = 0; j < 4; ++j) { const int n = (lane >> 3) + 8 * j; const LAS float* s = scr + (8 * c) * 33 + n;
        v4u o; o.x = pk2(s[0 * 33] * g[0], s[1 * 33] * g[1]); o.y = pk2(s[2 * 33] * g[2], s[3 * 33] * g[3]); o.z = pk2(s[4 * 33] * g[4], s[5 * 33] * g[5]); o.w = pk2(s[6 * 33] * g[6], s[7 * 33] * g[7]);
        *(GAS v4u*)(WT + (size_t)(n0dst + n) * K + k0 + 8 * c) = o; }
    LDS_WAIT(); asm volatile("" ::: "memory");
}

constexpr int NPH = 14;
struct Args { const float* in[14]; float* out; unsigned char* ws; int ph_lo, ph_hi; };
__global__ void __launch_bounds__(NWAVES * 64, 2) mk_fwd(Args args) {
    extern __shared__ __attribute__((aligned(16))) unsigned char lds[];
    LAS unsigned char* ldsp = (LAS unsigned char*)lds;
    volatile LAS unsigned* MISC = (volatile LAS unsigned*)(ldsp + MISC_OFF);
    gu32* ctl = (gu32*)(args.ws + WS_CTL);
    for (int u = threadIdx.x; u < (LDS_BYTES - LDSCTL_OFF) / 4; u += NWAVES * 64) ((LAS unsigned*)(ldsp + LDSCTL_OFF))[u] = 0u;
    __syncthreads();
    XcdBarrier bar = xcd_barrier_post((unsigned*)(ctl + CW_BAR), MISC + 8);
    const int lo = args.ph_lo, hi = args.ph_hi;
    for (int ph_ = lo; ph_ < hi; ++ph_) {
        int ph = ph_, bid = (int)blockIdx.x, G = (int)gridDim.x;
        typedef const __attribute__((address_space(4))) Args* KArgs;
        KArgs ap = (KArgs)__builtin_amdgcn_kernarg_segment_ptr(); asm volatile("" : "+s"(ap));
        unsigned char* ws = ap->ws; unsigned* barw = bar.bar;
        asm volatile("" : "+s"(ph), "+s"(bid), "+s"(G), "+s"(ws), "+s"(barw));
        int tid_ = threadIdx.x; asm volatile("" : "+v"(tid_));
        const int tid = tid_, lane = tid & 63, wave = __builtin_amdgcn_readfirstlane(tid >> 6);
        const int gw = bid * NWAVES + wave, NGW = G * NWAVES;
        const int gt = bid * (NWAVES * 64) + tid, NT = G * NWAVES * 64;
        bf16_t* W1T = (bf16_t*)(ws + WS_W1T); bf16_t* W2T = (bf16_t*)(ws + WS_W2T);
        bf16_t* WFGB = (bf16_t*)(ws + WS_WFG); float* LAM = (float*)(ws + WS_LAM); float* TOT = (float*)(ws + WS_TOT);
        bf16_t* WPT = (bf16_t*)(ws + WS_WPT); unsigned* KMX = (unsigned*)(ws + WS_KMX);
        ssq_t* SS = (ssq_t*)(ws + WS_SS); float* CUM = (float*)(ws + WS_CUM);
        bf16_t* HB = (bf16_t*)(ws + WS_HB); bf16_t* MIX = (bf16_t*)(ws + WS_MIX); bf16_t* PROJ = (bf16_t*)(ws + WS_PROJ);
        if (ph == 0) {
            const float* norm_g = ap->in[2]; const float* w_in = ap->in[3]; const float* w_pool = ap->in[10]; const float* w_out = ap->in[12];
            LAS float* scr = (LAS float*)(ldsp + RING_OFF + wave * 16384);
            constexpr int NIT1 = DEPTH * 16 * 112, NIT2 = DEPTH * 16 * 32;
            for (int it = gw; it < NIT1 + NIT2; it += NGW) {
                if (it < NIT1) { const int l = it / 1792, r = it % 1792, kb = r / 112, nb = r % 112, n0 = 32 * nb, col0 = n0 < 1024 ? n0 : n0 + 4;
                    transpose_item(w_in + (size_t)l * 1024 * IN_DIM, IN_DIM, col0, norm_g + l * 1024, W1T + (size_t)l * NP * 1024, 1024, scr, 64 * kb, n0, lane); }
                else { const int r0 = it - NIT1, l = r0 / 512, r = r0 % 512, kb = r / 32, nb = r % 32;
                    transpose_item(w_out + (size_t)l * 1024 * 1024, 1024, 32 * nb, nullptr, W2T + (size_t)l * 1024 * 1024, 1024, scr, 64 * kb, 32 * nb, lane); }
            }
            for (int i = gt; i < DEPTH * 16 * 1024; i += NT) { const int k = i & 1023, c = (i >> 10) & 15, l = i >> 14;
                WFGB[i] = c < 4 ? f2bf(w_in[((size_t)l * 1024 + k) * IN_DIM + 1024 + c] * norm_g[l * 1024 + k]) : (bf16_t)0; }
            for (int i = gt; i < DEPTH * 4 * 64 * 64; i += NT) { const int c = i & 63, d = (i >> 6) & 63, lg = i >> 12; WPT[i] = f2bf(w_pool[((size_t)lg * 64 + c) * 64 + d]); }
            unsigned zz = 0u; float big = 1e30f; asm volatile("" : "+v"(zz), "+v"(big));
            for (int i = gt; i < 48 * NP / 8; i += NT) ((uint4*)(PROJ + (size_t)(MR + 16) * NP))[i] = make_uint4(zz, zz, zz, zz);
            for (int i = gt; i < 48 * 4; i += NT) CUM[(size_t)(i / 48) * MTP + MR + 16 + (i % 48)] = big;
            for (int i = gt; i < MTP; i += NT) SS[MTP + i] = (ssq_t)zz;
            for (int i = gt; i < KMX_WORDS; i += NT) KMX[i] = zz;
            if (gt < DEPTH) { const int l = gt; float s1 = 0.f, s2 = 0.f;
                for (int i = 0; i < 64; ++i) { s1 += ap->in[5][l * 64 + i] * ap->in[6][l * 64 + i]; s2 += ap->in[7][l * 64 + i] * ap->in[8][l * 64 + i]; }
                float c08 = 0.8f; asm volatile("" : "+v"(c08));
                const float li0 = c08 - 0.6f * fexp(-0.3f * (float)l);
                LAM[l] = fexp(s1) - fexp(s2) + li0; LAM[4 + l] = li0; }
            { int lane_p = threadIdx.x & 63; asm volatile("" : "+v"(lane_p));
              for (int row = gw * 4; row < MT; row += NGW * 4) entry_rows4(row, lane_p, ap->in[0], ap->in[1], HB, SS); }
        } else if (ph <= 12) {
            const int l = (ph - 1) / 3, sub = (ph - 1) % 3;
            ssq_t* ssl = SS + (size_t)(l & 1) * MTP;
            ssq_t* ssn = SS + (size_t)((l + 1) & 1) * MTP;
            if (sub == 0) {
                { unsigned zz = 0u; asm volatile("" : "+v"(zz)); for (int i = gt; i < MTP; i += NT) ssn[i] = (ssq_t)zz; }
                {   LAS float* lf = (LAS float*)(ldsp + RING_OFF);
                    const bf16_t* wfg = WFGB + (size_t)l * 16 * 1024; const float* bfl = ap->in[4] + l * 4;
                    for (int blk = bid; blk < 257; blk += G) {
                        const bool mb = blk == 256; const int r0 = mb ? MR : 128 * blk + 16 * wave;
                        if (!mb || wave == 0) {
                            const mf32x4 acc = meta_gemm16(HB + (size_t)r0 * DM, wfg, 0, lane);
                            const int fr = lane & 15, fq = lane >> 4;
                            if (fr < 4) {
#pragma unroll
                                for (int j = 0; j < 4; ++j) { const int row = r0 + 4 * fq + j; const float rstd = rsqrtf(ss_val(ssl[row]) * (1.f / 1024.f) + 1e-6f);
                                    lf[((mb ? 0 : 16 * wave) + 4 * fq + j) * 4 + fr] = log_sigmoid(acc[j] * rstd + bfl[fr]); } }
                        }
                        __syncthreads();
                        if (!mb) { if (wave < 4) { const int h = wave; const float a = lf[(2 * lane) * 4 + h], b2 = lf[(2 * lane + 1) * 4 + h]; const float sm = a + b2; float inc = sm;
#pragma unroll
                                for (int o = 1; o < 64; o <<= 1) { const float t = shl(inc, lane >= o ? lane - o : lane); if (lane >= o) inc += t; }
                                *(float2*)(CUM + (size_t)h * MTP + 128 * blk + 2 * lane) = make_float2(inc - b2, inc);
                                if (lane == 63) TOT[h * 320 + blk] = inc; } }
                        else { if (wave == 0 && lane < 4) { const int h = lane; float c = 0.f; for (int j = 15; j >= 0; --j) { CUM[(size_t)h * MTP + MR + j] = -c; c += lf[j * 4 + h]; } } }
                        __syncthreads();
                    }
                }
                for (int nb = bid; nb < NP / 16; nb += G) {
                    const mf32x4 acc = meta_gemm16_k8(HB + (size_t)MR * DM, W1T + (size_t)l * NP * 1024, nb, wave, lane, (LAS float*)(ldsp + RING_OFF));
                    if (wave == 0) { const int col = 16 * nb + (lane & 15), fq = lane >> 4; const float sc = (col < 256 || (col >= 1024 && col < 1536)) ? att::C2 : 1.f;
#pragma unroll
                        for (int j = 0; j < 4; ++j) PROJ[(size_t)(MR + 4 * fq + j) * NP + col] = f2bf(acc[j] * sc * rsqrtf(ss_val(ssl[MR + 4 * fq + j]) * (1.f / 1024.f) + 1e-6f)); } }
                pg8::Gemm g{HB, W1T + (size_t)l * NP * 1024, MR, NP, 1024}; pg8::StaticOrder S; S.init(MR, NP, G, bid);
                pg8::EpiProj E{PROJ, NP, att::C2, KMX, ssl};
#ifndef DIAG_NO_GEMM
                pg8::gemm_phase<pg8::EpiProj, pg8::StaticOrder, PG8_ALIGN, PG8_SP2>(ldsp + RING_OFF, g, S, E);
#endif
            } else if (sub == 1) {
                const float li_raw = __int_as_float(__builtin_amdgcn_readfirstlane(__float_as_int(LAM[4 + l])));
                const float li = li_raw;
                const float oml = __int_as_float(__builtin_amdgcn_readfirstlane(__float_as_int(1.f - li_raw)));
                const float lam = __int_as_float(__builtin_amdgcn_readfirstlane(__float_as_int(LAM[l])));
                const float* subg = ap->in[9] + l * 128;
                float* park = (float*)(ws + WS_RES) + (size_t)bid * 4 * 4096;
#ifndef DIAG_NO_META
                if (bid == G - 1) {
                    if (wave < 4) fox_meta(wave, lane, PROJ, CUM, MIX); else diff_meta(wave - 4, lane, PROJ, subg, lam, li, MIX);
                    for (int tk = wave; tk < 64; tk += NWAVES) pool_meta(tk >> 2, tk & 3, lane, PROJ, ap->in[10] + (size_t)l * 4 * 64 * 64, ap->in[11] + l * 256, MIX);
                }
#endif
                gu32* qcnt = (gu32*)(ws + WS_CTL) + CW_Q + l * 8 * 64;
                int x = (int)(bar.x & 7u);
                if (tid == 0) MISC[16] = __hip_atomic_fetch_add(qcnt + x * 64, 1u, __ATOMIC_RELAXED, __HIP_MEMORY_SCOPE_AGENT);
                for (;;) {
                    __syncthreads();
                    int u = (int)MISC[16];
                    __syncthreads();
                    if (u >= 224) {
                        if (tid == 0) { int pick = -1;
#pragma unroll
                            for (int j = 1; j < 8; ++j) { const int xx = (x + j) & 7; if (pick < 0 && __hip_atomic_load(qcnt + xx * 64, __ATOMIC_RELAXED, __HIP_MEMORY_SCOPE_AGENT) < 224u) pick = xx; }
                            MISC[17] = (unsigned)pick;
                            if (pick >= 0) MISC[16] = __hip_atomic_fetch_add(qcnt + pick * 64, 1u, __ATOMIC_RELAXED, __HIP_MEMORY_SCOPE_AGENT); }
                        __syncthreads();
                        const int pick = (int)MISC[17];
                        if (pick < 0) break;
                        x = pick; continue;
                    }
                    gu32* qh = qcnt + x * 64;
                    int mode_, qb_ = 0, h_ = 0;
                    if (u < 96) { mode_ = 1; qb_ = 31 - u / 3; h_ = 3 - u % 3; }
                    else if (u < 160) { const int v = u - 96; mode_ = 0; qb_ = 15 - (v >> 2); h_ = 3 - (v & 3); }
                    else if (u < 192) { mode_ = 1; qb_ = 31 - (u - 160); h_ = 0; }
                    else mode_ = 2;
                    const int b_ = (x - h_) & 7;
                    if (mode_ == 1) {
#ifndef DIAG_NO_DIFF
                        att::attn_unit<1>(ldsp + RING_OFF, PROJ, CUM, MIX, b_, h_, qb_, lam, oml, subg, park, KMX, TOT, qh, MISC);
#endif
                    } else if (mode_ == 0) {
#ifndef DIAG_NO_FOX
                        att::attn_unit<0>(ldsp + RING_OFF, PROJ, CUM, MIX, b_, h_, qb_, lam, oml, subg, park, KMX, TOT, qh, MISC);
#endif
                    } else {
#ifndef DIAG_NO_POOL
                        att::pool_unit(ldsp + RING_OFF, PROJ, WPT + (size_t)l * 4 * 64 * 64, ap->in[11] + l * 256, MIX, x * 32 + (u - 192), qh, MISC);
#endif
                    }
                }
            } else {
                { unsigned zz = 0u; asm volatile("" : "+v"(zz)); for (int i = gt; i < KMX_WORDS; i += NT) KMX[i] = zz; }
                for (int nb = bid; nb < 64; nb += G) {
                    const mf32x4 acc = meta_gemm16_k8(MIX + (size_t)MR * DM, W2T + (size_t)l * 1024 * 1024, nb, wave, lane, (LAS float*)(ldsp + RING_OFF));
                    if (wave == 0) { const int col = 16 * nb + (lane & 15), fq = lane >> 4;
#pragma unroll
                        for (int j = 0; j < 4; ++j) { bf16_t* hp = HB + (size_t)(MR + 4 * fq + j) * DM + col; const bf16_t nv = f2bf(bf2f(*hp) + acc[j]); *hp = nv;
                            float q = bf2f(nv); q *= q; q += shx(q, 1, lane); q += shx(q, 2, lane); q += shx(q, 4, lane); q += shx(q, 8, lane);
                            if ((lane & 15) == 0) atomicAdd(ssn + MR + 4 * fq + j, ss_fix(q)); } } }
                pg8::Gemm g{MIX, W2T + (size_t)l * 1024 * 1024, MR, 1024, 1024}; pg8::StaticOrder S; S.init(MR, 1024, G, bid);
                pg8::EpiResidB E{HB, 1024, ssn};
#ifndef DIAG_NO_GEMM
                pg8::gemm_phase<pg8::EpiResidB, pg8::StaticOrder, PG8_ALIGN, PG8_SP2>(ldsp + RING_OFF, g, S, E);
#endif
            }
        } else {
            for (int row = gw * 4; row < MR; row += NGW * 4) final_rows4(row, lane, HB, SS + (size_t)(DEPTH & 1) * MTP, ap->out, ap->in[13]);
        }
        if (ph_ + 1 < hi) { XcdBarrier b2 = bar; b2.bar = barw; xcd_barrier(b2); }
    }
}

#ifndef MK_PER_PHASE
#define MK_PER_PHASE 0
#endif
extern "C" void kernel_launch(void* const* d_in, const int* in_sizes, int n_in, void* d_out, int out_size, void* d_ws, size_t ws_size, hipStream_t stream) {
    static int g_grid = 0;
    if (g_grid == 0) {
        int dev = 0, cus = 0, per_cu = 0;
        hipGetDevice(&dev); hipDeviceGetAttribute(&cus, hipDeviceAttributeMultiprocessorCount, dev);
        hipFuncSetAttribute((const void*)mk_fwd, hipFuncAttributeMaxDynamicSharedMemorySize, LDS_BYTES);
        hipOccupancyMaxActiveBlocksPerMultiprocessor(&per_cu, (const void*)mk_fwd, NWAVES * 64, LDS_BYTES);
        (void)hipGetLastError();
        g_grid = cus > 0 ? cus : 256;
    }
    hipMemsetAsync((unsigned char*)d_ws + WS_CTL, 0, CTL_ZERO_BYTES, stream);
    Args a{};
    for (int i = 0; i < 14; ++i) a.in[i] = (const float*)d_in[i];
    a.out = (float*)d_out; a.ws = (unsigned char*)d_ws;
#if MK_PER_PHASE
    for (int p = 0; p < NPH; ++p) { a.ph_lo = p; a.ph_hi = p + 1; hipLaunchKernelGGL(mk_fwd, dim3(g_grid), dim3(NWAVES * 64), LDS_BYTES, stream, a); }
#else
    a.ph_lo = 0; a.ph_hi = NPH;
    hipLaunchKernelGGL(mk_fwd, dim3(g_grid), dim3(NWAVES * 64), LDS_BYTES, stream, a);
#endif
}
```

```cpp
#include <hip/hip_runtime.h>
#include <stdint.h>

typedef unsigned short bf16_t;
__device__ __forceinline__ float bf2f(bf16_t v) { return __uint_as_float(((unsigned)v) << 16); }
__device__ __forceinline__ bf16_t f2bf(float f) { unsigned u = __float_as_uint(f); return (bf16_t)((u + 0x7fffu + ((u >> 16) & 1u)) >> 16); }

constexpr int BATCH = 8, SEQ = 4096, DM = 1024, DEPTH = 4, NMETA = 16;
constexpr int MR = BATCH * SEQ;
constexpr int MT = MR + NMETA;
constexpr int IN_DIM = 3588, NP = 3584;
constexpr int C_FQ = 0, C_FK = 256, C_FV = 512, C_FZ = 768, C_DQ = 1024, C_DK = 1536, C_DV = 2048, C_DZ = 2560, C_PU = 3072, C_PZ = 3328;
constexpr int M_A = 0, M_B = 256, M_C = 768;
constexpr float LN2F = 0.6931471805599453f;
__device__ __forceinline__ unsigned pk2(float lo, float hi) { return (unsigned)f2bf(lo) | ((unsigned)f2bf(hi) << 16); }

constexpr size_t MiB = 1u << 20;
constexpr size_t WS_CTL = 0;
constexpr size_t WS_W1T = 2 * MiB;
constexpr size_t WS_W2T = 30 * MiB;
constexpr size_t WS_WFG = 38 * MiB;
constexpr size_t WS_LAM = 38 * MiB + 196608;
constexpr size_t WS_TOT = 38 * MiB + 131072;
constexpr size_t WS_WPT = 38 * MiB + 262144;
constexpr size_t WS_KMX = 38 * MiB + 524288;
constexpr int KMX_WORDS = 24 * 2 * 8 * 64;
constexpr int MTP = MR + 64;
constexpr size_t WS_SS = 39 * MiB;
typedef unsigned long long ssq_t;
__device__ __forceinline__ ssq_t ss_fix(float q) { return (ssq_t)(q * 16777216.f); }
__device__ __forceinline__ float ss_val(ssq_t v) { return (float)v * (1.f / 16777216.f); }
constexpr size_t WS_CUM = 40 * MiB;
constexpr size_t WS_HB = 42 * MiB;
constexpr size_t WS_MIX = 108 * MiB;
constexpr size_t WS_PROJ = 174 * MiB;
constexpr size_t WS_RES = 400 * MiB;
constexpr size_t WS_END = 464 * MiB;

__device__ __forceinline__ float shx(float v, int m, int lane) { return __int_as_float(__builtin_amdgcn_ds_bpermute((lane ^ m) << 2, __float_as_int(v))); }
__device__ __forceinline__ float shl(float v, int src) { return __int_as_float(__builtin_amdgcn_ds_bpermute(src << 2, __float_as_int(v))); }
__device__ __forceinline__ float wave_sum(float v, int lane) {
#pragma unroll
    for (int o = 1; o < 64; o <<= 1) v += shx(v, o, lane);
    return v;
}
__device__ __forceinline__ float fexp(float x) { return __builtin_amdgcn_exp2f(x * 1.4426950408889634f); }
__device__ __forceinline__ float log_sigmoid(float x) { return fminf(x, 0.f) - __builtin_amdgcn_logf(1.f + fexp(-fabsf(x))) * 0.6931471805599453f; }
__device__ __forceinline__ float silu(float x) { return x / (1.f + fexp(-x)); }

__device__ __forceinline__ void entry_row(int row, int lane, const float* __restrict__ xreal, const float* __restrict__ xmeta, bf16_t* HB, ssq_t* SS0) {
    const float* hp = row < MR ? xreal + (size_t)row * DM : xmeta + (size_t)(row - MR) * DM;
    float ss = 0.f;
#pragma unroll
    for (int j = 0; j < 4; ++j) { const float4 v = *(const float4*)(hp + j * 256 + lane * 4);
        const unsigned w0 = pk2(v.x, v.y), w1 = pk2(v.z, v.w);
        const float a0 = __uint_as_float(w0 << 16), a1 = __uint_as_float(w0 & 0xffff0000u), a2 = __uint_as_float(w1 << 16), a3 = __uint_as_float(w1 & 0xffff0000u);
        ss += (a0 * a0 + a1 * a1) + (a2 * a2 + a3 * a3);
        *(uint2*)(HB + (size_t)row * DM + j * 256 + lane * 4) = make_uint2(w0, w1); }
    ss = wave_sum(ss, lane);
    if (lane == 0) SS0[row] = ss_fix(ss);
}
__device__ __forceinline__ void final_row(int row, int lane, const bf16_t* __restrict__ HB, const ssq_t* __restrict__ SSf, float* OUT, const float* __restrict__ final_g) {
    const float rstd = rsqrtf(ss_val(SSf[row]) * (1.f / DM) + 1e-6f);
#pragma unroll
    for (int j = 0; j < 4; ++j) {
        const uint2 w = *(const uint2*)(HB + (size_t)row * DM + j * 256 + lane * 4);
        const float4 g = *(const float4*)(final_g + j * 256 + lane * 4);
        float4 o; o.x = __uint_as_float(w.x << 16) * rstd * g.x; o.y = __uint_as_float(w.x & 0xffff0000u) * rstd * g.y; o.z = __uint_as_float(w.y << 16) * rstd * g.z; o.w = __uint_as_float(w.y & 0xffff0000u) * rstd * g.w;
        *(float4*)(OUT + (size_t)row * DM + j * 256 + lane * 4) = o;
    }
}
typedef float nt_f4 __attribute__((ext_vector_type(4)));
typedef unsigned nt_u2 __attribute__((ext_vector_type(2)));
__device__ __forceinline__ void entry_rows4(int row, int lane, const float* __restrict__ xreal, const float* __restrict__ xmeta, bf16_t* HB, ssq_t* SS0) {
    float4 v[4][4];
#pragma unroll
    for (int r = 0; r < 4; ++r) { const int rr = row + r < MT ? row + r : MT - 1; const float* hp = rr < MR ? xreal + (size_t)rr * DM : xmeta + (size_t)(rr - MR) * DM;
#pragma unroll
        for (int j = 0; j < 4; ++j) { const nt_f4 t = __builtin_nontemporal_load((const nt_f4*)(hp + j * 256 + lane * 4)); v[r][j] = make_float4(t.x, t.y, t.z, t.w); } }
#pragma unroll
    for (int r = 0; r < 4; ++r) { const int rr = row + r; if (rr >= MT) break; float ss = 0.f;
#pragma unroll
        for (int j = 0; j < 4; ++j) { const unsigned w0 = pk2(v[r][j].x, v[r][j].y), w1 = pk2(v[r][j].z, v[r][j].w);
            const float a0 = __uint_as_float(w0 << 16), a1 = __uint_as_float(w0 & 0xffff0000u), a2 = __uint_as_float(w1 << 16), a3 = __uint_as_float(w1 & 0xffff0000u);
            ss += (a0 * a0 + a1 * a1) + (a2 * a2 + a3 * a3);
            *(uint2*)(HB + (size_t)rr * DM + j * 256 + lane * 4) = make_uint2(w0, w1); }
        ss = wave_sum(ss, lane);
        if (lane == 0) SS0[rr] = ss_fix(ss); }
}
__device__ __forceinline__ void final_rows4(int row, int lane, const bf16_t* __restrict__ HB, const ssq_t* __restrict__ SSf, float* OUT, const float* __restrict__ final_g) {
    uint2 w[4][4]; float rstd[4];
#pragma unroll
    for (int r = 0; r < 4; ++r) { rstd[r] = rsqrtf(ss_val(SSf[row + r]) * (1.f / DM) + 1e-6f);
#pragma unroll
        for (int j = 0; j < 4; ++j) { const nt_u2 t = __builtin_nontemporal_load((const nt_u2*)(HB + (size_t)(row + r) * DM + j * 256 + lane * 4)); w[r][j] = make_uint2(t.x, t.y); } }
#pragma unroll
    for (int j = 0; j < 4; ++j) { const float4 g = *(const float4*)(final_g + j * 256 + lane * 4);
#pragma unroll
        for (int r = 0; r < 4; ++r) { float4 o; o.x = __uint_as_float(w[r][j].x << 16) * rstd[r] * g.x; o.y = __uint_as_float(w[r][j].x & 0xffff0000u) * rstd[r] * g.y;
            o.z = __uint_as_float(w[r][j].y << 16) * rstd[r] * g.z; o.w = __uint_as_float(w[r][j].y & 0xffff0000u) * rstd[r] * g.w;
            __builtin_nontemporal_store((nt_f4){o.x, o.y, o.z, o.w}, (nt_f4*)(OUT + (size_t)(row + r) * DM + j * 256 + lane * 4)); } }
}
typedef short mbf16x8 __attribute__((ext_vector_type(8)));
typedef float mf32x4 __attribute__((ext_vector_type(4)));
__device__ __forceinline__ mf32x4 meta_gemm16(const bf16_t* __restrict__ A16, const bf16_t* __restrict__ Bt, int nb, int lane) {
    const int fr = lane & 15, fq = lane >> 4; mf32x4 acc = {0.f, 0.f, 0.f, 0.f};
    const bf16_t* ap = A16 + fr * 1024 + fq * 8; const bf16_t* bp = Bt + (size_t)(16 * nb + fr) * 1024 + fq * 8;
#pragma unroll 16
    for (int kk = 0; kk < 32; ++kk) { const mbf16x8 a = *(const mbf16x8*)(ap + kk * 32), b = *(const mbf16x8*)(bp + kk * 32); acc = __builtin_amdgcn_mfma_f32_16x16x32_bf16(a, b, acc, 0, 0, 0); }
    return acc;
}
__device__ __forceinline__ void ld16(const bf16_t* p, float (&x)[16]) {
    const uint4 a = *(const uint4*)p, b = *(const uint4*)(p + 8);
    const unsigned w[8] = {a.x, a.y, a.z, a.w, b.x, b.y, b.z, b.w};
#pragma unroll
    for (int j = 0; j < 8; ++j) { x[2 * j] = __uint_as_float(w[j] << 16); x[2 * j + 1] = __uint_as_float(w[j] & 0xffff0000u); }
}
__device__ __forceinline__ mf32x4 meta_gemm16_k8(const bf16_t* __restrict__ A16, const bf16_t* __restrict__ Bt, int nb, int wave, int lane, __attribute__((address_space(3))) float* red) {
    const int fr = lane & 15, fq = lane >> 4; mf32x4 acc = {0.f, 0.f, 0.f, 0.f};
    const bf16_t* ap = A16 + fr * 1024 + fq * 8 + wave * 128; const bf16_t* bp = Bt + (size_t)(16 * nb + fr) * 1024 + fq * 8 + wave * 128;
    mbf16x8 a[4], b[4];
#pragma unroll
    for (int kk = 0; kk < 4; ++kk) { a[kk] = *(const mbf16x8*)(ap + kk * 32); b[kk] = *(const mbf16x8*)(bp + kk * 32); }
#pragma unroll
    for (int kk = 0; kk < 4; ++kk) acc = __builtin_amdgcn_mfma_f32_16x16x32_bf16(a[kk], b[kk], acc, 0, 0, 0);
    *(__attribute__((address_space(3))) mf32x4*)(red + (wave * 64 + lane) * 4) = acc;
    __syncthreads();
    mf32x4 sum = {0.f, 0.f, 0.f, 0.f};
#pragma unroll
    for (int w = 0; w < 8; ++w) sum += *(const __attribute__((address_space(3))) mf32x4*)(red + (w * 64 + lane) * 4);
    __syncthreads();
    return sum;
}
__device__ __forceinline__ void fox_meta(int h, int lane, const bf16_t* __restrict__ PROJ, const float* __restrict__ CUM, bf16_t* MIX) {
    const int t = lane >> 2, dq = lane & 3, row = MR + t;
    float ln2 = LN2F, m = -1e30f; asm volatile("" : "+v"(ln2), "+v"(m));
    float q[16], o[16], x[16];
    ld16(PROJ + (size_t)row * NP + C_FQ + h * 64 + dq * 16, q);
#pragma unroll
    for (int d = 0; d < 16; ++d) { q[d] *= ln2; o[d] = 0.f; }
    const float cq = CUM[(size_t)h * MTP + row];
    float lsum = 0.f;
    for (int kk = 0; kk < 16; ++kk) {
        const int krow = MR + kk;
        ld16(PROJ + (size_t)krow * NP + C_FK + h * 64 + dq * 16, x);
        float sc = 0.f;
#pragma unroll
        for (int d = 0; d < 16; ++d) sc += q[d] * x[d];
        sc += shx(sc, 1, lane); sc += shx(sc, 2, lane);
        sc += cq - CUM[(size_t)h * MTP + krow];
        ld16(PROJ + (size_t)krow * NP + C_FV + h * 64 + dq * 16, x);
        if (kk <= t) {
            if (sc > m) { const float a = fexp(m - sc); lsum *= a;
#pragma unroll
                for (int d = 0; d < 16; ++d) o[d] *= a;
                m = sc; }
            const float p = fexp(sc - m); lsum += p;
#pragma unroll
            for (int d = 0; d < 16; ++d) o[d] += p * x[d];
        }
    }
    const float inv = 1.f / lsum;
    ld16(PROJ + (size_t)row * NP + C_FZ + h * 64 + dq * 16, x);
    bf16_t* mp = MIX + (size_t)row * DM + M_A + h * 64 + dq * 16;
#pragma unroll
    for (int d = 0; d < 16; d += 2) *(unsigned*)(mp + d) = pk2(o[d] * inv * silu(x[d]), o[d + 1] * inv * silu(x[d + 1]));
}
__device__ __forceinline__ void diff_meta(int h, int lane, const bf16_t* __restrict__ PROJ, const float* __restrict__ subln_g_l, float lam, float li, bf16_t* MIX) {
    const int ri = lane >> 2, qq = lane & 3, row = MR + ri;
    const float posq = (float)ri, slope = 1.f / (float)(1 << (2 * h + 2));
    float res[32], x[16], y[16];
    for (int c = 0; c < 2; ++c) {
        float ln2 = LN2F, m = -1e30f; asm volatile("" : "+v"(ln2), "+v"(m));
        float q[16], o[32];
        ld16(PROJ + (size_t)row * NP + C_DQ + h * 128 + c * 64 + qq * 16, q);
#pragma unroll
        for (int d = 0; d < 16; ++d) q[d] *= ln2;
#pragma unroll
        for (int d = 0; d < 32; ++d) o[d] = 0.f;
        float lsum = 0.f;
        for (int kk = 0; kk < 16; ++kk) {
            const int krow = MR + kk;
            ld16(PROJ + (size_t)krow * NP + C_DK + h * 128 + c * 64 + qq * 16, x);
            float sc = 0.f;
#pragma unroll
            for (int d = 0; d < 16; ++d) sc += q[d] * x[d];
            sc += shx(sc, 1, lane); sc += shx(sc, 2, lane);
            sc -= slope * fabsf(posq - (float)kk);
            ld16(PROJ + (size_t)krow * NP + C_DV + h * 128 + qq * 32, x);
            ld16(PROJ + (size_t)krow * NP + C_DV + h * 128 + qq * 32 + 16, y);
            if (sc > m) { const float a = fexp(m - sc); lsum *= a;
#pragma unroll
                for (int d = 0; d < 32; ++d) o[d] *= a;
                m = sc; }
            const float p = fexp(sc - m); lsum += p;
#pragma unroll
            for (int d = 0; d < 16; ++d) { o[d] += p * x[d]; o[16 + d] += p * y[d]; }
        }
        const float inv = 1.f / lsum;
        if (c == 0) {
#pragma unroll
            for (int d = 0; d < 32; ++d) res[d] = o[d] * inv;
        } else {
#pragma unroll
            for (int d = 0; d < 32; ++d) res[d] -= lam * o[d] * inv;
        }
    }
    float ss = 0.f;
#pragma unroll
    for (int d = 0; d < 32; ++d) ss += res[d] * res[d];
    ss += shx(ss, 1, lane); ss += shx(ss, 2, lane);
    const float rstd = rsqrtf(ss * (1.f / 128.f) + 1e-5f) * (1.f - li);
    ld16(PROJ + (size_t)row * NP + C_DZ + h * 128 + qq * 32, x);
    ld16(PROJ + (size_t)row * NP + C_DZ + h * 128 + qq * 32 + 16, y);
    bf16_t* mp = MIX + (size_t)row * DM + M_B + h * 128 + qq * 32;
    const float* gp = subln_g_l + qq * 32;
#pragma unroll
    for (int d = 0; d < 16; d += 2) {
        *(unsigned*)(mp + d) = pk2(res[d] * rstd * gp[d] * silu(x[d]), res[d + 1] * rstd * gp[d + 1] * silu(x[d + 1]));
        *(unsigned*)(mp + 16 + d) = pk2(res[16 + d] * rstd * gp[16 + d] * silu(y[d]), res[17 + d] * rstd * gp[17 + d] * silu(y[d + 1])); }
}
__device__ __forceinline__ void pool_meta(int j, int g, int lane, const bf16_t* __restrict__ PROJ, const float* __restrict__ wpool_l, const float* __restrict__ pscale_l, bf16_t* MIX) {
    const int w = 2 << g, cnt = (j + 1) < w ? (j + 1) : w, row = MR + j;
    float s = 0.f;
    for (int i = 0; i < cnt; ++i) s += bf2f(PROJ[(size_t)(MR + j - i) * NP + C_PU + g * 64 + lane]);
    const float pooled = s / (float)cnt - bf2f(PROJ[(size_t)row * NP + C_PU + g * 64 + lane]);
    float y = 0.f;
    for (int i = 0; i < 64; ++i) y += shl(pooled, i) * wpool_l[(g * 64 + i) * 64 + lane];
    const float z = bf2f(PROJ[(size_t)row * NP + C_PZ + g * 64 + lane]);
    MIX[(size_t)row * DM + M_C + g * 64 + lane] = f2bf(y * pscale_l[g * 64 + lane] * silu(z));
}

template <class T> __device__ __forceinline__ T* as_global(T* p) { __attribute__((address_space(1))) T* g = (__attribute__((address_space(1))) T*)p; asm volatile("" : "+s"(g)); return (T*)g; }
namespace pg8 {
#define PG8_LAS __attribute__((address_space(3)))
typedef unsigned short bf16_t;
typedef short bf16x8 __attribute__((ext_vector_type(8)));
typedef float f32x4 __attribute__((ext_vector_type(4)));
typedef unsigned u32x4 __attribute__((ext_vector_type(4)));
constexpr int BM = 256, BK = 64, HALF = 128, HTB = HALF * BK * 2  , STAGE_BYTES = 8 * HTB, NXCD = 8, WGM = 8;

__host__ __device__ __forceinline__ int lds_byte(int r, int c) { const int st = (r >> 4) * 2 + (c >> 5), rr = r & 15, cc = c & 31, ob = rr * 64 + cc * 2; return st * 1024 + (ob ^ (((ob >> 9) & 1) << 5)); }
__host__ __device__ __forceinline__ void stage_rc(int b, int& R, int& C) { const int st = b / 1024, sb = b % 1024, swz = sb ^ (((sb >> 9) & 1) << 5); R = (st >> 1) * 16 + swz / 64; C = (st & 1) * 32 + (swz % 64) / 2; }
__host__ __device__ __forceinline__ int perm32(int rho) { const int n = rho >> 4, i = rho & 15; return 8 * (i >> 2) + 4 * n + (i & 3); }

struct Unit { int pm, pn; };
struct Gemm { const bf16_t* A; const bf16_t* Bt; int M, N, K; };

struct StaticOrder {
    int nM, nN, nwg, G, c;
    __host__ __device__ void init(int M, int N, int G_, int c_) { nM = M / BM; nN = N / BM; nwg = nM * nN; G = G_; c = c_; }
    __host__ __device__ bool next(int i, Unit& u) const {
        const long L = (long)i * G + c; if (L >= nwg) return false;
        int wgid = (int)L; { const int q = nwg / NXCD, r = nwg % NXCD, xcd = wgid % NXCD, off = wgid / NXCD; wgid = (xcd < r ? xcd * (q + 1) : r * (q + 1) + (xcd - r) * q) + off; }
        const int nig = WGM * nN, gid = wgid / nig, fm = gid * WGM, gsz = (nM - fm) < WGM ? (nM - fm) : WGM;
        u.pm = fm + ((wgid % nig) % gsz); u.pn = (wgid % nig) / gsz; return true;
    }
    __device__ __forceinline__ void a_ready(const Unit&) const {}
    __device__ __forceinline__ void done(const Unit&) const {}
};

__device__ __forceinline__ unsigned cvt_pk_bf16(float lo, float hi) { unsigned r; asm volatile("v_cvt_pk_bf16_f32 %0, %1, %2" : "=v"(r) : "v"(lo), "v"(hi)); return r; }
struct EpiProj {
    static constexpr bool PERM = true, AFTER_DRAIN = false;
    bf16_t* O; int ldc; float qscale; unsigned* kmx; const ssq_t* ss;
    template <bool NRM> __device__ __forceinline__ void body(const f32x4 (&acc)[2][2][4][2], const Unit& u, int wr, int wc, int fr, int fq, bf16_t* Og, const float (&rs)[2][4], unsigned* kmxg) const {
        const int row0 = u.pm * BM + wr * 64 + fr, col0 = u.pn * BM + wc * 32 + 8 * fq;
        float part[2][2][4];
#pragma unroll
        for (int ai = 0; ai < 2; ++ai)
#pragma unroll
            for (int m = 0; m < 4; ++m) { bf16_t* rowp = Og + (size_t)(row0 + ai * HALF + m * 16) * ldc + col0; const float r = rs[ai][m];
#pragma unroll
                for (int bj = 0; bj < 2; ++bj) { const f32x4 v0 = acc[ai][bj][m][0] * r, v1 = acc[ai][bj][m][1] * r;
                    if (NRM) part[ai][bj][m] = (v0[0] * v0[0] + v0[1] * v0[1]) + (v0[2] * v0[2] + v0[3] * v0[3]) + (v1[0] * v1[0] + v1[1] * v1[1]) + (v1[2] * v1[2] + v1[3] * v1[3]);
                    u32x4 w; w.x = cvt_pk_bf16(v0[0], v0[1]); w.y = cvt_pk_bf16(v0[2], v0[3]); w.z = cvt_pk_bf16(v1[0], v1[1]); w.w = cvt_pk_bf16(v1[2], v1[3]);
                    asm volatile("global_store_dwordx4 %0, %1, off sc1\n\ts_nop 1" :: "v"(rowp + bj * HALF), "v"(w) : "memory"); } }
        if (NRM) {
            const int lane = fr + 16 * fq;
#pragma unroll
            for (int ai = 0; ai < 2; ++ai)
#pragma unroll
                for (int bj = 0; bj < 2; ++bj) {
                    float mx = 0.f;
#pragma unroll
                    for (int m = 0; m < 4; ++m) { float p = part[ai][bj][m]; p += shx(p, 16, lane); p += shx(p, 32, lane); mx = fmaxf(mx, p); }
                    mx = fmaxf(mx, shx(mx, 1, lane)); mx = fmaxf(mx, shx(mx, 2, lane)); mx = fmaxf(mx, shx(mx, 4, lane)); mx = fmaxf(mx, shx(mx, 8, lane));
                    if (lane == 0) { const int R = u.pm * BM + ai * HALF + wr * 64, col = u.pn * BM + bj * HALF + wc * 32;
                        const int st = col < 512 ? (col >> 6) : 8 + ((col - 1024) >> 6), half = (col >> 5) & 1;
                        atomicMax(kmxg + ((st * 2 + half) * 8 + (R >> 12)) * 64 + ((R & 4095) >> 6), __float_as_uint(mx)); }
                }
        }
    }
    __device__ __forceinline__ void operator()(const f32x4 (&acc)[2][2][4][2], const Unit& u, int wr, int wc, int fr, int fq) const {
        bf16_t* const Og = as_global(O); const ssq_t* const ssg = as_global(ss); unsigned* const kmxg = as_global(kmx);
        const int row0 = u.pm * BM + wr * 64 + fr;
        const float sc = (u.pn == 0 || u.pn == 4 || u.pn == 5) ? qscale : 1.f;
        ssq_t sv[2][4]; float rs[2][4];
#pragma unroll
        for (int ai = 0; ai < 2; ++ai)
#pragma unroll
            for (int m = 0; m < 4; ++m) sv[ai][m] = ssg[row0 + ai * HALF + m * 16];
#pragma unroll
        for (int ai = 0; ai < 2; ++ai)
#pragma unroll
            for (int m = 0; m < 4; ++m) rs[ai][m] = sc * rsqrtf(ss_val(sv[ai][m]) * (1.f / 1024.f) + 1e-6f);
        if ((u.pn <= 1) || (u.pn >= 4 && u.pn <= 7)) body<true>(acc, u, wr, wc, fr, fq, Og, rs, kmxg); else body<false>(acc, u, wr, wc, fr, fq, Og, rs, kmxg);
    }
};
struct EpiResidB {
    static constexpr bool PERM = true, AFTER_DRAIN = false;
    bf16_t* H; int ldc; ssq_t* ssn; PG8_LAS float* red;
    __device__ __forceinline__ void operator()(const f32x4 (&acc)[2][2][4][2], const Unit& u, int wr, int wc, int fr, int fq) const {
        const int row0 = u.pm * BM + wr * 64 + fr, col0 = u.pn * BM + wc * 32 + 8 * fq, lane = fr + 16 * fq;
        bf16_t* const Hg = as_global(H); ssq_t* const ssg = as_global(ssn);
        u32x4 bv[2][4][2];
#pragma unroll
        for (int ai = 0; ai < 2; ++ai)
#pragma unroll
            for (int m = 0; m < 4; ++m)
#pragma unroll
                for (int bj = 0; bj < 2; ++bj) bv[ai][m][bj] = *(const u32x4*)(Hg + (size_t)(row0 + ai * HALF + m * 16) * ldc + col0 + bj * HALF);
#pragma unroll
        for (int ai = 0; ai < 2; ++ai)
#pragma unroll
            for (int m = 0; m < 4; ++m) { const int row = row0 + ai * HALF + m * 16; bf16_t* rowp = Hg + (size_t)row * ldc + col0; float q = 0.f;
#pragma unroll
                for (int bj = 0; bj < 2; ++bj) { const u32x4 b = bv[ai][m][bj]; const f32x4 a0 = acc[ai][bj][m][0], a1 = acc[ai][bj][m][1];
                    u32x4 w;
                    w.x = cvt_pk_bf16(__uint_as_float(b.x << 16) + a0[0], __uint_as_float(b.x & 0xffff0000u) + a0[1]);
                    w.y = cvt_pk_bf16(__uint_as_float(b.y << 16) + a0[2], __uint_as_float(b.y & 0xffff0000u) + a0[3]);
                    w.z = cvt_pk_bf16(__uint_as_float(b.z << 16) + a1[0], __uint_as_float(b.z & 0xffff0000u) + a1[1]);
                    w.w = cvt_pk_bf16(__uint_as_float(b.w << 16) + a1[2], __uint_as_float(b.w & 0xffff0000u) + a1[3]);
                    *(u32x4*)(rowp + bj * HALF) = w;
#pragma unroll
                    for (int k = 0; k < 4; ++k) { const float lo = __uint_as_float(w[k] << 16), hi = __uint_as_float(w[k] & 0xffff0000u); q += lo * lo + hi * hi; } }
                q += shx(q, 16, lane); q += shx(q, 32, lane);
                if (fq == 0) red[(wr * 64 + ai * HALF + m * 16 + fr) * 4 + wc] = q; }
        asm volatile("s_waitcnt lgkmcnt(0)\n\ts_barrier" ::: "memory");
        { const int t = (wr * 4 + wc) * 64 + lane;
          if (t < BM) { const f32x4 v = *(const PG8_LAS f32x4*)(red + t * 4); atomicAdd(ssg + u.pm * BM + t, ss_fix((v[0] + v[1]) + (v[2] + v[3]))); } }
    }
};
template <class Epi, class Sched, bool ALIGN_EPI = false, bool SP2 = false>
__device__ __forceinline__ void gemm_phase(PG8_LAS unsigned char* lds, const Gemm g, const Sched& S, const Epi& E) {
    int tid_ = threadIdx.x; asm volatile("" : "+v"(tid_));
    const int tid = tid_, wid = __builtin_amdgcn_readfirstlane(tid >> 6), lane = tid & 63, wr = wid >> 2, wc = wid & 3, fr = lane & 15, fq = lane >> 4;
    const int K = g.K, nt = K / BK;
    unsigned voffA[2], voffB[2];
#pragma unroll
    for (int i = 0; i < 2; ++i) { int R, C; stage_rc(tid * 16 + i * 8192, R, C); const int Rb = Epi::PERM ? ((R & ~31) + perm32(R & 31)) : R;
        voffA[i] = (unsigned)(R * K + C) * 2u; voffB[i] = (unsigned)(Rb * K + C) * 2u; }
    const size_t kstep = (size_t)(BK * 2);
    const size_t hstep = (size_t)HALF * K * 2;
    const size_t tstep = 2 * hstep;
    const unsigned ldsw = (unsigned)wid * 1024u;
    const int aoff = lds_byte(wr * 64 + fr, fq * 8), boff = lds_byte(wc * 32 + fr, fq * 8);
#define PG8_SA(b, h) (((b) * 2 + (h)) * HTB)
#define PG8_SB(b, h) ((4 + (b) * 2 + (h)) * HTB)
#define PG8_STAGE(bufoff, gbase, voff) do { _Pragma("unroll") for (int _i = 0; _i < 2; ++_i) \
        __builtin_amdgcn_global_load_lds((const unsigned*)((const char*)(gbase) + (voff)[_i]), (PG8_LAS unsigned*)(lds + (bufoff) + ldsw + _i * 8192), 16, 0, 0); } while (0)
#define PG8_LDA(dst, b, h) do { _Pragma("unroll") for (int m = 0; m < 4; ++m) _Pragma("unroll") for (int k = 0; k < 2; ++k) dst[m][k] = *(const PG8_LAS bf16x8*)(lds + PG8_SA(b, h) + aoff + m * 2048 + k * 1024); } while (0)
#define PG8_LDB(dst, b, h) do { _Pragma("unroll") for (int n = 0; n < 2; ++n) _Pragma("unroll") for (int k = 0; k < 2; ++k) dst[n][k] = *(const PG8_LAS bf16x8*)(lds + PG8_SB(b, h) + boff + n * 2048 + k * 1024); } while (0)
#define PG8_MMA(ai, bj, At, Bt) do { __builtin_amdgcn_s_setprio(1); _Pragma("unroll") for (int m = 0; m < 4; ++m) _Pragma("unroll") for (int n = 0; n < 2; ++n) _Pragma("unroll") for (int k = 0; k < 2; ++k) \
        acc[ai][bj][m][n] = __builtin_amdgcn_mfma_f32_16x16x32_bf16(Bt[n][k], At[m][k], acc[ai][bj][m][n], 0, 0, 0); __builtin_amdgcn_s_setprio(0); } while (0)
#define PG8_WAIT_V(n) asm volatile("s_waitcnt vmcnt(" #n ")" ::: "memory")
#define PG8_WAIT_L(n) asm volatile("s_waitcnt lgkmcnt(" #n ")" ::: "memory")
#define PG8_BAR __builtin_amdgcn_s_barrier()
#define PG8_SCHED __builtin_amdgcn_sched_barrier(0)
    Unit cur, nxt; int ui = 0;
    if (!S.next(0, cur)) return;
    f32x4 acc[2][2][4][2];
#pragma unroll
    for (int a = 0; a < 2; ++a)
#pragma unroll
        for (int b = 0; b < 2; ++b)
#pragma unroll
            for (int m = 0; m < 4; ++m)
#pragma unroll
                for (int n = 0; n < 2; ++n) acc[a][b][m][n] = (f32x4){0.f, 0.f, 0.f, 0.f};
    bf16x8 At[4][2], B0[2][2], B1[2][2];
    const char* cA = (const char*)g.A + (size_t)cur.pm * tstep; const char* cB = (const char*)g.Bt + (size_t)cur.pn * tstep;
    S.a_ready(cur);
    if constexpr (SP2) {
        PG8_STAGE(PG8_SB(0, 0), cB, voffB); PG8_STAGE(PG8_SB(0, 1), cB + hstep, voffB); PG8_STAGE(PG8_SA(0, 0), cA, voffA); PG8_STAGE(PG8_SA(0, 1), cA + hstep, voffA);
        if (wr == 1) PG8_BAR;
        PG8_WAIT_V(2); PG8_BAR;
        PG8_STAGE(PG8_SB(1, 0), cB + kstep, voffB); PG8_STAGE(PG8_SA(1, 0), cA + kstep, voffA); PG8_STAGE(PG8_SB(1, 1), cB + hstep + kstep, voffB);
        PG8_WAIT_V(6); PG8_BAR;
    } else {
        PG8_STAGE(PG8_SB(0, 0), cB, voffB); PG8_STAGE(PG8_SA(0, 0), cA, voffA); PG8_STAGE(PG8_SB(0, 1), cB + hstep, voffB); PG8_STAGE(PG8_SA(0, 1), cA + hstep, voffA);
        if (wr == 1) PG8_BAR;
        PG8_WAIT_V(4); PG8_BAR;
        PG8_STAGE(PG8_SB(1, 0), cB + kstep, voffB); PG8_STAGE(PG8_SA(1, 0), cA + kstep, voffA); PG8_STAGE(PG8_SB(1, 1), cB + hstep + kstep, voffB);
        PG8_WAIT_V(6); PG8_BAR;
    }
    for (;;) {
        const bool has_next = S.next(ui + 1, nxt);
        const char* nA = has_next ? (const char*)g.A + (size_t)nxt.pm * tstep : cA; const char* nB = has_next ? (const char*)g.Bt + (size_t)nxt.pn * tstep : cB;
        for (int t = 0; t < nt; t += 2) {
            const bool last = (t == nt - 2);
            const char* a1 = cA + (size_t)(t + 1) * kstep;
            const char* a2 = last ? nA : cA + (size_t)(t + 2) * kstep; const char* b2 = last ? nB : cB + (size_t)(t + 2) * kstep;
            const char* a3 = a2 + kstep; const char* b3 = b2 + kstep;
            if (last && has_next) S.a_ready(nxt);
            if constexpr (SP2) {
            PG8_LDB(B0, 0, 0); PG8_LDB(B1, 0, 1); PG8_SCHED; PG8_LDA(At, 0, 0); PG8_STAGE(PG8_SA(1, 1), a1 + hstep, voffA);
            PG8_WAIT_V(8); PG8_WAIT_L(0); PG8_BAR; PG8_MMA(0, 0, At, B0); PG8_MMA(0, 1, At, B1); PG8_BAR; PG8_SCHED;
            PG8_LDA(At, 0, 1); PG8_STAGE(PG8_SB(0, 0), b2, voffB); PG8_STAGE(PG8_SB(0, 1), b2 + hstep, voffB); PG8_STAGE(PG8_SA(0, 0), a2, voffA);
            PG8_WAIT_V(8); PG8_WAIT_L(0); PG8_BAR; PG8_MMA(1, 0, At, B0); PG8_MMA(1, 1, At, B1); PG8_BAR; PG8_SCHED;
            PG8_LDB(B0, 1, 0); PG8_LDB(B1, 1, 1); PG8_SCHED; PG8_LDA(At, 1, 0); PG8_STAGE(PG8_SA(0, 1), a2 + hstep, voffA);
            PG8_WAIT_V(8); PG8_WAIT_L(0); PG8_BAR; PG8_MMA(0, 0, At, B0); PG8_MMA(0, 1, At, B1); PG8_BAR; PG8_SCHED;
            PG8_LDA(At, 1, 1); PG8_STAGE(PG8_SB(1, 0), b3, voffB); PG8_STAGE(PG8_SB(1, 1), b3 + hstep, voffB); PG8_STAGE(PG8_SA(1, 0), a3, voffA);
            PG8_WAIT_V(8); PG8_WAIT_L(0); PG8_BAR; PG8_MMA(1, 0, At, B0); PG8_MMA(1, 1, At, B1); PG8_BAR; PG8_SCHED;
            } else {
            PG8_LDB(B0, 0, 0); PG8_SCHED; PG8_LDA(At, 0, 0); PG8_STAGE(PG8_SA(1, 1), a1 + hstep, voffA);
            PG8_WAIT_L(8); PG8_BAR; PG8_WAIT_L(0); PG8_MMA(0, 0, At, B0); PG8_BAR; PG8_SCHED;
            PG8_LDB(B1, 0, 1); PG8_STAGE(PG8_SB(0, 0), b2, voffB);
            PG8_BAR; PG8_WAIT_L(0); PG8_MMA(0, 1, At, B1); PG8_BAR;
            PG8_LDA(At, 0, 1); PG8_STAGE(PG8_SA(0, 0), a2, voffA);
            PG8_BAR; PG8_WAIT_L(0); PG8_MMA(1, 0, At, B0); PG8_BAR; PG8_SCHED;
            PG8_STAGE(PG8_SB(0, 1), b2 + hstep, voffB);
            PG8_WAIT_V(6); PG8_BAR; PG8_MMA(1, 1, At, B1); PG8_BAR;
            PG8_LDB(B0, 1, 0); PG8_SCHED; PG8_LDA(At, 1, 0); PG8_STAGE(PG8_SA(0, 1), a2 + hstep, voffA);
            PG8_WAIT_L(8); PG8_BAR; PG8_WAIT_L(0); PG8_MMA(0, 0, At, B0); PG8_BAR; PG8_SCHED;
            PG8_LDB(B1, 1, 1); PG8_STAGE(PG8_SB(1, 0), b3, voffB);
            PG8_BAR; PG8_WAIT_L(0); PG8_MMA(0, 1, At, B1); PG8_BAR;
            PG8_LDA(At, 1, 1); PG8_STAGE(PG8_SA(1, 0), a3, voffA);
            PG8_BAR; PG8_WAIT_L(0); PG8_MMA(1, 0, At, B0); PG8_BAR; PG8_SCHED;
            PG8_STAGE(PG8_SB(1, 1), b3 + hstep, voffB);
            PG8_WAIT_V(6); PG8_BAR; PG8_MMA(1, 1, At, B1); PG8_BAR;
            }
        }
        if constexpr (ALIGN_EPI) { if (wr == 0) PG8_BAR; }
        if constexpr (!Epi::AFTER_DRAIN) { E(acc, cur, wr, wc, fr, fq); S.done(cur); }
        if (!has_next) break;
#pragma unroll
        for (int a = 0; a < 2; ++a)
#pragma unroll
            for (int b = 0; b < 2; ++b)
#pragma unroll
                for (int m = 0; m < 4; ++m)
#pragma unroll
                    for (int n = 0; n < 2; ++n) acc[a][b][m][n] = (f32x4){0.f, 0.f, 0.f, 0.f};
        cur = nxt; cA = nA; cB = nB; ++ui;
        if constexpr (ALIGN_EPI) { if (wr == 1) PG8_BAR; }
    }
    PG8_WAIT_V(0);
    if constexpr (!ALIGN_EPI) { if (wr == 0) PG8_BAR; }
    PG8_BAR;
    if constexpr (Epi::AFTER_DRAIN) { E.fused(acc, cur, wr, wc, fr, fq, lds, wid, lane); S.done(cur); }
#undef PG8_SA
#undef PG8_SB
#undef PG8_STAGE
#undef PG8_LDA
#undef PG8_LDB
#undef PG8_MMA
#undef PG8_WAIT_V
#undef PG8_WAIT_L
#undef PG8_BAR
#undef PG8_SCHED
}
}
namespace att {
typedef float f32x16 __attribute__((ext_vector_type(16)));
typedef float f32x4 __attribute__((ext_vector_type(4)));
typedef short bf16x8 __attribute__((ext_vector_type(8)));
typedef short s16x4 __attribute__((ext_vector_type(4)));
typedef unsigned u32x4 __attribute__((ext_vector_type(4)));
#define ALAS __attribute__((address_space(3)))
constexpr int KCS = 1040, VDS = 4160, KBUF = 8 * KCS, VBUF = 4 * VDS, NSLOT = 3;
constexpr int KBOFF = KBUF + VBUF, STG0 = KBOFF + 256, STG1 = 2 * KBUF + VBUF;
template <int MODE> struct Geo { static constexpr int STG = MODE == 0 ? STG0 : STG1, VOFF = MODE == 0 ? KBUF : 2 * KBUF; };
constexpr int L_WSF = NSLOT * STG1, L_OST = L_WSF + 8 * 256, L_END = L_OST + 8 * 4096;
constexpr float LOG2E = 1.4426950408889634f, C2 = 0.125f * LOG2E, THR = 8.f, NEGBIG = -1e30f;
__device__ __forceinline__ int crow(int r, int hi) { return (r & 3) + 8 * (r >> 2) + 4 * hi; }
__device__ __forceinline__ unsigned cvtpk(float lo, float hi) { typedef float f2 __attribute__((ext_vector_type(2))); typedef __bf16 b2 __attribute__((ext_vector_type(2))); f2 v = {lo, hi}; b2 b = __builtin_convertvector(v, b2); return __builtin_bit_cast(unsigned, b); }
__device__ __forceinline__ s16x4 vtr(const ALAS unsigned char* p) { typedef short v4i16_t __attribute__((ext_vector_type(4))); return __builtin_bit_cast(s16x4, __builtin_amdgcn_ds_read_tr16_b64_v4i16((ALAS v4i16_t*)p)); }
__device__ __forceinline__ float bfl(unsigned w) { return __uint_as_float(w << 16); }
__device__ __forceinline__ float bfh(unsigned w) { return __uint_as_float(w & 0xffff0000u); }
__device__ __forceinline__ float silu_f(float x) { return x * __builtin_amdgcn_rcpf(1.f + fexp(-x)); }
__device__ __forceinline__ void glds16(const void* gsrc, unsigned lds_dst) { unsigned keep;
    asm volatile("s_mov_b32 %0, m0\n\ts_mov_b32 m0, %2\n\ts_nop 0\n\tglobal_load_lds_dwordx4 %1, off\n\ts_mov_b32 m0, %0" : "=&s"(keep) : "v"(gsrc), "s"(lds_dst) : "memory"); }
__device__ __forceinline__ void glds4(const void* gsrc, unsigned lds_dst) { unsigned keep;
    asm volatile("s_mov_b32 %0, m0\n\ts_mov_b32 m0, %2\n\ts_nop 0\n\tglobal_load_lds_dword %1, off\n\ts_mov_b32 m0, %0" : "=&s"(keep) : "v"(gsrc), "s"(lds_dst) : "memory"); }
#define ATT_SBAR0() __builtin_amdgcn_sched_barrier(0)
#define ATT_WAIT_BAR(N) asm volatile("s_waitcnt vmcnt(" #N ") lgkmcnt(0)\n\ts_barrier" ::: "memory")

template <int MODE> __device__ __forceinline__ void dma_k(unsigned slot, const bf16_t* __restrict__ PROJ, const float* __restrict__ CUM, size_t krow0, int kcol, int h, int wid, int lane) {
    if (MODE == 0 && wid == 0) glds4(CUM + (size_t)h * MTP + krow0 + lane, (unsigned)__builtin_amdgcn_readfirstlane(slot + KBOFF));
    glds16(PROJ + (krow0 + lane) * NP + kcol + wid * 8, (unsigned)__builtin_amdgcn_readfirstlane(slot + wid * KCS));
    if (MODE == 1) glds16(PROJ + (krow0 + lane) * NP + kcol + 64 + wid * 8, (unsigned)__builtin_amdgcn_readfirstlane(slot + KBUF + wid * KCS));
}
template <int MODE> __device__ __forceinline__ void dma_v(unsigned slot, const bf16_t* __restrict__ PROJ, size_t krow0, int vcol, int wid, int lane) {
    const bf16_t* vs = PROJ + (krow0 + (wid & 3) * 16 + (lane >> 2)) * NP + vcol + (wid >> 2) * 32 + (lane & 3) * 8;
    glds16(vs, (unsigned)__builtin_amdgcn_readfirstlane(slot + Geo<MODE>::VOFF + (wid >> 2) * VDS + (wid & 3) * 1024));
    if (MODE == 1) glds16(vs + 64, (unsigned)__builtin_amdgcn_readfirstlane(slot + Geo<MODE>::VOFF + (2 + (wid >> 2)) * VDS + (wid & 3) * 1024));
}

template <int MODE, bool DIAG, bool META> __device__ __forceinline__ bool qs_front(const ALAS unsigned char* buf, const ALAS unsigned char* vprev, s16x4 (&vl)[8], s16x4 (&vh)[8], const bf16x8 (&qr)[4], const ALAS bf16x8* qlds, f32x16& p0, f32x16& p1, float& mhat, float& l,
        int kidx0, int qw0, float slope2, float koffL, bool nomax, ALAS float* wsf, int lane) {
    constexpr bool diag = DIAG, meta = META;
    const int r32 = lane & 31, hi = lane >> 5;
    {
      const ALAS unsigned char* vb = vprev + Geo<MODE>::VOFF + ((lane >> 4) & 1) * 32 + (lane & 3) * 8 + (4 * hi + ((lane & 15) >> 2)) * 64; asm volatile("" : "+v"(vb));
#pragma unroll
      for (int i = 0; i < (MODE == 0 ? 8 : 4); ++i) { vl[i] = vtr(vb + (i & 1) * VDS + (i >> 1) * 1024); vh[i] = vtr(vb + (i & 1) * VDS + (i >> 1) * 1024 + 512); } }
    asm volatile("" : "+v"(slope2), "+s"(kidx0));
    if (MODE == 0) {
        const ALAS f32x4* kbp = (const ALAS f32x4*)(buf + KBOFF + hi * 16); asm volatile("" : "+v"(kbp));
#pragma unroll
        for (int g = 0; g < 4; ++g) { const f32x4 a = kbp[2 * g], b = kbp[8 + 2 * g];
#pragma unroll
            for (int j = 0; j < 4; ++j) { p0[4 * g + j] = fmaf(a[j], -LOG2E, -mhat - koffL); p1[4 * g + j] = fmaf(b[j], -LOG2E, -mhat - koffL); } }
    } else {
        if (!diag) {
            const float base = slope2 * (float)(kidx0 + 4 * hi - qw0) - mhat;
#pragma unroll
            for (int r = 0; r < 16; ++r) { const int c = (r & 3) + 8 * (r >> 2); p0[r] = fmaf((float)c, slope2, base); p1[r] = fmaf((float)(c + 32), slope2, base); }
            if (meta) {
#pragma unroll
                for (int r = 0; r < 16; ++r) { if ((r >> 2) >= 2) p0[r] = NEGBIG; p1[r] = NEGBIG; }
            }
        } else {
            const float dq = (float)(qw0 + r32 - kidx0 - 4 * hi), fr = (float)r32;
#pragma unroll
            for (int r = 0; r < 16; ++r) { const int c = (r & 3) + 8 * (r >> 2);
                p0[r] = slope2 * (fr - fabsf(dq - (float)c)) - mhat; p1[r] = slope2 * (fr - fabsf(dq - (float)(c + 32))) - mhat; }
        }
    }
    bf16x8 qfr[4];
#pragma unroll
    for (int d0 = 0; d0 < 4; ++d0) qfr[d0] = MODE == 0 ? qr[d0] : qlds[d0 * 64];
    if (MODE == 1) ATT_SBAR0();
    { const ALAS unsigned char* kb = buf + hi * KCS + r32 * 16; asm volatile("" : "+v"(kb));
#pragma unroll
      for (int d0 = 0; d0 < 4; ++d0) {
          const bf16x8 k0 = *(const ALAS bf16x8*)(kb + d0 * 2 * KCS), k1 = *(const ALAS bf16x8*)(kb + d0 * 2 * KCS + 512);
          const bf16x8 qf = qfr[d0];
          p0 = __builtin_amdgcn_mfma_f32_32x32x16_bf16(k0, qf, p0, 0, 0, 0);
          p1 = __builtin_amdgcn_mfma_f32_32x32x16_bf16(k1, qf, p1, 0, 0, 0); } }
    if (MODE == 0 && diag) {
        const int lim = qw0 + r32 - kidx0 - 4 * hi;
#pragma unroll
        for (int r = 0; r < 16; ++r) { const int c = (r & 3) + 8 * (r >> 2); if (c > lim) p0[r] = NEGBIG; if (c + 32 > lim) p1[r] = NEGBIG; }
    }
    bool resc = false;
    if (META || !nomax) {
        float rm;
        {
#define ATT_MX3(a, b, c) __builtin_fmaxf(__builtin_fmaxf((a), (b)), (c))
          float a = ATT_MX3(p0[0], p0[1], p1[0]), b = ATT_MX3(p0[2], p0[3], p1[1]); a = ATT_MX3(a, p1[2], p1[3]);
#pragma unroll
          for (int r = 4; r < 16; r += 4) { a = ATT_MX3(a, p0[r], p0[r + 1]); b = ATT_MX3(b, p0[r + 2], p0[r + 3]); a = ATT_MX3(a, p1[r], p1[r + 1]); b = ATT_MX3(b, p1[r + 2], p1[r + 3]); }
#undef ATT_MX3
          a = __builtin_fmaxf(a, b);
          auto rr = __builtin_amdgcn_permlane32_swap(__float_as_uint(a), __float_as_uint(a), false, false);
          rm = __builtin_fmaxf(__uint_as_float(rr[0]), __uint_as_float(rr[1])); }
        if (__any(rm > THR)) {
            const float dl = fmaxf(rm, 0.f); mhat += dl;
#pragma unroll
            for (int r = 0; r < 16; ++r) { p0[r] -= dl; p1[r] -= dl; }
            const float f = __builtin_amdgcn_exp2f(-dl); l *= f; if (hi == 0) wsf[r32] = f; resc = true;
        }
    }
    return resc;
}
#define ATT_SBAR() __builtin_amdgcn_sched_barrier(0)
#define ATT_PIN(x) asm volatile("" : "+v"(x))
#define ATT_VF(L, H, i) (bf16x8){L[i][0], L[i][1], L[i][2], L[i][3], H[i][0], H[i][1], H[i][2], H[i][3]}
template <int NDB> __device__ __forceinline__ void pv_exp(const ALAS unsigned char* vbuf, s16x4 (&vl)[8], s16x4 (&vh)[8], const u32x4 (&pwo)[4], f32x16 (&o)[NDB], f32x16& p0, f32x16& p1, u32x4 (&pwn)[4], float& l, int lane) {
    const int hi = lane >> 5;
    float s0 = 0.f, s1 = 0.f, s2 = 0.f, s3 = 0.f;
    ATT_SBAR();
    if (NDB == 2) {
#pragma unroll
        for (int k = 0; k < 8; ++k) {
            o[k & 1] = __builtin_amdgcn_mfma_f32_32x32x16_bf16(__builtin_bit_cast(bf16x8, pwo[k >> 1]), ATT_VF(vl, vh, k), o[k & 1], 0, 0, 0);
            p0[2 * k] = __builtin_amdgcn_exp2f(p0[2 * k]); p0[2 * k + 1] = __builtin_amdgcn_exp2f(p0[2 * k + 1]); p1[2 * k] = __builtin_amdgcn_exp2f(p1[2 * k]); p1[2 * k + 1] = __builtin_amdgcn_exp2f(p1[2 * k + 1]);
            s0 += p0[2 * k]; s1 += p0[2 * k + 1]; s2 += p1[2 * k]; s3 += p1[2 * k + 1];
            pwn[k >> 2][k & 3] = cvtpk(p0[2 * k], p0[2 * k + 1]); pwn[2 + (k >> 2)][k & 3] = cvtpk(p1[2 * k], p1[2 * k + 1]);
            ATT_PIN(p0); ATT_PIN(p1); ATT_PIN(s0); ATT_PIN(s1); ATT_PIN(s2); ATT_PIN(s3); ATT_PIN(pwn[k >> 2]); ATT_PIN(pwn[2 + (k >> 2)]);
            ATT_SBAR();
        }
    } else {
        const ALAS unsigned char* vb = vbuf + 2 * KBUF + ((lane >> 4) & 1) * 32 + (lane & 3) * 8 + (4 * hi + ((lane & 15) >> 2)) * 64; asm volatile("" : "+v"(vb));
        s16x4 (&wl)[8] = vl; s16x4 (&wh)[8] = vh;
#pragma unroll
        for (int k = 0; k < 16; ++k) {
            const int blk = 2 * (k >> 3) + (k & 1), ks = (k >> 1) & 3;
            o[blk] = __builtin_amdgcn_mfma_f32_32x32x16_bf16(__builtin_bit_cast(bf16x8, pwo[ks]), ATT_VF(wl, wh, k & 3), o[blk], 0, 0, 0);
            if (k + 4 < 16) { const int j = k + 4, jb = 2 * (j >> 3) + (j & 1), jk = (j >> 1) & 3; wl[k & 3] = vtr(vb + jb * VDS + jk * 1024); wh[k & 3] = vtr(vb + jb * VDS + jk * 1024 + 512); }
            if (k < 8) { p0[2 * k] = __builtin_amdgcn_exp2f(p0[2 * k]); p0[2 * k + 1] = __builtin_amdgcn_exp2f(p0[2 * k + 1]); s0 += p0[2 * k]; s1 += p0[2 * k + 1];
                pwn[k >> 2][k & 3] = cvtpk(p0[2 * k], p0[2 * k + 1]); ATT_PIN(p0); ATT_PIN(s0); ATT_PIN(s1); ATT_PIN(pwn[k >> 2]); }
            else { const int q = k - 8; p1[2 * q] = __builtin_amdgcn_exp2f(p1[2 * q]); p1[2 * q + 1] = __builtin_amdgcn_exp2f(p1[2 * q + 1]); s2 += p1[2 * q]; s3 += p1[2 * q + 1];
                pwn[2 + (q >> 2)][q & 3] = cvtpk(p1[2 * q], p1[2 * q + 1]); ATT_PIN(p1); ATT_PIN(s2); ATT_PIN(s3); ATT_PIN(pwn[2 + (q >> 2)]); }
            ATT_SBAR();
        }
    }
    l += (s0 + s1) + (s2 + s3);
}
template <int NDB> __device__ __forceinline__ void pv_only(const ALAS unsigned char* vbuf, const u32x4 (&pwo)[4], f32x16 (&o)[NDB], int lane) {
    const int hi = lane >> 5;
    const ALAS unsigned char* vb = vbuf + (NDB == 4 ? 2 * KBUF : KBUF) + ((lane >> 4) & 1) * 32 + (lane & 3) * 8 + (4 * hi + ((lane & 15) >> 2)) * 64; asm volatile("" : "+v"(vb));
#pragma unroll
    for (int d = 0; d < NDB; ++d) {
        s16x4 lo[4], hh[4];
#pragma unroll
        for (int ks = 0; ks < 4; ++ks) { lo[ks] = vtr(vb + d * VDS + ks * 1024); hh[ks] = vtr(vb + d * VDS + ks * 1024 + 512); }
#pragma unroll
        for (int ks = 0; ks < 4; ++ks) o[d] = __builtin_amdgcn_mfma_f32_32x32x16_bf16(__builtin_bit_cast(bf16x8, pwo[ks]), ATT_VF(lo, hh, ks), o[d], 0, 0, 0);
        ATT_SBAR();
    }
}
template <int NDB> __device__ __forceinline__ void rescale_o(f32x16 (&o)[NDB], const ALAS float* wsf, int lane) {
    const int hi = lane >> 5;
#pragma unroll
    for (int r = 0; r < 16; ++r) { const float f = wsf[crow(r, hi)];
#pragma unroll
        for (int d = 0; d < NDB; ++d) o[d][r] *= f; }
}
__device__ __forceinline__ u32x4 gate8(u32x4 v, u32x4 z) {
    u32x4 o;
#pragma unroll
    for (int j = 0; j < 4; ++j) { const float a = bfl(v[j]) * silu_f(bfl(z[j])), b = bfh(v[j]) * silu_f(bfh(z[j])); o[j] = cvtpk(a, b); }
    return o;
}


template <int NDB> __device__ __forceinline__ void gate_load(u32x4 (&z)[NDB * 2], const bf16_t* __restrict__ zbase_, int lane) {
    constexpr int CPR = NDB * 4, RPP = 64 / CPR;
    const bf16_t* const zbase = as_global(zbase_);
#pragma unroll
    for (int i = 0; i < 32 / RPP; ++i) { const int row = i * RPP + lane / CPR, ch = lane % CPR; z[i] = *(const u32x4*)(zbase + (size_t)row * NP + ch * 8); }
}
template <int NDB> __device__ __forceinline__ void stage_gate_store_z(const f32x16 (&res)[NDB], ALAS bf16_t* stg, const u32x4 (&z)[NDB * 2], bf16_t* __restrict__ mbase_, int lane) {
    const int r32 = lane & 31, hi = lane >> 5;
    bf16_t* const mbase = as_global(mbase_);
    constexpr int CPR = NDB * 4, RPP = 64 / CPR;
#pragma unroll
    for (int r = 0; r < 16; ++r) { const int orow = crow(r, hi);
#pragma unroll
        for (int d = 0; d < NDB; ++d) stg[orow * (NDB * 32) + d * 32 + r32] = f2bf(res[d][r]); }
#pragma unroll
    for (int i = 0; i < 32 / RPP; ++i) {
        const int row = i * RPP + lane / CPR, ch = lane % CPR;
        const u32x4 v = *(const ALAS u32x4*)(stg + row * (NDB * 32) + ch * 8);
        *(u32x4*)(mbase + (size_t)row * DM + ch * 8) = gate8(v, z[i]);
    }
}
template <int NDB> __device__ __forceinline__ void stage_gate_store(const f32x16 (&res)[NDB], ALAS bf16_t* stg, const bf16_t* __restrict__ zbase, bf16_t* __restrict__ mbase, int lane) {
    u32x4 z[NDB * 2];
    gate_load<NDB>(z, zbase, lane);
    stage_gate_store_z<NDB>(res, stg, z, mbase, lane);
}

__device__ __forceinline__ void unit_decode(int u, int& mode, int& qb, int& h) {
    qb = 0; h = 0;
    if (u < 96) { mode = 1; qb = 31 - u / 3; h = 3 - u % 3; }
    else if (u < 160) { const int v = u - 96; mode = 0; qb = 15 - (v >> 2); h = 3 - (v & 3); }
    else if (u < 192) { mode = 1; qb = 31 - (u - 160); h = 0; }
    else mode = 2;
}
template <int NM> __device__ __forceinline__ void seam_prefetch(unsigned ldsb, const bf16_t* __restrict__ PROJ, const float* __restrict__ CUM, int b, int h, int qb, int wv, int lane) {
    const int q0 = qb * (NM == 1 ? 128 : 256), NT = (q0 >> 6) + (NM == 1 ? 2 : 4);
    const size_t rowb = (size_t)b * SEQ;
    const int kcol = NM == 0 ? C_FK + h * 64 : C_DK + h * 128, vcol = NM == 0 ? C_FV + h * 64 : C_DV + h * 128;
    dma_k<NM>(ldsb, PROJ, CUM, rowb + (size_t)(NT - 1) * 64, kcol, h, wv, lane);
    dma_v<NM>(ldsb, PROJ, rowb + (size_t)(NT - 1) * 64, vcol, wv, lane);
    dma_k<NM>(ldsb + Geo<NM>::STG, PROJ, CUM, rowb + (size_t)(NT - 2) * 64, kcol, h, wv, lane);
}
__device__ __forceinline__ void seam_prefetch_any(int un, int xq, unsigned ldsb, const bf16_t* __restrict__ PROJ, const float* __restrict__ CUM, int wv, int lane_) {
    int lane = lane_; asm volatile("" : "+v"(lane));
    int nm, nqb, nh; unit_decode(un, nm, nqb, nh); const int nb = (xq - nh) & 7;
    if (nm == 1) seam_prefetch<1>(ldsb, PROJ, CUM, nb, nh, nqb, wv, lane); else seam_prefetch<0>(ldsb, PROJ, CUM, nb, nh, nqb, wv, lane);
}
template <int MODE> __device__ __forceinline__ void attn_unit(ALAS unsigned char* lds, const bf16_t* __restrict__ PROJ, const float* __restrict__ CUM, bf16_t* __restrict__ MIX,
        int b, int h, int qb, float lam, float li, const float* __restrict__ subg, float* park, const unsigned* __restrict__ kmx, const float* __restrict__ TOT,
        unsigned __attribute__((address_space(1)))* qhead, volatile ALAS unsigned* misc, int xq, bool pf) {
    constexpr int NDB = MODE == 1 ? 4 : 2, STG = Geo<MODE>::STG;
    int tid_ = threadIdx.x; asm volatile("" : "+v"(tid_));
    const int tid = tid_, lane = tid & 63, r32 = lane & 31, hi = lane >> 5, wid = __builtin_amdgcn_readfirstlane(tid >> 6);
    const int c = MODE == 1 ? (wid >> 2) : 0, wr = MODE == 1 ? (wid & 3) : wid;
    const int q0 = qb * (MODE == 1 ? 128 : 256), qw0 = q0 + wr * 32;
    const size_t rowb = (size_t)b * SEQ;
    const int band0 = q0 >> 6, NT = band0 + (MODE == 1 ? 2 : 4), my_last = band0 + (wr >> 1);
    ALAS float* wsf = (ALAS float*)(lds + L_WSF) + wid * 64;
    const unsigned ldsb = (unsigned)(size_t)lds;
    const float slope2 = MODE == 1 ? LOG2E / (float)(1 << (2 * h + 2)) : 0.f;
    const int qcol = MODE == 0 ? C_FQ + h * 64 : C_DQ + h * 128 + c * 64;
    const int kcol = MODE == 0 ? C_FK + h * 64 : C_DK + h * 128;
    const int vcol = MODE == 0 ? C_FV + h * 64 : C_DV + h * 128;
    if (!pf) {
        dma_k<MODE>(ldsb, PROJ, CUM, rowb + (size_t)(NT - 1) * 64, kcol, h, wid, lane);
        dma_v<MODE>(ldsb, PROJ, rowb + (size_t)(NT - 1) * 64, vcol, wid, lane);
        dma_k<MODE>(ldsb + STG, PROJ, CUM, rowb + (size_t)(NT - 2) * 64, kcol, h, wid, lane); }
    dma_v<MODE>(ldsb + 2 * STG, PROJ, rowb + (size_t)(NT - 1) * 64, vcol, wid, lane);
    const int T = lane; const bool inband = T >= band0 && T < NT;
    bf16x8 qr[4];
    { const bf16_t* Qw = PROJ + (rowb + qw0 + r32) * NP + qcol + hi * 8;
#pragma unroll
      for (int d0 = 0; d0 < 4; ++d0) qr[d0] = *(const bf16x8*)(Qw + d0 * 16); }
    const float tv = (MODE == 0 && lane < 32) ? TOT[h * 320 + b * 32 + lane] : 0.f;
    const int kr = (MODE == 0 && T < band0) ? 64 * T + 63 : q0;
    const float c_w0 = MODE == 0 ? CUM[(size_t)h * MTP + rowb + qw0] : 0.f, c_q0 = MODE == 0 ? CUM[(size_t)h * MTP + rowb + q0] : 0.f, c_kr = MODE == 0 ? CUM[(size_t)h * MTP + rowb + kr] : 0.f;
    const float c_lraw = MODE == 0 ? CUM[(size_t)h * MTP + rowb + q0 + 255] : 0.f;
    float k2v[2], q2v[2];
#pragma unroll
    for (int cc = 0; cc < (MODE == 1 ? 2 : 1); ++cc) { const int sq = MODE == 0 ? h : 8 + h * 2 + cc, sk = MODE == 0 ? 4 + h : 16 + h * 2 + cc;
        k2v[cc] = __uint_as_float(kmx[((sk * 2 + 0) * 8 + b) * 64 + T]) + __uint_as_float(kmx[((sk * 2 + 1) * 8 + b) * 64 + T]);
        q2v[cc] = __uint_as_float(kmx[((sq * 2 + 0) * 8 + b) * 64 + T]) + __uint_as_float(kmx[((sq * 2 + 1) * 8 + b) * 64 + T]); }
    float Pv = 0.f;
    if (MODE == 0) { float inc = tv;
#pragma unroll
        for (int o_ = 1; o_ < 32; o_ <<= 1) { const float t_ = shl(inc, lane >= o_ ? lane - o_ : lane); if (lane >= o_) inc += t_; }
        Pv = inc - tv; }
#define ATT_OFF(blk) __int_as_float(__builtin_amdgcn_readlane(__float_as_int(Pv), (blk)))
    const ALAS bf16x8* qlds = (const ALAS bf16x8*)(lds + L_OST + wid * 4096) + lane;
    if (MODE == 1) {
#pragma unroll
        for (int d0 = 0; d0 < 4; ++d0) ((ALAS bf16x8*)qlds)[d0 * 64] = qr[d0];
    }
    float mhat = MODE == 0 ? -(c_w0 + ATT_OFF(qw0 >> 7)) * LOG2E : 0.f, l = 0.f;
    const float c_last = MODE == 0 ? (c_lraw + ATT_OFF((q0 + 255) >> 7)) - ATT_OFF(q0 >> 7) : 0.f;
    int T_min; bool nomax;
    { bool need = inband; float sbound = 0.f;
#pragma unroll
      for (int cc = 0; cc < (MODE == 1 ? 2 : 1); ++cc) {
          const float kn = sqrtf(k2v[cc]) * 1.01f;
          float qv = inband ? q2v[cc] : 0.f, kv = inband ? kn : 0.f;
#pragma unroll
          for (int m = 1; m < 64; m <<= 1) { qv = fmaxf(qv, shx(qv, m, lane)); kv = fmaxf(kv, shx(kv, m, lane)); }
          const float Qn = sqrtf(qv) * 1.01f, Lown = Qn * kv;
          float D;
          if (MODE == 0) D = ((c_q0 + ATT_OFF(q0 >> 7)) - (c_kr + shl(Pv, kr >> 7))) * LOG2E;
          else D = -slope2 * (float)(q0 - 64 * T - 63);
          need = need || (T < band0 && (Qn * kn + D + Lown > -40.f));
          const float bpos = MODE == 0 ? (c_q0 - c_last) * LOG2E : 31.f * slope2;
          if (T < NT) sbound = fmaxf(sbound, Qn * kn + bpos); }
      const unsigned long long mask = __ballot(need);
      T_min = __builtin_amdgcn_readfirstlane((int)__builtin_ctzll(mask));
      if ((NT - T_min) & 1) T_min -= 1;
      nomax = __all(sbound <= 60.f) != 0; }
    const int NTr = NT - T_min;
    f32x16 o[NDB];
#pragma unroll
    for (int d = 0; d < NDB; ++d)
#pragma unroll
        for (int r = 0; r < 16; ++r) o[d][r] = 0.f;
    u32x4 pwa[4], pwb[4]; f32x16 p0, p1; s16x4 vl[8], vh[8];
#pragma unroll
    for (int k = 0; k < 4; ++k) { pwa[k] = (u32x4){0u, 0u, 0u, 0u}; pwb[k] = (u32x4){0u, 0u, 0u, 0u}; }
    const int kbo = c * KBUF;
#define ATT_TROW(i) ((i) < NTr ? rowb + (size_t)(NT - 1 - (i)) * 64 : (size_t)MR)
#define ATT_STEP(i, PIN_, POUT_, WAITBAR_) do { \
        if ((i) + 2 <= NTr) dma_k<MODE>(ldsb + (unsigned)s_prev, PROJ, CUM, ATT_TROW((i) + 2), kcol, h, wid, lane); \
        if ((i) + 1 <= NTr) dma_v<MODE>(ldsb + (unsigned)s_next, PROJ, ATT_TROW((i) + 1), vcol, wid, lane); \
        const bool mt_ = ((i) == NTr); const int t_ = NT - 1 - (i); \
        if (mt_ || t_ <= my_last) { \
            bool resc_; const float koff_ = (MODE == 0 && !mt_) ? ATT_OFF(t_ >> 1) * LOG2E : 0.f;       \
            if (mt_) resc_ = qs_front<MODE, false, true>(lds + s_cur + kbo, lds + s_prev, vl, vh, qr, qlds, p0, p1, mhat, l, -16, qw0, slope2, koff_, nomax, wsf, lane); \
            else if (t_ == my_last) resc_ = qs_front<MODE, true, false>(lds + s_cur + kbo, lds + s_prev, vl, vh, qr, qlds, p0, p1, mhat, l, 64 * t_, qw0, slope2, koff_, nomax, wsf, lane); \
            else resc_ = qs_front<MODE, false, false>(lds + s_cur + kbo, lds + s_prev, vl, vh, qr, qlds, p0, p1, mhat, l, 64 * t_, qw0, slope2, koff_, nomax, wsf, lane); \
            __builtin_amdgcn_s_setprio(1); pv_exp<NDB>(lds + s_prev, vl, vh, PIN_, o, p0, p1, POUT_, l, lane); __builtin_amdgcn_s_setprio(0); \
            if (resc_) rescale_o<NDB>(o, wsf, lane); \
        } \
        WAITBAR_; \
        { const int tt = s_prev; s_prev = s_cur; s_cur = s_next; s_next = tt; } } while (0)
#define ATT_WB_FULL() do { if (MODE == 0) ATT_WAIT_BAR(2); else ATT_WAIT_BAR(4); } while (0)
#define ATT_WB_VONLY() do { if (MODE == 0) ATT_WAIT_BAR(1); else ATT_WAIT_BAR(2); } while (0)
    ATT_WAIT_BAR(0);
    int s_prev = 2 * STG, s_cur = 0, s_next = STG;
#pragma clang loop unroll(disable)
    for (int i = 0; i < NTr - 2; i += 2) { ATT_STEP(i, pwa, pwb, ATT_WB_FULL()); ATT_STEP(i + 1, pwb, pwa, ATT_WB_FULL()); }
    ATT_STEP(NTr - 2, pwa, pwb, ATT_WB_FULL());
    ATT_STEP(NTr - 1, pwb, pwa, ATT_WB_VONLY());
    ATT_STEP(NTr, pwa, pwb, ATT_WAIT_BAR(0));
    pv_only<NDB>(lds + s_prev, pwb, o, lane);
#undef ATT_WB_FULL
#undef ATT_WB_VONLY
#undef ATT_STEP
#undef ATT_TROW
    ATT_WAIT_BAR(0);
    unsigned nxt_ = 0u;
    if (MODE == 0 && tid == 0) nxt_ = __hip_atomic_fetch_add(qhead, 1u, __ATOMIC_RELAXED, __HIP_MEMORY_SCOPE_AGENT);
    { auto rr = __builtin_amdgcn_permlane32_swap(__float_as_uint(l), __float_as_uint(l), false, false); l = __uint_as_float(rr[0]) + __uint_as_float(rr[1]); }
    if (hi == 0) wsf[32 + r32] = l;
    float rli[16];
    { const ALAS f32x4* lp = (const ALAS f32x4*)(wsf + 32 + 4 * hi);
#pragma unroll
      for (int k = 0; k < 4; ++k) { const f32x4 t = lp[2 * k];
#pragma unroll
          for (int j = 0; j < 4; ++j) rli[4 * k + j] = __builtin_amdgcn_rcpf(t[j]); } }
#pragma unroll
    for (int d = 0; d < NDB; ++d)
#pragma unroll
        for (int r = 0; r < 16; ++r) o[d][r] *= rli[r];
    u32x4 zg[NDB * 2];
    if (MODE == 1) {
        ALAS float* pk = (ALAS float*)(lds + wr * 16384) + lane;
        if (c == 1) {
#pragma unroll
            for (int d = 0; d < NDB; ++d)
#pragma unroll
                for (int r = 0; r < 16; ++r) pk[(d * 16 + r) * 64] = o[d][r];
        }
        ATT_WAIT_BAR(0);
        if (c == 1) {
            asm volatile("s_waitcnt lgkmcnt(0)\n\ts_barrier" ::: "memory");
            const int un = __builtin_amdgcn_readfirstlane((int)misc[16]);
            if (un < 192) { seam_prefetch_any(un, xq, ldsb, PROJ, CUM, wid - 4, lane); seam_prefetch_any(un, xq, ldsb, PROJ, CUM, wid, lane); }
            return; }
        if (tid == 0) nxt_ = __hip_atomic_fetch_add(qhead, 1u, __ATOMIC_RELAXED, __HIP_MEMORY_SCOPE_AGENT);
        gate_load<NDB>(zg, PROJ + (rowb + qw0) * NP + C_DZ + h * 128, lane);
#pragma unroll
        for (int d = 0; d < NDB; ++d)
#pragma unroll
            for (int r = 0; r < 16; ++r) o[d][r] -= lam * pk[(d * 16 + r) * 64];
        float ss[16];
#pragma unroll
        for (int r = 0; r < 16; ++r) { float sm = 0.f;
#pragma unroll
            for (int d = 0; d < NDB; ++d) sm += o[d][r] * o[d][r];
            ss[r] = sm; }
#pragma unroll
        for (int m = 1; m < 32; m <<= 1)
#pragma unroll
            for (int r = 0; r < 16; ++r) ss[r] += shx(ss[r], m, lane);
        float gc[NDB];
#pragma unroll
        for (int d = 0; d < NDB; ++d) gc[d] = subg[32 * d + r32] * li;
#pragma unroll
        for (int r = 0; r < 16; ++r) { const float rs = rsqrtf(ss[r] * (1.f / 128.f) + 1e-5f);
#pragma unroll
            for (int d = 0; d < NDB; ++d) o[d][r] *= rs * gc[d]; }
    }
    if (tid == 0) { misc[16] = nxt_; misc[19] = nxt_ < 192u ? (unsigned)((xq << 8) | (int)nxt_) + 1u : 0u; }
    asm volatile("s_waitcnt lgkmcnt(0)\n\ts_barrier" ::: "memory");
    if (MODE == 0) { const int un = __builtin_amdgcn_readfirstlane((int)misc[16]); if (un < 192) seam_prefetch_any(un, xq, ldsb, PROJ, CUM, wid, lane); }
    ALAS bf16_t* stg = (ALAS bf16_t*)(lds + L_OST + (MODE == 1 ? wr * 8192 : wid * 4096));
    const int zcol = MODE == 0 ? C_FZ + h * 64 : C_DZ + h * 128, mcol = MODE == 0 ? M_A + h * 64 : M_B + h * 128;
    if (MODE == 1) stage_gate_store_z<NDB>(o, stg, zg, MIX + (rowb + qw0) * DM + mcol, lane);
    else stage_gate_store<NDB>(o, stg, PROJ + (rowb + qw0) * NP + zcol, MIX + (rowb + qw0) * DM + mcol, lane);
#undef ATT_OFF
}

constexpr int PCS = 9 * 1024 + 64;
__device__ __forceinline__ void pool_unit(ALAS unsigned char* lds, const bf16_t* __restrict__ PROJ, const bf16_t* __restrict__ WPT_l, const float* __restrict__ pscale_l, bf16_t* __restrict__ MIX, int unit,
        unsigned __attribute__((address_space(1)))* qhead, volatile ALAS unsigned* misc) {
    int tid_ = threadIdx.x; asm volatile("" : "+v"(tid_));
    const int tid = tid_, lane = tid & 63, r32 = lane & 31, hi = lane >> 5, wid = __builtin_amdgcn_readfirstlane(tid >> 6);
    const int g = wid >> 1, half = wid & 1;
    const int Rw = unit * 128, b = Rw >> 12, tw = Rw & 4095;
    const unsigned ldsb = (unsigned)(size_t)lds;
    { const int sl = lane >> 2;
      const bf16_t* hsrc = PROJ + (size_t)(tw == 0 ? MR + sl : (size_t)b * SEQ + tw - 16 + sl) * NP + C_PU + g * 64 + half * 32 + (lane & 3) * 8;
      const bf16_t* src = PROJ + ((size_t)b * SEQ + tw + sl) * NP + C_PU + g * 64 + half * 32 + (lane & 3) * 8;
      const unsigned dst = ldsb + (unsigned)((g * 2 + half) * PCS);
      glds16(hsrc, (unsigned)__builtin_amdgcn_readfirstlane(dst));
#pragma unroll
      for (int sg = 1; sg < 9; ++sg) glds16(src + (size_t)(16 * (sg - 1)) * NP, (unsigned)__builtin_amdgcn_readfirstlane(dst + sg * 1024)); }
    const size_t row0 = (size_t)Rw + 64 * half;
    u32x4 z0[4], z1[4];
    gate_load<2>(z0, PROJ + row0 * NP + C_PZ + g * 64, lane);
    gate_load<2>(z1, PROJ + (row0 + 32) * NP + C_PZ + g * 64, lane);
    bf16x8 wb[2][4];
#pragma unroll
    for (int nb = 0; nb < 2; ++nb)
#pragma unroll
        for (int ks = 0; ks < 4; ++ks) { const bf16_t* wp = WPT_l + ((g * 64 + 32 * nb + r32) * 64 + 16 * ks + 4 * hi);
            const s16x4 lo = *(const s16x4*)wp, hh = *(const s16x4*)(wp + 8);
            wb[nb][ks] = (bf16x8){lo[0], lo[1], lo[2], lo[3], hh[0], hh[1], hh[2], hh[3]}; }
    const float ps0 = pscale_l[g * 64 + r32], ps1 = pscale_l[g * 64 + 32 + r32];
    unsigned nxt_ = 0u; if (tid == 0) nxt_ = __hip_atomic_fetch_add(qhead, 1u, __ATOMIC_RELAXED, __HIP_MEMORY_SCOPE_AGENT);
    bf16x8 band[3];
    { const int W = 2 << g, own = 16 + r32; const float invw = 1.f / (float)W;
#pragma unroll
      for (int sgi = 0; sgi < 3; ++sgi) { unsigned pk[4];
#pragma unroll
          for (int jj = 0; jj < 4; ++jj) { float wv[2];
#pragma unroll
              for (int e = 0; e < 2; ++e) { const int j = 2 * jj + e, sr = 16 * sgi + (j & 3) + 8 * (j >> 2) + 4 * hi;
                  wv[e] = (sr <= own && sr > own - W) ? invw : 0.f; if (sr == own) wv[e] -= 1.f; }
              pk[jj] = cvtpk(wv[0], wv[1]); }
          band[sgi] = __builtin_bit_cast(bf16x8, (u32x4){pk[0], pk[1], pk[2], pk[3]}); } }
    ALAS bf16_t* stg = (ALAS bf16_t*)(lds + L_OST + wid * 4096);
    ATT_WAIT_BAR(0);
    const ALAS unsigned char* vb = lds + (g * 2) * PCS + ((lane >> 4) & 1) * 32 + (lane & 3) * 8 + (4 * hi + ((lane & 15) >> 2)) * 64; asm volatile("" : "+v"(vb));
#pragma unroll
    for (int bi = 0; bi < 2; ++bi) {
        const int blk = 2 * half + bi;
        f32x16 D[2];
#pragma unroll
        for (int r = 0; r < 16; ++r) { D[0][r] = 0.f; D[1][r] = 0.f; }
#pragma unroll
        for (int sgi = 0; sgi < 3; ++sgi)
#pragma unroll
            for (int cb = 0; cb < 2; ++cb) { const ALAS unsigned char* pp = vb + cb * PCS + (2 * blk + sgi) * 1024;
                const s16x4 lo = vtr(pp), hh = vtr(pp + 512);
                D[cb] = __builtin_amdgcn_mfma_f32_32x32x16_bf16((bf16x8){lo[0], lo[1], lo[2], lo[3], hh[0], hh[1], hh[2], hh[3]}, band[sgi], D[cb], 0, 0, 0); }
        f32x16 acc[2];
#pragma unroll
        for (int r = 0; r < 16; ++r) { acc[0][r] = 0.f; acc[1][r] = 0.f; }
#pragma unroll
        for (int cb = 0; cb < 2; ++cb)
#pragma unroll
            for (int s2 = 0; s2 < 2; ++s2) { u32x4 pa;
#pragma unroll
                for (int j = 0; j < 4; ++j) pa[j] = cvtpk(D[cb][8 * s2 + 2 * j], D[cb][8 * s2 + 2 * j + 1]);
                const bf16x8 af = __builtin_bit_cast(bf16x8, pa);
                acc[0] = __builtin_amdgcn_mfma_f32_32x32x16_bf16(af, wb[0][2 * cb + s2], acc[0], 0, 0, 0);
                acc[1] = __builtin_amdgcn_mfma_f32_32x32x16_bf16(af, wb[1][2 * cb + s2], acc[1], 0, 0, 0); }
#pragma unroll
        for (int r = 0; r < 16; ++r) { acc[0][r] *= ps0; acc[1][r] *= ps1; }
        if (bi == 0) stage_gate_store_z<2>(acc, stg, z0, MIX + row0 * DM + M_C + g * 64, lane);
        else stage_gate_store_z<2>(acc, stg, z1, MIX + (row0 + 32) * DM + M_C + g * 64, lane);
    }
    ATT_WAIT_BAR(0);
    if (tid == 0) misc[16] = nxt_;
}
#undef ALAS
}


#ifndef PG8_SP2
#define PG8_SP2 true
#endif
#ifndef PG8_ALIGN
#define PG8_ALIGN true
#endif
constexpr int NWAVES = 8;
constexpr int RING_OFF = 0, RING_BYTES = 143360;
constexpr int LDSCTL_OFF = RING_BYTES, MISC_OFF = LDSCTL_OFF + 320;
constexpr int LDS_BYTES = RING_BYTES + 1024;
constexpr int CW_TMO = 0, CW_CODE = 1, CW_BAR = 4096, CW_Q = 16384;
constexpr size_t CTL_ZERO_BYTES = 1 * MiB;
static_assert(att::L_END <= RING_BYTES, "attention LDS map");
#define GAS __attribute__((address_space(1)))
#define LAS __attribute__((address_space(3)))
typedef unsigned short bf16;
typedef unsigned v4u __attribute__((ext_vector_type(4)));
typedef float f32x4 __attribute__((ext_vector_type(4)));
typedef short bf16x8 __attribute__((ext_vector_type(8)));
typedef GAS unsigned gu32;
typedef GAS unsigned long long gu64;
#define RLX_AGENT __ATOMIC_RELAXED, __HIP_MEMORY_SCOPE_AGENT
#define LDS_WAIT() asm volatile("s_waitcnt lgkmcnt(0)" ::: "memory")
#define VM_WAIT() asm volatile("s_waitcnt vmcnt(0)" ::: "memory")
__device__ __forceinline__ unsigned long long rt() { return __builtin_amdgcn_s_memrealtime(); }

#define XB_TMO      128
#define XB_XCNT(j)  (256  + 64 * (j))
#define XB_XSUB(j)  (1280 + 64 * (j))
#define XB_XGEN(j)  (2304 + 64 * (j))
#define XB_TOP      3328
#define XB_TOPGEN   3392
#define XCD_BAR_WORDS 3456
#define XB_SPIN_CAP (1u << 18)

__device__ __forceinline__ unsigned xb_ld(unsigned* p)              { return __hip_atomic_load(p, __ATOMIC_RELAXED, __HIP_MEMORY_SCOPE_AGENT); }
__device__ __forceinline__ unsigned xb_add(unsigned* p, unsigned v) { return __hip_atomic_fetch_add(p, v, __ATOMIC_RELAXED, __HIP_MEMORY_SCOPE_AGENT); }
__device__ __forceinline__ unsigned xb_xcc_id() { return (unsigned)__builtin_amdgcn_s_getreg((3 << 11) | 20) & 0xFu; }
#define XB_SPIN(cond, bar) do { unsigned _sp = 0; while (cond) { __builtin_amdgcn_s_sleep(1); \
    if ((++_sp & 255u) == 0u) { if (xb_ld(&(bar)[XB_TMO])) break; if (_sp > XB_SPIN_CAP) { atomicAdd(&(bar)[XB_TMO], 1u); break; } } } } while (0)

struct XcdBarrier {
    unsigned* bar; unsigned x;
    volatile LAS unsigned* st;
};

__device__ __forceinline__ XcdBarrier xcd_barrier_post(unsigned* bar, volatile LAS unsigned* st) {
    XcdBarrier b; b.bar = bar; b.x = xb_xcc_id(); b.st = st;
    if (threadIdx.x == 0) (void)xb_add(&bar[XB_XCNT(b.x)], 1u);
    return b;
}
__device__ __forceinline__ void xcd_barrier_complete(unsigned* bar, unsigned x, unsigned& nloc, unsigned& nx) {
    const unsigned G = gridDim.x * gridDim.y * gridDim.z;
    unsigned sum, cnt, mine, sp = 0u;
    for (;;) {
        sum = 0u; cnt = 0u; mine = 0u;
#pragma unroll
        for (unsigned j = 0; j < 16; ++j) { const unsigned c = xb_ld(&bar[XB_XCNT(j)]); sum += c; cnt += (c > 0u) ? 1u : 0u; mine = (j == x) ? c : mine; }
        if (sum == G) break;
        __builtin_amdgcn_s_sleep(1);
        if ((++sp & 255u) == 0u) { if (xb_ld(&bar[XB_TMO])) break; if (sp > XB_SPIN_CAP) { atomicAdd(&bar[XB_TMO], 1u); break; } }
    }
    nloc = mine > 0u ? mine : 1u; nx = cnt > 0u ? cnt : 1u;
}

__device__ __forceinline__ void xcd_barrier(const XcdBarrier& b) {
    asm volatile("s_waitcnt vmcnt(0)" ::: "memory");
    __syncthreads();
    if (threadIdx.x == 64) asm volatile("buffer_inv sc1\n\ts_waitcnt vmcnt(0)" ::: "memory");
    if (threadIdx.x == 0) {
        unsigned* bar = b.bar;
        __builtin_amdgcn_s_waitcnt(0);
        unsigned nloc = b.st[0], nx = b.st[1];
        if (nloc == 0u) { xcd_barrier_complete(bar, b.x, nloc, nx); b.st[0] = nloc; b.st[1] = nx; }
        const unsigned old = xb_add(&bar[XB_XSUB(b.x)], 1u);
        const unsigned gen = old / nloc;
        if (old + 1u == (gen + 1u) * nloc) {
            __builtin_amdgcn_fence(__ATOMIC_RELEASE, "agent");
            asm volatile("s_waitcnt vmcnt(0)" ::: "memory");
            const unsigned og = xb_add(&bar[XB_TOP], 1u);
            const unsigned tg = og / nx;
            if (og + 1u == (tg + 1u) * nx) xb_add(&bar[XB_TOPGEN], 1u);
            else XB_SPIN(xb_ld(&bar[XB_TOPGEN]) == tg, bar);
            asm volatile("" ::: "memory");
            xb_add(&bar[XB_XGEN(b.x)], 1u);
            asm volatile("s_waitcnt vmcnt(0)" ::: "memory");
        } else {
            XB_SPIN(xb_ld(&bar[XB_XGEN(b.x)]) == gen, bar);
            asm volatile("" ::: "memory");
            asm volatile("s_waitcnt vmcnt(0)" ::: "memory");
        }
    }
    __syncthreads();
}

__device__ __forceinline__ void transpose_item(const float* __restrict__ W, int ldw, int col0, const float* __restrict__ gk, bf16_t* WT, int K, LAS float* scr, int k0, int n0dst, int lane) {
    float v[32];
    const float* src = W + (size_t)(k0 + (lane >> 5)) * ldw + col0 + (lane & 31);
#pragma unroll
    for (int i = 0; i < 32; ++i) v[i] = src[(size_t)(2 * i) * ldw];
    const int c = lane & 7;
    float g[8];
#pragma unroll
    for (int j = 0; j < 8; ++j) g[j] = gk ? gk[k0 + 8 * c + j] : 1.f;
#pragma unroll
    for (int i = 0; i < 32; ++i) scr[(2 * i + (lane >> 5)) * 33 + (lane & 31)] = v[i];
    LDS_WAIT(); asm volatile("" ::: "memory");
#pragma unroll
    for (int j = 0; j < 4; ++j) { const int n = (lane >> 3) + 8 * j; const LAS float* s = scr + (8 * c) * 33 + n;
        v4u o; o.x = pk2(s[0 * 33] * g[0], s[1 * 33] * g[1]); o.y = pk2(s[2 * 33] * g[2], s[3 * 33] * g[3]); o.z = pk2(s[4 * 33] * g[4], s[5 * 33] * g[5]); o.w = pk2(s[6 * 33] * g[6], s[7 * 33] * g[7]);
        *(GAS v4u*)(WT + (size_t)(n0dst + n) * K + k0 + 8 * c) = o; }
    LDS_WAIT(); asm volatile("" ::: "memory");
}
constexpr int CONV_ITEMS = 16 * 112 + 16 * 32, CONV_UNITS = CONV_ITEMS / 8;
__device__ __forceinline__ void convert_item(int it, int l, const float* __restrict__ w_in, const float* __restrict__ norm_g, const float* __restrict__ w_out, bf16_t* W1T, bf16_t* W2T, LAS float* scr, int lane) {
    if (it < 1792) { const int kb = it / 112, nb = it % 112, n0 = 32 * nb, col0 = n0 < 1024 ? n0 : n0 + 4;
        transpose_item(w_in + (size_t)l * 1024 * IN_DIM, IN_DIM, col0, norm_g + l * 1024, W1T + (size_t)l * NP * 1024, 1024, scr, 64 * kb, n0, lane); }
    else { const int r = it - 1792, kb = r / 32, nb = r % 32;
        transpose_item(w_out + (size_t)l * 1024 * 1024, 1024, 32 * nb, nullptr, W2T + (size_t)l * 1024 * 1024, 1024, scr, 64 * kb, 32 * nb, lane); }
}

constexpr int NPH = 14;
struct Args { const float* in[14]; float* out; unsigned char* ws; int ph_lo, ph_hi; };
__global__ void __launch_bounds__(NWAVES * 64, 2) mk_fwd(Args args) {
    extern __shared__ __attribute__((aligned(16))) unsigned char lds[];
    LAS unsigned char* ldsp = (LAS unsigned char*)lds;
    volatile LAS unsigned* MISC = (volatile LAS unsigned*)(ldsp + MISC_OFF);
    gu32* ctl = (gu32*)(args.ws + WS_CTL);
    for (int u = threadIdx.x; u < (LDS_BYTES - LDSCTL_OFF) / 4; u += NWAVES * 64) ((LAS unsigned*)(ldsp + LDSCTL_OFF))[u] = 0u;
    __syncthreads();
    XcdBarrier bar = xcd_barrier_post((unsigned*)(ctl + CW_BAR), MISC + 8);
    const int lo = args.ph_lo, hi = args.ph_hi;
    for (int ph_ = lo; ph_ < hi; ++ph_) {
        int ph = ph_, bid = (int)blockIdx.x, G = (int)gridDim.x;
        typedef const __attribute__((address_space(4))) Args* KArgs;
        KArgs ap = (KArgs)__builtin_amdgcn_kernarg_segment_ptr(); asm volatile("" : "+s"(ap));
        unsigned char* ws = ap->ws; unsigned* barw = bar.bar;
        asm volatile("" : "+s"(ph), "+s"(bid), "+s"(G), "+s"(ws), "+s"(barw));
        int tid_ = threadIdx.x; asm volatile("" : "+v"(tid_));
        const int tid = tid_, lane = tid & 63, wave = __builtin_amdgcn_readfirstlane(tid >> 6);
        const int gw = bid * NWAVES + wave, NGW = G * NWAVES;
        const int gt = bid * (NWAVES * 64) + tid, NT = G * NWAVES * 64;
        bf16_t* W1T = (bf16_t*)(ws + WS_W1T); bf16_t* W2T = (bf16_t*)(ws + WS_W2T);
        bf16_t* WFGB = (bf16_t*)(ws + WS_WFG); float* LAM = (float*)(ws + WS_LAM); float* TOT = (float*)(ws + WS_TOT);
        bf16_t* WPT = (bf16_t*)(ws + WS_WPT); unsigned* KMX = (unsigned*)(ws + WS_KMX);
        ssq_t* SS = (ssq_t*)(ws + WS_SS); float* CUM = (float*)(ws + WS_CUM);
        bf16_t* HB = (bf16_t*)(ws + WS_HB); bf16_t* MIX = (bf16_t*)(ws + WS_MIX); bf16_t* PROJ = (bf16_t*)(ws + WS_PROJ);
        if (ph == 0) {
            const float* norm_g = ap->in[2]; const float* w_in = ap->in[3]; const float* w_pool = ap->in[10]; const float* w_out = ap->in[12];
            LAS float* scr = (LAS float*)(ldsp + RING_OFF + wave * 16384);
            for (int it = gw; it < CONV_ITEMS; it += NGW) convert_item(it, 0, w_in, norm_g, w_out, W1T, W2T, scr, lane);
            for (int i = gt; i < DEPTH * 16 * 1024; i += NT) { const int k = i & 1023, c = (i >> 10) & 15, l = i >> 14;
                WFGB[i] = c < 4 ? f2bf(w_in[((size_t)l * 1024 + k) * IN_DIM + 1024 + c] * norm_g[l * 1024 + k]) : (bf16_t)0; }
            for (int i = gt; i < DEPTH * 4 * 64 * 64; i += NT) { const int c = i & 63, d = (i >> 6) & 63, lg = i >> 12; WPT[i] = f2bf(w_pool[((size_t)lg * 64 + c) * 64 + d]); }
            unsigned zz = 0u; float big = 1e30f; asm volatile("" : "+v"(zz), "+v"(big));
            for (int i = gt; i < 48 * NP / 8; i += NT) ((uint4*)(PROJ + (size_t)(MR + 16) * NP))[i] = make_uint4(zz, zz, zz, zz);
            for (int i = gt; i < 48 * 4; i += NT) CUM[(size_t)(i / 48) * MTP + MR + 16 + (i % 48)] = big;
            for (int i = gt; i < MTP; i += NT) SS[MTP + i] = (ssq_t)zz;
            for (int i = gt; i < KMX_WORDS; i += NT) KMX[i] = zz;
            if (bid == G - 1 && wave < DEPTH) { const int l = wave;
                const float s1 = wave_sum(ap->in[5][l * 64 + lane] * ap->in[6][l * 64 + lane], lane), s2 = wave_sum(ap->in[7][l * 64 + lane] * ap->in[8][l * 64 + lane], lane);
                float c08 = 0.8f; asm volatile("" : "+v"(c08));
                const float li0 = c08 - 0.6f * fexp(-0.3f * (float)l);
                if (lane == 0) { LAM[l] = fexp(s1) - fexp(s2) + li0; LAM[4 + l] = li0; } }
            { int lane_p = threadIdx.x & 63; asm volatile("" : "+v"(lane_p));
              for (int row = gw * 4; row < MT; row += NGW * 4) entry_rows4(row, lane_p, ap->in[0], ap->in[1], HB, SS); }
        } else if (ph <= 12) {
            const int l = (ph - 1) / 3, sub = (ph - 1) % 3;
            ssq_t* ssl = SS + (size_t)(l & 1) * MTP;
            ssq_t* ssn = SS + (size_t)((l + 1) & 1) * MTP;
            if (sub == 0) {
                { unsigned zz = 0u; asm volatile("" : "+v"(zz)); for (int i = gt; i < MTP; i += NT) ssn[i] = (ssq_t)zz; }
                {   LAS float* lf = (LAS float*)(ldsp + RING_OFF);
                    const bf16_t* wfg = WFGB + (size_t)l * 16 * 1024; const float* bfl = ap->in[4] + l * 4;
                    for (int blk = G - 1 - bid; blk < 257; blk += G) {
                        const bool mb = blk == 256; const int r0 = mb ? MR : 128 * blk + 16 * wave;
                        if (!mb || wave == 0) {
                            const int fr = lane & 15, fq = lane >> 4;
                            ssq_t sv[4];
#pragma unroll
                            for (int j = 0; j < 4; ++j) sv[j] = ssl[r0 + 4 * fq + j];
                            const float bias = bfl[fr & 3];
                            const mf32x4 acc = meta_gemm16(HB + (size_t)r0 * DM, wfg, 0, lane);
                            if (fr < 4) {
#pragma unroll
                                for (int j = 0; j < 4; ++j) { const float rstd = rsqrtf(ss_val(sv[j]) * (1.f / 1024.f) + 1e-6f);
                                    lf[((mb ? 0 : 16 * wave) + 4 * fq + j) * 4 + fr] = log_sigmoid(acc[j] * rstd + bias); } }
                        }
                        __syncthreads();
                        if (!mb) { if (wave < 4) { const int h = wave; const float a = lf[(2 * lane) * 4 + h], b2 = lf[(2 * lane + 1) * 4 + h]; const float sm = a + b2; float inc = sm;
#pragma unroll
                                for (int o = 1; o < 64; o <<= 1) { const float t = shl(inc, lane >= o ? lane - o : lane); if (lane >= o) inc += t; }
                                *(float2*)(CUM + (size_t)h * MTP + 128 * blk + 2 * lane) = make_float2(inc - b2, inc);
                                if (lane == 63) TOT[h * 320 + blk] = inc; } }
                        else { if (wave == 0 && lane < 4) { const int h = lane; float c = 0.f; for (int j = 15; j >= 0; --j) { CUM[(size_t)h * MTP + MR + j] = -c; c += lf[j * 4 + h]; } } }
                        __syncthreads();
                    }
                }
                for (int nb = bid; nb < NP / 16; nb += G) {
                    ssq_t ms[4];
#pragma unroll
                    for (int j = 0; j < 4; ++j) ms[j] = ssl[MR + 4 * (lane >> 4) + j];
                    const mf32x4 acc = meta_gemm16_k8(HB + (size_t)MR * DM, W1T + (size_t)l * NP * 1024, nb, wave, lane, (LAS float*)(ldsp + RING_OFF));
                    if (wave == 0) { const int col = 16 * nb + (lane & 15), fq = lane >> 4; const float sc = (col < 256 || (col >= 1024 && col < 1536)) ? att::C2 : 1.f;
#pragma unroll
                        for (int j = 0; j < 4; ++j) PROJ[(size_t)(MR + 4 * fq + j) * NP + col] = f2bf(acc[j] * sc * rsqrtf(ss_val(ms[j]) * (1.f / 1024.f) + 1e-6f)); } }
                pg8::Gemm g{HB, W1T + (size_t)l * NP * 1024, MR, NP, 1024}; pg8::StaticOrder S; S.init(MR, NP, G, bid);
                pg8::EpiProj E{PROJ, NP, att::C2, KMX, ssl};
#ifndef DIAG_NO_GEMM
                pg8::gemm_phase<pg8::EpiProj, pg8::StaticOrder, PG8_ALIGN, PG8_SP2>(ldsp + RING_OFF, g, S, E);
#endif
            } else if (sub == 1) {
                const float li_raw = __int_as_float(__builtin_amdgcn_readfirstlane(__float_as_int(LAM[4 + l])));
                const float li = li_raw;
                const float oml = __int_as_float(__builtin_amdgcn_readfirstlane(__float_as_int(1.f - li_raw)));
                const float lam = __int_as_float(__builtin_amdgcn_readfirstlane(__float_as_int(LAM[l])));
                const float* subg = ap->in[9] + l * 128;
                float* park = (float*)(ws + WS_RES) + (size_t)bid * 4 * 4096;
#ifndef DIAG_NO_META
                if (bid == G - 1) {
                    if (wave < 4) fox_meta(wave, lane, PROJ, CUM, MIX); else diff_meta(wave - 4, lane, PROJ, subg, lam, li, MIX);
                    for (int tk = wave; tk < 64; tk += NWAVES) pool_meta(tk >> 2, tk & 3, lane, PROJ, ap->in[10] + (size_t)l * 4 * 64 * 64, ap->in[11] + l * 256, MIX);
                }
#endif
                gu32* qcnt = (gu32*)(ws + WS_CTL) + CW_Q + l * 8 * 64;
                const int QN = l + 1 < DEPTH ? 224 + CONV_UNITS / 8 : 224;
                int x = (int)(bar.x & 7u);
                if (tid == 0) { MISC[19] = 0u; MISC[16] = __hip_atomic_fetch_add(qcnt + x * 64, 1u, __ATOMIC_RELAXED, __HIP_MEMORY_SCOPE_AGENT); }
                for (;;) {
                    __syncthreads();
                    int u = (int)MISC[16];
                    __syncthreads();
                    if (u >= QN) {
                        if (tid == 0) { int pick = -1;
#pragma unroll
                            for (int j = 1; j < 8; ++j) { const int xx = (x + j) & 7; if (pick < 0 && __hip_atomic_load(qcnt + xx * 64, __ATOMIC_RELAXED, __HIP_MEMORY_SCOPE_AGENT) < (unsigned)QN) pick = xx; }
                            MISC[17] = (unsigned)pick;
                            if (pick >= 0) MISC[16] = __hip_atomic_fetch_add(qcnt + pick * 64, 1u, __ATOMIC_RELAXED, __HIP_MEMORY_SCOPE_AGENT); }
                        __syncthreads();
                        const int pick = (int)MISC[17];
                        if (pick < 0) break;
                        x = pick; continue;
                    }
                    gu32* qh = qcnt + x * 64;
                    int mode_, qb_, h_; att::unit_decode(u, mode_, qb_, h_);
                    const int b_ = (x - h_) & 7;
                    const bool pf_ = MISC[19] == (unsigned)((x << 8) | u) + 1u;
                    if (mode_ == 1) {
#ifndef DIAG_NO_DIFF
                        att::attn_unit<1>(ldsp + RING_OFF, PROJ, CUM, MIX, b_, h_, qb_, lam, oml, subg, park, KMX, TOT, qh, MISC, x, pf_);
#endif
                    } else if (mode_ == 0) {
#ifndef DIAG_NO_FOX
                        att::attn_unit<0>(ldsp + RING_OFF, PROJ, CUM, MIX, b_, h_, qb_, lam, oml, subg, park, KMX, TOT, qh, MISC, x, pf_);
#endif
                    } else if (u < 224) {
#ifndef DIAG_NO_POOL
                        att::pool_unit(ldsp + RING_OFF, PROJ, WPT + (size_t)l * 4 * 64 * 64, ap->in[11] + l * 256, MIX, x * 32 + (u - 192), qh, MISC);
#endif
                    } else {
                        unsigned nxt_ = 0u; if (tid == 0) nxt_ = __hip_atomic_fetch_add(qh, 1u, __ATOMIC_RELAXED, __HIP_MEMORY_SCOPE_AGENT);
                        int tc_ = threadIdx.x; asm volatile("" : "+v"(tc_));
                        const int lane_c = tc_ & 63, wave_c = __builtin_amdgcn_readfirstlane(tc_ >> 6);
                        convert_item((x * (CONV_UNITS / 8) + (u - 224)) * 8 + wave_c, l + 1, ap->in[3], ap->in[2], ap->in[12], W1T, W2T, (LAS float*)(ldsp + RING_OFF + wave_c * 16384), lane_c);
                        if (tid == 0) MISC[16] = nxt_;
                    }
                }
            } else {
                { unsigned zz = 0u; asm volatile("" : "+v"(zz)); for (int i = gt; i < KMX_WORDS; i += NT) KMX[i] = zz; }
                for (int nb = bid; nb < 64; nb += G) {
                    const mf32x4 acc = meta_gemm16_k8(MIX + (size_t)MR * DM, W2T + (size_t)l * 1024 * 1024, nb, wave, lane, (LAS float*)(ldsp + RING_OFF));
                    if (wave == 0) { const int col = 16 * nb + (lane & 15), fq = lane >> 4;
#pragma unroll
                        for (int j = 0; j < 4; ++j) { bf16_t* hp = HB + (size_t)(MR + 4 * fq + j) * DM + col; const bf16_t nv = f2bf(bf2f(*hp) + acc[j]); *hp = nv;
                            float q = bf2f(nv); q *= q; q += shx(q, 1, lane); q += shx(q, 2, lane); q += shx(q, 4, lane); q += shx(q, 8, lane);
                            if ((lane & 15) == 0) atomicAdd(ssn + MR + 4 * fq + j, ss_fix(q)); } } }
                pg8::Gemm g{MIX, W2T + (size_t)l * 1024 * 1024, MR, 1024, 1024}; pg8::StaticOrder S; S.init(MR, 1024, G, bid);
                pg8::EpiResidB E{HB, 1024, ssn, (PG8_LAS float*)(ldsp + RING_OFF + pg8::STAGE_BYTES)};
#ifndef DIAG_NO_GEMM
                pg8::gemm_phase<pg8::EpiResidB, pg8::StaticOrder, PG8_ALIGN, PG8_SP2>(ldsp + RING_OFF, g, S, E);
#endif
            }
        } else {
            for (int row = gw * 4; row < MR; row += NGW * 4) final_rows4(row, lane, HB, SS + (size_t)(DEPTH & 1) * MTP, ap->out, ap->in[13]);
        }
        if (ph_ + 1 < hi) { XcdBarrier b2 = bar; b2.bar = barw; xcd_barrier(b2); }
    }
}

#ifndef MK_PER_PHASE
#define MK_PER_PHASE 0
#endif
extern "C" void kernel_launch(void* const* d_in, const int* in_sizes, int n_in, void* d_out, int out_size, void* d_ws, size_t ws_size, hipStream_t stream) {
    static int g_grid = 0;
    if (g_grid == 0) {
        int dev = 0, cus = 0, per_cu = 0;
        hipGetDevice(&dev); hipDeviceGetAttribute(&cus, hipDeviceAttributeMultiprocessorCount, dev);
        hipFuncSetAttribute((const void*)mk_fwd, hipFuncAttributeMaxDynamicSharedMemorySize, LDS_BYTES);
        hipOccupancyMaxActiveBlocksPerMultiprocessor(&per_cu, (const void*)mk_fwd, NWAVES * 64, LDS_BYTES);
        (void)hipGetLastError();
        g_grid = cus > 0 ? cus : 256;
    }
    hipMemsetAsync((unsigned char*)d_ws + WS_CTL, 0, CTL_ZERO_BYTES, stream);
    Args a{};
    for (int i = 0; i < 14; ++i) a.in[i] = (const float*)d_in[i];
    a.out = (float*)d_out; a.ws = (unsigned char*)d_ws;
#if MK_PER_PHASE
    for (int p = 0; p < NPH; ++p) { a.ph_lo = p; a.ph_hi = p + 1; hipLaunchKernelGGL(mk_fwd, dim3(g_grid), dim3(NWAVES * 64), LDS_BYTES, stream, a); }
#else
    a.ph_lo = 0; a.ph_hi = NPH;
    hipLaunchKernelGGL(mk_fwd, dim3(g_grid), dim3(NWAVES * 64), LDS_BYTES, stream, a);
#endif
}
```
